# Optimizing an MI355X kernel written in HIP

```python
import jax, jax.numpy as jnp
from jax import lax
import numpy as np

D_MODEL = 1024
BATCH = 32
SEQ = 2048
DEPTH = 2
DEC_BATCH = 2
DEC_SEQ = 16384
PAST_LEN = 128

EPS = 1e-6
CHUNK = 64

GLA_HEADS = 4
GLA_DK = 32
GLA_DV = 64
GLA_RANK = 16
GLA_GATE_NORM = 16.0
GLA_QK = GLA_HEADS * GLA_DK
GLA_V = GLA_HEADS * GLA_DV
GLA_COLS = 2 * GLA_QK + 2 * GLA_V + 2 * GLA_RANK

RWKV_HEADS = 4
RWKV_HD = 64
RWKV_W = RWKV_HEADS * RWKV_HD
RWKV_W_RANK = 64
RWKV_A_RANK = 64
RWKV_G_RANK = 128
RWKV_LN_EPS = 64e-5
RWKV_COLS = 3 * RWKV_W + 2 * RWKV_W_RANK + 2 * RWKV_A_RANK + RWKV_G_RANK

SSD_HEADS = 8
SSD_HD = 64
SSD_INNER = SSD_HEADS * SSD_HD
SSD_STATE = 128
SSD_GROUPS = 2
SSD_CONV = 5
SSD_CONV_CH = SSD_INNER + 2 * SSD_GROUPS * SSD_STATE
SSD_COLS = SSD_INNER + SSD_CONV_CH + 2 * SSD_HEADS

D_MIX = GLA_V + RWKV_W + SSD_INNER
D_IN = GLA_COLS + RWKV_COLS + SSD_COLS
D_FF = -(-8 * D_MODEL // (3 * 256)) * 256

kernel_name = 'hybrid_gla_rwkv7_ssd_bidir_encoder'


def _split(t, sizes):
    idx = np.cumsum(sizes)[:-1].tolist()
    return jnp.split(t, idx, axis=-1)


def _rmsnorm(x, g):
    x32 = x.astype(jnp.float32)
    y = x32 * lax.rsqrt(jnp.mean(x32 * x32, axis=-1, keepdims=True) + EPS)
    return (y * g.astype(jnp.float32)).astype(x.dtype)


def _head_group_norm(y, g, b):
    y32 = y.astype(jnp.float32)
    mean = jnp.mean(y32, axis=-1, keepdims=True)
    var = jnp.mean(jnp.square(y32 - mean), axis=-1, keepdims=True)
    out = (y32 - mean) * lax.rsqrt(var + RWKV_LN_EPS) * g.astype(jnp.float32) + b.astype(jnp.float32)
    return out.astype(y.dtype)


def _l2_normalize(x):
    x32 = x.astype(jnp.float32)
    return (x32 * lax.rsqrt(jnp.sum(x32 * x32, axis=-1, keepdims=True) + 1e-12)).astype(x.dtype)


def _centred_shift(p):
    prev = jnp.pad(p, ((0, 0), (1, 0), (0, 0)))[:, :-1]
    nxt = jnp.pad(p, ((0, 0), (0, 1), (0, 0)))[:, 1:]
    return 0.5 * (prev + nxt)


def _chunk_mask(strict):
    return jnp.tril(jnp.ones((CHUNK, CHUNK), dtype=bool), k=-1 if strict else 0)


def _gla_chunked(q, k, v, log_a, strict):
    Bsz, L, H, DK = q.shape
    DV = v.shape[-1]
    N = L // CHUNK
    q = q.reshape(Bsz, N, CHUNK, H, DK)
    k = k.reshape(Bsz, N, CHUNK, H, DK)
    v = v.reshape(Bsz, N, CHUNK, H, DV)
    b = jnp.cumsum(log_a.reshape(Bsz, N, CHUNK, H, DK), axis=2)
    b_last = b[:, :, -1:]
    q_dec = q * jnp.exp(b)
    k_dec = k * jnp.exp(-b)
    scores = jnp.einsum('bnihk,bnjhk->bnhij', q_dec, k_dec)
    scores = jnp.where(_chunk_mask(strict), scores, jnp.zeros_like(scores))
    o_intra = jnp.einsum('bnhij,bnjhv->bnihv', scores, v)
    u = jnp.einsum('bnjhk,bnjhv->bnhkv', k * jnp.exp(b_last - b), v)
    d = jnp.exp(b_last[:, :, 0])

    def step(state, inp):
        dc, uc = inp
        return (dc[..., None] * state + uc).astype(state.dtype), state

    s0 = jnp.zeros((Bsz, H, DK, DV), u.dtype)
    _, s_prev = lax.scan(step, s0, (jnp.moveaxis(d, 1, 0), jnp.moveaxis(u, 1, 0)))
    s_prev = jnp.moveaxis(s_prev, 0, 1)
    o_inter = jnp.einsum('bnihk,bnhkv->bnihv', q_dec, s_prev)
    return (o_intra + o_inter).reshape(Bsz, L, H, DV)


def _gla_mixer(p, a_up, a_bias, norm_g):
    Bsz, L, _ = p.shape
    q, k, v, g, af, ab = _split(p, [GLA_QK, GLA_QK, GLA_V, GLA_V, GLA_RANK, GLA_RANK])
    q = q.reshape(Bsz, L, GLA_HEADS, GLA_DK) * (GLA_DK ** -0.5)
    k = k.reshape(Bsz, L, GLA_HEADS, GLA_DK)
    v = v.reshape(Bsz, L, GLA_HEADS, GLA_DV)
    la_f = (jax.nn.log_sigmoid(af @ a_up[0] + a_bias[0]) / GLA_GATE_NORM).reshape(Bsz, L, GLA_HEADS, GLA_DK)
    la_b = (jax.nn.log_sigmoid(ab @ a_up[1] + a_bias[1]) / GLA_GATE_NORM).reshape(Bsz, L, GLA_HEADS, GLA_DK)
    o_f = _gla_chunked(q, k, v, la_f, False)
    o_b = jnp.flip(_gla_chunked(jnp.flip(q, 1), jnp.flip(k, 1), jnp.flip(v, 1), jnp.flip(la_b, 1), True), 1)
    o = _rmsnorm(o_f + o_b, norm_g) * jax.nn.silu(g.reshape(Bsz, L, GLA_HEADS, GLA_DV))
    return o.reshape(Bsz, L, GLA_V)


def _rwkv7_scan(r, w, k, v, a_vec, b_vec):
    def step(S, inp):
        r_t, w_t, k_t, v_t, a_t, b_t = inp
        sa = jnp.einsum('dbhvk,dbhk->dbhv', S, a_t)
        S = (S * w_t[..., None, :] + sa[..., :, None] * b_t[..., None, :] + v_t[..., :, None] * k_t[..., None, :]).astype(S.dtype)
        return S, jnp.einsum('dbhvk,dbhk->dbhv', S, r_t)

    xs = tuple(jnp.moveaxis(t, 2, 0) for t in (r, w, k, v, a_vec, b_vec))
    D2, Bsz, _, H, HD = r.shape
    s0 = jnp.zeros((D2, Bsz, H, HD, HD), v.dtype)
    _, y = lax.scan(step, s0, xs)
    return jnp.moveaxis(y, 0, 2)


def _rwkv7_mixer(p, mu, w0, w_up, a0, a_up, g_up, k_k, k_a, r_k, ln_g, ln_b):
    Bsz, L, _ = p.shape
    H, HD = RWKV_HEADS, RWKV_HD
    p = p + mu * (_centred_shift(p) - p)
    r, k, v, wf, wb, af, ab, gd = _split(p, [RWKV_W] * 3 + [RWKV_W_RANK] * 2 + [RWKV_A_RANK] * 2 + [RWKV_G_RANK])
    r = r.reshape(Bsz, L, H, HD)
    k = k.reshape(Bsz, L, H, HD)
    v = v.reshape(Bsz, L, H, HD)
    w_raw = jnp.stack([w0[0] + jnp.tanh(wf) @ w_up[0], w0[1] + jnp.tanh(wb) @ w_up[1]])
    decay = jnp.exp(-jnp.exp(-jax.nn.softplus(-w_raw) - 0.5)).reshape(2, Bsz, L, H, HD)
    a = jax.nn.sigmoid(jnp.stack([a0[0] + af @ a_up[0], a0[1] + ab @ a_up[1]])).reshape(2, Bsz, L, H, HD)
    kk = _l2_normalize(k * k_k.reshape(H, HD))
    k_dir = k[None] * (1 + (a - 1) * k_a.reshape(H, HD))
    b_vec = kk[None] * a

    def both(t_f, t_b):
        return jnp.stack([t_f, jnp.flip(t_b, axis=1)])

    y = _rwkv7_scan(both(r, r), both(decay[0], decay[1]), both(k_dir[0], k_dir[1]),
                    both(v, v), both(-kk, -kk), both(b_vec[0], b_vec[1]))
    y_f = y[0]
    y_b = jnp.flip(y[1], axis=1) - v * jnp.sum(k_dir[1] * r, axis=-1, keepdims=True)
    o = _head_group_norm(y_f + y_b, ln_g.reshape(H, HD), ln_b.reshape(H, HD))
    o = o + jnp.sum(r * k * r_k.reshape(H, HD), axis=-1, keepdims=True) * v
    g = jax.nn.sigmoid(gd) @ g_up
    return o.reshape(Bsz, L, RWKV_W) * g


def _ssd_chunked(x, dt, A, Bm, Cm, strict):
    Bsz, L, H, P = x.shape
    G, S = Bm.shape[2], Bm.shape[3]
    R = H // G
    N = L // CHUNK
    x = x.reshape(Bsz, N, CHUNK, G, R, P)
    dt = dt.reshape(Bsz, N, CHUNK, G, R)
    Bm = Bm.reshape(Bsz, N, CHUNK, G, S)
    Cm = Cm.reshape(Bsz, N, CHUNK, G, S)
    acum = jnp.cumsum(dt * A.reshape(G, R), axis=2)
    a_t = jnp.moveaxis(acum, 2, -1)
    seg = jnp.exp(jnp.where(_chunk_mask(strict), a_t[..., :, None] - a_t[..., None, :], -jnp.inf))
    cb = jnp.einsum('bnigs,bnjgs->bngij', Cm, Bm)
    xdt = x * dt[..., None]
    y_diag = jnp.einsum('bngrij,bnjgrp->bnigrp', cb[:, :, :, None] * seg, xdt)
    a_last = acum[:, :, -1]
    u = jnp.einsum('bncgs,bncgrp->bngrps', Bm, xdt * jnp.exp(a_last[:, :, None] - acum)[..., None])

    def step(state, inp):
        dc, uc = inp
        return (dc[..., None, None] * state + uc).astype(state.dtype), state

    s0 = jnp.zeros((Bsz, G, R, P, S), u.dtype)
    _, s_prev = lax.scan(step, s0, (jnp.moveaxis(jnp.exp(a_last), 1, 0), jnp.moveaxis(u, 1, 0)))
    s_prev = jnp.moveaxis(s_prev, 0, 1)
    y_off = jnp.einsum('bncgs,bngrps->bncgrp', Cm, s_prev) * jnp.exp(acum)[..., None]
    return (y_diag + y_off).reshape(Bsz, L, H, P)


def _ssd_mixer(p, conv_w, conv_b, dt_bias, A_log, D, norm_g):
    Bsz, L, _ = p.shape
    z, xbc, dtf, dtb = _split(p, [SSD_INNER, SSD_CONV_CH, SSD_HEADS, SSD_HEADS])
    xbc = lax.conv_general_dilated(xbc, conv_w[:, None, :], window_strides=(1,),
                                   padding=[(SSD_CONV // 2, SSD_CONV // 2)],
                                   dimension_numbers=('NWC', 'WIO', 'NWC'),
                                   feature_group_count=SSD_CONV_CH)
    xbc = jax.nn.silu(xbc + conv_b)
    xs, Bm, Cm = _split(xbc, [SSD_INNER, SSD_GROUPS * SSD_STATE, SSD_GROUPS * SSD_STATE])
    xs = xs.reshape(Bsz, L, SSD_HEADS, SSD_HD)
    Bm = Bm.reshape(Bsz, L, SSD_GROUPS, SSD_STATE)
    Cm = Cm.reshape(Bsz, L, SSD_GROUPS, SSD_STATE)
    dt_f = jax.nn.softplus(dtf + dt_bias[0])
    dt_b = jax.nn.softplus(dtb + dt_bias[1])
    A = -jnp.exp(A_log)
    y_f = _ssd_chunked(xs, dt_f, A[0], Bm, Cm, False)
    y_b = jnp.flip(_ssd_chunked(jnp.flip(xs, 1), jnp.flip(dt_b, 1), A[1], jnp.flip(Bm, 1), jnp.flip(Cm, 1), True), 1)
    y = y_f + y_b + D[:, None] * xs
    y = y.reshape(Bsz, L, SSD_INNER) * jax.nn.silu(z)
    return _rmsnorm(y, norm_g)


def _trunk(x, prm):
    for l in range(DEPTH):
        h = _rmsnorm(x, prm['norm_mix'][l])
        p = h @ prm['w_in'][l]
        pg, pr, ps = _split(p, [GLA_COLS, RWKV_COLS, SSD_COLS])
        o_gla = _gla_mixer(pg, prm['gla_a_up'][l], prm['gla_a_bias'][l], prm['gla_norm'][l])
        o_rwkv = _rwkv7_mixer(pr, prm['rwkv_mu'][l], prm['rwkv_w0'][l], prm['rwkv_w_up'][l],
                              prm['rwkv_a0'][l], prm['rwkv_a_up'][l], prm['rwkv_g_up'][l],
                              prm['rwkv_k_k'][l], prm['rwkv_k_a'][l], prm['rwkv_r_k'][l],
                              prm['rwkv_ln_g'][l], prm['rwkv_ln_b'][l])
        o_ssd = _ssd_mixer(ps, prm['ssd_conv_w'][l], prm['ssd_conv_b'][l], prm['ssd_dt_bias'][l],
                           prm['ssd_A_log'][l], prm['ssd_D'][l], prm['ssd_norm'][l])
        mix = jnp.concatenate([o_gla, o_rwkv, o_ssd], axis=-1)
        x = x + mix @ prm['w_out'][l]
        h = _rmsnorm(x, prm['norm_ffn'][l])
        x = x + (jax.nn.silu(h @ prm['ffn_gate'][l]) * (h @ prm['ffn_up'][l])) @ prm['ffn_down'][l]
    return _rmsnorm(x, prm['final_norm'])


def setup_inputs(seed: int = 0) -> dict:
    key = jax.random.key(seed)
    ks = iter(jax.random.split(key, 40))
    f32 = jnp.float32

    def nrm(shape, scale):
        return jax.random.normal(next(ks), shape, f32) * scale

    def gain(shape):
        return 1.0 + nrm(shape, 0.05)

    dt_init = jnp.exp(jax.random.uniform(next(ks), (DEPTH, 2, SSD_HEADS), f32, np.log(1e-3), np.log(1e-1)))
    return {
        'x_prompt': nrm((BATCH, SEQ, D_MODEL), 1.0),
        'x_sample': nrm((DEC_BATCH, DEC_SEQ, D_MODEL), 1.0),
        'norm_mix': gain((DEPTH, D_MODEL)),
        'w_in': nrm((DEPTH, D_MODEL, D_IN), D_MODEL ** -0.5),
        'w_out': nrm((DEPTH, D_MIX, D_MODEL), D_MIX ** -0.5),
        'gla_a_up': nrm((DEPTH, 2, GLA_RANK, GLA_QK), GLA_RANK ** -0.5),
        'gla_a_bias': 1.0 + nrm((DEPTH, 2, GLA_QK), 0.5),
        'gla_norm': gain((DEPTH, GLA_DV)),
        'rwkv_mu': jax.random.uniform(next(ks), (DEPTH, RWKV_COLS), f32),
        'rwkv_w0': jax.random.uniform(next(ks), (DEPTH, 2, RWKV_W), f32, -6.0, -1.0),
        'rwkv_w_up': nrm((DEPTH, 2, RWKV_W_RANK, RWKV_W), 0.5 * RWKV_W_RANK ** -0.5),
        'rwkv_a0': nrm((DEPTH, 2, RWKV_W), 0.1),
        'rwkv_a_up': nrm((DEPTH, 2, RWKV_A_RANK, RWKV_W), 0.5 * RWKV_A_RANK ** -0.5),
        'rwkv_g_up': nrm((DEPTH, RWKV_G_RANK, RWKV_W), RWKV_G_RANK ** -0.5),
        'rwkv_k_k': 0.85 + nrm((DEPTH, RWKV_W), 0.05),
        'rwkv_k_a': gain((DEPTH, RWKV_W)),
        'rwkv_r_k': nrm((DEPTH, RWKV_W), 0.1),
        'rwkv_ln_g': gain((DEPTH, RWKV_W)),
        'rwkv_ln_b': nrm((DEPTH, RWKV_W), 0.02),
        'ssd_conv_w': nrm((DEPTH, SSD_CONV, SSD_CONV_CH), SSD_CONV ** -0.5),
        'ssd_conv_b': nrm((DEPTH, SSD_CONV_CH), 0.02),
        'ssd_dt_bias': dt_init + jnp.log(-jnp.expm1(-dt_init)),
        'ssd_A_log': jnp.log(jax.random.uniform(next(ks), (DEPTH, 2, SSD_HEADS), f32, 1.0, 16.0)),
        'ssd_D': gain((DEPTH, SSD_HEADS)),
        'ssd_norm': gain((DEPTH, SSD_INNER)),
        'norm_ffn': gain((DEPTH, D_MODEL)),
        'ffn_gate': nrm((DEPTH, D_MODEL, D_FF), D_MODEL ** -0.5),
        'ffn_up': nrm((DEPTH, D_MODEL, D_FF), D_MODEL ** -0.5),
        'ffn_down': nrm((DEPTH, D_FF, D_MODEL), D_FF ** -0.5),
        'final_norm': gain((D_MODEL,)),
    }


def reference(x_prompt, x_sample, norm_mix, w_in, w_out, gla_a_up, gla_a_bias, gla_norm,
              rwkv_mu, rwkv_w0, rwkv_w_up, rwkv_a0, rwkv_a_up, rwkv_g_up, rwkv_k_k, rwkv_k_a,
              rwkv_r_k, rwkv_ln_g, rwkv_ln_b, ssd_conv_w, ssd_conv_b, ssd_dt_bias, ssd_A_log,
              ssd_D, ssd_norm, norm_ffn, ffn_gate, ffn_up, ffn_down, final_norm):
    prm = {
        'norm_mix': norm_mix, 'w_in': w_in, 'w_out': w_out,
        'gla_a_up': gla_a_up, 'gla_a_bias': gla_a_bias, 'gla_norm': gla_norm,
        'rwkv_mu': rwkv_mu, 'rwkv_w0': rwkv_w0, 'rwkv_w_up': rwkv_w_up, 'rwkv_a0': rwkv_a0,
        'rwkv_a_up': rwkv_a_up, 'rwkv_g_up': rwkv_g_up, 'rwkv_k_k': rwkv_k_k, 'rwkv_k_a': rwkv_k_a,
        'rwkv_r_k': rwkv_r_k, 'rwkv_ln_g': rwkv_ln_g, 'rwkv_ln_b': rwkv_ln_b,
        'ssd_conv_w': ssd_conv_w, 'ssd_conv_b': ssd_conv_b, 'ssd_dt_bias': ssd_dt_bias,
        'ssd_A_log': ssd_A_log, 'ssd_D': ssd_D, 'ssd_norm': ssd_norm,
        'norm_ffn': norm_ffn, 'ffn_gate': ffn_gate, 'ffn_up': ffn_up, 'ffn_down': ffn_down,
        'final_norm': final_norm,
    }
    y_prompt = _trunk(x_prompt, prm)
    y_sample = _trunk(x_sample, prm)
    return (y_prompt, y_sample)
```

```cpp
#include <hip/hip_runtime.h>
#include <hip/hip_cooperative_groups.h>
#include <cstdio>
namespace cg = cooperative_groups;

#define LAS __attribute__((address_space(3)))
typedef unsigned short bf16_t;
typedef short bf16x8 __attribute__((ext_vector_type(8)));
typedef float f32x4 __attribute__((ext_vector_type(4)));
typedef float f32x2 __attribute__((ext_vector_type(2)));
typedef unsigned u32x4 __attribute__((ext_vector_type(4)));
typedef unsigned u32x2 __attribute__((ext_vector_type(2)));

constexpr int DM = 1024, TALL = 98304, TG = 32768, NGROUP = 3;
constexpr int DINP = 3584, DIN = 3504, DFF = 2816;
constexpr int LDS_BYTES = 131072 + 2048;
constexpr float EPS = 1e-6f;
constexpr int PC_GQ = 0, PC_GK = 128, PC_GV = 256, PC_GG = 512, PC_GAF = 768;
constexpr int PC_R = 800, PC_RK = 1056, PC_RV = 1312, PC_RLOW = 1568;
constexpr int PC_Z = 1952, PC_XBC = 2464, PC_DT = 3488;

constexpr size_t WS_CTL = 0;
constexpr size_t WS_SW = 65536;
constexpr int SW_L = 106496;
constexpr size_t WS_WIN = WS_SW + 524288;
constexpr size_t WS_WOUT = WS_WIN + (size_t)2 * DINP * DM * 2;
constexpr size_t WS_WGU = WS_WOUT + (size_t)2 * DM * DM * 2;
constexpr size_t WS_WDN = WS_WGU + (size_t)2 * 2 * DFF * DM * 2;
constexpr size_t WS_XB = WS_WDN + (size_t)2 * DM * DFF * 2;
constexpr size_t WS_P = WS_XB + (size_t)TG * DM * 2;
constexpr size_t WS_MIX = WS_P + (size_t)TG * DINP * 2;
constexpr size_t WS_SSP = WS_MIX + (size_t)TG * DM * 2;
constexpr size_t WS_GLA_LA = WS_SSP + (size_t)TG * 16 * 4;
constexpr size_t WS_GLA_O = WS_GLA_LA + (size_t)2 * TG * 128 * 4;
constexpr size_t WS_RW = WS_GLA_O + (size_t)2 * TG * 256 * 4;
constexpr size_t WS_RW_S = WS_RW + (size_t)10 * TG * 256 * 2;
constexpr size_t WS_RW_Y = WS_RW_S + (size_t)2 * TG * 4 * 4;
constexpr size_t WS_SSD_X = WS_RW_Y + (size_t)2 * TG * 256 * 4;
constexpr size_t WS_SSD_DT = WS_SSD_X + (size_t)TG * 1024 * 2;
constexpr size_t WS_SSD_Y = WS_SSD_DT + (size_t)TG * 16 * 4;
constexpr size_t WS_RWQ = WS_SSD_Y + (size_t)2 * TG * 512 * 4;
constexpr size_t WS_END = WS_RWQ + (size_t)4096 * 3 * 4096 * 2;
static_assert(WS_END <= ((size_t)1 << 30), "workspace over 1 GiB");

struct Params { const float* in[30]; float* out; unsigned char* ws; };

__device__ __forceinline__ int otid() { int t = threadIdx.x; asm volatile("" : "+v"(t)); return t; }
__device__ __forceinline__ float bf2f(bf16_t b) { return __uint_as_float(((unsigned)b) << 16); }
typedef __bf16 bf16x2_t __attribute__((ext_vector_type(2)));
__device__ __forceinline__ unsigned pk2(float lo, float hi) { f32x2 f = {lo, hi}; bf16x2_t v = __builtin_convertvector(f, bf16x2_t); return __builtin_bit_cast(unsigned, v); }
__device__ __forceinline__ unsigned f2bf(float f) { return (unsigned)__builtin_bit_cast(unsigned short, (__bf16)f); }
__device__ __forceinline__ float sigm(float x) { return __builtin_amdgcn_rcpf(1.0f + __expf(-x)); }
__device__ __forceinline__ float silu(float x) { return x * __builtin_amdgcn_rcpf(1.0f + __expf(-x)); }
__device__ __forceinline__ float softplus(float x) { return fmaxf(x, 0.f) + __logf(1.0f + __expf(-fabsf(x))); }
__device__ __forceinline__ void lds_barrier() { asm volatile("s_waitcnt lgkmcnt(0)" ::: "memory"); __builtin_amdgcn_s_barrier(); asm volatile("" ::: "memory"); }

__device__ __forceinline__ float dpp_add(float v, float src_carrier) { return v + src_carrier; }
#define DPPF(x, ctrl, rmask) __int_as_float(__builtin_amdgcn_update_dpp(0, __float_as_int(x), (ctrl), (rmask), 0xf, false))
__device__ __forceinline__ float wave_incl_scan(float v, int lane) {
    v += DPPF(v, 0x111, 0xf);
    v += DPPF(v, 0x112, 0xf);
    v += DPPF(v, 0x114, 0xf);
    v += DPPF(v, 0x118, 0xf);
    v += DPPF(v, 0x142, 0xa);
    v += DPPF(v, 0x143, 0xc);
    return v;
}
__device__ __forceinline__ float lane_bcast(float v, int l) { return __int_as_float(__builtin_amdgcn_readlane(__float_as_int(v), l)); }
__device__ __forceinline__ float wave_sum(float v) { return lane_bcast(wave_incl_scan(v, 0), 63); }
__device__ __forceinline__ void unpack8(u32x4 v, float* f) {
    f[0] = __uint_as_float(v.x << 16); f[1] = __uint_as_float(v.x & 0xffff0000u);
    f[2] = __uint_as_float(v.y << 16); f[3] = __uint_as_float(v.y & 0xffff0000u);
    f[4] = __uint_as_float(v.z << 16); f[5] = __uint_as_float(v.z & 0xffff0000u);
    f[6] = __uint_as_float(v.w << 16); f[7] = __uint_as_float(v.w & 0xffff0000u);
}


#define XB_TMO      128
#define XB_XCNT(j)  (256  + 64 * (j))
#define XB_XSUB(j)  (1280 + 64 * (j))
#define XB_XGEN(j)  (2304 + 64 * (j))
#define XB_TOP      3328
#define XB_TOPGEN   3392
#define XB_SPIN_CAP (1u << 22)
__device__ __forceinline__ unsigned xb_ld(unsigned* p)              { return __hip_atomic_load(p, __ATOMIC_RELAXED, __HIP_MEMORY_SCOPE_AGENT); }
__device__ __forceinline__ unsigned xb_add(unsigned* p, unsigned v) { return __hip_atomic_fetch_add(p, v, __ATOMIC_RELAXED, __HIP_MEMORY_SCOPE_AGENT); }
__device__ __forceinline__ unsigned xb_xcc_id() { return (unsigned)__builtin_amdgcn_s_getreg((3 << 11) | 20) & 0xFu; }
#define XB_SPIN(cond, bar) do { unsigned _sp = 0; while (cond) { __builtin_amdgcn_s_sleep(1); \
    if ((++_sp & 255u) == 0u) { if (xb_ld(&(bar)[XB_TMO])) break; if (_sp > XB_SPIN_CAP) { atomicAdd(&(bar)[XB_TMO], 1u); break; } } } } while (0)
struct XcdBarrier { unsigned* bar; unsigned x; volatile LAS unsigned* st; };
__device__ __forceinline__ XcdBarrier xcd_barrier_post(unsigned* bar, volatile LAS unsigned* st) {
    XcdBarrier b; b.bar = bar; b.x = xb_xcc_id(); b.st = st;
    if (threadIdx.x == 0) (void)xb_add(&bar[XB_XCNT(b.x)], 1u);
    return b;
}
__device__ __forceinline__ void xcd_barrier_complete(unsigned* bar, unsigned x, unsigned& nloc, unsigned& nx) {
    const unsigned G = gridDim.x * gridDim.y * gridDim.z;
    unsigned sum, cnt, mine, sp = 0u;
    for (;;) {
        sum = 0u; cnt = 0u; mine = 0u;
#pragma unroll
        for (unsigned j = 0; j < 16; ++j) { const unsigned c = xb_ld(&bar[XB_XCNT(j)]); sum += c; cnt += (c > 0u) ? 1u : 0u; mine = (j == x) ? c : mine; }
        if (sum == G) break;
        __builtin_amdgcn_s_sleep(1);
        if ((++sp & 255u) == 0u) { if (xb_ld(&bar[XB_TMO])) break; if (sp > XB_SPIN_CAP) { atomicAdd(&bar[XB_TMO], 1u); break; } }
    }
    nloc = mine > 0u ? mine : 1u; nx = cnt > 0u ? cnt : 1u;
}
__device__ __forceinline__ void xcd_barrier(const XcdBarrier& b) {
    asm volatile("s_waitcnt vmcnt(0)" ::: "memory");
    __syncthreads();
    if (threadIdx.x == 0) {
        unsigned* bar = b.bar;
        __builtin_amdgcn_s_waitcnt(0);
        unsigned nloc = b.st[0], nx = b.st[1];
        if (nloc == 0u) { xcd_barrier_complete(bar, b.x, nloc, nx); b.st[0] = nloc; b.st[1] = nx; }
        const unsigned old = xb_add(&bar[XB_XSUB(b.x)], 1u);
        const unsigned gen = old / nloc;
        if (old + 1u == (gen + 1u) * nloc) {
            __builtin_amdgcn_fence(__ATOMIC_RELEASE, "agent");
            asm volatile("s_waitcnt vmcnt(0)" ::: "memory");
            const unsigned og = xb_add(&bar[XB_TOP], 1u);
            const unsigned tg = og / nx;
            if (og + 1u == (tg + 1u) * nx) xb_add(&bar[XB_TOPGEN], 1u);
            else XB_SPIN(xb_ld(&bar[XB_TOPGEN]) == tg, bar);
            __builtin_amdgcn_fence(__ATOMIC_ACQUIRE, "agent");
            xb_add(&bar[XB_XGEN(b.x)], 1u);
            asm volatile("s_waitcnt vmcnt(0)" ::: "memory");
        } else {
            XB_SPIN(xb_ld(&bar[XB_XGEN(b.x)]) == gen, bar);
            __builtin_amdgcn_fence(__ATOMIC_ACQUIRE, "agent");
            asm volatile("s_waitcnt vmcnt(0)" ::: "memory");
        }
    }
    __syncthreads();
}

namespace pg8 {
constexpr int BM = 256, BK = 64, HALF = 128, HTB = HALF * BK * 2, NXCD = 8, WGM = 8;
__device__ __forceinline__ int lds_byte(int r, int c) { const int st = (r >> 4) * 2 + (c >> 5), rr = r & 15, cc = c & 31, ob = rr * 64 + cc * 2; return st * 1024 + (ob ^ (((ob >> 9) & 1) << 5)); }
__device__ __forceinline__ void stage_rc(int b, int& R, int& C) { const int st = b / 1024, sb = b % 1024, swz = sb ^ (((sb >> 9) & 1) << 5); R = (st >> 1) * 16 + swz / 64; C = (st & 1) * 32 + (swz % 64) / 2; }
__device__ __forceinline__ int perm32(int rho) { const int n = rho >> 4, i = rho & 15; return 8 * (i >> 2) + 4 * n + (i & 3); }
struct Unit { int pm, pn; };
struct Gemm { const bf16_t* A; const bf16_t* Bt; int M, N, K; };
struct StaticOrder {
    int nM, nN, nwg, G, c;
    __device__ void init(int M, int N, int G_, int c_) { nM = M / BM; nN = N / BM; nwg = nM * nN; G = G_; c = c_; }
    __device__ bool next(int i, Unit& u) const {
        const long L = (long)i * G + c; if (L >= nwg) return false;
        int wgid = (int)L; { const int q = nwg / NXCD, r = nwg % NXCD, xcd = wgid % NXCD, off = wgid / NXCD; wgid = (xcd < r ? xcd * (q + 1) : r * (q + 1) + (xcd - r) * q) + off; }
        const int nig = WGM * nN, gid = wgid / nig, fm = gid * WGM, gsz = (nM - fm) < WGM ? (nM - fm) : WGM;
        u.pm = fm + ((wgid % nig) % gsz); u.pn = (wgid % nig) / gsz; return true;
    }
};

template <class Epi>
__device__ __forceinline__ void gemm_phase(LAS unsigned char* lds, const Gemm g, const StaticOrder& S, const Epi& E) {
    const int tid = otid(), wid = __builtin_amdgcn_readfirstlane(tid >> 6), lane = tid & 63, wr = wid >> 2, wc = wid & 3, fr = lane & 15, fq = lane >> 4;
    const int K = g.K, nt = K / BK;
    unsigned voffA[2], voffB[2];
#pragma unroll
    for (int i = 0; i < 2; ++i) { int R, C; stage_rc(tid * 16 + i * 8192, R, C); const int Rb = Epi::PERM ? ((R & ~31) + perm32(R & 31)) : R;
        voffA[i] = (unsigned)(R * K + C) * 2u; voffB[i] = (unsigned)(Rb * K + C) * 2u; }
    const size_t kstep = (size_t)(BK * 2);
    const size_t hstep = (size_t)HALF * K * 2;
    const size_t tstep = 2 * hstep;
    const unsigned ldsw = (unsigned)wid * 1024u;
    const int aoff = lds_byte(wr * 64 + fr, fq * 8), boff = lds_byte(wc * 32 + fr, fq * 8);
#define PG8_SA(b, h) (((b) * 2 + (h)) * HTB)
#define PG8_SB(b, h) ((4 + (b) * 2 + (h)) * HTB)
#define PG8_STAGE(bufoff, gbase, voff) do { _Pragma("unroll") for (int _i = 0; _i < 2; ++_i) \
        __builtin_amdgcn_global_load_lds((const unsigned*)((const char*)(gbase) + (voff)[_i]), (LAS unsigned*)(lds + (bufoff) + ldsw + _i * 8192), 16, 0, 0); } while (0)
#define PG8_LDA(dst, b, h) do { _Pragma("unroll") for (int m = 0; m < 4; ++m) _Pragma("unroll") for (int k = 0; k < 2; ++k) dst[m][k] = *(const LAS bf16x8*)(lds + PG8_SA(b, h) + aoff + m * 2048 + k * 1024); } while (0)
#define PG8_LDB(dst, b, h) do { _Pragma("unroll") for (int n = 0; n < 2; ++n) _Pragma("unroll") for (int k = 0; k < 2; ++k) dst[n][k] = *(const LAS bf16x8*)(lds + PG8_SB(b, h) + boff + n * 2048 + k * 1024); } while (0)
#define PG8_MMA(ai, bj, At, Bt) do { __builtin_amdgcn_s_setprio(1); _Pragma("unroll") for (int m = 0; m < 4; ++m) _Pragma("unroll") for (int n = 0; n < 2; ++n) _Pragma("unroll") for (int k = 0; k < 2; ++k) \
        acc[ai][bj][m][n] = __builtin_amdgcn_mfma_f32_16x16x32_bf16(Bt[n][k], At[m][k], acc[ai][bj][m][n], 0, 0, 0); __builtin_amdgcn_s_setprio(0); } while (0)
#define PG8_WAIT_V(n) asm volatile("s_waitcnt vmcnt(" #n ")" ::: "memory")
#define PG8_WAIT_L(n) asm volatile("s_waitcnt lgkmcnt(" #n ")" ::: "memory")
#define PG8_BAR __builtin_amdgcn_s_barrier()
#define PG8_SCHED __builtin_amdgcn_sched_barrier(0)
    Unit cur, nxt; int ui = 0;
    if (!S.next(0, cur)) return;
    f32x4 acc[2][2][4][2];
#pragma unroll
    for (int a = 0; a < 2; ++a)
#pragma unroll
        for (int b = 0; b < 2; ++b)
#pragma unroll
            for (int m = 0; m < 4; ++m)
#pragma unroll
                for (int n = 0; n < 2; ++n) acc[a][b][m][n] = (f32x4){0.f, 0.f, 0.f, 0.f};
    bf16x8 At[4][2], B0[2][2], B1[2][2];
    const char* cA = (const char*)g.A + (size_t)cur.pm * tstep; const char* cB = (const char*)g.Bt + (size_t)cur.pn * tstep;
    PG8_STAGE(PG8_SB(0, 0), cB, voffB); PG8_STAGE(PG8_SA(0, 0), cA, voffA); PG8_STAGE(PG8_SB(0, 1), cB + hstep, voffB); PG8_STAGE(PG8_SA(0, 1), cA + hstep, voffA);
    if (wr == 1) PG8_BAR;
    PG8_WAIT_V(4); PG8_BAR;
    PG8_STAGE(PG8_SB(1, 0), cB + kstep, voffB); PG8_STAGE(PG8_SA(1, 0), cA + kstep, voffA); PG8_STAGE(PG8_SB(1, 1), cB + hstep + kstep, voffB);
    PG8_WAIT_V(6); PG8_BAR;
    for (;;) {
        const bool has_next = S.next(ui + 1, nxt);
        const char* nA = has_next ? (const char*)g.A + (size_t)nxt.pm * tstep : cA; const char* nB = has_next ? (const char*)g.Bt + (size_t)nxt.pn * tstep : cB;
        for (int t = 0; t < nt; t += 2) {
            const bool last = (t == nt - 2);
            const char* a1 = cA + (size_t)(t + 1) * kstep;
            const char* a2 = last ? nA : cA + (size_t)(t + 2) * kstep; const char* b2 = last ? nB : cB + (size_t)(t + 2) * kstep;
            const char* a3 = a2 + kstep; const char* b3 = b2 + kstep;
            PG8_LDB(B0, 0, 0); PG8_SCHED; PG8_LDA(At, 0, 0); PG8_STAGE(PG8_SA(1, 1), a1 + hstep, voffA);
            PG8_WAIT_L(8); PG8_BAR; PG8_WAIT_L(0); PG8_MMA(0, 0, At, B0); PG8_BAR; PG8_SCHED;
            PG8_LDB(B1, 0, 1); PG8_STAGE(PG8_SB(0, 0), b2, voffB);
            PG8_BAR; PG8_WAIT_L(0); PG8_MMA(0, 1, At, B1); PG8_BAR;
            PG8_LDA(At, 0, 1); PG8_STAGE(PG8_SA(0, 0), a2, voffA);
            PG8_BAR; PG8_WAIT_L(0); PG8_MMA(1, 0, At, B0); PG8_BAR; PG8_SCHED;
            PG8_STAGE(PG8_SB(0, 1), b2 + hstep, voffB);
            PG8_WAIT_V(6); PG8_BAR; PG8_MMA(1, 1, At, B1); PG8_BAR;
            PG8_LDB(B0, 1, 0); PG8_SCHED; PG8_LDA(At, 1, 0); PG8_STAGE(PG8_SA(0, 1), a2 + hstep, voffA);
            PG8_WAIT_L(8); PG8_BAR; PG8_WAIT_L(0); PG8_MMA(0, 0, At, B0); PG8_BAR; PG8_SCHED;
            PG8_LDB(B1, 1, 1); PG8_STAGE(PG8_SB(1, 0), b3, voffB);
            PG8_BAR; PG8_WAIT_L(0); PG8_MMA(0, 1, At, B1); PG8_BAR;
            PG8_LDA(At, 1, 1); PG8_STAGE(PG8_SA(1, 0), a3, voffA);
            PG8_BAR; PG8_WAIT_L(0); PG8_MMA(1, 0, At, B0); PG8_BAR; PG8_SCHED;
            PG8_STAGE(PG8_SB(1, 1), b3 + hstep, voffB);
            PG8_WAIT_V(6); PG8_BAR; PG8_MMA(1, 1, At, B1); PG8_BAR;
        }
        E(acc, cur, wr, wc, fr, fq);
        if (!has_next) break;
#pragma unroll
        for (int a = 0; a < 2; ++a)
#pragma unroll
            for (int b = 0; b < 2; ++b)
#pragma unroll
                for (int m = 0; m < 4; ++m)
#pragma unroll
                    for (int n = 0; n < 2; ++n) acc[a][b][m][n] = (f32x4){0.f, 0.f, 0.f, 0.f};
        cur = nxt; cA = nA; cB = nB; ++ui;
    }
    PG8_WAIT_V(0);
    if (wr == 0) PG8_BAR;
    PG8_BAR;
#undef PG8_SA
#undef PG8_SB
#undef PG8_STAGE
#undef PG8_LDA
#undef PG8_LDB
#undef PG8_MMA
#undef PG8_WAIT_V
#undef PG8_WAIT_L
#undef PG8_BAR
#undef PG8_SCHED
}
}

__device__ __forceinline__ float row_rs(const float* ssp, int row) {
    const f32x4* p = (const f32x4*)(ssp + (size_t)row * 16);
    f32x4 a = p[0], b = p[1], c = p[2], d = p[3];
    float s = (a[0] + a[1] + a[2] + a[3]) + (b[0] + b[1] + b[2] + b[3]) + (c[0] + c[1] + c[2] + c[3]) + (d[0] + d[1] + d[2] + d[3]);
    return rsqrtf(s * (1.0f / 1024.0f) + EPS);
}

__device__ __forceinline__ f32x4 rs_part(const float* ssp, int row, int fq) { return *(const f32x4*)(ssp + (size_t)row * 16 + fq * 4); }
__device__ __forceinline__ float rs_fin(f32x4 a) { float s = (a[0] + a[1]) + (a[2] + a[3]); s += __shfl_xor(s, 16); s += __shfl_xor(s, 32); return rsqrtf(s * (1.0f / 1024.0f) + EPS); }
struct EpiInproj {
    static constexpr bool PERM = true;
    bf16_t* O; const float* ssp;
    __device__ __forceinline__ void operator()(const f32x4 (&acc)[2][2][4][2], const pg8::Unit& u, int wr, int wc, int fr, int fq) const {
        const int row0 = u.pm * 256 + wr * 64 + fr, col0 = u.pn * 256 + wc * 32 + 8 * fq;
        f32x4 rp[2][4];
#pragma unroll
        for (int ai = 0; ai < 2; ++ai)
#pragma unroll
            for (int m = 0; m < 4; ++m) rp[ai][m] = rs_part(ssp, row0 + ai * 128 + m * 16, fq);
#pragma unroll
        for (int ai = 0; ai < 2; ++ai)
#pragma unroll
            for (int m = 0; m < 4; ++m) {
                const int row = row0 + ai * 128 + m * 16; const float rs = rs_fin(rp[ai][m]);
                bf16_t* rowp = O + (size_t)row * DINP + col0;
#pragma unroll
                for (int bj = 0; bj < 2; ++bj) { f32x4 v0 = acc[ai][bj][m][0] * rs, v1 = acc[ai][bj][m][1] * rs;
                    u32x4 w; w.x = pk2(v0[0], v0[1]); w.y = pk2(v0[2], v0[3]); w.z = pk2(v1[0], v1[1]); w.w = pk2(v1[2], v1[3]);
                    *(u32x4*)(rowp + bj * 128) = w; }
            }
    }
};
struct EpiGateUp {
    static constexpr bool PERM = true;
    bf16_t* O; const float* ssp;
    __device__ __forceinline__ void operator()(const f32x4 (&acc)[2][2][4][2], const pg8::Unit& u, int wr, int wc, int fr, int fq) const {
        const int row0 = u.pm * 256 + wr * 64 + fr, col0 = u.pn * 128 + wc * 32 + 8 * fq;
        f32x4 rp[2][4];
#pragma unroll
        for (int ai = 0; ai < 2; ++ai)
#pragma unroll
            for (int m = 0; m < 4; ++m) rp[ai][m] = rs_part(ssp, row0 + ai * 128 + m * 16, fq);
#pragma unroll
        for (int ai = 0; ai < 2; ++ai)
#pragma unroll
            for (int m = 0; m < 4; ++m) {
                const int row = row0 + ai * 128 + m * 16; const float rs = rs_fin(rp[ai][m]);
                float h[8];
#pragma unroll
                for (int n = 0; n < 2; ++n)
#pragma unroll
                    for (int j = 0; j < 4; ++j) h[n * 4 + j] = silu(acc[ai][0][m][n][j] * rs) * (acc[ai][1][m][n][j] * rs);
                u32x4 w; w.x = pk2(h[0], h[1]); w.y = pk2(h[2], h[3]); w.z = pk2(h[4], h[5]); w.w = pk2(h[6], h[7]);
                *(u32x4*)(O + (size_t)row * DFF + col0) = w;
            }
    }
};
struct EpiResid {
    static constexpr bool PERM = false;
    bf16_t* XB; float* ssp;
    __device__ __forceinline__ void operator()(const f32x4 (&acc)[2][2][4][2], const pg8::Unit& u, int wr, int wc, int fr, int fq) const {
        const int row0 = u.pm * 256 + wr * 64 + fr, col0 = u.pn * 256 + wc * 32 + 4 * fq;
        u32x2 xnx[4];
        { const bf16_t* xr0 = XB + (size_t)row0 * DM + col0;
#pragma unroll
          for (int e = 0; e < 4; ++e) xnx[e] = *(const u32x2*)(xr0 + (e >> 1) * 128 + (e & 1) * 16); }
#pragma unroll
        for (int ai = 0; ai < 2; ++ai)
#pragma unroll
            for (int m = 0; m < 4; ++m) {
                const int row = row0 + ai * 128 + m * 16;
                bf16_t* br = XB + (size_t)row * DM + col0;
                u32x2 xc[4];
#pragma unroll
                for (int e = 0; e < 4; ++e) xc[e] = xnx[e];
                if (ai * 4 + m < 7) { const int idx = ai * 4 + m + 1; const bf16_t* xrn = XB + (size_t)(row0 + (idx >> 2) * 128 + (idx & 3) * 16) * DM + col0;
#pragma unroll
                    for (int e = 0; e < 4; ++e) xnx[e] = *(const u32x2*)(xrn + (e >> 1) * 128 + (e & 1) * 16); }
                float ss = 0.f;
#pragma unroll
                for (int bj = 0; bj < 2; ++bj)
#pragma unroll
                    for (int n = 0; n < 2; ++n) {
                        const u32x2 xo = xc[bj * 2 + n];
                        f32x4 xn = acc[ai][bj][m][n];
                        xn[0] += __uint_as_float(xo.x << 16); xn[1] += __uint_as_float(xo.x & 0xffff0000u); xn[2] += __uint_as_float(xo.y << 16); xn[3] += __uint_as_float(xo.y & 0xffff0000u);
                        ss += (xn[0] * xn[0] + xn[1] * xn[1]) + (xn[2] * xn[2] + xn[3] * xn[3]);
                        u32x2 w; w.x = pk2(xn[0], xn[1]); w.y = pk2(xn[2], xn[3]);
                        *(u32x2*)(br + bj * 128 + n * 16) = w;
                    }
                ss += __shfl_xor(ss, 16); ss += __shfl_xor(ss, 32);
                if (fq == 0) ssp[(size_t)row * 16 + u.pn * 4 + wc] = ss;
                asm volatile("" ::: "memory");
            }
    }
};

__device__ __forceinline__ void wtile(LAS float* tile, const float* src, int lds_src, const float* gain, bf16_t* dst, int K, int n0, int k0, int c0, int nvalid) {
    const int tid = otid();
    __syncthreads();
#pragma unroll
    for (int i = 0; i < 8; ++i) {
        const int kk = (tid >> 6) + 8 * i, c = tid & 63;
        float v = 0.f;
        if (c0 + c < nvalid) { v = src[(size_t)(k0 + kk) * lds_src + c0 + c]; if (gain) v *= gain[k0 + kk]; }
        tile[kk * 65 + c] = v;
    }
    __syncthreads();
    const int n = tid >> 3, kc = (tid & 7) * 8;
    float f[8];
#pragma unroll
    for (int j = 0; j < 8; ++j) f[j] = tile[(kc + j) * 65 + n];
    u32x4 w; w.x = pk2(f[0], f[1]); w.y = pk2(f[2], f[3]); w.z = pk2(f[4], f[5]); w.w = pk2(f[6], f[7]);
    *(u32x4*)(dst + (size_t)(n0 + n) * K + k0 + kc) = w;
}
__device__ __forceinline__ void phase_weights(LAS unsigned char* lds, const Params& P) {
    LAS float* tile = (LAS float*)lds;
    unsigned char* ws = P.ws;
    constexpr int T_IN = 56 * 16, T_OUT = 16 * 16, T_GU = 88 * 16, T_DN = 16 * 44, T_L = T_IN + T_OUT + T_GU + T_DN;
    for (int t = blockIdx.x; t < 2 * 24; t += gridDim.x) {
        const int l = t / 24, idx = t % 24; bf16_t* sw = (bf16_t*)(ws + WS_SW) + (size_t)l * SW_L;
        if (idx < 16) { const int m = idx >> 2, nb = idx & 3, d = m & 1;
            const float* src = (m < 2 ? P.in[10] : P.in[12]) + (size_t)(l * 2 + d) * 64 * 256;
            wtile(tile, src, 256, nullptr, sw + m * 16384, 64, nb * 64, 0, nb * 64, 256);
        } else { const int nb = (idx - 16) >> 1, kb = (idx - 16) & 1;
            wtile(tile, P.in[13] + (size_t)l * 128 * 256, 256, nullptr, sw + 65536, 128, nb * 64, kb * 64, nb * 64, 256); }
    }
    for (int i = blockIdx.x * 512 + threadIdx.x; i < 2 * 8192; i += gridDim.x * 512) {
        const int l = i >> 13, rem = i & 8191, d = rem >> 12, c = (rem & 4095) >> 5, k = rem & 31;
        const float v = ((k >> 4) == d) ? P.in[5][((size_t)(l * 2 + d) * 16 + (k & 15)) * 128 + c] : 0.f;
        ((bf16_t*)(ws + WS_SW))[(size_t)l * SW_L + 98304 + rem] = (bf16_t)f2bf(v);
    }
    for (int t = blockIdx.x; t < 2 * T_L; t += gridDim.x) {
        const int l = t / T_L; int r = t % T_L;
        if (r < T_IN) { const int nb = r / 16, kb = r % 16;
            wtile(tile, P.in[3] + (size_t)l * DM * DIN, DIN, P.in[2] + l * DM, (bf16_t*)(ws + WS_WIN) + (size_t)l * DINP * DM, DM, nb * 64, kb * 64, nb * 64, DIN);
        } else if ((r -= T_IN) < T_OUT) { const int nb = r / 16, kb = r % 16;
            wtile(tile, P.in[4] + (size_t)l * DM * DM, DM, nullptr, (bf16_t*)(ws + WS_WOUT) + (size_t)l * DM * DM, DM, nb * 64, kb * 64, nb * 64, DM);
        } else if ((r -= T_OUT) < T_GU) { const int nb = r / 16, kb = r % 16;
            const int j = nb >> 2, qd = nb & 3; const float* src = (qd < 2 ? P.in[26] : P.in[27]) + (size_t)l * DM * DFF;
            wtile(tile, src, DFF, P.in[25] + l * DM, (bf16_t*)(ws + WS_WGU) + (size_t)l * 2 * DFF * DM, DM, nb * 64, kb * 64, j * 128 + (qd & 1) * 64, DFF);
        } else { r -= T_GU; const int nb = r / 44, kb = r % 44;
            wtile(tile, P.in[28] + (size_t)l * DFF * DM, DM, nullptr, (bf16_t*)(ws + WS_WDN) + (size_t)l * DM * DFF, DFF, nb * 64, kb * 64, nb * 64, DM);
        }
    }
}

__device__ __forceinline__ void phase_xprep(const Params& P, int g) {
    const float* xin = (g < 2) ? P.in[0] + (size_t)g * TG * DM : P.in[1];
    bf16_t* xb = (bf16_t*)(P.ws + WS_XB); float* ssp = (float*)(P.ws + WS_SSP);
    const int tid_ = otid(); const int lane = tid_ & 63, gw = blockIdx.x * 8 + (tid_ >> 6), nw = gridDim.x * 8;
    for (int row = gw; row < TG; row += nw) {
        float ss = 0.f;
#pragma unroll
        for (int i = 0; i < 4; ++i) {
            const int c = i * 256 + lane * 4;
            f32x4 v = *(const f32x4*)(xin + (size_t)row * DM + c);
            u32x2 w; w.x = pk2(v[0], v[1]); w.y = pk2(v[2], v[3]);
            *(u32x2*)(xb + (size_t)row * DM + c) = w;
            ss += (v[0] * v[0] + v[1] * v[1]) + (v[2] * v[2] + v[3] * v[3]);
        }
        ss = wave_sum(ss);
        if (lane < 16) ssp[(size_t)row * 16 + lane] = (lane == 0) ? ss : 0.f;
    }
}
__device__ __forceinline__ void phase_final(const Params& P, int g) {
    float* xo = P.out + (size_t)g * TG * DM; const bf16_t* xb = (const bf16_t*)(P.ws + WS_XB); const float* ssp = (const float*)(P.ws + WS_SSP); const float* gn = P.in[29];
    const int tid_ = otid(); const int lane = tid_ & 63, gw = blockIdx.x * 8 + (tid_ >> 6), nw = gridDim.x * 8;
    for (int row = gw; row < TG; row += nw) {
        const float rs = row_rs(ssp, row);
#pragma unroll
        for (int i = 0; i < 2; ++i) {
            const int c = i * 512 + lane * 8;
            float v[8]; unpack8(*(const u32x4*)(xb + (size_t)row * DM + c), v);
            const f32x4 g0 = *(const f32x4*)(gn + c), g1 = *(const f32x4*)(gn + c + 4);
            *(f32x4*)(xo + (size_t)row * DM + c) = (f32x4){v[0] * rs * g0[0], v[1] * rs * g0[1], v[2] * rs * g0[2], v[3] * rs * g0[3]};
            *(f32x4*)(xo + (size_t)row * DM + c + 4) = (f32x4){v[4] * rs * g1[0], v[5] * rs * g1[1], v[6] * rs * g1[2], v[7] * rs * g1[3]};
        }
    }
}

struct MixBufs {
    const bf16_t* p; float* gla_la; bf16_t* gla_o; bf16_t* rw; float* rw_s; bf16_t* rw_y; bf16_t* ssd_x; float* ssd_dt; bf16_t* ssd_y; bf16_t* mix;
};
__device__ __forceinline__ MixBufs mixbufs(const Params& P) {
    MixBufs B; unsigned char* ws = P.ws;
    B.p = (const bf16_t*)(ws + WS_P); B.gla_la = (float*)(ws + WS_GLA_LA); B.gla_o = (bf16_t*)(ws + WS_GLA_O); B.rw = (bf16_t*)(ws + WS_RW);
    B.rw_s = (float*)(ws + WS_RW_S); B.rw_y = (bf16_t*)(ws + WS_RW_Y); B.ssd_x = (bf16_t*)(ws + WS_SSD_X); B.ssd_dt = (float*)(ws + WS_SSD_DT);
    B.ssd_y = (bf16_t*)(ws + WS_SSD_Y); B.mix = (bf16_t*)(ws + WS_MIX); return B;
}
constexpr size_t RWA = (size_t)TG * 256;

__device__ __forceinline__ void prep_tile(LAS unsigned char* lds, const Params& P, const MixBufs& B, int layer, int L, int tile) {
    const int tid = otid(), lane = tid & 63;
    const int t0 = tile * 32;
    LAS float* lin = (LAS float*)lds;
    LAS float* gin = (LAS float*)(lds + 49152);
    const bf16_t* p = B.p;
    const float* mu = P.in[8] + layer * 1152;
    __syncthreads();
    for (int idx = tid; idx < 32 * 384; idx += 512) {
        const int t = idx / 384, cc = idx % 384, tl = t0 + t, pos = tl % L, col = PC_RLOW + cc;
        const float cur = bf2f(p[(size_t)tl * DINP + col]);
        const float prv = pos > 0 ? bf2f(p[(size_t)(tl - 1) * DINP + col]) : 0.f;
        const float nxt = pos < L - 1 ? bf2f(p[(size_t)(tl + 1) * DINP + col]) : 0.f;
        float v = cur + mu[col - PC_R] * (0.5f * (prv + nxt) - cur);
        if (cc < 128) { const float e = __expf(2.f * v); v = 1.f - 2.f / (e + 1.f); }
        else if (cc >= 256) v = sigm(v);
        lin[t * 384 + cc] = v;
    }
    for (int idx = tid; idx < 32 * 32; idx += 512) { const int t = idx >> 5, j = idx & 31; gin[idx] = bf2f(p[(size_t)(t0 + t) * DINP + PC_GAF + j]); }
    __syncthreads();
#pragma unroll 1
    for (int i = 0; i < 8; ++i) {
        const int idx = tid + 512 * i, t = idx >> 7, c0 = (idx & 127) * 8, tl = t0 + t, pos = tl % L;
        float acc[8];
        { const f32x4 b0 = *(const f32x4*)(P.in[20] + layer * 1024 + c0), b1 = *(const f32x4*)(P.in[20] + layer * 1024 + c0 + 4);
          acc[0] = b0[0]; acc[1] = b0[1]; acc[2] = b0[2]; acc[3] = b0[3]; acc[4] = b1[0]; acc[5] = b1[1]; acc[6] = b1[2]; acc[7] = b1[3]; }
#pragma unroll
        for (int tap = 0; tap < 5; ++tap) {
            const int pp = pos + tap - 2;
            if (pp >= 0 && pp < L) {
                float x[8]; unpack8(*(const u32x4*)(p + (size_t)(tl + tap - 2) * DINP + PC_XBC + c0), x);
                const float* w = P.in[19] + (size_t)(layer * 5 + tap) * 1024 + c0;
                const f32x4 w0 = *(const f32x4*)w, w1 = *(const f32x4*)(w + 4);
                acc[0] += w0[0] * x[0]; acc[1] += w0[1] * x[1]; acc[2] += w0[2] * x[2]; acc[3] += w0[3] * x[3];
                acc[4] += w1[0] * x[4]; acc[5] += w1[1] * x[5]; acc[6] += w1[2] * x[6]; acc[7] += w1[3] * x[7];
            }
        }
        u32x4 o; o.x = pk2(silu(acc[0]), silu(acc[1])); o.y = pk2(silu(acc[2]), silu(acc[3])); o.z = pk2(silu(acc[4]), silu(acc[5])); o.w = pk2(silu(acc[6]), silu(acc[7]));
        *(u32x4*)(B.ssd_x + (size_t)tl * 1024 + c0) = o;
    }
    { const int t = tid >> 4, j = tid & 15, tl = t0 + t;
      B.ssd_dt[(size_t)tl * 16 + j] = softplus(bf2f(p[(size_t)tl * DINP + PC_DT + j]) + P.in[21][layer * 16 + j]); }
    if (tid < 256) {
        const int d = tid >> 7, c = tid & 127;
        float ac[16];
#pragma unroll
        for (int j = 0; j < 16; ++j) ac[j] = P.in[5][((size_t)(layer * 2 + d) * 16 + j) * 128 + c];
        const float bias = P.in[6][(layer * 2 + d) * 128 + c];
#pragma unroll 4
        for (int t = 0; t < 32; ++t) {
            float a = bias;
#pragma unroll
            for (int j = 0; j < 16; ++j) a += gin[t * 32 + d * 16 + j] * ac[j];
            B.gla_la[((size_t)d * TG + t0 + t) * 128 + c] = -softplus(-a) * (1.0f / 16.0f);
        }
    }
    asm volatile("" ::: "memory");
    {
        const int h2 = __builtin_amdgcn_readfirstlane(tid >> 8), c = tid & 255, head = c >> 6;
        float wcol[64];
        const float kkc = P.in[14][layer * 256 + c], kac = P.in[15][layer * 256 + c], rkc = P.in[16][layer * 256 + c];
        const float mur = mu[c], muk = mu[256 + c], muv = mu[512 + c];
        {
            { const float* wsrc = P.in[10] + (size_t)(layer * 2 + h2) * 64 * 256;
#pragma unroll
            for (int k = 0; k < 64; ++k) wcol[k] = wsrc[k * 256 + c]; }
            const float w0c = P.in[9][(layer * 2 + h2) * 256 + c];
#pragma unroll 1
            for (int t = 0; t < 32; ++t) {
                float aw = w0c;
                const LAS f32x4* lw = (const LAS f32x4*)(lin + t * 384 + h2 * 64);
#pragma unroll
                for (int k4 = 0; k4 < 16; ++k4) { const f32x4 x = lw[k4];
                    aw += x[0] * wcol[k4 * 4] + x[1] * wcol[k4 * 4 + 1] + x[2] * wcol[k4 * 4 + 2] + x[3] * wcol[k4 * 4 + 3]; }
                B.rw[(4 + h2) * RWA + (size_t)(t0 + t) * 256 + c] = (bf16_t)f2bf(sigm(aw) * 0.60653066f);
            }
        }
        asm volatile("" ::: "memory");
        {
            { const float* wsrc = P.in[12] + (size_t)(layer * 2 + h2) * 64 * 256;
#pragma unroll
            for (int k = 0; k < 64; ++k) wcol[k] = wsrc[k * 256 + c]; }
            const float a0c = P.in[11][(layer * 2 + h2) * 256 + c];
#pragma unroll 1
            for (int t = 0; t < 32; ++t) {
                const int tl = t0 + t, pos = tl % L;
                const bf16_t* pc = p + (size_t)tl * DINP;
                const bool hp = pos > 0, hn = pos < L - 1;
                const float rc = bf2f(pc[PC_R + c]), kc = bf2f(pc[PC_RK + c]), vc = bf2f(pc[PC_RV + c]);
                const float rp = hp ? bf2f(pc[PC_R + c - DINP]) : 0.f, kp = hp ? bf2f(pc[PC_RK + c - DINP]) : 0.f, vp = hp ? bf2f(pc[PC_RV + c - DINP]) : 0.f;
                const float rn = hn ? bf2f(pc[PC_R + c + DINP]) : 0.f, kn = hn ? bf2f(pc[PC_RK + c + DINP]) : 0.f, vn = hn ? bf2f(pc[PC_RV + c + DINP]) : 0.f;
                const float r = rc + mur * (0.5f * (rp + rn) - rc), k = kc + muk * (0.5f * (kp + kn) - kc), v = vc + muv * (0.5f * (vp + vn) - vc);
                float aa = a0c;
                const LAS f32x4* la = (const LAS f32x4*)(lin + t * 384 + 128 + h2 * 64);
#pragma unroll
                for (int k4 = 0; k4 < 16; ++k4) { const f32x4 y = la[k4];
                    aa += y[0] * wcol[k4 * 4] + y[1] * wcol[k4 * 4 + 1] + y[2] * wcol[k4 * 4 + 2] + y[3] * wcol[k4 * 4 + 3]; }
                const float asg = sigm(aa);
                const float kr = k * kkc; const float kk = kr * rsqrtf(wave_sum(kr * kr) + 1e-12f);
                const float kd = k * (1.f + (asg - 1.f) * kac), bb = kk * asg;
                const size_t o = (size_t)tl * 256 + c;
                B.rw[(6 + h2) * RWA + o] = (bf16_t)f2bf(kd); B.rw[(8 + h2) * RWA + o] = (bf16_t)f2bf(bb);
                if (h2 == 0) {
                    B.rw[0 * RWA + o] = (bf16_t)f2bf(r); B.rw[1 * RWA + o] = (bf16_t)f2bf(v); B.rw[2 * RWA + o] = (bf16_t)f2bf(kk);
                    const float s = wave_sum(r * k * rkc); if (lane == 0) B.rw_s[(size_t)tl * 4 + head] = s;
                } else {
                    const float s = wave_sum(bf2f((bf16_t)f2bf(kd)) * bf2f((bf16_t)f2bf(r))); if (lane == 0) B.rw_s[(size_t)TG * 4 + (size_t)tl * 4 + head] = s;
                }
            }
        }
        asm volatile("" ::: "memory");
        float ga[16];
#pragma unroll
        for (int i = 0; i < 16; ++i) ga[i] = 0.f;
#pragma unroll 1
        for (int sub = 0; sub < 2; ++sub) {
            asm volatile("" ::: "memory");
            { const float* wsrc = P.in[13] + (size_t)(layer * 128 + sub * 64) * 256;
#pragma unroll
            for (int k = 0; k < 64; ++k) wcol[k] = wsrc[k * 256 + c]; }
#pragma unroll
            for (int tt = 0; tt < 16; ++tt) {
                const LAS f32x4* lg = (const LAS f32x4*)(lin + (h2 * 16 + tt) * 384 + 256 + sub * 64);
                float a = ga[tt];
#pragma unroll
                for (int k4 = 0; k4 < 16; ++k4) { const f32x4 x = lg[k4]; a += x[0] * wcol[k4 * 4] + x[1] * wcol[k4 * 4 + 1] + x[2] * wcol[k4 * 4 + 2] + x[3] * wcol[k4 * 4 + 3]; }
                ga[tt] = a;
            }
        }
#pragma unroll
        for (int tt = 0; tt < 16; ++tt) B.rw[3 * RWA + (size_t)(t0 + h2 * 16 + tt) * 256 + c] = (bf16_t)f2bf(ga[tt]);
    }
}

__device__ __forceinline__ f32x4 mfma16(bf16x8 a, bf16x8 b, f32x4 c) { return __builtin_amdgcn_mfma_f32_16x16x32_bf16(a, b, c, 0, 0, 0); }
__device__ __forceinline__ void prep_tile64(LAS unsigned char* lds, const Params& P, const MixBufs& B, const bf16_t* sw, int layer, int L, int tile) {
    const int tid = otid(), w = tid >> 6, lane = tid & 63, r = lane & 15, q = lane >> 4;
    const int t0 = tile * 64;
    constexpr int LL = 392, LA = 264;
    LAS bf16_t* lin = (LAS bf16_t*)lds;
    LAS bf16_t* gin = (LAS bf16_t*)(lds + 50176);
    LAS bf16_t* AS = (LAS bf16_t*)(lds + 55296);
    const bf16_t* p = B.p;
    const float* mu = P.in[8] + layer * 1152;
    __syncthreads();
#pragma unroll 3
    for (int i6 = 0; i6 < 6; ++i6) {
        const int it = tid + 512 * i6;
        const int t = it / 48, cg8 = it % 48, tl = t0 + t, pos = tl % L, col = PC_RLOW + cg8 * 8;
        float cur[8], prv[8], nxt[8], v[8];
        unpack8(*(const u32x4*)(p + (size_t)tl * DINP + col), cur);
        if (pos > 0) unpack8(*(const u32x4*)(p + (size_t)(tl - 1) * DINP + col), prv); else {
#pragma unroll
            for (int j = 0; j < 8; ++j) prv[j] = 0.f; }
        if (pos < L - 1) unpack8(*(const u32x4*)(p + (size_t)(tl + 1) * DINP + col), nxt); else {
#pragma unroll
            for (int j = 0; j < 8; ++j) nxt[j] = 0.f; }
        const f32x4 m0 = *(const f32x4*)(mu + col - PC_R), m1 = *(const f32x4*)(mu + col - PC_R + 4);
#pragma unroll
        for (int j = 0; j < 8; ++j) { const float m = j < 4 ? m0[j] : m1[j - 4]; v[j] = cur[j] + m * (0.5f * (prv[j] + nxt[j]) - cur[j]); }
        if (cg8 < 16) {
#pragma unroll
            for (int j = 0; j < 8; ++j) { const float e = __expf(2.f * v[j]); v[j] = 1.f - 2.f * __builtin_amdgcn_rcpf(e + 1.f); }
        } else if (cg8 >= 32) {
#pragma unroll
            for (int j = 0; j < 8; ++j) v[j] = sigm(v[j]);
        }
        u32x4 o; o.x = pk2(v[0], v[1]); o.y = pk2(v[2], v[3]); o.z = pk2(v[4], v[5]); o.w = pk2(v[6], v[7]);
        *(LAS u32x4*)(lin + t * LL + cg8 * 8) = o;
    }
    if (tid < 256) { const int t = tid >> 2, g4 = tid & 3; *(LAS u32x4*)(gin + t * 40 + g4 * 8) = *(const u32x4*)(p + (size_t)(t0 + t) * DINP + PC_GAF + g4 * 8); }
    __syncthreads();
#pragma unroll 1
    for (int d = 0; d < 2; ++d)
#pragma unroll 1
        for (int tt = 0; tt < 2; ++tt) {
            const int tn = 2 * w + tt, c = tn * 16 + r;
            const float a0c = P.in[11][(layer * 2 + d) * 256 + c];
            const bf16_t* wb = sw + 32768 + d * 16384 + (size_t)(tn * 16 + r) * 64 + q * 8;
            const bf16x8 b0 = *(const bf16x8*)wb, b1 = *(const bf16x8*)(wb + 32);
#pragma unroll
            for (int tm = 0; tm < 4; ++tm) {
                const LAS bf16_t* ap = lin + (tm * 16 + r) * LL + 128 + d * 64 + q * 8;
                f32x4 acc = (f32x4){0.f, 0.f, 0.f, 0.f};
                acc = mfma16(*(const LAS bf16x8*)ap, b0, acc); acc = mfma16(*(const LAS bf16x8*)(ap + 32), b1, acc);
#pragma unroll
                for (int jj = 0; jj < 4; ++jj) AS[(d * 64 + tm * 16 + q * 4 + jj) * LA + c] = (bf16_t)f2bf(sigm(a0c + acc[jj]));
            }
        }
    __syncthreads();
    {
        const int c0 = (tid & 31) * 8, head = (tid & 31) >> 3;
        float mr_[8], mk_[8], mv_[8], kkc[8], kac[8], rkc[8];
#define LD8F(dst, ptr) do { const f32x4 a_ = *(const f32x4*)(ptr), b_ = *(const f32x4*)((ptr) + 4); dst[0] = a_[0]; dst[1] = a_[1]; dst[2] = a_[2]; dst[3] = a_[3]; dst[4] = b_[0]; dst[5] = b_[1]; dst[6] = b_[2]; dst[7] = b_[3]; } while (0)
        LD8F(mr_, mu + c0); LD8F(mk_, mu + 256 + c0); LD8F(mv_, mu + 512 + c0);
        LD8F(kkc, P.in[14] + layer * 256 + c0); LD8F(kac, P.in[15] + layer * 256 + c0); LD8F(rkc, P.in[16] + layer * 256 + c0);
#undef LD8F
        u32x4 nx[9], cu[9];
        const u32x4 Z = (u32x4){0u, 0u, 0u, 0u};
#define EL_LOAD(dst, ii) do { const int t_ = (tid + 512 * (ii)) >> 5, tl_ = t0 + t_, pos_ = tl_ % L; const bf16_t* pc_ = p + (size_t)tl_ * DINP + c0; \
            const bool hp_ = pos_ > 0, hn_ = pos_ < L - 1; \
            dst[0] = *(const u32x4*)(pc_ + PC_R); dst[1] = *(const u32x4*)(pc_ + PC_RK); dst[2] = *(const u32x4*)(pc_ + PC_RV); \
            dst[3] = hp_ ? *(const u32x4*)(pc_ + PC_R - DINP) : Z; dst[4] = hp_ ? *(const u32x4*)(pc_ + PC_RK - DINP) : Z; dst[5] = hp_ ? *(const u32x4*)(pc_ + PC_RV - DINP) : Z; \
            dst[6] = hn_ ? *(const u32x4*)(pc_ + PC_R + DINP) : Z; dst[7] = hn_ ? *(const u32x4*)(pc_ + PC_RK + DINP) : Z; dst[8] = hn_ ? *(const u32x4*)(pc_ + PC_RV + DINP) : Z; } while (0)
        EL_LOAD(nx, 0);
#pragma unroll 1
        for (int i = 0; i < 4; ++i) {
#pragma unroll
            for (int e = 0; e < 9; ++e) cu[e] = nx[e];
            if (i < 3) EL_LOAD(nx, i + 1);
            const int t = (tid + 512 * i) >> 5, tl = t0 + t;
            float rr[8], kx[8], vx[8], c_[8], p_[8], n_[8];
            unpack8(cu[0], c_); unpack8(cu[3], p_); unpack8(cu[6], n_);
#pragma unroll
            for (int j = 0; j < 8; ++j) rr[j] = c_[j] + mr_[j] * (0.5f * (p_[j] + n_[j]) - c_[j]);
            unpack8(cu[1], c_); unpack8(cu[4], p_); unpack8(cu[7], n_);
#pragma unroll
            for (int j = 0; j < 8; ++j) kx[j] = c_[j] + mk_[j] * (0.5f * (p_[j] + n_[j]) - c_[j]);
            unpack8(cu[2], c_); unpack8(cu[5], p_); unpack8(cu[8], n_);
#pragma unroll
            for (int j = 0; j < 8; ++j) vx[j] = c_[j] + mv_[j] * (0.5f * (p_[j] + n_[j]) - c_[j]);
            float as0[8], as1[8];
            unpack8(*(const LAS u32x4*)(AS + (0 * 64 + t) * LA + c0), as0); unpack8(*(const LAS u32x4*)(AS + (1 * 64 + t) * LA + c0), as1);
            float kr[8], ss = 0.f, srk = 0.f;
#pragma unroll
            for (int j = 0; j < 8; ++j) { kr[j] = kx[j] * kkc[j]; ss += kr[j] * kr[j]; srk += rr[j] * kx[j] * rkc[j]; }
            ss += __shfl_xor(ss, 1); ss += __shfl_xor(ss, 2); ss += __shfl_xor(ss, 4);
            const float inv = rsqrtf(ss + 1e-12f);
            float kkv[8], kd0[8], kd1[8], b0v[8], b1v[8], skr = 0.f;
#pragma unroll
            for (int j = 0; j < 8; ++j) {
                kkv[j] = kr[j] * inv; kd0[j] = kx[j] * (1.f + (as0[j] - 1.f) * kac[j]); kd1[j] = kx[j] * (1.f + (as1[j] - 1.f) * kac[j]);
                b0v[j] = kkv[j] * as0[j]; b1v[j] = kkv[j] * as1[j];
                skr += bf2f((bf16_t)f2bf(kd1[j])) * bf2f((bf16_t)f2bf(rr[j])); }
            srk += __shfl_xor(srk, 1); srk += __shfl_xor(srk, 2); srk += __shfl_xor(srk, 4);
            skr += __shfl_xor(skr, 1); skr += __shfl_xor(skr, 2); skr += __shfl_xor(skr, 4);
            const size_t o = (size_t)tl * 256 + c0;
#define ST8(arr, f) do { u32x4 o4; o4.x = pk2(f[0], f[1]); o4.y = pk2(f[2], f[3]); o4.z = pk2(f[4], f[5]); o4.w = pk2(f[6], f[7]); *(u32x4*)(B.rw + (size_t)(arr) * RWA + o) = o4; } while (0)
            ST8(0, rr); ST8(1, vx); ST8(2, kkv); ST8(6, kd0); ST8(7, kd1); ST8(8, b0v); ST8(9, b1v);
#undef ST8
            if ((lane & 7) == 0) { B.rw_s[(size_t)tl * 4 + head] = srk; B.rw_s[(size_t)TG * 4 + (size_t)tl * 4 + head] = skr; }
        }
#undef EL_LOAD
    }
#pragma unroll 1
    for (int d = 0; d < 2; ++d)
#pragma unroll 1
        for (int tt = 0; tt < 2; ++tt) {
            const int tn = 2 * w + tt, c = tn * 16 + r;
            const float w0c = P.in[9][(layer * 2 + d) * 256 + c];
            const bf16_t* wb = sw + d * 16384 + (size_t)(tn * 16 + r) * 64 + q * 8;
            const bf16x8 b0 = *(const bf16x8*)wb, b1 = *(const bf16x8*)(wb + 32);
#pragma unroll
            for (int tm = 0; tm < 4; ++tm) {
                const LAS bf16_t* ap = lin + (tm * 16 + r) * LL + d * 64 + q * 8;
                f32x4 acc = (f32x4){0.f, 0.f, 0.f, 0.f};
                acc = mfma16(*(const LAS bf16x8*)ap, b0, acc); acc = mfma16(*(const LAS bf16x8*)(ap + 32), b1, acc);
#pragma unroll
                for (int jj = 0; jj < 4; ++jj) B.rw[(size_t)(4 + d) * RWA + (size_t)(t0 + tm * 16 + q * 4 + jj) * 256 + c] = (bf16_t)f2bf(sigm(w0c + acc[jj]) * 0.60653066f);
            }
        }
#pragma unroll 1
    for (int tt = 0; tt < 2; ++tt) {
        const int tn = 2 * w + tt, c = tn * 16 + r;
        const bf16_t* wb = sw + 65536 + (size_t)(tn * 16 + r) * 128 + q * 8;
        const bf16x8 b0 = *(const bf16x8*)wb, b1 = *(const bf16x8*)(wb + 32), b2 = *(const bf16x8*)(wb + 64), b3 = *(const bf16x8*)(wb + 96);
#pragma unroll
        for (int tm = 0; tm < 4; ++tm) {
            const LAS bf16_t* ap = lin + (tm * 16 + r) * LL + 256 + q * 8;
            f32x4 acc = (f32x4){0.f, 0.f, 0.f, 0.f};
            acc = mfma16(*(const LAS bf16x8*)ap, b0, acc); acc = mfma16(*(const LAS bf16x8*)(ap + 32), b1, acc);
            acc = mfma16(*(const LAS bf16x8*)(ap + 64), b2, acc); acc = mfma16(*(const LAS bf16x8*)(ap + 96), b3, acc);
#pragma unroll
            for (int jj = 0; jj < 4; ++jj) B.rw[(size_t)3 * RWA + (size_t)(t0 + tm * 16 + q * 4 + jj) * 256 + c] = (bf16_t)f2bf(acc[jj]);
        }
    }
#pragma unroll 1
    for (int d = 0; d < 2; ++d) {
        const int c = w * 16 + r;
        const float bias = P.in[6][(layer * 2 + d) * 128 + c];
        const bf16x8 b0 = *(const bf16x8*)(sw + 98304 + d * 4096 + (size_t)(w * 16 + r) * 32 + q * 8);
#pragma unroll
        for (int tm = 0; tm < 4; ++tm) {
            f32x4 acc = (f32x4){0.f, 0.f, 0.f, 0.f};
            acc = mfma16(*(const LAS bf16x8*)(gin + (tm * 16 + r) * 40 + q * 8), b0, acc);
#pragma unroll
            for (int jj = 0; jj < 4; ++jj) B.gla_la[((size_t)d * TG + t0 + tm * 16 + q * 4 + jj) * 128 + c] = -softplus(-(acc[jj] + bias)) * (1.0f / 16.0f);
        }
    }
    {
        const int c0 = (tid & 127) * 8;
        float wt[5][8], bs[8];
        { const f32x4 b0 = *(const f32x4*)(P.in[20] + layer * 1024 + c0), b1 = *(const f32x4*)(P.in[20] + layer * 1024 + c0 + 4);
          bs[0] = b0[0]; bs[1] = b0[1]; bs[2] = b0[2]; bs[3] = b0[3]; bs[4] = b1[0]; bs[5] = b1[1]; bs[6] = b1[2]; bs[7] = b1[3]; }
#pragma unroll
        for (int tap = 0; tap < 5; ++tap) { const float* wp = P.in[19] + (size_t)(layer * 5 + tap) * 1024 + c0;
            const f32x4 w0 = *(const f32x4*)wp, w1 = *(const f32x4*)(wp + 4);
            wt[tap][0] = w0[0]; wt[tap][1] = w0[1]; wt[tap][2] = w0[2]; wt[tap][3] = w0[3]; wt[tap][4] = w1[0]; wt[tap][5] = w1[1]; wt[tap][6] = w1[2]; wt[tap][7] = w1[3]; }
        u32x4 xr[5], xn[5];
#define CONV_LOAD(dst, ii) do { const int t_ = (tid + 512 * (ii)) >> 7, tl_ = t0 + t_, pos_ = tl_ % L; \
            _Pragma("unroll") for (int tap = 0; tap < 5; ++tap) { const int pp = pos_ + tap - 2; \
                dst[tap] = (pp >= 0 && pp < L) ? *(const u32x4*)(p + (size_t)(tl_ + tap - 2) * DINP + PC_XBC + c0) : (u32x4){0u, 0u, 0u, 0u}; } } while (0)
        CONV_LOAD(xn, 0);
#pragma unroll 1
        for (int i = 0; i < 16; ++i) {
#pragma unroll
            for (int tap = 0; tap < 5; ++tap) xr[tap] = xn[tap];
            if (i < 15) CONV_LOAD(xn, i + 1);
            float acc[8];
#pragma unroll
            for (int j = 0; j < 8; ++j) acc[j] = bs[j];
#pragma unroll
            for (int tap = 0; tap < 5; ++tap) { float x[8]; unpack8(xr[tap], x);
#pragma unroll
                for (int j = 0; j < 8; ++j) acc[j] += wt[tap][j] * x[j]; }
            const int tl = t0 + ((tid + 512 * i) >> 7);
            u32x4 o; o.x = pk2(silu(acc[0]), silu(acc[1])); o.y = pk2(silu(acc[2]), silu(acc[3])); o.z = pk2(silu(acc[4]), silu(acc[5])); o.w = pk2(silu(acc[6]), silu(acc[7]));
            *(u32x4*)(B.ssd_x + (size_t)tl * 1024 + c0) = o;
        }
#undef CONV_LOAD
    }
#pragma unroll
    for (int i = 0; i < 2; ++i) { const int idx = tid + 512 * i, t = idx >> 4, j = idx & 15, tl = t0 + t;
        B.ssd_dt[(size_t)tl * 16 + j] = softplus(bf2f(p[(size_t)tl * DINP + PC_DT + j]) + P.in[21][layer * 16 + j]); }
}

__device__ __forceinline__ f32x4 mma_nt(f32x4 acc, const LAS bf16_t* A, int lda, const LAS bf16_t* Bt, int ldb, int K, int lane) {
    const int r = lane & 15, q = lane >> 4;
    for (int k = 0; k < K; k += 32) {
        const bf16x8 a = *(const LAS bf16x8*)(A + r * lda + k + q * 8);
        const bf16x8 b = *(const LAS bf16x8*)(Bt + r * ldb + k + q * 8);
        acc = __builtin_amdgcn_mfma_f32_16x16x32_bf16(a, b, acc, 0, 0, 0);
    }
    return acc;
}
__device__ __forceinline__ f32x4 mma_nt_x(f32x4 acc, const LAS bf16_t* A, int lda, const LAS bf16_t* Bt, int ldb, int K, int lane, int xa, int xb) {
    const int r = lane & 15, q = lane >> 4;
    for (int k = 0; k < K; k += 32) {
        const bf16x8 a = *(const LAS bf16x8*)(A + r * lda + ((((k >> 3) + q) ^ xa) << 3));
        const bf16x8 b = *(const LAS bf16x8*)(Bt + r * ldb + ((((k >> 3) + q) ^ xb) << 3));
        acc = __builtin_amdgcn_mfma_f32_16x16x32_bf16(a, b, acc, 0, 0, 0);
    }
    return acc;
}
__device__ __forceinline__ f32x4 mma_tn_x(f32x4 acc, const LAS bf16_t* A, int lda, const LAS bf16_t* Bt, int ldb, int K, int lane, int xa, int xb) {
    const int r = lane & 15, q = lane >> 4;
    for (int k = 0; k < K; k += 32) {
        const bf16x8 a = *(const LAS bf16x8*)(A + r * lda + ((((k >> 3) + q) ^ xa) << 3));
        const bf16x8 b = *(const LAS bf16x8*)(Bt + r * ldb + ((((k >> 3) + q) ^ xb) << 3));
        acc = __builtin_amdgcn_mfma_f32_16x16x32_bf16(b, a, acc, 0, 0, 0);
    }
    return acc;
}
template <int DK> struct CL {
    static constexpr int LQ = DK + 8, LT = 72;
    static constexpr int QA = 0, KA = QA + 64 * LQ * 2, KBT = KA + 64 * LQ * 2, VT = KBT + DK * LT * 2, SC = VT + 64 * LT * 2, STT = SC + 64 * LT * 2;
    static constexpr int FA = STT + 64 * LQ * 2;
};

__device__ __forceinline__ void ssd_unit(LAS unsigned char* lds, const Params& P, const MixBufs& B, float* segst, int layer, int L, int seq, int h, int d, int seg, bool state_only) {
    typedef CL<128> C;
    const int tid = otid(), w = tid >> 6, lane = tid & 63, r = lane & 15, q = lane >> 4;
    LAS bf16_t* Qa = (LAS bf16_t*)(lds + C::QA); LAS bf16_t* Ka = (LAS bf16_t*)(lds + C::KA); LAS bf16_t* KbT = (LAS bf16_t*)(lds + C::KBT);
    LAS bf16_t* VT = (LAS bf16_t*)(lds + C::VT); LAS bf16_t* Sc = (LAS bf16_t*)(lds + C::SC); LAS bf16_t* StT = (LAS bf16_t*)(lds + C::STT);
    LAS float* acum = (LAS float*)(lds + C::FA); LAS float* dtl = acum + 64;
    const int grp = h >> 2;
    const float Aneg = -__expf(P.in[22][layer * 16 + d * 8 + h]);
    const int base = seq * L, cbeg = seg * 32, cend = cbeg + 32;
    __syncthreads();
    f32x4 st[4];
#pragma unroll
    for (int i = 0; i < 4; ++i) st[i] = (f32x4){0.f, 0.f, 0.f, 0.f};
    const int kidx = h * 2 + d;
    if (!state_only) {
        for (int ps = 0; ps < seg; ++ps) {
            const float* sp = segst + (size_t)((seq * 8 + ps) * 24 + kidx) * 8256;
            const float dcy = __expf(sp[8192]);
#pragma unroll
            for (int tv = 0; tv < 4; ++tv)
#pragma unroll
                for (int jj = 0; jj < 4; ++jj) st[tv][jj] = st[tv][jj] * dcy + sp[(tv * 4 + jj) * 512 + tid];
        }
#pragma unroll
        for (int tv = 0; tv < 4; ++tv) {
            u32x2 o; o.x = pk2(st[tv][0], st[tv][1]); o.y = pk2(st[tv][2], st[tv][3]);
            *(LAS u32x2*)(StT + (tv * 16 + r) * C::LQ + w * 16 + q * 4) = o;
        }
    }
    float asum = 0.f;
    const int row = tid >> 3, part = tid & 7;
    const int tm = w >> 1, tn0 = (w & 1) * 2;
    bf16_t* yout = B.ssd_y + (size_t)d * TG * 512;
    u32x4 c0, c1, b0, b1, x0; float dtv;
#define SSD_LOAD(cc) do { const int n0_ = (cc) * 64; \
        const int tok = d == 0 ? base + n0_ + row : base + L - 1 - (n0_ + row); \
        const bf16_t* xr = B.ssd_x + (size_t)tok * 1024; \
        c0 = *(const u32x4*)(xr + 768 + grp * 128 + part * 16); c1 = *(const u32x4*)(xr + 768 + grp * 128 + part * 16 + 8); \
        b0 = *(const u32x4*)(xr + 512 + grp * 128 + part * 16); b1 = *(const u32x4*)(xr + 512 + grp * 128 + part * 16 + 8); \
        x0 = *(const u32x4*)(xr + h * 64 + part * 8); \
        const int tl_ = d == 0 ? base + n0_ + lane : base + L - 1 - (n0_ + lane); \
        dtv = B.ssd_dt[(size_t)tl_ * 16 + d * 8 + h]; } while (0)
    SSD_LOAD(cbeg);
    for (int c = cbeg; c < cend; ++c) {
        const int n0 = c * 64;
        const float ac = wave_incl_scan(dtv * Aneg, lane);
        const float alast = lane_bcast(ac, 63);
        asum += alast;
        if (w == 0) { acum[lane] = ac; dtl[lane] = dtv; }
        {
            const float ks = __shfl(dtv, row) * __expf(alast - __shfl(ac, row));
            *(LAS u32x4*)(Qa + row * C::LQ + part * 16) = c0; *(LAS u32x4*)(Qa + row * C::LQ + part * 16 + 8) = c1;
            *(LAS u32x4*)(Ka + row * C::LQ + part * 16) = b0; *(LAS u32x4*)(Ka + row * C::LQ + part * 16 + 8) = b1;
            float bf[16]; unpack8(b0, bf); unpack8(b1, bf + 8);
            const int rsw = row ^ (part << 3);
#pragma unroll
            for (int j = 0; j < 16; ++j) KbT[(part * 16 + j) * C::LT + rsw] = (bf16_t)f2bf(bf[j] * ks);
            const unsigned xs[4] = {x0.x, x0.y, x0.z, x0.w};
#pragma unroll
            for (int j = 0; j < 4; ++j) { VT[(part * 8 + 2 * j) * C::LT + rsw] = (bf16_t)(xs[j] & 0xffffu); VT[(part * 8 + 2 * j + 1) * C::LT + rsw] = (bf16_t)(xs[j] >> 16); }
        }
        if (c + 1 < cend) SSD_LOAD(c + 1);
        lds_barrier();
        if (!state_only) {
#pragma unroll
        for (int tt = 0; tt < 2; ++tt) {
            const int tn = tn0 + tt;
            f32x4 s = (f32x4){0.f, 0.f, 0.f, 0.f};
            s = mma_tn_x(s, Qa + tm * 16 * C::LQ, C::LQ, Ka + tn * 16 * C::LQ, C::LQ, 128, lane, 0, 0);
            const int i = tm * 16 + r, j0 = tn * 16 + q * 4;
            const float ai = acum[i];
            const f32x4 aj = *(const LAS f32x4*)(acum + j0), dj = *(const LAS f32x4*)(dtl + j0);
            float v[4];
#pragma unroll
            for (int jj = 0; jj < 4; ++jj) {
                const int j = j0 + jj;
                const bool on = d == 0 ? (i >= j) : (i > j);
                v[jj] = on ? s[jj] * __expf(ai - aj[jj]) * dj[jj] : 0.f;
            }
            u32x2 o; o.x = pk2(v[0], v[1]); o.y = pk2(v[2], v[3]);
            *(LAS u32x2*)(Sc + i * C::LT + j0) = o;
        }
        lds_barrier();
#pragma unroll
        for (int tt = 0; tt < 2; ++tt) {
            const int tn = tn0 + tt;
            f32x4 o1 = (f32x4){0.f, 0.f, 0.f, 0.f}, o2 = (f32x4){0.f, 0.f, 0.f, 0.f};
            o1 = mma_tn_x(o1, Sc + tm * 16 * C::LT, C::LT, VT + tn * 16 * C::LT, C::LT, 64, lane, 0, (tn * 2 + (r >> 3)) & 7);
            o2 = mma_tn_x(o2, Qa + tm * 16 * C::LQ, C::LQ, StT + tn * 16 * C::LQ, C::LQ, 128, lane, 0, 0);
            const int i = tm * 16 + r;
            const int tl = d == 0 ? base + n0 + i : base + L - 1 - (n0 + i);
            const float ei = __expf(acum[i]);
            { const f32x4 ov = o1 + o2 * ei; u32x2 o; o.x = pk2(ov[0], ov[1]); o.y = pk2(ov[2], ov[3]); *(u32x2*)(yout + (size_t)tl * 512 + h * 64 + tn * 16 + q * 4) = o; }
        }
        }
        {
            const float ds = __expf(alast);
#pragma unroll
            for (int tv = 0; tv < 4; ++tv) {
                st[tv] = st[tv] * ds;
                st[tv] = mma_nt_x(st[tv], KbT + w * 16 * C::LT, C::LT, VT + tv * 16 * C::LT, C::LT, 64, lane, w, (tv * 2 + (r >> 3)) & 7);
            }
        }
        lds_barrier();
        if (!state_only) {
#pragma unroll
        for (int tv = 0; tv < 4; ++tv) {
            u32x2 o; o.x = pk2(st[tv][0], st[tv][1]); o.y = pk2(st[tv][2], st[tv][3]);
            *(LAS u32x2*)(StT + (tv * 16 + r) * C::LQ + w * 16 + q * 4) = o;
        }
        }
    }
    if (state_only) {
        float* sp = segst + (size_t)((seq * 8 + seg) * 24 + kidx) * 8256;
#pragma unroll
        for (int tv = 0; tv < 4; ++tv)
#pragma unroll
            for (int jj = 0; jj < 4; ++jj) sp[(tv * 4 + jj) * 512 + tid] = st[tv][jj];
        if (tid == 0) sp[8192] = asum;
    }
#undef SSD_LOAD
}

__device__ __forceinline__ void gla_unit(LAS unsigned char* lds, const Params& P, const MixBufs& B, float* segst, int layer, int L, int seq, int h, int d, int seg, bool state_only) {
    typedef CL<32> C;
    const int tid = otid(), w = tid >> 6, lane = tid & 63, r = lane & 15, q = lane >> 4;
    LAS bf16_t* Qa = (LAS bf16_t*)(lds + C::QA); LAS bf16_t* Ka = (LAS bf16_t*)(lds + C::KA); LAS bf16_t* KbT = (LAS bf16_t*)(lds + C::KBT);
    LAS bf16_t* VT = (LAS bf16_t*)(lds + C::VT); LAS bf16_t* Sc = (LAS bf16_t*)(lds + C::SC); LAS bf16_t* StT = (LAS bf16_t*)(lds + C::STT);
    LAS float* dstate = (LAS float*)(lds + C::FA);
    const int base = seq * L, cbeg = seg * 32, cend = cbeg + 32;
    __syncthreads();
    f32x4 st = (f32x4){0.f, 0.f, 0.f, 0.f};
    const int row = tid >> 3, part = tid & 7;
    const int tm = w >> 1, tn0 = (w & 1) * 2;
    const int tk = w >> 2, tv = w & 3;
    const int kidx = 16 + h * 2 + d;
    if (!state_only) {
        for (int ps = 0; ps < seg; ++ps) {
            const float* sp = segst + (size_t)((seq * 8 + ps) * 24 + kidx) * 8256;
#pragma unroll
            for (int jj = 0; jj < 4; ++jj) st[jj] = st[jj] * __expf(sp[8192 + tk * 16 + q * 4 + jj]) + sp[jj * 512 + tid];
        }
        { u32x2 o; o.x = pk2(st[0], st[1]); o.y = pk2(st[2], st[3]); *(LAS u32x2*)(StT + (tv * 16 + r) * C::LQ + tk * 16 + q * 4) = o; }
    }
    float blsum[4] = {0.f, 0.f, 0.f, 0.f};
    const float* la = B.gla_la + (size_t)d * TG * 128;
    bf16_t* oout = B.gla_o + (size_t)d * TG * 256;
    const float qscale = 0.17677669529663687f;
    f32x4 lv; u32x2 qr, kr; u32x4 x0;
#define GLA_LOAD(cc) do { const int n0_ = (cc) * 64; \
        const int tl_ = d == 0 ? base + n0_ + lane : base + L - 1 - (n0_ + lane); \
        lv = *(const f32x4*)(la + (size_t)tl_ * 128 + h * 32 + 4 * w); \
        qr = *(const u32x2*)(B.p + (size_t)tl_ * DINP + PC_GQ + h * 32 + 4 * w); \
        kr = *(const u32x2*)(B.p + (size_t)tl_ * DINP + PC_GK + h * 32 + 4 * w); \
        const int tr_ = d == 0 ? base + n0_ + row : base + L - 1 - (n0_ + row); \
        x0 = *(const u32x4*)(B.p + (size_t)tr_ * DINP + PC_GV + h * 64 + part * 8); } while (0)
    GLA_LOAD(cbeg);
    for (int c = cbeg; c < cend; ++c) {
        const int n0 = c * 64;
        {
            const float qf[4] = {__uint_as_float(qr.x << 16), __uint_as_float(qr.x & 0xffff0000u), __uint_as_float(qr.y << 16), __uint_as_float(qr.y & 0xffff0000u)};
            const float kf[4] = {__uint_as_float(kr.x << 16), __uint_as_float(kr.x & 0xffff0000u), __uint_as_float(kr.y << 16), __uint_as_float(kr.y & 0xffff0000u)};
            float qd[4], kd[4];
#pragma unroll
            for (int kk = 0; kk < 4; ++kk) {
                const float b = wave_incl_scan(lv[kk], lane);
                const float bl = lane_bcast(b, 63);
                blsum[kk] += bl;
                qd[kk] = qf[kk] * qscale * __expf(b); kd[kk] = kf[kk] * __expf(-b);
                KbT[(4 * w + kk) * C::LT + lane] = (bf16_t)f2bf(kf[kk] * __expf(bl - b));
                if (lane == 63) dstate[4 * w + kk] = __expf(bl);
            }
            u32x2 o; o.x = pk2(qd[0], qd[1]); o.y = pk2(qd[2], qd[3]); *(LAS u32x2*)(Qa + lane * C::LQ + 4 * w) = o;
            o.x = pk2(kd[0], kd[1]); o.y = pk2(kd[2], kd[3]); *(LAS u32x2*)(Ka + lane * C::LQ + 4 * w) = o;
            const unsigned xs[4] = {x0.x, x0.y, x0.z, x0.w};
            const int rsw = row ^ (part << 3);
#pragma unroll
            for (int j = 0; j < 4; ++j) { VT[(part * 8 + 2 * j) * C::LT + rsw] = (bf16_t)(xs[j] & 0xffffu); VT[(part * 8 + 2 * j + 1) * C::LT + rsw] = (bf16_t)(xs[j] >> 16); }
        }
        if (c + 1 < cend) GLA_LOAD(c + 1);
        lds_barrier();
        if (!state_only) {
#pragma unroll
        for (int tt = 0; tt < 2; ++tt) {
            const int tn = tn0 + tt;
            f32x4 s = (f32x4){0.f, 0.f, 0.f, 0.f};
            s = mma_tn_x(s, Qa + tm * 16 * C::LQ, C::LQ, Ka + tn * 16 * C::LQ, C::LQ, 32, lane, 0, 0);
            const int i = tm * 16 + r, j0 = tn * 16 + q * 4;
            float v[4];
#pragma unroll
            for (int jj = 0; jj < 4; ++jj) { const int j = j0 + jj; const bool on = d == 0 ? (i >= j) : (i > j); v[jj] = on ? s[jj] : 0.f; }
            u32x2 o; o.x = pk2(v[0], v[1]); o.y = pk2(v[2], v[3]);
            *(LAS u32x2*)(Sc + i * C::LT + j0) = o;
        }
        lds_barrier();
#pragma unroll
        for (int tt = 0; tt < 2; ++tt) {
            const int tn = tn0 + tt;
            f32x4 o1 = (f32x4){0.f, 0.f, 0.f, 0.f};
            o1 = mma_tn_x(o1, Sc + tm * 16 * C::LT, C::LT, VT + tn * 16 * C::LT, C::LT, 64, lane, 0, (tn * 2 + (r >> 3)) & 7);
            o1 = mma_tn_x(o1, Qa + tm * 16 * C::LQ, C::LQ, StT + tn * 16 * C::LQ, C::LQ, 32, lane, 0, 0);
            const int i = tm * 16 + r;
            const int tl = d == 0 ? base + n0 + i : base + L - 1 - (n0 + i);
            { u32x2 o; o.x = pk2(o1[0], o1[1]); o.y = pk2(o1[2], o1[3]); *(u32x2*)(oout + (size_t)tl * 256 + h * 64 + tn * 16 + q * 4) = o; }
        }
        }
        {
#pragma unroll
            for (int jj = 0; jj < 4; ++jj) st[jj] *= dstate[tk * 16 + q * 4 + jj];
            st = mma_nt_x(st, KbT + tk * 16 * C::LT, C::LT, VT + tv * 16 * C::LT, C::LT, 64, lane, 0, (tv * 2 + (r >> 3)) & 7);
        }
        lds_barrier();
        if (!state_only) { u32x2 o; o.x = pk2(st[0], st[1]); o.y = pk2(st[2], st[3]); *(LAS u32x2*)(StT + (tv * 16 + r) * C::LQ + tk * 16 + q * 4) = o; }
    }
    if (state_only) {
        float* sp = segst + (size_t)((seq * 8 + seg) * 24 + kidx) * 8256;
#pragma unroll
        for (int jj = 0; jj < 4; ++jj) sp[jj * 512 + tid] = st[jj];
        if (lane == 0) {
#pragma unroll
            for (int kk = 0; kk < 4; ++kk) sp[8192 + 4 * w + kk] = blsum[kk];
        }
    }
#undef GLA_LOAD
}

constexpr int RL = 72;
struct RwRaw { u32x4 e, kk, bb, kd, rr, v; };
__device__ __forceinline__ void rwkv_pre_load(RwRaw& R, const MixBufs& B, int L, int u, int tid) {
    const int w = tid >> 6, lane = tid & 63, nch = L / 64, hd = u & 7, ch = u >> 3, h = hd >> 1, d = hd & 1;
    const int base = (ch / nch) * L, n0 = (ch % nch) * 64;
    const int tl = d == 0 ? base + n0 + lane : base + L - 1 - (n0 + lane);
    const size_t o = (size_t)tl * 256 + h * 64 + 8 * w;
    R.e = *(const u32x4*)(B.rw + (4 + d) * RWA + o); R.kk = *(const u32x4*)(B.rw + 2 * RWA + o);
    R.bb = *(const u32x4*)(B.rw + (8 + d) * RWA + o); R.kd = *(const u32x4*)(B.rw + (6 + d) * RWA + o);
    R.rr = *(const u32x4*)(B.rw + 0 * RWA + o);
    const int row = tid >> 3, part = tid & 7;
    const int tr = d == 0 ? base + n0 + row : base + L - 1 - (n0 + row);
    R.v = *(const u32x4*)(B.rw + 1 * RWA + (size_t)tr * 256 + h * 64 + part * 8);
}
__device__ __forceinline__ void rwkv_pre(LAS unsigned char* lds, const MixBufs& B, bf16_t* rq, int L, int u, int unext, RwRaw& R) {
    const int tid = otid(), w = tid >> 6, lane = tid & 63, r = lane & 15, q = lane >> 4;
#define RG(i) ((LAS bf16_t*)(lds + (i) * 9216))
    LAS bf16_t* At = RG(0); LAS bf16_t* Bt_ = RG(1); LAS bf16_t* Kt = RG(2); LAS bf16_t* Rt = RG(3); LAS bf16_t* AtT = RG(4); LAS bf16_t* BhT = RG(5);
    LAS bf16_t* KhT = RG(6); LAS bf16_t* VT = RG(7); LAS bf16_t* Lak = RG(8); LAS bf16_t* Mrb = RG(9); LAS bf16_t* Mrk = RG(10); LAS bf16_t* WT = RG(11);
    LAS bf16_t* Tm = RG(0); LAS bf16_t* XT = RG(1); LAS bf16_t* UT = RG(2);
#undef RG
    LAS float* Lf = (LAS float*)(lds + 12 * 9216);
    LAS float* gC = (LAS float*)(lds + 12 * 9216 + 17408);
    LAS bf16_t* L21b = (LAS bf16_t*)(lds + 12 * 9216 + 17408 + 512);
    LAS bf16_t* T11T = WT;
    LAS bf16_t* X1T = WT + 32 * 40;
    const int nch = L / 64, hd = u & 7, ch = u >> 3, h = hd >> 1, d = hd & 1, seq = ch / nch, c = ch % nch;
    const int base = seq * L, n0 = c * 64;
    const int cu = (((seq * nch + c) * 4 + h) * 2 + d);
    bf16_t* gq = rq + (size_t)cu * 3 * 4096;
    lds_barrier();
    {
        float e[8], kk[8], bb[8], kd[8], rr[8];
        unpack8(R.e, e); unpack8(R.kk, kk); unpack8(R.bb, bb); unpack8(R.kd, kd); unpack8(R.rr, rr);
        float at[8], bt[8], kt[8], rt[8];
#pragma unroll
        for (int j = 0; j < 8; ++j) {
            const float cum = wave_incl_scan(e[j], lane);
            const float cmid = lane_bcast(cum, 31), clast = lane_bcast(cum, 63);
            const float ea = __expf(-(cum - e[j] - cmid)), eb = __expf(cum - cmid), er = __expf(-(cum - cmid)), eh = __expf(-(clast - cum));
            at[j] = -kk[j] * ea; bt[j] = bb[j] * eb; kt[j] = kd[j] * eb; rt[j] = rr[j] * er;
            AtT[(8 * w + j) * RL + lane] = (bf16_t)f2bf(at[j]);
            BhT[(8 * w + j) * RL + lane] = (bf16_t)f2bf(bb[j] * eh);
            KhT[(8 * w + j) * RL + lane] = (bf16_t)f2bf(kd[j] * eh);
            if (lane == 63) { gC[8 * w + j] = __expf(-clast); gC[64 + 8 * w + j] = __expf(-cmid); }
        }
        u32x4 o4;
        o4.x = pk2(at[0], at[1]); o4.y = pk2(at[2], at[3]); o4.z = pk2(at[4], at[5]); o4.w = pk2(at[6], at[7]); *(LAS u32x4*)(At + lane * RL + 8 * w) = o4;
        o4.x = pk2(bt[0], bt[1]); o4.y = pk2(bt[2], bt[3]); o4.z = pk2(bt[4], bt[5]); o4.w = pk2(bt[6], bt[7]); *(LAS u32x4*)(Bt_ + lane * RL + 8 * w) = o4;
        o4.x = pk2(kt[0], kt[1]); o4.y = pk2(kt[2], kt[3]); o4.z = pk2(kt[4], kt[5]); o4.w = pk2(kt[6], kt[7]); *(LAS u32x4*)(Kt + lane * RL + 8 * w) = o4;
        o4.x = pk2(rt[0], rt[1]); o4.y = pk2(rt[2], rt[3]); o4.z = pk2(rt[4], rt[5]); o4.w = pk2(rt[6], rt[7]); *(LAS u32x4*)(Rt + lane * RL + 8 * w) = o4;
        const int row = tid >> 3, part = tid & 7;
        const unsigned xs[4] = {R.v.x, R.v.y, R.v.z, R.v.w};
#pragma unroll
        for (int j = 0; j < 4; ++j) { VT[(part * 8 + 2 * j) * RL + row] = (bf16_t)(xs[j] & 0xffffu); VT[(part * 8 + 2 * j + 1) * RL + row] = (bf16_t)(xs[j] >> 16); }
    }
    if (unext >= 0) rwkv_pre_load(R, B, L, unext, tid);
    lds_barrier();
    const int tm = w >> 1, tn0 = (w & 1) * 2;
    const f32x4 Z4 = (f32x4){0.f, 0.f, 0.f, 0.f};
#pragma unroll
    for (int tt = 0; tt < 2; ++tt) {
        const int tn = tn0 + tt;
        const f32x4 lab = mma_tn_x(Z4, At + tm * 16 * RL, RL, Bt_ + tn * 16 * RL, RL, 64, lane, 0, 0);
        const f32x4 lak = mma_tn_x(Z4, At + tm * 16 * RL, RL, Kt + tn * 16 * RL, RL, 64, lane, 0, 0);
        const f32x4 mrb = mma_tn_x(Z4, Rt + tm * 16 * RL, RL, Bt_ + tn * 16 * RL, RL, 64, lane, 0, 0);
        const f32x4 mrk = mma_tn_x(Z4, Rt + tm * 16 * RL, RL, Kt + tn * 16 * RL, RL, 64, lane, 0, 0);
        const int i = tm * 16 + r, j0 = tn * 16 + q * 4;
        f32x4 lf; float vk[4], vb[4], vm[4];
#pragma unroll
        for (int jj = 0; jj < 4; ++jj) {
            const int j = j0 + jj; const bool st_ = j < i, in_ = j <= i;
            lf[jj] = st_ ? lab[jj] : 0.f; vk[jj] = st_ ? lak[jj] : 0.f; vb[jj] = in_ ? mrb[jj] : 0.f; vm[jj] = in_ ? mrk[jj] : 0.f;
        }
        *(LAS f32x4*)(Lf + i * 68 + j0) = lf;
        u32x2 o;
        if (tm >= 2 && tn < 2) { o.x = pk2(lab[0], lab[1]); o.y = pk2(lab[2], lab[3]); *(LAS u32x2*)(L21b + (i - 32) * 40 + j0) = o; }
        o.x = pk2(vk[0], vk[1]); o.y = pk2(vk[2], vk[3]); *(LAS u32x2*)(Lak + i * RL + j0) = o;
        o.x = pk2(vb[0], vb[1]); o.y = pk2(vb[2], vb[3]); *(LAS u32x2*)(Mrb + i * RL + j0) = o;
        o.x = pk2(vm[0], vm[1]); o.y = pk2(vm[2], vm[3]); *(LAS u32x2*)(Mrk + i * RL + j0) = o;
    }
    lds_barrier();
#pragma unroll
    for (int tt = 0; tt < 2; ++tt) {
        const int tn = tn0 + tt;
        const f32x4 x = mma_nt(Z4, Lak + tm * 16 * RL, RL, VT + tn * 16 * RL, RL, 64, lane);
        u32x2 o; o.x = pk2(x[0], x[1]); o.y = pk2(x[2], x[3]);
        *(LAS u32x2*)(XT + (tn * 16 + r) * RL + tm * 16 + q * 4) = o;
    }
    if (w < 2) {
        const int ob = w * 32, j = lane & 31;
        float T[32];
        int zv = 0; asm volatile("" : "+v"(zv));
        const LAS float* Lfz = Lf + zv + ob * 68 + ob;
#pragma unroll
        for (int t = 0; t < 32; ++t) {
            float a0 = (t == j) ? 1.f : 0.f, a1 = 0.f;
#pragma unroll
            for (int s4 = 0; s4 < (t + 3) / 4; ++s4) {
                const f32x4 l = *(const LAS f32x4*)(Lfz + t * 68 + s4 * 4);
#pragma unroll
                for (int e2 = 0; e2 < 4; ++e2) { const int s_ = s4 * 4 + e2; if (s_ < t) { if (e2 & 1) a1 += l[e2] * T[s_]; else a0 += l[e2] * T[s_]; } }
            }
            T[t] = a0 + a1;
            if (lane < 32) {
                Tm[(ob + t) * RL + ob + j] = (bf16_t)f2bf(T[t]);
                if (w == 0) T11T[j * 40 + t] = (bf16_t)f2bf(T[t]);
            }
        }
    } else if (w == 2) {
        for (int i = lane; i < 32 * 16; i += 64) { const int t = i >> 4, c2 = (i & 15) * 2; *(LAS unsigned*)(Tm + t * RL + 32 + c2) = 0u; }
    }
    lds_barrier();
    if (w < 4) {
        const int mi = w >> 1, ni = w & 1;
        const f32x4 x1 = mma_nt(Z4, L21b + mi * 16 * 40, 40, T11T + ni * 16 * 40, 40, 32, lane);
        u32x2 o; o.x = pk2(x1[0], x1[1]); o.y = pk2(x1[2], x1[3]);
        *(LAS u32x2*)(X1T + (ni * 16 + r) * 40 + mi * 16 + q * 4) = o;
    }
    lds_barrier();
    if (w < 4) {
        const int mi = w >> 1, ni = w & 1;
        const f32x4 t21 = mma_tn_x(Z4, Tm + (32 + mi * 16) * RL + 32, RL, X1T + ni * 16 * 40, 40, 32, lane, 0, 0);
        u32x2 o; o.x = pk2(t21[0], t21[1]); o.y = pk2(t21[2], t21[3]);
        *(LAS u32x2*)(Tm + (32 + mi * 16 + r) * RL + ni * 16 + q * 4) = o;
    }
    lds_barrier();
    f32x4 uu[2], ww[2];
#pragma unroll
    for (int tt = 0; tt < 2; ++tt) {
        const int tn = tn0 + tt;
        uu[tt] = mma_nt(Z4, Tm + tm * 16 * RL, RL, XT + tn * 16 * RL, RL, 64, lane);
        ww[tt] = mma_nt(Z4, Tm + tm * 16 * RL, RL, AtT + tn * 16 * RL, RL, 64, lane);
    }
#pragma unroll
    for (int tt = 0; tt < 2; ++tt) {
        const int tn = tn0 + tt;
        u32x2 o; o.x = pk2(uu[tt][0], uu[tt][1]); o.y = pk2(uu[tt][2], uu[tt][3]);
        *(LAS u32x2*)(UT + (tn * 16 + r) * RL + tm * 16 + q * 4) = o;
        o.x = pk2(ww[tt][0], ww[tt][1]); o.y = pk2(ww[tt][2], ww[tt][3]);
        *(LAS u32x2*)(WT + (tn * 16 + r) * RL + tm * 16 + q * 4) = o;
    }
    lds_barrier();
    bf16_t* yout = B.rw_y + (size_t)d * TG * 256;
#pragma unroll
    for (int tt = 0; tt < 2; ++tt) {
        const int tn = tn0 + tt;
        const f32x4 qe = mma_tn_x(Z4, Mrb + tm * 16 * RL, RL, WT + tn * 16 * RL, RL, 64, lane, 0, 0);
        f32x4 yl = mma_tn_x(Z4, Mrb + tm * 16 * RL, RL, UT + tn * 16 * RL, RL, 64, lane, 0, 0);
        yl = mma_tn_x(yl, Mrk + tm * 16 * RL, RL, VT + tn * 16 * RL, RL, 64, lane, 0, 0);
        const f32x4 pe = mma_tn_x(Z4, BhT + tm * 16 * RL, RL, WT + tn * 16 * RL, RL, 64, lane, 0, 0);
        f32x4 hl = mma_nt(Z4, BhT + tm * 16 * RL, RL, UT + tn * 16 * RL, RL, 64, lane);
        hl = mma_nt(hl, KhT + tm * 16 * RL, RL, VT + tn * 16 * RL, RL, 64, lane);
        const int i = tm * 16 + r, n0c = tn * 16 + q * 4;
        const f32x4 um = *(const LAS f32x4*)(gC + 64 + n0c);
        const u32x2 rtp = *(const LAS u32x2*)(Rt + i * RL + n0c);
        const float rt4[4] = {__uint_as_float(rtp.x << 16), __uint_as_float(rtp.x & 0xffff0000u), __uint_as_float(rtp.y << 16), __uint_as_float(rtp.y & 0xffff0000u)};
        const float gci = gC[i];
        float qv[4], pv[4];
#pragma unroll
        for (int jj = 0; jj < 4; ++jj) { qv[jj] = (qe[jj] + rt4[jj]) * um[jj]; pv[jj] = pe[jj] * um[jj] + ((n0c + jj) == i ? gci : 0.f); }
        u32x2 o; o.x = pk2(qv[0], qv[1]); o.y = pk2(qv[2], qv[3]); *(u32x2*)(gq + i * 64 + n0c) = o;
        o.x = pk2(pv[0], pv[1]); o.y = pk2(pv[2], pv[3]); *(u32x2*)(gq + 4096 + i * 64 + n0c) = o;
        const int tl = d == 0 ? base + n0 + i : base + L - 1 - (n0 + i);
        o.x = pk2(yl[0], yl[1]); o.y = pk2(yl[2], yl[3]); *(u32x2*)(yout + (size_t)tl * 256 + h * 64 + n0c) = o;
        o.x = pk2(hl[0], hl[1]); o.y = pk2(hl[2], hl[3]);
        *(u32x2*)(gq + 8192 + (tn * 16 + r) * 64 + tm * 16 + q * 4) = o;
    }
}

__device__ __forceinline__ void rwkv_seq(LAS unsigned char* lds, const MixBufs& B, const bf16_t* rq, int L, int seq, int h, int d) {
    const int tid = otid(), w = tid >> 6, lane = tid & 63, r = lane & 15, q = lane >> 4;
    const int tm = w >> 1, tn0 = (w & 1) * 2;
    const int base = seq * L, nch = L / 64;
    __syncthreads();
    for (int i = tid; i < 64 * RL / 2; i += 512) ((LAS unsigned*)lds)[i] = 0u;
    bf16_t* yout = B.rw_y + (size_t)d * TG * 256;
    const size_t custride = (size_t)8 * 3 * 4096;
    const bf16_t* g = rq + (size_t)(((seq * nch) * 4 + h) * 2 + d) * 3 * 4096;
    const int aoff = (tm * 16 + r) * 64 + q * 8;
    bf16x8 qa0 = *(const bf16x8*)(g + aoff), qa1 = *(const bf16x8*)(g + aoff + 32);
    bf16x8 pa0 = *(const bf16x8*)(g + 4096 + aoff), pa1 = *(const bf16x8*)(g + 4096 + aoff + 32);
    u32x2 hl0 = *(const u32x2*)(g + 8192 + (tn0 * 16 + r) * 64 + tm * 16 + q * 4), hl1 = *(const u32x2*)(g + 8192 + ((tn0 + 1) * 16 + r) * 64 + tm * 16 + q * 4);
    for (int c = 0; c < nch; ++c) {
        const bf16_t* gn = g + (c + 1 < nch ? custride : 0);
        const bf16x8 nqa0 = *(const bf16x8*)(gn + aoff), nqa1 = *(const bf16x8*)(gn + aoff + 32);
        const bf16x8 npa0 = *(const bf16x8*)(gn + 4096 + aoff), npa1 = *(const bf16x8*)(gn + 4096 + aoff + 32);
        const u32x2 nhl0 = *(const u32x2*)(gn + 8192 + (tn0 * 16 + r) * 64 + tm * 16 + q * 4), nhl1 = *(const u32x2*)(gn + 8192 + ((tn0 + 1) * 16 + r) * 64 + tm * 16 + q * 4);
        u32x2 yl[2];
        const int ti_ = tm * 16 + r;
        bf16_t* yrow = yout + (size_t)(d == 0 ? base + c * 64 + ti_ : base + L - 1 - (c * 64 + ti_)) * 256 + h * 64 + q * 4;
#pragma unroll
        for (int tt = 0; tt < 2; ++tt) yl[tt] = *(const u32x2*)(yrow + (tn0 + tt) * 16);
        lds_barrier();
        const LAS bf16_t* cur = (const LAS bf16_t*)(lds + (c & 1) * 9216);
        LAS bf16_t* nxt = (LAS bf16_t*)(lds + ((c + 1) & 1) * 9216);
#pragma unroll
        for (int tt = 0; tt < 2; ++tt) {
            const int tn = tn0 + tt;
            const bf16x8 b0 = *(const LAS bf16x8*)(cur + (tn * 16 + r) * RL + q * 8), b1 = *(const LAS bf16x8*)(cur + (tn * 16 + r) * RL + 32 + q * 8);
            f32x4 y = (f32x4){0.f, 0.f, 0.f, 0.f}, hn = (f32x4){0.f, 0.f, 0.f, 0.f};
            y = __builtin_amdgcn_mfma_f32_16x16x32_bf16(b0, qa0, y, 0, 0, 0); y = __builtin_amdgcn_mfma_f32_16x16x32_bf16(b1, qa1, y, 0, 0, 0);
            hn = __builtin_amdgcn_mfma_f32_16x16x32_bf16(pa0, b0, hn, 0, 0, 0); hn = __builtin_amdgcn_mfma_f32_16x16x32_bf16(pa1, b1, hn, 0, 0, 0);
            const u32x2 hl = tt == 0 ? hl0 : hl1;
            hn[0] += __uint_as_float(hl.x << 16); hn[1] += __uint_as_float(hl.x & 0xffff0000u); hn[2] += __uint_as_float(hl.y << 16); hn[3] += __uint_as_float(hl.y & 0xffff0000u);
            u32x2 o; o.x = pk2(hn[0], hn[1]); o.y = pk2(hn[2], hn[3]);
            *(LAS u32x2*)(nxt + (tn * 16 + r) * RL + tm * 16 + q * 4) = o;
            { const u32x2 yo = yl[tt];
              y[0] += __uint_as_float(yo.x << 16); y[1] += __uint_as_float(yo.x & 0xffff0000u); y[2] += __uint_as_float(yo.y << 16); y[3] += __uint_as_float(yo.y & 0xffff0000u);
              u32x2 o2; o2.x = pk2(y[0], y[1]); o2.y = pk2(y[2], y[3]); *(u32x2*)(yrow + tn * 16) = o2; }
        }
        g = gn; qa0 = nqa0; qa1 = nqa1; pa0 = npa0; pa1 = npa1; hl0 = nhl0; hl1 = nhl1;
    }
}

__device__ __forceinline__ void phase_post(const Params& P, const MixBufs& B, int layer) {
    const int tid_ = otid(); const int lane = tid_ & 63, gw = blockIdx.x * 8 + (tid_ >> 6), nw = gridDim.x * 8;
    const float gng = P.in[7][layer * 64 + lane];
    const float* ssdn = P.in[24] + layer * 512;
    float lng[4], lnb[4];
#pragma unroll
    for (int h = 0; h < 4; ++h) { lng[h] = P.in[17][layer * 256 + h * 64 + lane]; lnb[h] = P.in[18][layer * 256 + h * 64 + lane]; }
    const int c0 = lane * 8;
    const f32x4 sg0 = *(const f32x4*)(ssdn + c0), sg1 = *(const f32x4*)(ssdn + c0 + 4);
    const float Dh = P.in[23][layer * 8 + (lane >> 3)];
    for (int tl = gw; tl < TG; tl += nw) {
        const bf16_t* pr = B.p + (size_t)tl * DINP;
        bf16_t* mr = B.mix + (size_t)tl * DM;
        bf16_t go0[4], go1[4], ry0[4], ry1[4]; bf16_t ggt[4], rvv[4], rgg[4];
#pragma unroll
        for (int h = 0; h < 4; ++h) {
            const size_t o = (size_t)tl * 256 + h * 64 + lane;
            go0[h] = B.gla_o[o]; go1[h] = B.gla_o[(size_t)TG * 256 + o]; ggt[h] = pr[PC_GG + h * 64 + lane];
            ry0[h] = B.rw_y[o]; ry1[h] = B.rw_y[(size_t)TG * 256 + o]; rvv[h] = B.rw[1 * RWA + o]; rgg[h] = B.rw[3 * RWA + o];
        }
        const f32x4 srk = *(const f32x4*)(B.rw_s + (size_t)tl * 4), skr = *(const f32x4*)(B.rw_s + (size_t)TG * 4 + (size_t)tl * 4);
        const u32x4 ya = *(const u32x4*)(B.ssd_y + (size_t)tl * 512 + c0), yb = *(const u32x4*)(B.ssd_y + (size_t)TG * 512 + (size_t)tl * 512 + c0);
        const u32x4 xsr = *(const u32x4*)(B.ssd_x + (size_t)tl * 1024 + c0), zr = *(const u32x4*)(pr + PC_Z + c0);
#pragma unroll
        for (int h = 0; h < 4; ++h) {
            const float o = bf2f(go0[h]) + bf2f(go1[h]);
            const float ms = wave_sum(o * o) * (1.0f / 64.0f);
            mr[h * 64 + lane] = (bf16_t)f2bf(o * rsqrtf(ms + EPS) * gng * silu(bf2f(ggt[h])));
        }
#pragma unroll
        for (int h = 0; h < 4; ++h) {
            const float v = bf2f(rvv[h]);
            const float y = bf2f(ry0[h]) + bf2f(ry1[h]) - v * skr[h];
            const float mean = wave_sum(y) * (1.0f / 64.0f);
            const float dv = y - mean; const float var = wave_sum(dv * dv) * (1.0f / 64.0f);
            float oo = dv * rsqrtf(var + 64e-5f) * lng[h] + lnb[h];
            oo += srk[h] * v;
            mr[256 + h * 64 + lane] = (bf16_t)f2bf(oo * bf2f(rgg[h]));
        }
        {
            float xs[8], z[8], yfa[8], yfb[8]; unpack8(xsr, xs); unpack8(zr, z); unpack8(ya, yfa); unpack8(yb, yfb);
            float yv[8]; float ss = 0.f;
#pragma unroll
            for (int j = 0; j < 8; ++j) { const float yy = (yfa[j] + yfb[j]) + Dh * xs[j]; yv[j] = yy * silu(z[j]); ss += yv[j] * yv[j]; }
            ss = wave_sum(ss);
            const float rs = rsqrtf(ss * (1.0f / 512.0f) + EPS);
            u32x4 o; o.x = pk2(yv[0] * rs * sg0[0], yv[1] * rs * sg0[1]); o.y = pk2(yv[2] * rs * sg0[2], yv[3] * rs * sg0[3]);
            o.z = pk2(yv[4] * rs * sg1[0], yv[5] * rs * sg1[1]); o.w = pk2(yv[6] * rs * sg1[2], yv[7] * rs * sg1[3]);
            *(u32x4*)(mr + 512 + c0) = o;
        }
    }
}

__global__ void __launch_bounds__(512, 2) fwd_megakernel(Params P) {
    extern __shared__ __attribute__((aligned(16))) unsigned char shm[];
    LAS unsigned char* lds = (LAS unsigned char*)shm;
    unsigned char* ws = P.ws;
    volatile LAS unsigned* bst = (volatile LAS unsigned*)(lds + 131072 + 1024);
    if (threadIdx.x == 0) { bst[0] = 0u; bst[1] = 0u; }
    __syncthreads();
    const XcdBarrier xbar = xcd_barrier_post((unsigned*)(ws + WS_CTL), bst);
    bf16_t* xb = (bf16_t*)(ws + WS_XB); float* ssp = (float*)(ws + WS_SSP); bf16_t* pbuf = (bf16_t*)(ws + WS_P);

    phase_weights(lds, P);
    for (int g = 0; g < NGROUP; ++g) {
        const int L = g < 2 ? 2048 : 16384, nseq = TG / L;
        phase_xprep(P, g);
        if (g == 0) cg::this_grid().sync(); else xcd_barrier(xbar);
        for (int layer = 0; layer < 2; ++layer) {
            pg8::StaticOrder S;
            {
                pg8::Gemm gm; gm.A = xb; gm.Bt = (const bf16_t*)(ws + WS_WIN) + (size_t)layer * DINP * DM; gm.M = TG; gm.N = DINP; gm.K = DM;
                S.init(TG, DINP, gridDim.x, blockIdx.x);
                EpiInproj E; E.O = pbuf; E.ssp = ssp;
                pg8::gemm_phase(lds, gm, S, E);
            }
            xcd_barrier(xbar);
            { const MixBufs B = mixbufs(P); const bf16_t* sw = (const bf16_t*)(ws + WS_SW) + (size_t)layer * SW_L;
              for (int t = blockIdx.x; t < TG / 64; t += gridDim.x) prep_tile64(lds, P, B, sw, layer, L, t); }
            xcd_barrier(xbar);
            {
                const MixBufs B = mixbufs(P);
                bf16_t* rq = (bf16_t*)(ws + WS_RWQ); float* segst = P.out + (size_t)g * TG * DM;
                const int nseg = L / 2048, nch = L / 64;
                const int nchain = nseg == 1 ? nseq * 24 : nseq * (nseg - 1) * 24;
                if (nseg == 1 && gridDim.x == 256) {
                    const int b = blockIdx.x;
                    ssd_unit(lds, P, B, segst, layer, L, b / 24 * 0 + (b >> 4), (b >> 1) & 7, b & 1, 0, false);
                    const int p0 = b * 16, pn = 16;
                    __syncthreads();
                    RwRaw R; rwkv_pre_load(R, B, L, p0, otid());
                    for (int u = p0; u < p0 + pn; ++u) rwkv_pre(lds, B, rq, L, u, u + 1 < p0 + pn ? u + 1 : -1, R);
                } else if (nseg == 8 && nseq == 2 && gridDim.x == 256) {
                    const int b = blockIdx.x;
                    for (int rep = 0; rep < 2; ++rep) {
                        const int it = b + rep * 256;
                        if (it < nchain) {
                            const int k = it % 24, sg = it / 24, seq = sg / (nseg - 1), seg = sg % (nseg - 1);
                            if (k < 16) ssd_unit(lds, P, B, segst, layer, L, seq, k >> 1, k & 1, seg, true);
                            else gla_unit(lds, P, B, segst, layer, L, seq, (k - 16) >> 1, k & 1, seg, true);
                        }
                    }
                    const int kx = b - 80;
                    const int p0 = b < 80 ? b * 9 : 720 + kx * 19 + (kx < 32 ? kx : 32), pn = b < 80 ? 9 : 19 + (kx < 32 ? 1 : 0);
                    __syncthreads();
                    RwRaw R; rwkv_pre_load(R, B, L, p0, otid());
                    for (int u = p0; u < p0 + pn; ++u) rwkv_pre(lds, B, rq, L, u, u + 1 < p0 + pn ? u + 1 : -1, R);
                } else
                for (int it = blockIdx.x; it < nchain + 4096; it += gridDim.x) {
                    if (it < nchain) {
                        const int k = it % 24, sg = it / 24, seq = nseg == 1 ? sg : sg / (nseg - 1), seg = nseg == 1 ? 0 : sg % (nseg - 1);
                        if (k < 16) ssd_unit(lds, P, B, segst, layer, L, seq, k >> 1, k & 1, seg, nseg > 1);
                        else gla_unit(lds, P, B, segst, layer, L, seq, (k - 16) >> 1, k & 1, seg, nseg > 1);
                    } else { const int u = it - nchain; __syncthreads(); RwRaw R; rwkv_pre_load(R, B, L, u, otid()); rwkv_pre(lds, B, rq, L, u, -1, R); }
                }
            }
            xcd_barrier(xbar);
            {
                const MixBufs B = mixbufs(P);
                const bf16_t* rq = (const bf16_t*)(ws + WS_RWQ); float* segst = P.out + (size_t)g * TG * DM;
                const int nseg = L / 2048;
                const int nchain = nseg == 1 ? 0 : nseq * nseg * 24;
                const int nrs = nseq * 8, G = gridDim.x;
                if (nseg == 1 && G == 256) {
                    const int b = blockIdx.x;
                    if (b < 128) rwkv_seq(lds, B, rq, L, b >> 3, (b >> 1) & 3, b & 1);
                    else { const int u = b - 128; gla_unit(lds, P, B, segst, layer, L, u >> 3, (u >> 1) & 3, u & 1, 0, false); }
                } else
                for (int rnd = 0; rnd * G < nchain + nrs; ++rnd) {
                    const int it = rnd * G + ((rnd & 1) ? (G - 1 - (int)blockIdx.x) : (int)blockIdx.x);
                    if (it >= nchain + nrs) continue;
                    if (it >= nrs) {
                        const int ci = it - nrs, k = ci % 24, sg = ci / 24, seq = sg / nseg, seg = sg % nseg;
                        if (k < 16) ssd_unit(lds, P, B, segst, layer, L, seq, k >> 1, k & 1, seg, false);
                        else gla_unit(lds, P, B, segst, layer, L, seq, (k - 16) >> 1, k & 1, seg, false);
                    } else { rwkv_seq(lds, B, rq, L, it >> 3, (it >> 1) & 3, it & 1); }
                }
            }
            xcd_barrier(xbar);
            { const MixBufs B = mixbufs(P); phase_post(P, B, layer); }
            xcd_barrier(xbar);
            {
                pg8::Gemm gm; gm.A = (const bf16_t*)(ws + WS_MIX); gm.Bt = (const bf16_t*)(ws + WS_WOUT) + (size_t)layer * DM * DM; gm.M = TG; gm.N = DM; gm.K = DM;
                S.init(TG, DM, gridDim.x, blockIdx.x);
                EpiResid E; E.XB = xb; E.ssp = ssp;
                pg8::gemm_phase(lds, gm, S, E);
            }
            xcd_barrier(xbar);
            {
                pg8::Gemm gm; gm.A = xb; gm.Bt = (const bf16_t*)(ws + WS_WGU) + (size_t)layer * 2 * DFF * DM; gm.M = TG; gm.N = 2 * DFF; gm.K = DM;
                S.init(TG, 2 * DFF, gridDim.x, blockIdx.x);
                EpiGateUp E; E.O = pbuf; E.ssp = ssp;
                pg8::gemm_phase(lds, gm, S, E);
            }
            xcd_barrier(xbar);
            {
                pg8::Gemm gm; gm.A = pbuf; gm.Bt = (const bf16_t*)(ws + WS_WDN) + (size_t)layer * DM * DFF; gm.M = TG; gm.N = DM; gm.K = DFF;
                S.init(TG, DM, gridDim.x, blockIdx.x);
                EpiResid E; E.XB = xb; E.ssp = ssp;
                pg8::gemm_phase(lds, gm, S, E);
            }
            xcd_barrier(xbar);
        }
        phase_final(P, g);
        xcd_barrier(xbar);
    }
}

extern "C" void kernel_launch(void* const* d_in, const int* in_sizes, int n_in, void* d_out, int out_size, void* d_ws, size_t ws_size, hipStream_t stream) {
    static int grid = 0;
    if (grid == 0) {
        if (n_in != 30 || ws_size < WS_END) { fprintf(stderr, "kernel_launch: need 30 inputs and %zu ws bytes; got %d, %zu\n", (size_t)WS_END, n_in, ws_size); grid = -1; return; }
        int dev = 0, cus = 0, per_cu = 0;
        hipGetDevice(&dev);
        hipDeviceGetAttribute(&cus, hipDeviceAttributeMultiprocessorCount, dev);
        hipFuncSetAttribute((const void*)fwd_megakernel, hipFuncAttributeMaxDynamicSharedMemorySize, LDS_BYTES);
        hipOccupancyMaxActiveBlocksPerMultiprocessor(&per_cu, (const void*)fwd_megakernel, 512, LDS_BYTES);
        if (per_cu < 1) per_cu = 1;
        grid = cus * 1;
        if (grid > 256) grid = 256;
    }
    if (grid < 0) return;
    if (hipMemsetAsync((char*)d_ws + WS_CTL, 0, 65536, stream) != hipSuccess) { fprintf(stderr, "memset failed\n"); return; }
    Params p{};
    for (int i = 0; i < 30; ++i) p.in[i] = (const float*)d_in[i];
    p.out = (float*)d_out; p.ws = (unsigned char*)d_ws;
    void* args[] = {&p};
    hipError_t e = hipLaunchCooperativeKernel((const void*)fwd_megakernel, dim3(grid), dim3(512), args, LDS_BYTES, stream);
    if (e != hipSuccess) fprintf(stderr, "cooperative launch failed: %s (grid %d)\n", hipGetErrorString(e), grid);
}
```

```cpp
#include <hip/hip_runtime.h>
#include <hip/hip_cooperative_groups.h>
#include <cstdio>
namespace cg = cooperative_groups;

#define LAS __attribute__((address_space(3)))
typedef unsigned short bf16_t;
typedef short bf16x8 __attribute__((ext_vector_type(8)));
typedef float f32x4 __attribute__((ext_vector_type(4)));
typedef float f32x2 __attribute__((ext_vector_type(2)));
typedef unsigned u32x4 __attribute__((ext_vector_type(4)));
typedef unsigned u32x2 __attribute__((ext_vector_type(2)));

constexpr int DM = 1024, TALL = 98304, TG = 32768, NGROUP = 3;
constexpr int DINP = 3584, DIN = 3504, DFF = 2816;
constexpr int LDS_BYTES = 131072 + 2048;
constexpr float EPS = 1e-6f;
constexpr int PC_GQ = 0, PC_GK = 128, PC_GV = 256, PC_GG = 512, PC_GAF = 768;
constexpr int PC_R = 800, PC_RK = 1056, PC_RV = 1312, PC_RLOW = 1568;
constexpr int PC_Z = 1952, PC_XBC = 2464, PC_DT = 3488;

constexpr size_t WS_CTL = 0;
constexpr size_t WS_SW = 65536;
constexpr int SW_L = 106496;
constexpr size_t WS_WIN = WS_SW + 524288;
constexpr size_t WS_WOUT = WS_WIN + (size_t)2 * DINP * DM * 2;
constexpr size_t WS_WGU = WS_WOUT + (size_t)2 * DM * DM * 2;
constexpr size_t WS_WDN = WS_WGU + (size_t)2 * 2 * DFF * DM * 2;
constexpr size_t WS_XB = WS_WDN + (size_t)2 * DM * DFF * 2;
constexpr size_t WS_P = WS_XB + (size_t)TG * DM * 2;
constexpr size_t WS_MIX = WS_P + (size_t)TG * DINP * 2;
constexpr size_t WS_SSP = WS_MIX + (size_t)TG * DM * 2;
constexpr size_t WS_GLA_LA = WS_SSP + (size_t)TG * 16 * 4;
constexpr size_t WS_GLA_O = WS_GLA_LA + (size_t)2 * TG * 128 * 4;
constexpr size_t WS_RW = WS_GLA_O + (size_t)2 * TG * 256 * 4;
constexpr size_t WS_RW_S = WS_RW + (size_t)10 * TG * 256 * 2;
constexpr size_t WS_RW_Y = WS_RW_S + (size_t)2 * TG * 4 * 4;
constexpr size_t WS_SSD_X = WS_RW_Y + (size_t)2 * TG * 256 * 4;
constexpr size_t WS_SSD_DT = WS_SSD_X + (size_t)TG * 1024 * 2;
constexpr size_t WS_SSD_Y = WS_SSD_DT + (size_t)TG * 16 * 4;
constexpr size_t WS_RWQ = WS_SSD_Y + (size_t)2 * TG * 512 * 4;
constexpr size_t WS_END = WS_RWQ + (size_t)4096 * 3 * 4096 * 2;
static_assert(WS_END <= ((size_t)1 << 30), "workspace over 1 GiB");

struct Params { const float* in[30]; float* out; unsigned char* ws; };

__device__ __forceinline__ int otid() { int t = threadIdx.x; asm volatile("" : "+v"(t)); return t; }
__device__ __forceinline__ float bf2f(bf16_t b) { return __uint_as_float(((unsigned)b) << 16); }
typedef __bf16 bf16x2_t __attribute__((ext_vector_type(2)));
__device__ __forceinline__ unsigned pk2(float lo, float hi) { f32x2 f = {lo, hi}; bf16x2_t v = __builtin_convertvector(f, bf16x2_t); return __builtin_bit_cast(unsigned, v); }
__device__ __forceinline__ unsigned f2bf(float f) { return (unsigned)__builtin_bit_cast(unsigned short, (__bf16)f); }
__device__ __forceinline__ float sigm(float x) { return __builtin_amdgcn_rcpf(1.0f + __expf(-x)); }
__device__ __forceinline__ float silu(float x) { return x * __builtin_amdgcn_rcpf(1.0f + __expf(-x)); }
__device__ __forceinline__ float softplus(float x) { return fmaxf(x, 0.f) + __logf(1.0f + __expf(-fabsf(x))); }
__device__ __forceinline__ void lds_barrier() { asm volatile("s_waitcnt lgkmcnt(0)" ::: "memory"); __builtin_amdgcn_s_barrier(); asm volatile("" ::: "memory"); }

__device__ __forceinline__ float dpp_add(float v, float src_carrier) { return v + src_carrier; }
#define DPPF(x, ctrl, rmask) __int_as_float(__builtin_amdgcn_update_dpp(0, __float_as_int(x), (ctrl), (rmask), 0xf, false))
__device__ __forceinline__ float wave_incl_scan(float v, int lane) {
    v += DPPF(v, 0x111, 0xf);
    v += DPPF(v, 0x112, 0xf);
    v += DPPF(v, 0x114, 0xf);
    v += DPPF(v, 0x118, 0xf);
    v += DPPF(v, 0x142, 0xa);
    v += DPPF(v, 0x143, 0xc);
    return v;
}
__device__ __forceinline__ float lane_bcast(float v, int l) { return __int_as_float(__builtin_amdgcn_readlane(__float_as_int(v), l)); }
__device__ __forceinline__ float wave_sum(float v) { return lane_bcast(wave_incl_scan(v, 0), 63); }
__device__ __forceinline__ void unpack8(u32x4 v, float* f) {
    f[0] = __uint_as_float(v.x << 16); f[1] = __uint_as_float(v.x & 0xffff0000u);
    f[2] = __uint_as_float(v.y << 16); f[3] = __uint_as_float(v.y & 0xffff0000u);
    f[4] = __uint_as_float(v.z << 16); f[5] = __uint_as_float(v.z & 0xffff0000u);
    f[6] = __uint_as_float(v.w << 16); f[7] = __uint_as_float(v.w & 0xffff0000u);
}


#define XB_TMO      128
#define XB_XCNT(j)  (256  + 64 * (j))
#define XB_XSUB(j)  (1280 + 64 * (j))
#define XB_XGEN(j)  (2304 + 64 * (j))
#define XB_TOP      3328
#define XB_TOPGEN   3392
#define XB_SPIN_CAP (1u << 22)
__device__ __forceinline__ unsigned xb_ld(unsigned* p)              { return __hip_atomic_load(p, __ATOMIC_RELAXED, __HIP_MEMORY_SCOPE_AGENT); }
__device__ __forceinline__ unsigned xb_add(unsigned* p, unsigned v) { return __hip_atomic_fetch_add(p, v, __ATOMIC_RELAXED, __HIP_MEMORY_SCOPE_AGENT); }
__device__ __forceinline__ unsigned xb_xcc_id() { return (unsigned)__builtin_amdgcn_s_getreg((3 << 11) | 20) & 0xFu; }
#define XB_SPIN(cond, bar) do { unsigned _sp = 0; while (cond) { __builtin_amdgcn_s_sleep(1); \
    if ((++_sp & 255u) == 0u) { if (xb_ld(&(bar)[XB_TMO])) break; if (_sp > XB_SPIN_CAP) { atomicAdd(&(bar)[XB_TMO], 1u); break; } } } } while (0)
struct XcdBarrier { unsigned* bar; unsigned x; volatile LAS unsigned* st; };
__device__ __forceinline__ XcdBarrier xcd_barrier_post(unsigned* bar, volatile LAS unsigned* st) {
    XcdBarrier b; b.bar = bar; b.x = xb_xcc_id(); b.st = st;
    if (threadIdx.x == 0) (void)xb_add(&bar[XB_XCNT(b.x)], 1u);
    return b;
}
__device__ __forceinline__ void xcd_barrier_complete(unsigned* bar, unsigned x, unsigned& nloc, unsigned& nx) {
    const unsigned G = gridDim.x * gridDim.y * gridDim.z;
    unsigned sum, cnt, mine, sp = 0u;
    for (;;) {
        sum = 0u; cnt = 0u; mine = 0u;
#pragma unroll
        for (unsigned j = 0; j < 16; ++j) { const unsigned c = xb_ld(&bar[XB_XCNT(j)]); sum += c; cnt += (c > 0u) ? 1u : 0u; mine = (j == x) ? c : mine; }
        if (sum == G) break;
        __builtin_amdgcn_s_sleep(1);
        if ((++sp & 255u) == 0u) { if (xb_ld(&bar[XB_TMO])) break; if (sp > XB_SPIN_CAP) { atomicAdd(&bar[XB_TMO], 1u); break; } }
    }
    nloc = mine > 0u ? mine : 1u; nx = cnt > 0u ? cnt : 1u;
}
__device__ __forceinline__ void xcd_barrier(const XcdBarrier& b) {
    asm volatile("s_waitcnt vmcnt(0)" ::: "memory");
    __syncthreads();
    if (threadIdx.x == 0) {
        unsigned* bar = b.bar;
        __builtin_amdgcn_s_waitcnt(0);
        unsigned nloc = b.st[0], nx = b.st[1];
        if (nloc == 0u) { xcd_barrier_complete(bar, b.x, nloc, nx); b.st[0] = nloc; b.st[1] = nx; }
        const unsigned old = xb_add(&bar[XB_XSUB(b.x)], 1u);
        const unsigned gen = old / nloc;
        if (old + 1u == (gen + 1u) * nloc) {
            __builtin_amdgcn_fence(__ATOMIC_RELEASE, "agent");
            asm volatile("s_waitcnt vmcnt(0)" ::: "memory");
            const unsigned og = xb_add(&bar[XB_TOP], 1u);
            const unsigned tg = og / nx;
            if (og + 1u == (tg + 1u) * nx) xb_add(&bar[XB_TOPGEN], 1u);
            else XB_SPIN(xb_ld(&bar[XB_TOPGEN]) == tg, bar);
            __builtin_amdgcn_fence(__ATOMIC_ACQUIRE, "agent");
            xb_add(&bar[XB_XGEN(b.x)], 1u);
            asm volatile("s_waitcnt vmcnt(0)" ::: "memory");
        } else {
            XB_SPIN(xb_ld(&bar[XB_XGEN(b.x)]) == gen, bar);
            __builtin_amdgcn_fence(__ATOMIC_ACQUIRE, "agent");
            asm volatile("s_waitcnt vmcnt(0)" ::: "memory");
        }
    }
    __syncthreads();
}

namespace pg8 {
constexpr int BM = 256, BK = 64, HALF = 128, HTB = HALF * BK * 2, NXCD = 8, WGM = 8;
__device__ __forceinline__ int lds_byte(int r, int c) { const int st = (r >> 4) * 2 + (c >> 5), rr = r & 15, cc = c & 31, ob = rr * 64 + cc * 2; return st * 1024 + (ob ^ (((ob >> 9) & 1) << 5)); }
__device__ __forceinline__ void stage_rc(int b, int& R, int& C) { const int st = b / 1024, sb = b % 1024, swz = sb ^ (((sb >> 9) & 1) << 5); R = (st >> 1) * 16 + swz / 64; C = (st & 1) * 32 + (swz % 64) / 2; }
__device__ __forceinline__ int perm32(int rho) { const int n = rho >> 4, i = rho & 15; return 8 * (i >> 2) + 4 * n + (i & 3); }
struct Unit { int pm, pn; };
struct Gemm { const bf16_t* A; const bf16_t* Bt; int M, N, K; };
struct StaticOrder {
    int nM, nN, nwg, G, c;
    __device__ void init(int M, int N, int G_, int c_) { nM = M / BM; nN = N / BM; nwg = nM * nN; G = G_; c = c_; }
    __device__ bool next(int i, Unit& u) const {
        const long L = (long)i * G + c; if (L >= nwg) return false;
        int wgid = (int)L; { const int q = nwg / NXCD, r = nwg % NXCD, xcd = wgid % NXCD, off = wgid / NXCD; wgid = (xcd < r ? xcd * (q + 1) : r * (q + 1) + (xcd - r) * q) + off; }
        const int nig = WGM * nN, gid = wgid / nig, fm = gid * WGM, gsz = (nM - fm) < WGM ? (nM - fm) : WGM;
        u.pm = fm + ((wgid % nig) % gsz); u.pn = (wgid % nig) / gsz; return true;
    }
};

template <class Epi>
__device__ __forceinline__ void gemm_phase(LAS unsigned char* lds, const Gemm g, const StaticOrder& S, const Epi& E) {
    const int tid = otid(), wid = __builtin_amdgcn_readfirstlane(tid >> 6), lane = tid & 63, wr = wid >> 2, wc = wid & 3, fr = lane & 15, fq = lane >> 4;
    const int K = g.K, nt = K / BK;
    unsigned voffA[2], voffB[2];
#pragma unroll
    for (int i = 0; i < 2; ++i) { int R, C; stage_rc(tid * 16 + i * 8192, R, C); const int Rb = Epi::PERM ? ((R & ~31) + perm32(R & 31)) : R;
        voffA[i] = (unsigned)(R * K + C) * 2u; voffB[i] = (unsigned)(Rb * K + C) * 2u; }
    const size_t kstep = (size_t)(BK * 2);
    const size_t hstep = (size_t)HALF * K * 2;
    const size_t tstep = 2 * hstep;
    const unsigned ldsw = (unsigned)wid * 1024u;
    const int aoff = lds_byte(wr * 64 + fr, fq * 8), boff = lds_byte(wc * 32 + fr, fq * 8);
#define PG8_SA(b, h) (((b) * 2 + (h)) * HTB)
#define PG8_SB(b, h) ((4 + (b) * 2 + (h)) * HTB)
#define PG8_STAGE(bufoff, gbase, voff) do { _Pragma("unroll") for (int _i = 0; _i < 2; ++_i) \
        __builtin_amdgcn_global_load_lds((const unsigned*)((const char*)(gbase) + (voff)[_i]), (LAS unsigned*)(lds + (bufoff) + ldsw + _i * 8192), 16, 0, 0); } while (0)
#define PG8_LDA(dst, b, h) do { _Pragma("unroll") for (int m = 0; m < 4; ++m) _Pragma("unroll") for (int k = 0; k < 2; ++k) dst[m][k] = *(const LAS bf16x8*)(lds + PG8_SA(b, h) + aoff + m * 2048 + k * 1024); } while (0)
#define PG8_LDB(dst, b, h) do { _Pragma("unroll") for (int n = 0; n < 2; ++n) _Pragma("unroll") for (int k = 0; k < 2; ++k) dst[n][k] = *(const LAS bf16x8*)(lds + PG8_SB(b, h) + boff + n * 2048 + k * 1024); } while (0)
#define PG8_MMA(ai, bj, At, Bt) do { __builtin_amdgcn_s_setprio(1); _Pragma("unroll") for (int m = 0; m < 4; ++m) _Pragma("unroll") for (int n = 0; n < 2; ++n) _Pragma("unroll") for (int k = 0; k < 2; ++k) \
        acc[ai][bj][m][n] = __builtin_amdgcn_mfma_f32_16x16x32_bf16(Bt[n][k], At[m][k], acc[ai][bj][m][n], 0, 0, 0); __builtin_amdgcn_s_setprio(0); } while (0)
#define PG8_WAIT_V(n) asm volatile("s_waitcnt vmcnt(" #n ")" ::: "memory")
#define PG8_WAIT_L(n) asm volatile("s_waitcnt lgkmcnt(" #n ")" ::: "memory")
#define PG8_BAR __builtin_amdgcn_s_barrier()
#define PG8_SCHED __builtin_amdgcn_sched_barrier(0)
    Unit cur, nxt; int ui = 0;
    if (!S.next(0, cur)) return;
    f32x4 acc[2][2][4][2];
#pragma unroll
    for (int a = 0; a < 2; ++a)
#pragma unroll
        for (int b = 0; b < 2; ++b)
#pragma unroll
            for (int m = 0; m < 4; ++m)
#pragma unroll
                for (int n = 0; n < 2; ++n) acc[a][b][m][n] = (f32x4){0.f, 0.f, 0.f, 0.f};
    bf16x8 At[4][2], B0[2][2], B1[2][2];
    const char* cA = (const char*)g.A + (size_t)cur.pm * tstep; const char* cB = (const char*)g.Bt + (size_t)cur.pn * tstep;
    PG8_STAGE(PG8_SB(0, 0), cB, voffB); PG8_STAGE(PG8_SA(0, 0), cA, voffA); PG8_STAGE(PG8_SB(0, 1), cB + hstep, voffB); PG8_STAGE(PG8_SA(0, 1), cA + hstep, voffA);
    if (wr == 1) PG8_BAR;
    PG8_WAIT_V(4); PG8_BAR;
    PG8_STAGE(PG8_SB(1, 0), cB + kstep, voffB); PG8_STAGE(PG8_SA(1, 0), cA + kstep, voffA); PG8_STAGE(PG8_SB(1, 1), cB + hstep + kstep, voffB);
    PG8_WAIT_V(6); PG8_BAR;
    for (;;) {
        const bool has_next = S.next(ui + 1, nxt);
        const char* nA = has_next ? (const char*)g.A + (size_t)nxt.pm * tstep : cA; const char* nB = has_next ? (const char*)g.Bt + (size_t)nxt.pn * tstep : cB;
        for (int t = 0; t < nt; t += 2) {
            const bool last = (t == nt - 2);
            const char* a1 = cA + (size_t)(t + 1) * kstep;
            const char* a2 = last ? nA : cA + (size_t)(t + 2) * kstep; const char* b2 = last ? nB : cB + (size_t)(t + 2) * kstep;
            const char* a3 = a2 + kstep; const char* b3 = b2 + kstep;
            PG8_LDB(B0, 0, 0); PG8_SCHED; PG8_LDA(At, 0, 0); PG8_STAGE(PG8_SA(1, 1), a1 + hstep, voffA);
            PG8_WAIT_L(8); PG8_BAR; PG8_WAIT_L(0); PG8_MMA(0, 0, At, B0); PG8_BAR; PG8_SCHED;
            PG8_LDB(B1, 0, 1); PG8_STAGE(PG8_SB(0, 0), b2, voffB);
            PG8_BAR; PG8_WAIT_L(0); PG8_MMA(0, 1, At, B1); PG8_BAR;
            PG8_LDA(At, 0, 1); PG8_STAGE(PG8_SA(0, 0), a2, voffA);
            PG8_BAR; PG8_WAIT_L(0); PG8_MMA(1, 0, At, B0); PG8_BAR; PG8_SCHED;
            PG8_STAGE(PG8_SB(0, 1), b2 + hstep, voffB);
            PG8_WAIT_V(6); PG8_BAR; PG8_MMA(1, 1, At, B1); PG8_BAR;
            PG8_LDB(B0, 1, 0); PG8_SCHED; PG8_LDA(At, 1, 0); PG8_STAGE(PG8_SA(0, 1), a2 + hstep, voffA);
            PG8_WAIT_L(8); PG8_BAR; PG8_WAIT_L(0); PG8_MMA(0, 0, At, B0); PG8_BAR; PG8_SCHED;
            PG8_LDB(B1, 1, 1); PG8_STAGE(PG8_SB(1, 0), b3, voffB);
            PG8_BAR; PG8_WAIT_L(0); PG8_MMA(0, 1, At, B1); PG8_BAR;
            PG8_LDA(At, 1, 1); PG8_STAGE(PG8_SA(1, 0), a3, voffA);
            PG8_BAR; PG8_WAIT_L(0); PG8_MMA(1, 0, At, B0); PG8_BAR; PG8_SCHED;
            PG8_STAGE(PG8_SB(1, 1), b3 + hstep, voffB);
            PG8_WAIT_V(6); PG8_BAR; PG8_MMA(1, 1, At, B1); PG8_BAR;
        }
        E(acc, cur, wr, wc, fr, fq);
        if (!has_next) break;
#pragma unroll
        for (int a = 0; a < 2; ++a)
#pragma unroll
            for (int b = 0; b < 2; ++b)
#pragma unroll
                for (int m = 0; m < 4; ++m)
#pragma unroll
                    for (int n = 0; n < 2; ++n) acc[a][b][m][n] = (f32x4){0.f, 0.f, 0.f, 0.f};
        cur = nxt; cA = nA; cB = nB; ++ui;
    }
    PG8_WAIT_V(0);
    if (wr == 0) PG8_BAR;
    PG8_BAR;
#undef PG8_SA
#undef PG8_SB
#undef PG8_STAGE
#undef PG8_LDA
#undef PG8_LDB
#undef PG8_MMA
#undef PG8_WAIT_V
#undef PG8_WAIT_L
#undef PG8_BAR
#undef PG8_SCHED
}
}

__device__ __forceinline__ float row_rs(const float* ssp, int row) {
    const f32x4* p = (const f32x4*)(ssp + (size_t)row * 16);
    f32x4 a = p[0], b = p[1], c = p[2], d = p[3];
    float s = (a[0] + a[1] + a[2] + a[3]) + (b[0] + b[1] + b[2] + b[3]) + (c[0] + c[1] + c[2] + c[3]) + (d[0] + d[1] + d[2] + d[3]);
    return rsqrtf(s * (1.0f / 1024.0f) + EPS);
}

__device__ __forceinline__ f32x4 rs_part(const float* ssp, int row, int fq) { return *(const f32x4*)(ssp + (size_t)row * 16 + fq * 4); }
__device__ __forceinline__ float rs_fin(f32x4 a) { float s = (a[0] + a[1]) + (a[2] + a[3]); s += __shfl_xor(s, 16); s += __shfl_xor(s, 32); return rsqrtf(s * (1.0f / 1024.0f) + EPS); }
struct EpiInproj {
    static constexpr bool PERM = true;
    bf16_t* O; const float* ssp;
    __device__ __forceinline__ void operator()(const f32x4 (&acc)[2][2][4][2], const pg8::Unit& u, int wr, int wc, int fr, int fq) const {
        const int row0 = u.pm * 256 + wr * 64 + fr, col0 = u.pn * 256 + wc * 32 + 8 * fq;
        f32x4 rp[2][4];
#pragma unroll
        for (int ai = 0; ai < 2; ++ai)
#pragma unroll
            for (int m = 0; m < 4; ++m) rp[ai][m] = rs_part(ssp, row0 + ai * 128 + m * 16, fq);
#pragma unroll
        for (int ai = 0; ai < 2; ++ai)
#pragma unroll
            for (int m = 0; m < 4; ++m) {
                const int row = row0 + ai * 128 + m * 16; const float rs = rs_fin(rp[ai][m]);
                bf16_t* rowp = O + (size_t)row * DINP + col0;
#pragma unroll
                for (int bj = 0; bj < 2; ++bj) { f32x4 v0 = acc[ai][bj][m][0] * rs, v1 = acc[ai][bj][m][1] * rs;
                    u32x4 w; w.x = pk2(v0[0], v0[1]); w.y = pk2(v0[2], v0[3]); w.z = pk2(v1[0], v1[1]); w.w = pk2(v1[2], v1[3]);
                    __builtin_nontemporal_store(w, (u32x4*)(rowp + bj * 128)); }
            }
    }
};
struct EpiGateUp {
    static constexpr bool PERM = true;
    bf16_t* O; const float* ssp;
    __device__ __forceinline__ void operator()(const f32x4 (&acc)[2][2][4][2], const pg8::Unit& u, int wr, int wc, int fr, int fq) const {
        const int row0 = u.pm * 256 + wr * 64 + fr, col0 = u.pn * 128 + wc * 32 + 8 * fq;
        f32x4 rp[2][4];
#pragma unroll
        for (int ai = 0; ai < 2; ++ai)
#pragma unroll
            for (int m = 0; m < 4; ++m) rp[ai][m] = rs_part(ssp, row0 + ai * 128 + m * 16, fq);
#pragma unroll
        for (int ai = 0; ai < 2; ++ai)
#pragma unroll
            for (int m = 0; m < 4; ++m) {
                const int row = row0 + ai * 128 + m * 16; const float rs = rs_fin(rp[ai][m]);
                float h[8];
#pragma unroll
                for (int n = 0; n < 2; ++n)
#pragma unroll
                    for (int j = 0; j < 4; ++j) h[n * 4 + j] = silu(acc[ai][0][m][n][j] * rs) * (acc[ai][1][m][n][j] * rs);
                u32x4 w; w.x = pk2(h[0], h[1]); w.y = pk2(h[2], h[3]); w.z = pk2(h[4], h[5]); w.w = pk2(h[6], h[7]);
                __builtin_nontemporal_store(w, (u32x4*)(O + (size_t)row * DFF + col0));
            }
    }
};
struct EpiResid {
    static constexpr bool PERM = false;
    bf16_t* XB; float* ssp;
    __device__ __forceinline__ void operator()(const f32x4 (&acc)[2][2][4][2], const pg8::Unit& u, int wr, int wc, int fr, int fq) const {
        const int row0 = u.pm * 256 + wr * 64 + fr, col0 = u.pn * 256 + wc * 32 + 4 * fq;
        u32x2 xnx[4];
        { const bf16_t* xr0 = XB + (size_t)row0 * DM + col0;
#pragma unroll
          for (int e = 0; e < 4; ++e) xnx[e] = *(const u32x2*)(xr0 + (e >> 1) * 128 + (e & 1) * 16); }
#pragma unroll
        for (int ai = 0; ai < 2; ++ai)
#pragma unroll
            for (int m = 0; m < 4; ++m) {
                const int row = row0 + ai * 128 + m * 16;
                bf16_t* br = XB + (size_t)row * DM + col0;
                u32x2 xc[4];
#pragma unroll
                for (int e = 0; e < 4; ++e) xc[e] = xnx[e];
                if (ai * 4 + m < 7) { const int idx = ai * 4 + m + 1; const bf16_t* xrn = XB + (size_t)(row0 + (idx >> 2) * 128 + (idx & 3) * 16) * DM + col0;
#pragma unroll
                    for (int e = 0; e < 4; ++e) xnx[e] = *(const u32x2*)(xrn + (e >> 1) * 128 + (e & 1) * 16); }
                float ss = 0.f;
#pragma unroll
                for (int bj = 0; bj < 2; ++bj)
#pragma unroll
                    for (int n = 0; n < 2; ++n) {
                        const u32x2 xo = xc[bj * 2 + n];
                        f32x4 xn = acc[ai][bj][m][n];
                        xn[0] += __uint_as_float(xo.x << 16); xn[1] += __uint_as_float(xo.x & 0xffff0000u); xn[2] += __uint_as_float(xo.y << 16); xn[3] += __uint_as_float(xo.y & 0xffff0000u);
                        ss += (xn[0] * xn[0] + xn[1] * xn[1]) + (xn[2] * xn[2] + xn[3] * xn[3]);
                        u32x2 w; w.x = pk2(xn[0], xn[1]); w.y = pk2(xn[2], xn[3]);
                        *(u32x2*)(br + bj * 128 + n * 16) = w;
                    }
                ss += __shfl_xor(ss, 16); ss += __shfl_xor(ss, 32);
                if (fq == 0) ssp[(size_t)row * 16 + u.pn * 4 + wc] = ss;
                asm volatile("" ::: "memory");
            }
    }
};

__device__ __forceinline__ void wtile(LAS float* tile, const float* src, int lds_src, const float* gain, bf16_t* dst, int K, int n0, int k0, int c0, int nvalid) {
    const int tid = otid();
    __syncthreads();
#pragma unroll
    for (int i = 0; i < 8; ++i) {
        const int kk = (tid >> 6) + 8 * i, c = tid & 63;
        float v = 0.f;
        if (c0 + c < nvalid) { v = src[(size_t)(k0 + kk) * lds_src + c0 + c]; if (gain) v *= gain[k0 + kk]; }
        tile[kk * 65 + c] = v;
    }
    __syncthreads();
    const int n = tid >> 3, kc = (tid & 7) * 8;
    float f[8];
#pragma unroll
    for (int j = 0; j < 8; ++j) f[j] = tile[(kc + j) * 65 + n];
    u32x4 w; w.x = pk2(f[0], f[1]); w.y = pk2(f[2], f[3]); w.z = pk2(f[4], f[5]); w.w = pk2(f[6], f[7]);
    *(u32x4*)(dst + (size_t)(n0 + n) * K + k0 + kc) = w;
}
__device__ __forceinline__ void phase_weights(LAS unsigned char* lds, const Params& P) {
    LAS float* tile = (LAS float*)lds;
    unsigned char* ws = P.ws;
    constexpr int T_IN = 56 * 16, T_OUT = 16 * 16, T_GU = 88 * 16, T_DN = 16 * 44, T_L = T_IN + T_OUT + T_GU + T_DN;
    for (int t = blockIdx.x; t < 2 * 24; t += gridDim.x) {
        const int l = t / 24, idx = t % 24; bf16_t* sw = (bf16_t*)(ws + WS_SW) + (size_t)l * SW_L;
        if (idx < 16) { const int m = idx >> 2, nb = idx & 3, d = m & 1;
            const float* src = (m < 2 ? P.in[10] : P.in[12]) + (size_t)(l * 2 + d) * 64 * 256;
            wtile(tile, src, 256, nullptr, sw + m * 16384, 64, nb * 64, 0, nb * 64, 256);
        } else { const int nb = (idx - 16) >> 1, kb = (idx - 16) & 1;
            wtile(tile, P.in[13] + (size_t)l * 128 * 256, 256, nullptr, sw + 65536, 128, nb * 64, kb * 64, nb * 64, 256); }
    }
    for (int i = blockIdx.x * 512 + threadIdx.x; i < 2 * 8192; i += gridDim.x * 512) {
        const int l = i >> 13, rem = i & 8191, d = rem >> 12, c = (rem & 4095) >> 5, k = rem & 31;
        const float v = ((k >> 4) == d) ? P.in[5][((size_t)(l * 2 + d) * 16 + (k & 15)) * 128 + c] : 0.f;
        ((bf16_t*)(ws + WS_SW))[(size_t)l * SW_L + 98304 + rem] = (bf16_t)f2bf(v);
    }
    for (int t = blockIdx.x; t < 2 * T_L; t += gridDim.x) {
        const int l = t / T_L; int r = t % T_L;
        if (r < T_IN) { const int nb = r / 16, kb = r % 16;
            wtile(tile, P.in[3] + (size_t)l * DM * DIN, DIN, P.in[2] + l * DM, (bf16_t*)(ws + WS_WIN) + (size_t)l * DINP * DM, DM, nb * 64, kb * 64, nb * 64, DIN);
        } else if ((r -= T_IN) < T_OUT) { const int nb = r / 16, kb = r % 16;
            wtile(tile, P.in[4] + (size_t)l * DM * DM, DM, nullptr, (bf16_t*)(ws + WS_WOUT) + (size_t)l * DM * DM, DM, nb * 64, kb * 64, nb * 64, DM);
        } else if ((r -= T_OUT) < T_GU) { const int nb = r / 16, kb = r % 16;
            const int j = nb >> 2, qd = nb & 3; const float* src = (qd < 2 ? P.in[26] : P.in[27]) + (size_t)l * DM * DFF;
            wtile(tile, src, DFF, P.in[25] + l * DM, (bf16_t*)(ws + WS_WGU) + (size_t)l * 2 * DFF * DM, DM, nb * 64, kb * 64, j * 128 + (qd & 1) * 64, DFF);
        } else { r -= T_GU; const int nb = r / 44, kb = r % 44;
            wtile(tile, P.in[28] + (size_t)l * DFF * DM, DM, nullptr, (bf16_t*)(ws + WS_WDN) + (size_t)l * DM * DFF, DFF, nb * 64, kb * 64, nb * 64, DM);
        }
    }
}

__device__ __forceinline__ void phase_xprep(const Params& P, int g) {
    const float* xin = (g < 2) ? P.in[0] + (size_t)g * TG * DM : P.in[1];
    bf16_t* xb = (bf16_t*)(P.ws + WS_XB); float* ssp = (float*)(P.ws + WS_SSP);
    const int tid_ = otid(); const int lane = tid_ & 63, gw = blockIdx.x * 8 + (tid_ >> 6), nw = gridDim.x * 8;
    for (int row = gw; row < TG; row += nw) {
        float ss = 0.f;
#pragma unroll
        for (int i = 0; i < 4; ++i) {
            const int c = i * 256 + lane * 4;
            f32x4 v = *(const f32x4*)(xin + (size_t)row * DM + c);
            u32x2 w; w.x = pk2(v[0], v[1]); w.y = pk2(v[2], v[3]);
            *(u32x2*)(xb + (size_t)row * DM + c) = w;
            ss += (v[0] * v[0] + v[1] * v[1]) + (v[2] * v[2] + v[3] * v[3]);
        }
        ss = wave_sum(ss);
        if (lane < 16) ssp[(size_t)row * 16 + lane] = (lane == 0) ? ss : 0.f;
    }
}
__device__ __forceinline__ void phase_final(const Params& P, int g) {
    float* xo = P.out + (size_t)g * TG * DM; const bf16_t* xb = (const bf16_t*)(P.ws + WS_XB); const float* ssp = (const float*)(P.ws + WS_SSP); const float* gn = P.in[29];
    const int tid_ = otid(); const int lane = tid_ & 63, gw = blockIdx.x * 8 + (tid_ >> 6), nw = gridDim.x * 8;
    for (int row = gw; row < TG; row += nw) {
        const float rs = row_rs(ssp, row);
#pragma unroll
        for (int i = 0; i < 2; ++i) {
            const int c = i * 512 + lane * 8;
            float v[8]; unpack8(*(const u32x4*)(xb + (size_t)row * DM + c), v);
            const f32x4 g0 = *(const f32x4*)(gn + c), g1 = *(const f32x4*)(gn + c + 4);
            *(f32x4*)(xo + (size_t)row * DM + c) = (f32x4){v[0] * rs * g0[0], v[1] * rs * g0[1], v[2] * rs * g0[2], v[3] * rs * g0[3]};
            *(f32x4*)(xo + (size_t)row * DM + c + 4) = (f32x4){v[4] * rs * g1[0], v[5] * rs * g1[1], v[6] * rs * g1[2], v[7] * rs * g1[3]};
        }
    }
}

struct MixBufs {
    const bf16_t* p; float* gla_la; bf16_t* gla_o; bf16_t* rw; float* rw_s; bf16_t* rw_y; bf16_t* ssd_x; float* ssd_dt; bf16_t* ssd_y; bf16_t* mix;
};
__device__ __forceinline__ MixBufs mixbufs(const Params& P) {
    MixBufs B; unsigned char* ws = P.ws;
    B.p = (const bf16_t*)(ws + WS_P); B.gla_la = (float*)(ws + WS_GLA_LA); B.gla_o = (bf16_t*)(ws + WS_GLA_O); B.rw = (bf16_t*)(ws + WS_RW);
    B.rw_s = (float*)(ws + WS_RW_S); B.rw_y = (bf16_t*)(ws + WS_RW_Y); B.ssd_x = (bf16_t*)(ws + WS_SSD_X); B.ssd_dt = (float*)(ws + WS_SSD_DT);
    B.ssd_y = (bf16_t*)(ws + WS_SSD_Y); B.mix = (bf16_t*)(ws + WS_MIX); return B;
}
constexpr size_t RWA = (size_t)TG * 256;

__device__ __forceinline__ void prep_tile(LAS unsigned char* lds, const Params& P, const MixBufs& B, int layer, int L, int tile) {
    const int tid = otid(), lane = tid & 63;
    const int t0 = tile * 32;
    LAS float* lin = (LAS float*)lds;
    LAS float* gin = (LAS float*)(lds + 49152);
    const bf16_t* p = B.p;
    const float* mu = P.in[8] + layer * 1152;
    __syncthreads();
    for (int idx = tid; idx < 32 * 384; idx += 512) {
        const int t = idx / 384, cc = idx % 384, tl = t0 + t, pos = tl % L, col = PC_RLOW + cc;
        const float cur = bf2f(p[(size_t)tl * DINP + col]);
        const float prv = pos > 0 ? bf2f(p[(size_t)(tl - 1) * DINP + col]) : 0.f;
        const float nxt = pos < L - 1 ? bf2f(p[(size_t)(tl + 1) * DINP + col]) : 0.f;
        float v = cur + mu[col - PC_R] * (0.5f * (prv + nxt) - cur);
        if (cc < 128) { const float e = __expf(2.f * v); v = 1.f - 2.f / (e + 1.f); }
        else if (cc >= 256) v = sigm(v);
        lin[t * 384 + cc] = v;
    }
    for (int idx = tid; idx < 32 * 32; idx += 512) { const int t = idx >> 5, j = idx & 31; gin[idx] = bf2f(p[(size_t)(t0 + t) * DINP + PC_GAF + j]); }
    __syncthreads();
#pragma unroll 1
    for (int i = 0; i < 8; ++i) {
        const int idx = tid + 512 * i, t = idx >> 7, c0 = (idx & 127) * 8, tl = t0 + t, pos = tl % L;
        float acc[8];
        { const f32x4 b0 = *(const f32x4*)(P.in[20] + layer * 1024 + c0), b1 = *(const f32x4*)(P.in[20] + layer * 1024 + c0 + 4);
          acc[0] = b0[0]; acc[1] = b0[1]; acc[2] = b0[2]; acc[3] = b0[3]; acc[4] = b1[0]; acc[5] = b1[1]; acc[6] = b1[2]; acc[7] = b1[3]; }
#pragma unroll
        for (int tap = 0; tap < 5; ++tap) {
            const int pp = pos + tap - 2;
            if (pp >= 0 && pp < L) {
                float x[8]; unpack8(*(const u32x4*)(p + (size_t)(tl + tap - 2) * DINP + PC_XBC + c0), x);
                const float* w = P.in[19] + (size_t)(layer * 5 + tap) * 1024 + c0;
                const f32x4 w0 = *(const f32x4*)w, w1 = *(const f32x4*)(w + 4);
                acc[0] += w0[0] * x[0]; acc[1] += w0[1] * x[1]; acc[2] += w0[2] * x[2]; acc[3] += w0[3] * x[3];
                acc[4] += w1[0] * x[4]; acc[5] += w1[1] * x[5]; acc[6] += w1[2] * x[6]; acc[7] += w1[3] * x[7];
            }
        }
        u32x4 o; o.x = pk2(silu(acc[0]), silu(acc[1])); o.y = pk2(silu(acc[2]), silu(acc[3])); o.z = pk2(silu(acc[4]), silu(acc[5])); o.w = pk2(silu(acc[6]), silu(acc[7]));
        *(u32x4*)(B.ssd_x + (size_t)tl * 1024 + c0) = o;
    }
    { const int t = tid >> 4, j = tid & 15, tl = t0 + t;
      B.ssd_dt[(size_t)tl * 16 + j] = softplus(bf2f(p[(size_t)tl * DINP + PC_DT + j]) + P.in[21][layer * 16 + j]); }
    if (tid < 256) {
        const int d = tid >> 7, c = tid & 127;
        float ac[16];
#pragma unroll
        for (int j = 0; j < 16; ++j) ac[j] = P.in[5][((size_t)(layer * 2 + d) * 16 + j) * 128 + c];
        const float bias = P.in[6][(layer * 2 + d) * 128 + c];
#pragma unroll 4
        for (int t = 0; t < 32; ++t) {
            float a = bias;
#pragma unroll
            for (int j = 0; j < 16; ++j) a += gin[t * 32 + d * 16 + j] * ac[j];
            B.gla_la[((size_t)d * TG + t0 + t) * 128 + c] = -softplus(-a) * (1.0f / 16.0f);
        }
    }
    asm volatile("" ::: "memory");
    {
        const int h2 = __builtin_amdgcn_readfirstlane(tid >> 8), c = tid & 255, head = c >> 6;
        float wcol[64];
        const float kkc = P.in[14][layer * 256 + c], kac = P.in[15][layer * 256 + c], rkc = P.in[16][layer * 256 + c];
        const float mur = mu[c], muk = mu[256 + c], muv = mu[512 + c];
        {
            { const float* wsrc = P.in[10] + (size_t)(layer * 2 + h2) * 64 * 256;
#pragma unroll
            for (int k = 0; k < 64; ++k) wcol[k] = wsrc[k * 256 + c]; }
            const float w0c = P.in[9][(layer * 2 + h2) * 256 + c];
#pragma unroll 1
            for (int t = 0; t < 32; ++t) {
                float aw = w0c;
                const LAS f32x4* lw = (const LAS f32x4*)(lin + t * 384 + h2 * 64);
#pragma unroll
                for (int k4 = 0; k4 < 16; ++k4) { const f32x4 x = lw[k4];
                    aw += x[0] * wcol[k4 * 4] + x[1] * wcol[k4 * 4 + 1] + x[2] * wcol[k4 * 4 + 2] + x[3] * wcol[k4 * 4 + 3]; }
                B.rw[(4 + h2) * RWA + (size_t)(t0 + t) * 256 + c] = (bf16_t)f2bf(sigm(aw) * 0.60653066f);
            }
        }
        asm volatile("" ::: "memory");
        {
            { const float* wsrc = P.in[12] + (size_t)(layer * 2 + h2) * 64 * 256;
#pragma unroll
            for (int k = 0; k < 64; ++k) wcol[k] = wsrc[k * 256 + c]; }
            const float a0c = P.in[11][(layer * 2 + h2) * 256 + c];
#pragma unroll 1
            for (int t = 0; t < 32; ++t) {
                const int tl = t0 + t, pos = tl % L;
                const bf16_t* pc = p + (size_t)tl * DINP;
                const bool hp = pos > 0, hn = pos < L - 1;
                const float rc = bf2f(pc[PC_R + c]), kc = bf2f(pc[PC_RK + c]), vc = bf2f(pc[PC_RV + c]);
                const float rp = hp ? bf2f(pc[PC_R + c - DINP]) : 0.f, kp = hp ? bf2f(pc[PC_RK + c - DINP]) : 0.f, vp = hp ? bf2f(pc[PC_RV + c - DINP]) : 0.f;
                const float rn = hn ? bf2f(pc[PC_R + c + DINP]) : 0.f, kn = hn ? bf2f(pc[PC_RK + c + DINP]) : 0.f, vn = hn ? bf2f(pc[PC_RV + c + DINP]) : 0.f;
                const float r = rc + mur * (0.5f * (rp + rn) - rc), k = kc + muk * (0.5f * (kp + kn) - kc), v = vc + muv * (0.5f * (vp + vn) - vc);
                float aa = a0c;
                const LAS f32x4* la = (const LAS f32x4*)(lin + t * 384 + 128 + h2 * 64);
#pragma unroll
                for (int k4 = 0; k4 < 16; ++k4) { const f32x4 y = la[k4];
                    aa += y[0] * wcol[k4 * 4] + y[1] * wcol[k4 * 4 + 1] + y[2] * wcol[k4 * 4 + 2] + y[3] * wcol[k4 * 4 + 3]; }
                const float asg = sigm(aa);
                const float kr = k * kkc; const float kk = kr * rsqrtf(wave_sum(kr * kr) + 1e-12f);
                const float kd = k * (1.f + (asg - 1.f) * kac), bb = kk * asg;
                const size_t o = (size_t)tl * 256 + c;
                B.rw[(6 + h2) * RWA + o] = (bf16_t)f2bf(kd); B.rw[(8 + h2) * RWA + o] = (bf16_t)f2bf(bb);
                if (h2 == 0) {
                    B.rw[0 * RWA + o] = (bf16_t)f2bf(r); B.rw[1 * RWA + o] = (bf16_t)f2bf(v); B.rw[2 * RWA + o] = (bf16_t)f2bf(kk);
                    const float s = wave_sum(r * k * rkc); if (lane == 0) B.rw_s[(size_t)tl * 4 + head] = s;
                } else {
                    const float s = wave_sum(bf2f((bf16_t)f2bf(kd)) * bf2f((bf16_t)f2bf(r))); if (lane == 0) B.rw_s[(size_t)TG * 4 + (size_t)tl * 4 + head] = s;
                }
            }
        }
        asm volatile("" ::: "memory");
        float ga[16];
#pragma unroll
        for (int i = 0; i < 16; ++i) ga[i] = 0.f;
#pragma unroll 1
        for (int sub = 0; sub < 2; ++sub) {
            asm volatile("" ::: "memory");
            { const float* wsrc = P.in[13] + (size_t)(layer * 128 + sub * 64) * 256;
#pragma unroll
            for (int k = 0; k < 64; ++k) wcol[k] = wsrc[k * 256 + c]; }
#pragma unroll
            for (int tt = 0; tt < 16; ++tt) {
                const LAS f32x4* lg = (const LAS f32x4*)(lin + (h2 * 16 + tt) * 384 + 256 + sub * 64);
                float a = ga[tt];
#pragma unroll
                for (int k4 = 0; k4 < 16; ++k4) { const f32x4 x = lg[k4]; a += x[0] * wcol[k4 * 4] + x[1] * wcol[k4 * 4 + 1] + x[2] * wcol[k4 * 4 + 2] + x[3] * wcol[k4 * 4 + 3]; }
                ga[tt] = a;
            }
        }
#pragma unroll
        for (int tt = 0; tt < 16; ++tt) B.rw[3 * RWA + (size_t)(t0 + h2 * 16 + tt) * 256 + c] = (bf16_t)f2bf(ga[tt]);
    }
}

__device__ __forceinline__ f32x4 mfma16(bf16x8 a, bf16x8 b, f32x4 c) { return __builtin_amdgcn_mfma_f32_16x16x32_bf16(a, b, c, 0, 0, 0); }
__device__ __forceinline__ void prep_tile64(LAS unsigned char* lds, const Params& P, const MixBufs& B, const bf16_t* sw, int layer, int L, int tile) {
    const int tid = otid(), w = tid >> 6, lane = tid & 63, r = lane & 15, q = lane >> 4;
    const int t0 = tile * 64;
    constexpr int LL = 392, LA = 264;
    LAS bf16_t* lin = (LAS bf16_t*)lds;
    LAS bf16_t* gin = (LAS bf16_t*)(lds + 50176);
    LAS bf16_t* AS = (LAS bf16_t*)(lds + 55296);
    const bf16_t* p = B.p;
    const float* mu = P.in[8] + layer * 1152;
    __syncthreads();
#pragma unroll 3
    for (int i6 = 0; i6 < 6; ++i6) {
        const int it = tid + 512 * i6;
        const int t = it / 48, cg8 = it % 48, tl = t0 + t, pos = tl % L, col = PC_RLOW + cg8 * 8;
        float cur[8], prv[8], nxt[8], v[8];
        unpack8(*(const u32x4*)(p + (size_t)tl * DINP + col), cur);
        if (pos > 0) unpack8(*(const u32x4*)(p + (size_t)(tl - 1) * DINP + col), prv); else {
#pragma unroll
            for (int j = 0; j < 8; ++j) prv[j] = 0.f; }
        if (pos < L - 1) unpack8(*(const u32x4*)(p + (size_t)(tl + 1) * DINP + col), nxt); else {
#pragma unroll
            for (int j = 0; j < 8; ++j) nxt[j] = 0.f; }
        const f32x4 m0 = *(const f32x4*)(mu + col - PC_R), m1 = *(const f32x4*)(mu + col - PC_R + 4);
#pragma unroll
        for (int j = 0; j < 8; ++j) { const float m = j < 4 ? m0[j] : m1[j - 4]; v[j] = cur[j] + m * (0.5f * (prv[j] + nxt[j]) - cur[j]); }
        if (cg8 < 16) {
#pragma unroll
            for (int j = 0; j < 8; ++j) { const float e = __expf(2.f * v[j]); v[j] = 1.f - 2.f * __builtin_amdgcn_rcpf(e + 1.f); }
        } else if (cg8 >= 32) {
#pragma unroll
            for (int j = 0; j < 8; ++j) v[j] = sigm(v[j]);
        }
        u32x4 o; o.x = pk2(v[0], v[1]); o.y = pk2(v[2], v[3]); o.z = pk2(v[4], v[5]); o.w = pk2(v[6], v[7]);
        *(LAS u32x4*)(lin + t * LL + cg8 * 8) = o;
    }
    if (tid < 256) { const int t = tid >> 2, g4 = tid & 3; *(LAS u32x4*)(gin + t * 40 + g4 * 8) = *(const u32x4*)(p + (size_t)(t0 + t) * DINP + PC_GAF + g4 * 8); }
    __syncthreads();
#pragma unroll 1
    for (int d = 0; d < 2; ++d)
#pragma unroll 1
        for (int tt = 0; tt < 2; ++tt) {
            const int tn = 2 * w + tt, c = tn * 16 + r;
            const float a0c = P.in[11][(layer * 2 + d) * 256 + c];
            const bf16_t* wb = sw + 32768 + d * 16384 + (size_t)(tn * 16 + r) * 64 + q * 8;
            const bf16x8 b0 = *(const bf16x8*)wb, b1 = *(const bf16x8*)(wb + 32);
#pragma unroll
            for (int tm = 0; tm < 4; ++tm) {
                const LAS bf16_t* ap = lin + (tm * 16 + r) * LL + 128 + d * 64 + q * 8;
                f32x4 acc = (f32x4){0.f, 0.f, 0.f, 0.f};
                acc = mfma16(*(const LAS bf16x8*)ap, b0, acc); acc = mfma16(*(const LAS bf16x8*)(ap + 32), b1, acc);
#pragma unroll
                for (int jj = 0; jj < 4; ++jj) AS[(d * 64 + tm * 16 + q * 4 + jj) * LA + c] = (bf16_t)f2bf(sigm(a0c + acc[jj]));
            }
        }
    __syncthreads();
    {
        const int c0 = (tid & 31) * 8, head = (tid & 31) >> 3;
        float mr_[8], mk_[8], mv_[8], kkc[8], kac[8], rkc[8];
#define LD8F(dst, ptr) do { const f32x4 a_ = *(const f32x4*)(ptr), b_ = *(const f32x4*)((ptr) + 4); dst[0] = a_[0]; dst[1] = a_[1]; dst[2] = a_[2]; dst[3] = a_[3]; dst[4] = b_[0]; dst[5] = b_[1]; dst[6] = b_[2]; dst[7] = b_[3]; } while (0)
        LD8F(mr_, mu + c0); LD8F(mk_, mu + 256 + c0); LD8F(mv_, mu + 512 + c0);
        LD8F(kkc, P.in[14] + layer * 256 + c0); LD8F(kac, P.in[15] + layer * 256 + c0); LD8F(rkc, P.in[16] + layer * 256 + c0);
#undef LD8F
        u32x4 nx[9], cu[9];
        const u32x4 Z = (u32x4){0u, 0u, 0u, 0u};
#define EL_LOAD(dst, ii) do { const int t_ = (tid + 512 * (ii)) >> 5, tl_ = t0 + t_, pos_ = tl_ % L; const bf16_t* pc_ = p + (size_t)tl_ * DINP + c0; \
            const bool hp_ = pos_ > 0, hn_ = pos_ < L - 1; \
            dst[0] = *(const u32x4*)(pc_ + PC_R); dst[1] = *(const u32x4*)(pc_ + PC_RK); dst[2] = *(const u32x4*)(pc_ + PC_RV); \
            dst[3] = hp_ ? *(const u32x4*)(pc_ + PC_R - DINP) : Z; dst[4] = hp_ ? *(const u32x4*)(pc_ + PC_RK - DINP) : Z; dst[5] = hp_ ? *(const u32x4*)(pc_ + PC_RV - DINP) : Z; \
            dst[6] = hn_ ? *(const u32x4*)(pc_ + PC_R + DINP) : Z; dst[7] = hn_ ? *(const u32x4*)(pc_ + PC_RK + DINP) : Z; dst[8] = hn_ ? *(const u32x4*)(pc_ + PC_RV + DINP) : Z; } while (0)
        EL_LOAD(nx, 0);
#pragma unroll 1
        for (int i = 0; i < 4; ++i) {
#pragma unroll
            for (int e = 0; e < 9; ++e) cu[e] = nx[e];
            if (i < 3) EL_LOAD(nx, i + 1);
            const int t = (tid + 512 * i) >> 5, tl = t0 + t;
            float rr[8], kx[8], vx[8], c_[8], p_[8], n_[8];
            unpack8(cu[0], c_); unpack8(cu[3], p_); unpack8(cu[6], n_);
#pragma unroll
            for (int j = 0; j < 8; ++j) rr[j] = c_[j] + mr_[j] * (0.5f * (p_[j] + n_[j]) - c_[j]);
            unpack8(cu[1], c_); unpack8(cu[4], p_); unpack8(cu[7], n_);
#pragma unroll
            for (int j = 0; j < 8; ++j) kx[j] = c_[j] + mk_[j] * (0.5f * (p_[j] + n_[j]) - c_[j]);
            unpack8(cu[2], c_); unpack8(cu[5], p_); unpack8(cu[8], n_);
#pragma unroll
            for (int j = 0; j < 8; ++j) vx[j] = c_[j] + mv_[j] * (0.5f * (p_[j] + n_[j]) - c_[j]);
            float as0[8], as1[8];
            unpack8(*(const LAS u32x4*)(AS + (0 * 64 + t) * LA + c0), as0); unpack8(*(const LAS u32x4*)(AS + (1 * 64 + t) * LA + c0), as1);
            float kr[8], ss = 0.f, srk = 0.f;
#pragma unroll
            for (int j = 0; j < 8; ++j) { kr[j] = kx[j] * kkc[j]; ss += kr[j] * kr[j]; srk += rr[j] * kx[j] * rkc[j]; }
            ss += __shfl_xor(ss, 1); ss += __shfl_xor(ss, 2); ss += __shfl_xor(ss, 4);
            const float inv = rsqrtf(ss + 1e-12f);
            float kkv[8], kd0[8], kd1[8], b0v[8], b1v[8], skr = 0.f;
#pragma unroll
            for (int j = 0; j < 8; ++j) {
                kkv[j] = kr[j] * inv; kd0[j] = kx[j] * (1.f + (as0[j] - 1.f) * kac[j]); kd1[j] = kx[j] * (1.f + (as1[j] - 1.f) * kac[j]);
                b0v[j] = kkv[j] * as0[j]; b1v[j] = kkv[j] * as1[j];
                skr += bf2f((bf16_t)f2bf(kd1[j])) * bf2f((bf16_t)f2bf(rr[j])); }
            srk += __shfl_xor(srk, 1); srk += __shfl_xor(srk, 2); srk += __shfl_xor(srk, 4);
            skr += __shfl_xor(skr, 1); skr += __shfl_xor(skr, 2); skr += __shfl_xor(skr, 4);
            const size_t o = (size_t)tl * 256 + c0;
#define ST8(arr, f) do { u32x4 o4; o4.x = pk2(f[0], f[1]); o4.y = pk2(f[2], f[3]); o4.z = pk2(f[4], f[5]); o4.w = pk2(f[6], f[7]); *(u32x4*)(B.rw + (size_t)(arr) * RWA + o) = o4; } while (0)
            ST8(0, rr); ST8(1, vx); ST8(2, kkv); ST8(6, kd0); ST8(7, kd1); ST8(8, b0v); ST8(9, b1v);
#undef ST8
            if ((lane & 7) == 0) { B.rw_s[(size_t)tl * 4 + head] = srk; B.rw_s[(size_t)TG * 4 + (size_t)tl * 4 + head] = skr; }
        }
#undef EL_LOAD
    }
#pragma unroll 1
    for (int d = 0; d < 2; ++d)
#pragma unroll 1
        for (int tt = 0; tt < 2; ++tt) {
            const int tn = 2 * w + tt, c = tn * 16 + r;
            const float w0c = P.in[9][(layer * 2 + d) * 256 + c];
            const bf16_t* wb = sw + d * 16384 + (size_t)(tn * 16 + r) * 64 + q * 8;
            const bf16x8 b0 = *(const bf16x8*)wb, b1 = *(const bf16x8*)(wb + 32);
#pragma unroll
            for (int tm = 0; tm < 4; ++tm) {
                const LAS bf16_t* ap = lin + (tm * 16 + r) * LL + d * 64 + q * 8;
                f32x4 acc = (f32x4){0.f, 0.f, 0.f, 0.f};
                acc = mfma16(*(const LAS bf16x8*)ap, b0, acc); acc = mfma16(*(const LAS bf16x8*)(ap + 32), b1, acc);
#pragma unroll
                for (int jj = 0; jj < 4; ++jj) B.rw[(size_t)(4 + d) * RWA + (size_t)(t0 + tm * 16 + q * 4 + jj) * 256 + c] = (bf16_t)f2bf(sigm(w0c + acc[jj]) * 0.60653066f);
            }
        }
#pragma unroll 1
    for (int tt = 0; tt < 2; ++tt) {
        const int tn = 2 * w + tt, c = tn * 16 + r;
        const bf16_t* wb = sw + 65536 + (size_t)(tn * 16 + r) * 128 + q * 8;
        const bf16x8 b0 = *(const bf16x8*)wb, b1 = *(const bf16x8*)(wb + 32), b2 = *(const bf16x8*)(wb + 64), b3 = *(const bf16x8*)(wb + 96);
#pragma unroll
        for (int tm = 0; tm < 4; ++tm) {
            const LAS bf16_t* ap = lin + (tm * 16 + r) * LL + 256 + q * 8;
            f32x4 acc = (f32x4){0.f, 0.f, 0.f, 0.f};
            acc = mfma16(*(const LAS bf16x8*)ap, b0, acc); acc = mfma16(*(const LAS bf16x8*)(ap + 32), b1, acc);
            acc = mfma16(*(const LAS bf16x8*)(ap + 64), b2, acc); acc = mfma16(*(const LAS bf16x8*)(ap + 96), b3, acc);
#pragma unroll
            for (int jj = 0; jj < 4; ++jj) B.rw[(size_t)3 * RWA + (size_t)(t0 + tm * 16 + q * 4 + jj) * 256 + c] = (bf16_t)f2bf(acc[jj]);
        }
    }
#pragma unroll 1
    for (int d = 0; d < 2; ++d) {
        const int c = w * 16 + r;
        const float bias = P.in[6][(layer * 2 + d) * 128 + c];
        const bf16x8 b0 = *(const bf16x8*)(sw + 98304 + d * 4096 + (size_t)(w * 16 + r) * 32 + q * 8);
#pragma unroll
        for (int tm = 0; tm < 4; ++tm) {
            f32x4 acc = (f32x4){0.f, 0.f, 0.f, 0.f};
            acc = mfma16(*(const LAS bf16x8*)(gin + (tm * 16 + r) * 40 + q * 8), b0, acc);
#pragma unroll
            for (int jj = 0; jj < 4; ++jj) B.gla_la[((size_t)d * TG + t0 + tm * 16 + q * 4 + jj) * 128 + c] = -softplus(-(acc[jj] + bias)) * (1.0f / 16.0f);
        }
    }
    {
        const int c0 = (tid & 127) * 8;
        float wt[5][8], bs[8];
        { const f32x4 b0 = *(const f32x4*)(P.in[20] + layer * 1024 + c0), b1 = *(const f32x4*)(P.in[20] + layer * 1024 + c0 + 4);
          bs[0] = b0[0]; bs[1] = b0[1]; bs[2] = b0[2]; bs[3] = b0[3]; bs[4] = b1[0]; bs[5] = b1[1]; bs[6] = b1[2]; bs[7] = b1[3]; }
#pragma unroll
        for (int tap = 0; tap < 5; ++tap) { const float* wp = P.in[19] + (size_t)(layer * 5 + tap) * 1024 + c0;
            const f32x4 w0 = *(const f32x4*)wp, w1 = *(const f32x4*)(wp + 4);
            wt[tap][0] = w0[0]; wt[tap][1] = w0[1]; wt[tap][2] = w0[2]; wt[tap][3] = w0[3]; wt[tap][4] = w1[0]; wt[tap][5] = w1[1]; wt[tap][6] = w1[2]; wt[tap][7] = w1[3]; }
        u32x4 xr[5], xn[5];
#define CONV_LOAD(dst, ii) do { const int t_ = (tid + 512 * (ii)) >> 7, tl_ = t0 + t_, pos_ = tl_ % L; \
            _Pragma("unroll") for (int tap = 0; tap < 5; ++tap) { const int pp = pos_ + tap - 2; \
                dst[tap] = (pp >= 0 && pp < L) ? *(const u32x4*)(p + (size_t)(tl_ + tap - 2) * DINP + PC_XBC + c0) : (u32x4){0u, 0u, 0u, 0u}; } } while (0)
        CONV_LOAD(xn, 0);
#pragma unroll 1
        for (int i = 0; i < 16; ++i) {
#pragma unroll
            for (int tap = 0; tap < 5; ++tap) xr[tap] = xn[tap];
            if (i < 15) CONV_LOAD(xn, i + 1);
            float acc[8];
#pragma unroll
            for (int j = 0; j < 8; ++j) acc[j] = bs[j];
#pragma unroll
            for (int tap = 0; tap < 5; ++tap) { float x[8]; unpack8(xr[tap], x);
#pragma unroll
                for (int j = 0; j < 8; ++j) acc[j] += wt[tap][j] * x[j]; }
            const int tl = t0 + ((tid + 512 * i) >> 7);
            u32x4 o; o.x = pk2(silu(acc[0]), silu(acc[1])); o.y = pk2(silu(acc[2]), silu(acc[3])); o.z = pk2(silu(acc[4]), silu(acc[5])); o.w = pk2(silu(acc[6]), silu(acc[7]));
            *(u32x4*)(B.ssd_x + (size_t)tl * 1024 + c0) = o;
        }
#undef CONV_LOAD
    }
#pragma unroll
    for (int i = 0; i < 2; ++i) { const int idx = tid + 512 * i, t = idx >> 4, j = idx & 15, tl = t0 + t;
        B.ssd_dt[(size_t)tl * 16 + j] = softplus(bf2f(p[(size_t)tl * DINP + PC_DT + j]) + P.in[21][layer * 16 + j]); }
}

__device__ __forceinline__ f32x4 mma_nt(f32x4 acc, const LAS bf16_t* A, int lda, const LAS bf16_t* Bt, int ldb, int K, int lane) {
    const int r = lane & 15, q = lane >> 4;
    for (int k = 0; k < K; k += 32) {
        const bf16x8 a = *(const LAS bf16x8*)(A + r * lda + k + q * 8);
        const bf16x8 b = *(const LAS bf16x8*)(Bt + r * ldb + k + q * 8);
        acc = __builtin_amdgcn_mfma_f32_16x16x32_bf16(a, b, acc, 0, 0, 0);
    }
    return acc;
}
__device__ __forceinline__ f32x4 mma_nt_x(f32x4 acc, const LAS bf16_t* A, int lda, const LAS bf16_t* Bt, int ldb, int K, int lane, int xa, int xb) {
    const int r = lane & 15, q = lane >> 4;
    for (int k = 0; k < K; k += 32) {
        const bf16x8 a = *(const LAS bf16x8*)(A + r * lda + ((((k >> 3) + q) ^ xa) << 3));
        const bf16x8 b = *(const LAS bf16x8*)(Bt + r * ldb + ((((k >> 3) + q) ^ xb) << 3));
        acc = __builtin_amdgcn_mfma_f32_16x16x32_bf16(a, b, acc, 0, 0, 0);
    }
    return acc;
}
__device__ __forceinline__ f32x4 mma_tn_x(f32x4 acc, const LAS bf16_t* A, int lda, const LAS bf16_t* Bt, int ldb, int K, int lane, int xa, int xb) {
    const int r = lane & 15, q = lane >> 4;
    for (int k = 0; k < K; k += 32) {
        const bf16x8 a = *(const LAS bf16x8*)(A + r * lda + ((((k >> 3) + q) ^ xa) << 3));
        const bf16x8 b = *(const LAS bf16x8*)(Bt + r * ldb + ((((k >> 3) + q) ^ xb) << 3));
        acc = __builtin_amdgcn_mfma_f32_16x16x32_bf16(b, a, acc, 0, 0, 0);
    }
    return acc;
}
template <int DK> struct CL {
    static constexpr int LQ = DK + 8, LT = 72;
    static constexpr int QA = 0, KA = QA + 64 * LQ * 2, KBT = KA + 64 * LQ * 2, VT = KBT + DK * LT * 2, SC = VT + 64 * LT * 2, STT = SC + 64 * LT * 2;
    static constexpr int FA = STT + 64 * LQ * 2;
};

__device__ __forceinline__ void ssd_unit(LAS unsigned char* lds, const Params& P, const MixBufs& B, float* segst, int layer, int L, int seq, int h, int d, int seg, bool state_only) {
    typedef CL<128> C;
    const int tid = otid(), w = tid >> 6, lane = tid & 63, r = lane & 15, q = lane >> 4;
    LAS bf16_t* Qa = (LAS bf16_t*)(lds + C::QA); LAS bf16_t* Ka = (LAS bf16_t*)(lds + C::KA); LAS bf16_t* KbT = (LAS bf16_t*)(lds + C::KBT);
    LAS bf16_t* VT = (LAS bf16_t*)(lds + C::VT); LAS bf16_t* Sc = (LAS bf16_t*)(lds + C::SC); LAS bf16_t* StT = (LAS bf16_t*)(lds + C::STT);
    LAS float* acum = (LAS float*)(lds + C::FA); LAS float* dtl = acum + 64;
    const int grp = h >> 2;
    const float Aneg = -__expf(P.in[22][layer * 16 + d * 8 + h]);
    const int base = seq * L, cbeg = seg * 32, cend = cbeg + 32;
    __syncthreads();
    f32x4 st[4];
#pragma unroll
    for (int i = 0; i < 4; ++i) st[i] = (f32x4){0.f, 0.f, 0.f, 0.f};
    const int kidx = h * 2 + d;
    if (!state_only) {
        for (int ps = 0; ps < seg; ++ps) {
            const float* sp = segst + (size_t)((seq * 8 + ps) * 24 + kidx) * 8256;
            const float dcy = __expf(sp[8192]);
#pragma unroll
            for (int tv = 0; tv < 4; ++tv)
#pragma unroll
                for (int jj = 0; jj < 4; ++jj) st[tv][jj] = st[tv][jj] * dcy + sp[(tv * 4 + jj) * 512 + tid];
        }
#pragma unroll
        for (int tv = 0; tv < 4; ++tv) {
            u32x2 o; o.x = pk2(st[tv][0], st[tv][1]); o.y = pk2(st[tv][2], st[tv][3]);
            *(LAS u32x2*)(StT + (tv * 16 + r) * C::LQ + w * 16 + q * 4) = o;
        }
    }
    float asum = 0.f;
    const int row = tid >> 3, part = tid & 7;
    const int tm = w >> 1, tn0 = (w & 1) * 2;
    bf16_t* yout = B.ssd_y + (size_t)d * TG * 512;
    u32x4 c0, c1, b0, b1, x0; float dtv;
#define SSD_LOAD(cc) do { const int n0_ = (cc) * 64; \
        const int tok = d == 0 ? base + n0_ + row : base + L - 1 - (n0_ + row); \
        const bf16_t* xr = B.ssd_x + (size_t)tok * 1024; \
        c0 = *(const u32x4*)(xr + 768 + grp * 128 + part * 16); c1 = *(const u32x4*)(xr + 768 + grp * 128 + part * 16 + 8); \
        b0 = *(const u32x4*)(xr + 512 + grp * 128 + part * 16); b1 = *(const u32x4*)(xr + 512 + grp * 128 + part * 16 + 8); \
        x0 = *(const u32x4*)(xr + h * 64 + part * 8); \
        const int tl_ = d == 0 ? base + n0_ + lane : base + L - 1 - (n0_ + lane); \
        dtv = B.ssd_dt[(size_t)tl_ * 16 + d * 8 + h]; } while (0)
    SSD_LOAD(cbeg);
    for (int c = cbeg; c < cend; ++c) {
        const int n0 = c * 64;
        const float ac = wave_incl_scan(dtv * Aneg, lane);
        const float alast = lane_bcast(ac, 63);
        asum += alast;
        if (w == 0) { acum[lane] = ac; dtl[lane] = dtv; }
        {
            const float ks = __shfl(dtv, row) * __expf(alast - __shfl(ac, row));
            *(LAS u32x4*)(Qa + row * C::LQ + part * 16) = c0; *(LAS u32x4*)(Qa + row * C::LQ + part * 16 + 8) = c1;
            *(LAS u32x4*)(Ka + row * C::LQ + part * 16) = b0; *(LAS u32x4*)(Ka + row * C::LQ + part * 16 + 8) = b1;
            float bf[16]; unpack8(b0, bf); unpack8(b1, bf + 8);
            const int rsw = row ^ (part << 3);
#pragma unroll
            for (int j = 0; j < 16; ++j) KbT[(part * 16 + j) * C::LT + rsw] = (bf16_t)f2bf(bf[j] * ks);
            const unsigned xs[4] = {x0.x, x0.y, x0.z, x0.w};
#pragma unroll
            for (int j = 0; j < 4; ++j) { VT[(part * 8 + 2 * j) * C::LT + rsw] = (bf16_t)(xs[j] & 0xffffu); VT[(part * 8 + 2 * j + 1) * C::LT + rsw] = (bf16_t)(xs[j] >> 16); }
        }
        if (c + 1 < cend) SSD_LOAD(c + 1);
        lds_barrier();
        if (!state_only) {
#pragma unroll
        for (int tt = 0; tt < 2; ++tt) {
            const int tn = tn0 + tt;
            f32x4 s = (f32x4){0.f, 0.f, 0.f, 0.f};
            s = mma_tn_x(s, Qa + tm * 16 * C::LQ, C::LQ, Ka + tn * 16 * C::LQ, C::LQ, 128, lane, 0, 0);
            const int i = tm * 16 + r, j0 = tn * 16 + q * 4;
            const float ai = acum[i];
            const f32x4 aj = *(const LAS f32x4*)(acum + j0), dj = *(const LAS f32x4*)(dtl + j0);
            float v[4];
#pragma unroll
            for (int jj = 0; jj < 4; ++jj) {
                const int j = j0 + jj;
                const bool on = d == 0 ? (i >= j) : (i > j);
                v[jj] = on ? s[jj] * __expf(ai - aj[jj]) * dj[jj] : 0.f;
            }
            u32x2 o; o.x = pk2(v[0], v[1]); o.y = pk2(v[2], v[3]);
            *(LAS u32x2*)(Sc + i * C::LT + j0) = o;
        }
        lds_barrier();
#pragma unroll
        for (int tt = 0; tt < 2; ++tt) {
            const int tn = tn0 + tt;
            f32x4 o1 = (f32x4){0.f, 0.f, 0.f, 0.f}, o2 = (f32x4){0.f, 0.f, 0.f, 0.f};
            o1 = mma_tn_x(o1, Sc + tm * 16 * C::LT, C::LT, VT + tn * 16 * C::LT, C::LT, 64, lane, 0, (tn * 2 + (r >> 3)) & 7);
            o2 = mma_tn_x(o2, Qa + tm * 16 * C::LQ, C::LQ, StT + tn * 16 * C::LQ, C::LQ, 128, lane, 0, 0);
            const int i = tm * 16 + r;
            const int tl = d == 0 ? base + n0 + i : base + L - 1 - (n0 + i);
            const float ei = __expf(acum[i]);
            { const f32x4 ov = o1 + o2 * ei; u32x2 o; o.x = pk2(ov[0], ov[1]); o.y = pk2(ov[2], ov[3]); *(u32x2*)(yout + (size_t)tl * 512 + h * 64 + tn * 16 + q * 4) = o; }
        }
        }
        {
            const float ds = __expf(alast);
#pragma unroll
            for (int tv = 0; tv < 4; ++tv) {
                st[tv] = st[tv] * ds;
                st[tv] = mma_nt_x(st[tv], KbT + w * 16 * C::LT, C::LT, VT + tv * 16 * C::LT, C::LT, 64, lane, w, (tv * 2 + (r >> 3)) & 7);
            }
        }
        lds_barrier();
        if (!state_only) {
#pragma unroll
        for (int tv = 0; tv < 4; ++tv) {
            u32x2 o; o.x = pk2(st[tv][0], st[tv][1]); o.y = pk2(st[tv][2], st[tv][3]);
            *(LAS u32x2*)(StT + (tv * 16 + r) * C::LQ + w * 16 + q * 4) = o;
        }
        }
    }
    if (state_only) {
        float* sp = segst + (size_t)((seq * 8 + seg) * 24 + kidx) * 8256;
#pragma unroll
        for (int tv = 0; tv < 4; ++tv)
#pragma unroll
            for (int jj = 0; jj < 4; ++jj) sp[(tv * 4 + jj) * 512 + tid] = st[tv][jj];
        if (tid == 0) sp[8192] = asum;
    }
#undef SSD_LOAD
}

__device__ __forceinline__ void gla_unit(LAS unsigned char* lds, const Params& P, const MixBufs& B, float* segst, int layer, int L, int seq, int h, int d, int seg, bool state_only) {
    typedef CL<32> C;
    const int tid = otid(), w = tid >> 6, lane = tid & 63, r = lane & 15, q = lane >> 4;
    LAS bf16_t* Qa = (LAS bf16_t*)(lds + C::QA); LAS bf16_t* Ka = (LAS bf16_t*)(lds + C::KA); LAS bf16_t* KbT = (LAS bf16_t*)(lds + C::KBT);
    LAS bf16_t* VT = (LAS bf16_t*)(lds + C::VT); LAS bf16_t* Sc = (LAS bf16_t*)(lds + C::SC); LAS bf16_t* StT = (LAS bf16_t*)(lds + C::STT);
    LAS float* dstate = (LAS float*)(lds + C::FA);
    const int base = seq * L, cbeg = seg * 32, cend = cbeg + 32;
    __syncthreads();
    f32x4 st = (f32x4){0.f, 0.f, 0.f, 0.f};
    const int row = tid >> 3, part = tid & 7;
    const int tm = w >> 1, tn0 = (w & 1) * 2;
    const int tk = w >> 2, tv = w & 3;
    const int kidx = 16 + h * 2 + d;
    if (!state_only) {
        for (int ps = 0; ps < seg; ++ps) {
            const float* sp = segst + (size_t)((seq * 8 + ps) * 24 + kidx) * 8256;
#pragma unroll
            for (int jj = 0; jj < 4; ++jj) st[jj] = st[jj] * __expf(sp[8192 + tk * 16 + q * 4 + jj]) + sp[jj * 512 + tid];
        }
        { u32x2 o; o.x = pk2(st[0], st[1]); o.y = pk2(st[2], st[3]); *(LAS u32x2*)(StT + (tv * 16 + r) * C::LQ + tk * 16 + q * 4) = o; }
    }
    float blsum[4] = {0.f, 0.f, 0.f, 0.f};
    const float* la = B.gla_la + (size_t)d * TG * 128;
    bf16_t* oout = B.gla_o + (size_t)d * TG * 256;
    const float qscale = 0.17677669529663687f;
    f32x4 lv; u32x2 qr, kr; u32x4 x0;
#define GLA_LOAD(cc) do { const int n0_ = (cc) * 64; \
        const int tl_ = d == 0 ? base + n0_ + lane : base + L - 1 - (n0_ + lane); \
        lv = *(const f32x4*)(la + (size_t)tl_ * 128 + h * 32 + 4 * w); \
        qr = *(const u32x2*)(B.p + (size_t)tl_ * DINP + PC_GQ + h * 32 + 4 * w); \
        kr = *(const u32x2*)(B.p + (size_t)tl_ * DINP + PC_GK + h * 32 + 4 * w); \
        const int tr_ = d == 0 ? base + n0_ + row : base + L - 1 - (n0_ + row); \
        x0 = *(const u32x4*)(B.p + (size_t)tr_ * DINP + PC_GV + h * 64 + part * 8); } while (0)
    GLA_LOAD(cbeg);
    for (int c = cbeg; c < cend; ++c) {
        const int n0 = c * 64;
        {
            const float qf[4] = {__uint_as_float(qr.x << 16), __uint_as_float(qr.x & 0xffff0000u), __uint_as_float(qr.y << 16), __uint_as_float(qr.y & 0xffff0000u)};
            const float kf[4] = {__uint_as_float(kr.x << 16), __uint_as_float(kr.x & 0xffff0000u), __uint_as_float(kr.y << 16), __uint_as_float(kr.y & 0xffff0000u)};
            float qd[4], kd[4];
#pragma unroll
            for (int kk = 0; kk < 4; ++kk) {
                const float b = wave_incl_scan(lv[kk], lane);
                const float bl = lane_bcast(b, 63);
                blsum[kk] += bl;
                qd[kk] = qf[kk] * qscale * __expf(b); kd[kk] = kf[kk] * __expf(-b);
                KbT[(4 * w + kk) * C::LT + lane] = (bf16_t)f2bf(kf[kk] * __expf(bl - b));
                if (lane == 63) dstate[4 * w + kk] = __expf(bl);
            }
            u32x2 o; o.x = pk2(qd[0], qd[1]); o.y = pk2(qd[2], qd[3]); *(LAS u32x2*)(Qa + lane * C::LQ + 4 * w) = o;
            o.x = pk2(kd[0], kd[1]); o.y = pk2(kd[2], kd[3]); *(LAS u32x2*)(Ka + lane * C::LQ + 4 * w) = o;
            const unsigned xs[4] = {x0.x, x0.y, x0.z, x0.w};
            const int rsw = row ^ (part << 3);
#pragma unroll
            for (int j = 0; j < 4; ++j) { VT[(part * 8 + 2 * j) * C::LT + rsw] = (bf16_t)(xs[j] & 0xffffu); VT[(part * 8 + 2 * j + 1) * C::LT + rsw] = (bf16_t)(xs[j] >> 16); }
        }
        if (c + 1 < cend) GLA_LOAD(c + 1);
        lds_barrier();
        if (!state_only) {
#pragma unroll
        for (int tt = 0; tt < 2; ++tt) {
            const int tn = tn0 + tt;
            f32x4 s = (f32x4){0.f, 0.f, 0.f, 0.f};
            s = mma_tn_x(s, Qa + tm * 16 * C::LQ, C::LQ, Ka + tn * 16 * C::LQ, C::LQ, 32, lane, 0, 0);
            const int i = tm * 16 + r, j0 = tn * 16 + q * 4;
            float v[4];
#pragma unroll
            for (int jj = 0; jj < 4; ++jj) { const int j = j0 + jj; const bool on = d == 0 ? (i >= j) : (i > j); v[jj] = on ? s[jj] : 0.f; }
            u32x2 o; o.x = pk2(v[0], v[1]); o.y = pk2(v[2], v[3]);
            *(LAS u32x2*)(Sc + i * C::LT + j0) = o;
        }
        lds_barrier();
#pragma unroll
        for (int tt = 0; tt < 2; ++tt) {
            const int tn = tn0 + tt;
            f32x4 o1 = (f32x4){0.f, 0.f, 0.f, 0.f};
            o1 = mma_tn_x(o1, Sc + tm * 16 * C::LT, C::LT, VT + tn * 16 * C::LT, C::LT, 64, lane, 0, (tn * 2 + (r >> 3)) & 7);
            o1 = mma_tn_x(o1, Qa + tm * 16 * C::LQ, C::LQ, StT + tn * 16 * C::LQ, C::LQ, 32, lane, 0, 0);
            const int i = tm * 16 + r;
            const int tl = d == 0 ? base + n0 + i : base + L - 1 - (n0 + i);
            { u32x2 o; o.x = pk2(o1[0], o1[1]); o.y = pk2(o1[2], o1[3]); *(u32x2*)(oout + (size_t)tl * 256 + h * 64 + tn * 16 + q * 4) = o; }
        }
        }
        {
#pragma unroll
            for (int jj = 0; jj < 4; ++jj) st[jj] *= dstate[tk * 16 + q * 4 + jj];
            st = mma_nt_x(st, KbT + tk * 16 * C::LT, C::LT, VT + tv * 16 * C::LT, C::LT, 64, lane, 0, (tv * 2 + (r >> 3)) & 7);
        }
        lds_barrier();
        if (!state_only) { u32x2 o; o.x = pk2(st[0], st[1]); o.y = pk2(st[2], st[3]); *(LAS u32x2*)(StT + (tv * 16 + r) * C::LQ + tk * 16 + q * 4) = o; }
    }
    if (state_only) {
        float* sp = segst + (size_t)((seq * 8 + seg) * 24 + kidx) * 8256;
#pragma unroll
        for (int jj = 0; jj < 4; ++jj) sp[jj * 512 + tid] = st[jj];
        if (lane == 0) {
#pragma unroll
            for (int kk = 0; kk < 4; ++kk) sp[8192 + 4 * w + kk] = blsum[kk];
        }
    }
#undef GLA_LOAD
}

constexpr int RL = 72;
struct RwRaw { u32x4 e, kk, bb, kd, rr, v; };
__device__ __forceinline__ void rwkv_pre_load(RwRaw& R, const MixBufs& B, int L, int u, int tid) {
    const int w = tid >> 6, lane = tid & 63, nch = L / 64, hd = u & 7, ch = u >> 3, h = hd >> 1, d = hd & 1;
    const int base = (ch / nch) * L, n0 = (ch % nch) * 64;
    const int tl = d == 0 ? base + n0 + lane : base + L - 1 - (n0 + lane);
    const size_t o = (size_t)tl * 256 + h * 64 + 8 * w;
    R.e = *(const u32x4*)(B.rw + (4 + d) * RWA + o); R.kk = *(const u32x4*)(B.rw + 2 * RWA + o);
    R.bb = *(const u32x4*)(B.rw + (8 + d) * RWA + o); R.kd = *(const u32x4*)(B.rw + (6 + d) * RWA + o);
    R.rr = *(const u32x4*)(B.rw + 0 * RWA + o);
    const int row = tid >> 3, part = tid & 7;
    const int tr = d == 0 ? base + n0 + row : base + L - 1 - (n0 + row);
    R.v = *(const u32x4*)(B.rw + 1 * RWA + (size_t)tr * 256 + h * 64 + part * 8);
}
__device__ __forceinline__ void rwkv_pre(LAS unsigned char* lds, const MixBufs& B, bf16_t* rq, int L, int u, int unext, RwRaw& R) {
    const int tid = otid(), w = tid >> 6, lane = tid & 63, r = lane & 15, q = lane >> 4;
#define RG(i) ((LAS bf16_t*)(lds + (i) * 9216))
    LAS bf16_t* At = RG(0); LAS bf16_t* Bt_ = RG(1); LAS bf16_t* Kt = RG(2); LAS bf16_t* Rt = RG(3); LAS bf16_t* AtT = RG(4); LAS bf16_t* BhT = RG(5);
    LAS bf16_t* KhT = RG(6); LAS bf16_t* VT = RG(7); LAS bf16_t* Lak = RG(8); LAS bf16_t* Mrb = RG(9); LAS bf16_t* Mrk = RG(10); LAS bf16_t* WT = RG(11);
    LAS bf16_t* Tm = RG(0); LAS bf16_t* XT = RG(1); LAS bf16_t* UT = RG(2);
#undef RG
    LAS float* Lf = (LAS float*)(lds + 12 * 9216);
    LAS float* gC = (LAS float*)(lds + 12 * 9216 + 17408);
    LAS bf16_t* L21b = (LAS bf16_t*)(lds + 12 * 9216 + 17408 + 512);
    LAS bf16_t* T11T = WT;
    LAS bf16_t* X1T = WT + 32 * 40;
    const int nch = L / 64, hd = u & 7, ch = u >> 3, h = hd >> 1, d = hd & 1, seq = ch / nch, c = ch % nch;
    const int base = seq * L, n0 = c * 64;
    const int cu = (((seq * nch + c) * 4 + h) * 2 + d);
    bf16_t* gq = rq + (size_t)cu * 3 * 4096;
    lds_barrier();
    {
        float e[8], kk[8], bb[8], kd[8], rr[8];
        unpack8(R.e, e); unpack8(R.kk, kk); unpack8(R.bb, bb); unpack8(R.kd, kd); unpack8(R.rr, rr);
        float at[8], bt[8], kt[8], rt[8];
#pragma unroll
        for (int j = 0; j < 8; ++j) {
            const float cum = wave_incl_scan(e[j], lane);
            const float cmid = lane_bcast(cum, 31), clast = lane_bcast(cum, 63);
            const float ea = __expf(-(cum - e[j] - cmid)), eb = __expf(cum - cmid), er = __expf(-(cum - cmid)), eh = __expf(-(clast - cum));
            at[j] = -kk[j] * ea; bt[j] = bb[j] * eb; kt[j] = kd[j] * eb; rt[j] = rr[j] * er;
            AtT[(8 * w + j) * RL + lane] = (bf16_t)f2bf(at[j]);
            BhT[(8 * w + j) * RL + lane] = (bf16_t)f2bf(bb[j] * eh);
            KhT[(8 * w + j) * RL + lane] = (bf16_t)f2bf(kd[j] * eh);
            if (lane == 63) { gC[8 * w + j] = __expf(-clast); gC[64 + 8 * w + j] = __expf(-cmid); }
        }
        u32x4 o4;
        o4.x = pk2(at[0], at[1]); o4.y = pk2(at[2], at[3]); o4.z = pk2(at[4], at[5]); o4.w = pk2(at[6], at[7]); *(LAS u32x4*)(At + lane * RL + 8 * w) = o4;
        o4.x = pk2(bt[0], bt[1]); o4.y = pk2(bt[2], bt[3]); o4.z = pk2(bt[4], bt[5]); o4.w = pk2(bt[6], bt[7]); *(LAS u32x4*)(Bt_ + lane * RL + 8 * w) = o4;
        o4.x = pk2(kt[0], kt[1]); o4.y = pk2(kt[2], kt[3]); o4.z = pk2(kt[4], kt[5]); o4.w = pk2(kt[6], kt[7]); *(LAS u32x4*)(Kt + lane * RL + 8 * w) = o4;
        o4.x = pk2(rt[0], rt[1]); o4.y = pk2(rt[2], rt[3]); o4.z = pk2(rt[4], rt[5]); o4.w = pk2(rt[6], rt[7]); *(LAS u32x4*)(Rt + lane * RL + 8 * w) = o4;
        const int row = tid >> 3, part = tid & 7;
        const unsigned xs[4] = {R.v.x, R.v.y, R.v.z, R.v.w};
#pragma unroll
        for (int j = 0; j < 4; ++j) { VT[(part * 8 + 2 * j) * RL + row] = (bf16_t)(xs[j] & 0xffffu); VT[(part * 8 + 2 * j + 1) * RL + row] = (bf16_t)(xs[j] >> 16); }
    }
    if (unext >= 0) rwkv_pre_load(R, B, L, unext, tid);
    lds_barrier();
    const int tm = w >> 1, tn0 = (w & 1) * 2;
    const f32x4 Z4 = (f32x4){0.f, 0.f, 0.f, 0.f};
#pragma unroll
    for (int tt = 0; tt < 2; ++tt) {
        const int tn = tn0 + tt;
        const f32x4 lab = mma_tn_x(Z4, At + tm * 16 * RL, RL, Bt_ + tn * 16 * RL, RL, 64, lane, 0, 0);
        const f32x4 lak = mma_tn_x(Z4, At + tm * 16 * RL, RL, Kt + tn * 16 * RL, RL, 64, lane, 0, 0);
        const f32x4 mrb = mma_tn_x(Z4, Rt + tm * 16 * RL, RL, Bt_ + tn * 16 * RL, RL, 64, lane, 0, 0);
        const f32x4 mrk = mma_tn_x(Z4, Rt + tm * 16 * RL, RL, Kt + tn * 16 * RL, RL, 64, lane, 0, 0);
        const int i = tm * 16 + r, j0 = tn * 16 + q * 4;
        f32x4 lf; float vk[4], vb[4], vm[4];
#pragma unroll
        for (int jj = 0; jj < 4; ++jj) {
            const int j = j0 + jj; const bool st_ = j < i, in_ = j <= i;
            lf[jj] = st_ ? lab[jj] : 0.f; vk[jj] = st_ ? lak[jj] : 0.f; vb[jj] = in_ ? mrb[jj] : 0.f; vm[jj] = in_ ? mrk[jj] : 0.f;
        }
        *(LAS f32x4*)(Lf + i * 68 + j0) = lf;
        u32x2 o;
        if (tm >= 2 && tn < 2) { o.x = pk2(lab[0], lab[1]); o.y = pk2(lab[2], lab[3]); *(LAS u32x2*)(L21b + (i - 32) * 40 + j0) = o; }
        o.x = pk2(vk[0], vk[1]); o.y = pk2(vk[2], vk[3]); *(LAS u32x2*)(Lak + i * RL + j0) = o;
        o.x = pk2(vb[0], vb[1]); o.y = pk2(vb[2], vb[3]); *(LAS u32x2*)(Mrb + i * RL + j0) = o;
        o.x = pk2(vm[0], vm[1]); o.y = pk2(vm[2], vm[3]); *(LAS u32x2*)(Mrk + i * RL + j0) = o;
    }
    lds_barrier();
#pragma unroll
    for (int tt = 0; tt < 2; ++tt) {
        const int tn = tn0 + tt;
        const f32x4 x = mma_nt(Z4, Lak + tm * 16 * RL, RL, VT + tn * 16 * RL, RL, 64, lane);
        u32x2 o; o.x = pk2(x[0], x[1]); o.y = pk2(x[2], x[3]);
        *(LAS u32x2*)(XT + (tn * 16 + r) * RL + tm * 16 + q * 4) = o;
    }
    if (w < 2) {
        const int ob = w * 32, j = lane & 31;
        float T[32];
        int zv = 0; asm volatile("" : "+v"(zv));
        const LAS float* Lfz = Lf + zv + ob * 68 + ob;
#pragma unroll
        for (int t = 0; t < 32; ++t) {
            float a0 = (t == j) ? 1.f : 0.f, a1 = 0.f;
#pragma unroll
            for (int s4 = 0; s4 < (t + 3) / 4; ++s4) {
                const f32x4 l = *(const LAS f32x4*)(Lfz + t * 68 + s4 * 4);
#pragma unroll
                for (int e2 = 0; e2 < 4; ++e2) { const int s_ = s4 * 4 + e2; if (s_ < t) { if (e2 & 1) a1 += l[e2] * T[s_]; else a0 += l[e2] * T[s_]; } }
            }
            T[t] = a0 + a1;
            if (lane < 32) {
                Tm[(ob + t) * RL + ob + j] = (bf16_t)f2bf(T[t]);
                if (w == 0) T11T[j * 40 + t] = (bf16_t)f2bf(T[t]);
            }
        }
    } else if (w == 2) {
        for (int i = lane; i < 32 * 16; i += 64) { const int t = i >> 4, c2 = (i & 15) * 2; *(LAS unsigned*)(Tm + t * RL + 32 + c2) = 0u; }
    }
    lds_barrier();
    if (w < 4) {
        const int mi = w >> 1, ni = w & 1;
        const f32x4 x1 = mma_nt(Z4, L21b + mi * 16 * 40, 40, T11T + ni * 16 * 40, 40, 32, lane);
        u32x2 o; o.x = pk2(x1[0], x1[1]); o.y = pk2(x1[2], x1[3]);
        *(LAS u32x2*)(X1T + (ni * 16 + r) * 40 + mi * 16 + q * 4) = o;
    }
    lds_barrier();
    if (w < 4) {
        const int mi = w >> 1, ni = w & 1;
        const f32x4 t21 = mma_tn_x(Z4, Tm + (32 + mi * 16) * RL + 32, RL, X1T + ni * 16 * 40, 40, 32, lane, 0, 0);
        u32x2 o; o.x = pk2(t21[0], t21[1]); o.y = pk2(t21[2], t21[3]);
        *(LAS u32x2*)(Tm + (32 + mi * 16 + r) * RL + ni * 16 + q * 4) = o;
    }
    lds_barrier();
    f32x4 uu[2], ww[2];
#pragma unroll
    for (int tt = 0; tt < 2; ++tt) {
        const int tn = tn0 + tt;
        uu[tt] = mma_nt(Z4, Tm + tm * 16 * RL, RL, XT + tn * 16 * RL, RL, 64, lane);
        ww[tt] = mma_nt(Z4, Tm + tm * 16 * RL, RL, AtT + tn * 16 * RL, RL, 64, lane);
    }
#pragma unroll
    for (int tt = 0; tt < 2; ++tt) {
        const int tn = tn0 + tt;
        u32x2 o; o.x = pk2(uu[tt][0], uu[tt][1]); o.y = pk2(uu[tt][2], uu[tt][3]);
        *(LAS u32x2*)(UT + (tn * 16 + r) * RL + tm * 16 + q * 4) = o;
        o.x = pk2(ww[tt][0], ww[tt][1]); o.y = pk2(ww[tt][2], ww[tt][3]);
        *(LAS u32x2*)(WT + (tn * 16 + r) * RL + tm * 16 + q * 4) = o;
    }
    lds_barrier();
    bf16_t* yout = B.rw_y + (size_t)d * TG * 256;
#pragma unroll
    for (int tt = 0; tt < 2; ++tt) {
        const int tn = tn0 + tt;
        const f32x4 qe = mma_tn_x(Z4, Mrb + tm * 16 * RL, RL, WT + tn * 16 * RL, RL, 64, lane, 0, 0);
        f32x4 yl = mma_tn_x(Z4, Mrb + tm * 16 * RL, RL, UT + tn * 16 * RL, RL, 64, lane, 0, 0);
        yl = mma_tn_x(yl, Mrk + tm * 16 * RL, RL, VT + tn * 16 * RL, RL, 64, lane, 0, 0);
        const f32x4 pe = mma_tn_x(Z4, BhT + tm * 16 * RL, RL, WT + tn * 16 * RL, RL, 64, lane, 0, 0);
        f32x4 hl = mma_nt(Z4, BhT + tm * 16 * RL, RL, UT + tn * 16 * RL, RL, 64, lane);
        hl = mma_nt(hl, KhT + tm * 16 * RL, RL, VT + tn * 16 * RL, RL, 64, lane);
        const int i = tm * 16 + r, n0c = tn * 16 + q * 4;
        const f32x4 um = *(const LAS f32x4*)(gC + 64 + n0c);
        const u32x2 rtp = *(const LAS u32x2*)(Rt + i * RL + n0c);
        const float rt4[4] = {__uint_as_float(rtp.x << 16), __uint_as_float(rtp.x & 0xffff0000u), __uint_as_float(rtp.y << 16), __uint_as_float(rtp.y & 0xffff0000u)};
        const float gci = gC[i];
        float qv[4], pv[4];
#pragma unroll
        for (int jj = 0; jj < 4; ++jj) { qv[jj] = (qe[jj] + rt4[jj]) * um[jj]; pv[jj] = pe[jj] * um[jj] + ((n0c + jj) == i ? gci : 0.f); }
        u32x2 o; o.x = pk2(qv[0], qv[1]); o.y = pk2(qv[2], qv[3]); *(u32x2*)(gq + i * 64 + n0c) = o;
        o.x = pk2(pv[0], pv[1]); o.y = pk2(pv[2], pv[3]); *(u32x2*)(gq + 4096 + i * 64 + n0c) = o;
        const int tl = d == 0 ? base + n0 + i : base + L - 1 - (n0 + i);
        o.x = pk2(yl[0], yl[1]); o.y = pk2(yl[2], yl[3]); *(u32x2*)(yout + (size_t)tl * 256 + h * 64 + n0c) = o;
        o.x = pk2(hl[0], hl[1]); o.y = pk2(hl[2], hl[3]);
        *(u32x2*)(gq + 8192 + (tn * 16 + r) * 64 + tm * 16 + q * 4) = o;
    }
}

__device__ __forceinline__ void rwkv_seq(LAS unsigned char* lds, const MixBufs& B, const bf16_t* rq, int L, int seq, int h, int d) {
    const int tid = otid(), w = tid >> 6, lane = tid & 63, r = lane & 15, q = lane >> 4;
    const int tm = w >> 1, tn0 = (w & 1) * 2;
    const int base = seq * L, nch = L / 64;
    __syncthreads();
    for (int i = tid; i < 64 * RL / 2; i += 512) ((LAS unsigned*)lds)[i] = 0u;
    bf16_t* yout = B.rw_y + (size_t)d * TG * 256;
    const size_t custride = (size_t)8 * 3 * 4096;
    const bf16_t* g = rq + (size_t)(((seq * nch) * 4 + h) * 2 + d) * 3 * 4096;
    const int aoff = (tm * 16 + r) * 64 + q * 8;
    bf16x8 qa0 = *(const bf16x8*)(g + aoff), qa1 = *(const bf16x8*)(g + aoff + 32);
    bf16x8 pa0 = *(const bf16x8*)(g + 4096 + aoff), pa1 = *(const bf16x8*)(g + 4096 + aoff + 32);
    u32x2 hl0 = *(const u32x2*)(g + 8192 + (tn0 * 16 + r) * 64 + tm * 16 + q * 4), hl1 = *(const u32x2*)(g + 8192 + ((tn0 + 1) * 16 + r) * 64 + tm * 16 + q * 4);
    for (int c = 0; c < nch; ++c) {
        const bf16_t* gn = g + (c + 1 < nch ? custride : 0);
        const bf16x8 nqa0 = *(const bf16x8*)(gn + aoff), nqa1 = *(const bf16x8*)(gn + aoff + 32);
        const bf16x8 npa0 = *(const bf16x8*)(gn + 4096 + aoff), npa1 = *(const bf16x8*)(gn + 4096 + aoff + 32);
        const u32x2 nhl0 = *(const u32x2*)(gn + 8192 + (tn0 * 16 + r) * 64 + tm * 16 + q * 4), nhl1 = *(const u32x2*)(gn + 8192 + ((tn0 + 1) * 16 + r) * 64 + tm * 16 + q * 4);
        u32x2 yl[2];
        const int ti_ = tm * 16 + r;
        bf16_t* yrow = yout + (size_t)(d == 0 ? base + c * 64 + ti_ : base + L - 1 - (c * 64 + ti_)) * 256 + h * 64 + q * 4;
#pragma unroll
        for (int tt = 0; tt < 2; ++tt) yl[tt] = *(const u32x2*)(yrow + (tn0 + tt) * 16);
        lds_barrier();
        const LAS bf16_t* cur = (const LAS bf16_t*)(lds + (c & 1) * 9216);
        LAS bf16_t* nxt = (LAS bf16_t*)(lds + ((c + 1) & 1) * 9216);
#pragma unroll
        for (int tt = 0; tt < 2; ++tt) {
            const int tn = tn0 + tt;
            const bf16x8 b0 = *(const LAS bf16x8*)(cur + (tn * 16 + r) * RL + q * 8), b1 = *(const LAS bf16x8*)(cur + (tn * 16 + r) * RL + 32 + q * 8);
            f32x4 y = (f32x4){0.f, 0.f, 0.f, 0.f}, hn = (f32x4){0.f, 0.f, 0.f, 0.f};
            y = __builtin_amdgcn_mfma_f32_16x16x32_bf16(b0, qa0, y, 0, 0, 0); y = __builtin_amdgcn_mfma_f32_16x16x32_bf16(b1, qa1, y, 0, 0, 0);
            hn = __builtin_amdgcn_mfma_f32_16x16x32_bf16(pa0, b0, hn, 0, 0, 0); hn = __builtin_amdgcn_mfma_f32_16x16x32_bf16(pa1, b1, hn, 0, 0, 0);
            const u32x2 hl = tt == 0 ? hl0 : hl1;
            hn[0] += __uint_as_float(hl.x << 16); hn[1] += __uint_as_float(hl.x & 0xffff0000u); hn[2] += __uint_as_float(hl.y << 16); hn[3] += __uint_as_float(hl.y & 0xffff0000u);
            u32x2 o; o.x = pk2(hn[0], hn[1]); o.y = pk2(hn[2], hn[3]);
            *(LAS u32x2*)(nxt + (tn * 16 + r) * RL + tm * 16 + q * 4) = o;
            { const u32x2 yo = yl[tt];
              y[0] += __uint_as_float(yo.x << 16); y[1] += __uint_as_float(yo.x & 0xffff0000u); y[2] += __uint_as_float(yo.y << 16); y[3] += __uint_as_float(yo.y & 0xffff0000u);
              u32x2 o2; o2.x = pk2(y[0], y[1]); o2.y = pk2(y[2], y[3]); *(u32x2*)(yrow + tn * 16) = o2; }
        }
        g = gn; qa0 = nqa0; qa1 = nqa1; pa0 = npa0; pa1 = npa1; hl0 = nhl0; hl1 = nhl1;
    }
}

__device__ __forceinline__ void phase_post(const Params& P, const MixBufs& B, int layer) {
    const int tid_ = otid(); const int lane = tid_ & 63, gw = blockIdx.x * 8 + (tid_ >> 6), nw = gridDim.x * 8;
    const float gng = P.in[7][layer * 64 + lane];
    const float* ssdn = P.in[24] + layer * 512;
    float lng[4], lnb[4];
#pragma unroll
    for (int h = 0; h < 4; ++h) { lng[h] = P.in[17][layer * 256 + h * 64 + lane]; lnb[h] = P.in[18][layer * 256 + h * 64 + lane]; }
    const int c0 = lane * 8;
    const f32x4 sg0 = *(const f32x4*)(ssdn + c0), sg1 = *(const f32x4*)(ssdn + c0 + 4);
    const float Dh = P.in[23][layer * 8 + (lane >> 3)];
    for (int tl = gw; tl < TG; tl += nw) {
        const bf16_t* pr = B.p + (size_t)tl * DINP;
        bf16_t* mr = B.mix + (size_t)tl * DM;
        bf16_t go0[4], go1[4], ry0[4], ry1[4]; bf16_t ggt[4], rvv[4], rgg[4];
#pragma unroll
        for (int h = 0; h < 4; ++h) {
            const size_t o = (size_t)tl * 256 + h * 64 + lane;
            go0[h] = B.gla_o[o]; go1[h] = B.gla_o[(size_t)TG * 256 + o]; ggt[h] = pr[PC_GG + h * 64 + lane];
            ry0[h] = B.rw_y[o]; ry1[h] = B.rw_y[(size_t)TG * 256 + o]; rvv[h] = B.rw[1 * RWA + o]; rgg[h] = B.rw[3 * RWA + o];
        }
        const f32x4 srk = *(const f32x4*)(B.rw_s + (size_t)tl * 4), skr = *(const f32x4*)(B.rw_s + (size_t)TG * 4 + (size_t)tl * 4);
        const u32x4 ya = *(const u32x4*)(B.ssd_y + (size_t)tl * 512 + c0), yb = *(const u32x4*)(B.ssd_y + (size_t)TG * 512 + (size_t)tl * 512 + c0);
        const u32x4 xsr = *(const u32x4*)(B.ssd_x + (size_t)tl * 1024 + c0), zr = *(const u32x4*)(pr + PC_Z + c0);
#pragma unroll
        for (int h = 0; h < 4; ++h) {
            const float o = bf2f(go0[h]) + bf2f(go1[h]);
            const float ms = wave_sum(o * o) * (1.0f / 64.0f);
            mr[h * 64 + lane] = (bf16_t)f2bf(o * rsqrtf(ms + EPS) * gng * silu(bf2f(ggt[h])));
        }
#pragma unroll
        for (int h = 0; h < 4; ++h) {
            const float v = bf2f(rvv[h]);
            const float y = bf2f(ry0[h]) + bf2f(ry1[h]) - v * skr[h];
            const float mean = wave_sum(y) * (1.0f / 64.0f);
            const float dv = y - mean; const float var = wave_sum(dv * dv) * (1.0f / 64.0f);
            float oo = dv * rsqrtf(var + 64e-5f) * lng[h] + lnb[h];
            oo += srk[h] * v;
            mr[256 + h * 64 + lane] = (bf16_t)f2bf(oo * bf2f(rgg[h]));
        }
        {
            float xs[8], z[8], yfa[8], yfb[8]; unpack8(xsr, xs); unpack8(zr, z); unpack8(ya, yfa); unpack8(yb, yfb);
            float yv[8]; float ss = 0.f;
#pragma unroll
            for (int j = 0; j < 8; ++j) { const float yy = (yfa[j] + yfb[j]) + Dh * xs[j]; yv[j] = yy * silu(z[j]); ss += yv[j] * yv[j]; }
            ss = wave_sum(ss);
            const float rs = rsqrtf(ss * (1.0f / 512.0f) + EPS);
            u32x4 o; o.x = pk2(yv[0] * rs * sg0[0], yv[1] * rs * sg0[1]); o.y = pk2(yv[2] * rs * sg0[2], yv[3] * rs * sg0[3]);
            o.z = pk2(yv[4] * rs * sg1[0], yv[5] * rs * sg1[1]); o.w = pk2(yv[6] * rs * sg1[2], yv[7] * rs * sg1[3]);
            *(u32x4*)(mr + 512 + c0) = o;
        }
    }
}

__global__ void __launch_bounds__(512, 2) fwd_megakernel(Params P) {
    extern __shared__ __attribute__((aligned(16))) unsigned char shm[];
    LAS unsigned char* lds = (LAS unsigned char*)shm;
    unsigned char* ws = P.ws;
    volatile LAS unsigned* bst = (volatile LAS unsigned*)(lds + 131072 + 1024);
    if (threadIdx.x == 0) { bst[0] = 0u; bst[1] = 0u; }
    __syncthreads();
    const XcdBarrier xbar = xcd_barrier_post((unsigned*)(ws + WS_CTL), bst);
    bf16_t* xb = (bf16_t*)(ws + WS_XB); float* ssp = (float*)(ws + WS_SSP); bf16_t* pbuf = (bf16_t*)(ws + WS_P);

    phase_weights(lds, P);
    for (int g = 0; g < NGROUP; ++g) {
        const int L = g < 2 ? 2048 : 16384, nseq = TG / L;
        phase_xprep(P, g);
        if (g == 0) cg::this_grid().sync(); else xcd_barrier(xbar);
        for (int layer = 0; layer < 2; ++layer) {
            pg8::StaticOrder S;
            {
                pg8::Gemm gm; gm.A = xb; gm.Bt = (const bf16_t*)(ws + WS_WIN) + (size_t)layer * DINP * DM; gm.M = TG; gm.N = DINP; gm.K = DM;
                S.init(TG, DINP, gridDim.x, blockIdx.x);
                EpiInproj E; E.O = pbuf; E.ssp = ssp;
                pg8::gemm_phase(lds, gm, S, E);
            }
            xcd_barrier(xbar);
            { const MixBufs B = mixbufs(P); const bf16_t* sw = (const bf16_t*)(ws + WS_SW) + (size_t)layer * SW_L;
              for (int t = blockIdx.x; t < TG / 64; t += gridDim.x) prep_tile64(lds, P, B, sw, layer, L, t); }
            xcd_barrier(xbar);
            {
                const MixBufs B = mixbufs(P);
                bf16_t* rq = (bf16_t*)(ws + WS_RWQ); float* segst = P.out + (size_t)g * TG * DM;
                const int nseg = L / 2048, nch = L / 64;
                const int nchain = nseg == 1 ? nseq * 24 : nseq * (nseg - 1) * 24;
                if (nseg == 1 && gridDim.x == 256) {
                    const int b = blockIdx.x;
                    ssd_unit(lds, P, B, segst, layer, L, b / 24 * 0 + (b >> 4), (b >> 1) & 7, b & 1, 0, false);
                    const int p0 = b * 16, pn = 16;
                    __syncthreads();
                    RwRaw R; rwkv_pre_load(R, B, L, p0, otid());
                    for (int u = p0; u < p0 + pn; ++u) rwkv_pre(lds, B, rq, L, u, u + 1 < p0 + pn ? u + 1 : -1, R);
                } else if (nseg == 8 && nseq == 2 && gridDim.x == 256) {
                    const int b = blockIdx.x;
                    for (int rep = 0; rep < 2; ++rep) {
                        const int it = b + rep * 256;
                        if (it < nchain) {
                            const int k = it % 24, sg = it / 24, seq = sg / (nseg - 1), seg = sg % (nseg - 1);
                            if (k < 16) ssd_unit(lds, P, B, segst, layer, L, seq, k >> 1, k & 1, seg, true);
                            else gla_unit(lds, P, B, segst, layer, L, seq, (k - 16) >> 1, k & 1, seg, true);
                        }
                    }
                    const int kx = b - 80;
                    const int p0 = b < 80 ? b * 9 : 720 + kx * 19 + (kx < 32 ? kx : 32), pn = b < 80 ? 9 : 19 + (kx < 32 ? 1 : 0);
                    __syncthreads();
                    RwRaw R; rwkv_pre_load(R, B, L, p0, otid());
                    for (int u = p0; u < p0 + pn; ++u) rwkv_pre(lds, B, rq, L, u, u + 1 < p0 + pn ? u + 1 : -1, R);
                } else
                for (int it = blockIdx.x; it < nchain + 4096; it += gridDim.x) {
                    if (it < nchain) {
                        const int k = it % 24, sg = it / 24, seq = nseg == 1 ? sg : sg / (nseg - 1), seg = nseg == 1 ? 0 : sg % (nseg - 1);
                        if (k < 16) ssd_unit(lds, P, B, segst, layer, L, seq, k >> 1, k & 1, seg, nseg > 1);
                        else gla_unit(lds, P, B, segst, layer, L, seq, (k - 16) >> 1, k & 1, seg, nseg > 1);
                    } else { const int u = it - nchain; __syncthreads(); RwRaw R; rwkv_pre_load(R, B, L, u, otid()); rwkv_pre(lds, B, rq, L, u, -1, R); }
                }
            }
            xcd_barrier(xbar);
            {
                const MixBufs B = mixbufs(P);
                const bf16_t* rq = (const bf16_t*)(ws + WS_RWQ); float* segst = P.out + (size_t)g * TG * DM;
                const int nseg = L / 2048;
                const int nchain = nseg == 1 ? 0 : nseq * nseg * 24;
                const int nrs = nseq * 8, G = gridDim.x;
                if (nseg == 1 && G == 256) {
                    const int b = blockIdx.x;
                    if (b < 128) rwkv_seq(lds, B, rq, L, b >> 3, (b >> 1) & 3, b & 1);
                    else { const int u = b - 128; gla_unit(lds, P, B, segst, layer, L, u >> 3, (u >> 1) & 3, u & 1, 0, false); }
                } else
                for (int rnd = 0; rnd * G < nchain + nrs; ++rnd) {
                    const int it = rnd * G + ((rnd & 1) ? (G - 1 - (int)blockIdx.x) : (int)blockIdx.x);
                    if (it >= nchain + nrs) continue;
                    if (it >= nrs) {
                        const int ci = it - nrs, k = ci % 24, sg = ci / 24, seq = sg / nseg, seg = sg % nseg;
                        if (k < 16) ssd_unit(lds, P, B, segst, layer, L, seq, k >> 1, k & 1, seg, false);
                        else gla_unit(lds, P, B, segst, layer, L, seq, (k - 16) >> 1, k & 1, seg, false);
                    } else { rwkv_seq(lds, B, rq, L, it >> 3, (it >> 1) & 3, it & 1); }
                }
            }
            xcd_barrier(xbar);
            { const MixBufs B = mixbufs(P); phase_post(P, B, layer); }
            xcd_barrier(xbar);
            {
                pg8::Gemm gm; gm.A = (const bf16_t*)(ws + WS_MIX); gm.Bt = (const bf16_t*)(ws + WS_WOUT) + (size_t)layer * DM * DM; gm.M = TG; gm.N = DM; gm.K = DM;
                S.init(TG, DM, gridDim.x, blockIdx.x);
                EpiResid E; E.XB = xb; E.ssp = ssp;
                pg8::gemm_phase(lds, gm, S, E);
            }
            xcd_barrier(xbar);
            {
                pg8::Gemm gm; gm.A = xb; gm.Bt = (const bf16_t*)(ws + WS_WGU) + (size_t)layer * 2 * DFF * DM; gm.M = TG; gm.N = 2 * DFF; gm.K = DM;
                S.init(TG, 2 * DFF, gridDim.x, blockIdx.x);
                EpiGateUp E; E.O = pbuf; E.ssp = ssp;
                pg8::gemm_phase(lds, gm, S, E);
            }
            xcd_barrier(xbar);
            {
                pg8::Gemm gm; gm.A = pbuf; gm.Bt = (const bf16_t*)(ws + WS_WDN) + (size_t)layer * DM * DFF; gm.M = TG; gm.N = DM; gm.K = DFF;
                S.init(TG, DM, gridDim.x, blockIdx.x);
                EpiResid E; E.XB = xb; E.ssp = ssp;
                pg8::gemm_phase(lds, gm, S, E);
            }
            xcd_barrier(xbar);
        }
        phase_final(P, g);
        xcd_barrier(xbar);
    }
}

extern "C" void kernel_launch(void* const* d_in, const int* in_sizes, int n_in, void* d_out, int out_size, void* d_ws, size_t ws_size, hipStream_t stream) {
    static int grid = 0;
    if (grid == 0) {
        if (n_in != 30 || ws_size < WS_END) { fprintf(stderr, "kernel_launch: need 30 inputs and %zu ws bytes; got %d, %zu\n", (size_t)WS_END, n_in, ws_size); grid = -1; return; }
        int dev = 0, cus = 0, per_cu = 0;
        hipGetDevice(&dev);
        hipDeviceGetAttribute(&cus, hipDeviceAttributeMultiprocessorCount, dev);
        hipFuncSetAttribute((const void*)fwd_megakernel, hipFuncAttributeMaxDynamicSharedMemorySize, LDS_BYTES);
        hipOccupancyMaxActiveBlocksPerMultiprocessor(&per_cu, (const void*)fwd_megakernel, 512, LDS_BYTES);
        if (per_cu < 1) per_cu = 1;
        grid = cus * 1;
        if (grid > 256) grid = 256;
    }
    if (grid < 0) return;
    if (hipMemsetAsync((char*)d_ws + WS_CTL, 0, 65536, stream) != hipSuccess) { fprintf(stderr, "memset failed\n"); return; }
    Params p{};
    for (int i = 0; i < 30; ++i) p.in[i] = (const float*)d_in[i];
    p.out = (float*)d_out; p.ws = (unsigned char*)d_ws;
    void* args[] = {&p};
    hipError_t e = hipLaunchCooperativeKernel((const void*)fwd_megakernel, dim3(grid), dim3(512), args, LDS_BYTES, stream);
    if (e != hipSuccess) fprintf(stderr, "cooperative launch failed: %s (grid %d)\n", hipGetErrorString(e), grid);
}
```

```cpp
#include <hip/hip_runtime.h>
#include <hip/hip_cooperative_groups.h>
#include <cstdio>
namespace cg = cooperative_groups;

#define LAS __attribute__((address_space(3)))
typedef unsigned short bf16_t;
typedef short bf16x8 __attribute__((ext_vector_type(8)));
typedef float f32x4 __attribute__((ext_vector_type(4)));
typedef float f32x2 __attribute__((ext_vector_type(2)));
typedef unsigned u32x4 __attribute__((ext_vector_type(4)));
typedef unsigned u32x2 __attribute__((ext_vector_type(2)));

constexpr int DM = 1024, TALL = 98304, TG = 32768, NGROUP = 3;
constexpr int DINP = 3584, DIN = 3504, DFF = 2816;
constexpr int LDS_BYTES = 131072 + 2048;
constexpr float EPS = 1e-6f;
constexpr int PC_GQ = 0, PC_GK = 128, PC_GV = 256, PC_GG = 512, PC_GAF = 768;
constexpr int PC_R = 800, PC_RK = 1056, PC_RV = 1312, PC_RLOW = 1568;
constexpr int PC_Z = 1952, PC_XBC = 2464, PC_DT = 3488;

constexpr size_t WS_CTL = 0;
constexpr size_t WS_SW = 65536;
constexpr int SW_L = 106496;
constexpr size_t WS_WIN = WS_SW + 524288;
constexpr size_t WS_WOUT = WS_WIN + (size_t)2 * DINP * DM * 2;
constexpr size_t WS_WGU = WS_WOUT + (size_t)2 * DM * DM * 2;
constexpr size_t WS_WDN = WS_WGU + (size_t)2 * 2 * DFF * DM * 2;
constexpr size_t WS_XB = WS_WDN + (size_t)2 * DM * DFF * 2;
constexpr size_t WS_P = WS_XB + (size_t)TG * DM * 2;
constexpr size_t WS_MIX = WS_P + (size_t)TG * DINP * 2;
constexpr size_t WS_SSP = WS_MIX + (size_t)TG * DM * 2;
constexpr size_t WS_GLA_LA = WS_SSP + (size_t)TG * 16 * 4;
constexpr size_t WS_GLA_O = WS_GLA_LA + (size_t)2 * TG * 128 * 4;
constexpr size_t WS_RW = WS_GLA_O + (size_t)2 * TG * 256 * 4;
constexpr size_t WS_RW_S = WS_RW + (size_t)10 * TG * 256 * 2;
constexpr size_t WS_RW_Y = WS_RW_S + (size_t)2 * TG * 4 * 4;
constexpr size_t WS_SSD_X = WS_RW_Y + (size_t)2 * TG * 256 * 4;
constexpr size_t WS_SSD_DT = WS_SSD_X + (size_t)TG * 1024 * 2;
constexpr size_t WS_SSD_Y = WS_SSD_DT + (size_t)TG * 16 * 4;
constexpr size_t WS_RWQ = WS_SSD_Y + (size_t)2 * TG * 512 * 4;
constexpr size_t WS_END = WS_RWQ + (size_t)4096 * 3 * 4096 * 2;
static_assert(WS_END <= ((size_t)1 << 30), "workspace over 1 GiB");

struct Params { const float* in[30]; float* out; unsigned char* ws; };

__device__ __forceinline__ int otid() { int t = threadIdx.x; asm volatile("" : "+v"(t)); return t; }
__device__ __forceinline__ float bf2f(bf16_t b) { return __uint_as_float(((unsigned)b) << 16); }
typedef __bf16 bf16x2_t __attribute__((ext_vector_type(2)));
__device__ __forceinline__ unsigned pk2(float lo, float hi) { f32x2 f = {lo, hi}; bf16x2_t v = __builtin_convertvector(f, bf16x2_t); return __builtin_bit_cast(unsigned, v); }
__device__ __forceinline__ unsigned f2bf(float f) { return (unsigned)__builtin_bit_cast(unsigned short, (__bf16)f); }
__device__ __forceinline__ float sigm(float x) { return __builtin_amdgcn_rcpf(1.0f + __expf(-x)); }
__device__ __forceinline__ float silu(float x) { return x * __builtin_amdgcn_rcpf(1.0f + __expf(-x)); }
__device__ __forceinline__ float softplus(float x) { return fmaxf(x, 0.f) + __logf(1.0f + __expf(-fabsf(x))); }
__device__ __forceinline__ void lds_barrier() { asm volatile("s_waitcnt lgkmcnt(0)" ::: "memory"); __builtin_amdgcn_s_barrier(); asm volatile("" ::: "memory"); }

__device__ __forceinline__ float dpp_add(float v, float src_carrier) { return v + src_carrier; }
#define DPPF(x, ctrl, rmask) __int_as_float(__builtin_amdgcn_update_dpp(0, __float_as_int(x), (ctrl), (rmask), 0xf, false))
__device__ __forceinline__ float wave_incl_scan(float v, int lane) {
    v += DPPF(v, 0x111, 0xf);
    v += DPPF(v, 0x112, 0xf);
    v += DPPF(v, 0x114, 0xf);
    v += DPPF(v, 0x118, 0xf);
    v += DPPF(v, 0x142, 0xa);
    v += DPPF(v, 0x143, 0xc);
    return v;
}
__device__ __forceinline__ float lane_bcast(float v, int l) { return __int_as_float(__builtin_amdgcn_readlane(__float_as_int(v), l)); }
__device__ __forceinline__ float wave_sum(float v) { return lane_bcast(wave_incl_scan(v, 0), 63); }
__device__ __forceinline__ void unpack8(u32x4 v, float* f) {
    f[0] = __uint_as_float(v.x << 16); f[1] = __uint_as_float(v.x & 0xffff0000u);
    f[2] = __uint_as_float(v.y << 16); f[3] = __uint_as_float(v.y & 0xffff0000u);
    f[4] = __uint_as_float(v.z << 16); f[5] = __uint_as_float(v.z & 0xffff0000u);
    f[6] = __uint_as_float(v.w << 16); f[7] = __uint_as_float(v.w & 0xffff0000u);
}


#define XB_TMO      128
#define XB_XCNT(j)  (256  + 64 * (j))
#define XB_XSUB(j)  (1280 + 64 * (j))
#define XB_XGEN(j)  (2304 + 64 * (j))
#define XB_TOP      3328
#define XB_TOPGEN   3392
#define XB_SPIN_CAP (1u << 22)
__device__ __forceinline__ unsigned xb_ld(unsigned* p)              { return __hip_atomic_load(p, __ATOMIC_RELAXED, __HIP_MEMORY_SCOPE_AGENT); }
__device__ __forceinline__ unsigned xb_add(unsigned* p, unsigned v) { return __hip_atomic_fetch_add(p, v, __ATOMIC_RELAXED, __HIP_MEMORY_SCOPE_AGENT); }
__device__ __forceinline__ unsigned xb_xcc_id() { return (unsigned)__builtin_amdgcn_s_getreg((3 << 11) | 20) & 0xFu; }
#define XB_SPIN(cond, bar) do { unsigned _sp = 0; while (cond) { __builtin_amdgcn_s_sleep(1); \
    if ((++_sp & 255u) == 0u) { if (xb_ld(&(bar)[XB_TMO])) break; if (_sp > XB_SPIN_CAP) { atomicAdd(&(bar)[XB_TMO], 1u); break; } } } } while (0)
struct XcdBarrier { unsigned* bar; unsigned x; volatile LAS unsigned* st; };
__device__ __forceinline__ XcdBarrier xcd_barrier_post(unsigned* bar, volatile LAS unsigned* st) {
    XcdBarrier b; b.bar = bar; b.x = xb_xcc_id(); b.st = st;
    if (threadIdx.x == 0) (void)xb_add(&bar[XB_XCNT(b.x)], 1u);
    return b;
}
__device__ __forceinline__ void xcd_barrier_complete(unsigned* bar, unsigned x, unsigned& nloc, unsigned& nx) {
    const unsigned G = gridDim.x * gridDim.y * gridDim.z;
    unsigned sum, cnt, mine, sp = 0u;
    for (;;) {
        sum = 0u; cnt = 0u; mine = 0u;
#pragma unroll
        for (unsigned j = 0; j < 16; ++j) { const unsigned c = xb_ld(&bar[XB_XCNT(j)]); sum += c; cnt += (c > 0u) ? 1u : 0u; mine = (j == x) ? c : mine; }
        if (sum == G) break;
        __builtin_amdgcn_s_sleep(1);
        if ((++sp & 255u) == 0u) { if (xb_ld(&bar[XB_TMO])) break; if (sp > XB_SPIN_CAP) { atomicAdd(&bar[XB_TMO], 1u); break; } }
    }
    nloc = mine > 0u ? mine : 1u; nx = cnt > 0u ? cnt : 1u;
}
__device__ __forceinline__ void xcd_barrier(const XcdBarrier& b) {
    asm volatile("s_waitcnt vmcnt(0)" ::: "memory");
    __syncthreads();
    if (threadIdx.x == 0) {
        unsigned* bar = b.bar;
        __builtin_amdgcn_s_waitcnt(0);
        unsigned nloc = b.st[0], nx = b.st[1];
        if (nloc == 0u) { xcd_barrier_complete(bar, b.x, nloc, nx); b.st[0] = nloc; b.st[1] = nx; }
        const unsigned old = xb_add(&bar[XB_XSUB(b.x)], 1u);
        const unsigned gen = old / nloc;
        if (old + 1u == (gen + 1u) * nloc) {
            __builtin_amdgcn_fence(__ATOMIC_RELEASE, "agent");
            asm volatile("s_waitcnt vmcnt(0)" ::: "memory");
            const unsigned og = xb_add(&bar[XB_TOP], 1u);
            const unsigned tg = og / nx;
            if (og + 1u == (tg + 1u) * nx) xb_add(&bar[XB_TOPGEN], 1u);
            else XB_SPIN(xb_ld(&bar[XB_TOPGEN]) == tg, bar);
            __builtin_amdgcn_fence(__ATOMIC_ACQUIRE, "agent");
            xb_add(&bar[XB_XGEN(b.x)], 1u);
            asm volatile("s_waitcnt vmcnt(0)" ::: "memory");
        } else {
            XB_SPIN(xb_ld(&bar[XB_XGEN(b.x)]) == gen, bar);
            __builtin_amdgcn_fence(__ATOMIC_ACQUIRE, "agent");
            asm volatile("s_waitcnt vmcnt(0)" ::: "memory");
        }
    }
    __syncthreads();
}

namespace pg8 {
constexpr int BM = 256, BK = 64, HALF = 128, HTB = HALF * BK * 2, NXCD = 8, WGM = 8;
__device__ __forceinline__ int lds_byte(int r, int c) { const int st = (r >> 4) * 2 + (c >> 5), rr = r & 15, cc = c & 31, ob = rr * 64 + cc * 2; return st * 1024 + (ob ^ (((ob >> 9) & 1) << 5)); }
__device__ __forceinline__ void stage_rc(int b, int& R, int& C) { const int st = b / 1024, sb = b % 1024, swz = sb ^ (((sb >> 9) & 1) << 5); R = (st >> 1) * 16 + swz / 64; C = (st & 1) * 32 + (swz % 64) / 2; }
__device__ __forceinline__ int perm32(int rho) { const int n = rho >> 4, i = rho & 15; return 8 * (i >> 2) + 4 * n + (i & 3); }
struct Unit { int pm, pn; };
struct Gemm { const bf16_t* A; const bf16_t* Bt; int M, N, K; };
struct StaticOrder {
    int nM, nN, nwg, G, c;
    __device__ void init(int M, int N, int G_, int c_) { nM = M / BM; nN = N / BM; nwg = nM * nN; G = G_; c = c_; }
    __device__ bool next(int i, Unit& u) const {
        const long L = (long)i * G + c; if (L >= nwg) return false;
        int wgid = (int)L; { const int q = nwg / NXCD, r = nwg % NXCD, xcd = wgid % NXCD, off = wgid / NXCD; wgid = (xcd < r ? xcd * (q + 1) : r * (q + 1) + (xcd - r) * q) + off; }
        const int nig = WGM * nN, gid = wgid / nig, fm = gid * WGM, gsz = (nM - fm) < WGM ? (nM - fm) : WGM;
        u.pm = fm + ((wgid % nig) % gsz); u.pn = (wgid % nig) / gsz; return true;
    }
};

template <class Epi>
__device__ __forceinline__ void gemm_phase(LAS unsigned char* lds, const Gemm g, const StaticOrder& S, const Epi& E) {
    const int tid = otid(), wid = __builtin_amdgcn_readfirstlane(tid >> 6), lane = tid & 63, wr = wid >> 2, wc = wid & 3, fr = lane & 15, fq = lane >> 4;
    const int K = g.K, nt = K / BK;
    unsigned voffA[2], voffB[2];
#pragma unroll
    for (int i = 0; i < 2; ++i) { int R, C; stage_rc(tid * 16 + i * 8192, R, C); const int Rb = Epi::PERM ? ((R & ~31) + perm32(R & 31)) : R;
        voffA[i] = (unsigned)(R * K + C) * 2u; voffB[i] = (unsigned)(Rb * K + C) * 2u; }
    const size_t kstep = (size_t)(BK * 2);
    const size_t hstep = (size_t)HALF * K * 2;
    const size_t tstep = 2 * hstep;
    const unsigned ldsw = (unsigned)wid * 1024u;
    const int aoff = lds_byte(wr * 64 + fr, fq * 8), boff = lds_byte(wc * 32 + fr, fq * 8);
#define PG8_SA(b, h) (((b) * 2 + (h)) * HTB)
#define PG8_SB(b, h) ((4 + (b) * 2 + (h)) * HTB)
#define PG8_STAGE(bufoff, gbase, voff) do { _Pragma("unroll") for (int _i = 0; _i < 2; ++_i) \
        __builtin_amdgcn_global_load_lds((const unsigned*)((const char*)(gbase) + (voff)[_i]), (LAS unsigned*)(lds + (bufoff) + ldsw + _i * 8192), 16, 0, 0); } while (0)
#define PG8_LDA(dst, b, h) do { _Pragma("unroll") for (int m = 0; m < 4; ++m) _Pragma("unroll") for (int k = 0; k < 2; ++k) dst[m][k] = *(const LAS bf16x8*)(lds + PG8_SA(b, h) + aoff + m * 2048 + k * 1024); } while (0)
#define PG8_LDB(dst, b, h) do { _Pragma("unroll") for (int n = 0; n < 2; ++n) _Pragma("unroll") for (int k = 0; k < 2; ++k) dst[n][k] = *(const LAS bf16x8*)(lds + PG8_SB(b, h) + boff + n * 2048 + k * 1024); } while (0)
#define PG8_MMA(ai, bj, At, Bt) do { __builtin_amdgcn_s_setprio(1); _Pragma("unroll") for (int m = 0; m < 4; ++m) _Pragma("unroll") for (int n = 0; n < 2; ++n) _Pragma("unroll") for (int k = 0; k < 2; ++k) \
        acc[ai][bj][m][n] = __builtin_amdgcn_mfma_f32_16x16x32_bf16(Bt[n][k], At[m][k], acc[ai][bj][m][n], 0, 0, 0); __builtin_amdgcn_s_setprio(0); } while (0)
#define PG8_WAIT_V(n) asm volatile("s_waitcnt vmcnt(" #n ")" ::: "memory")
#define PG8_WAIT_L(n) asm volatile("s_waitcnt lgkmcnt(" #n ")" ::: "memory")
#define PG8_BAR __builtin_amdgcn_s_barrier()
#define PG8_SCHED __builtin_amdgcn_sched_barrier(0)
    Unit cur, nxt; int ui = 0;
    if (!S.next(0, cur)) return;
    f32x4 acc[2][2][4][2];
#pragma unroll
    for (int a = 0; a < 2; ++a)
#pragma unroll
        for (int b = 0; b < 2; ++b)
#pragma unroll
            for (int m = 0; m < 4; ++m)
#pragma unroll
                for (int n = 0; n < 2; ++n) acc[a][b][m][n] = (f32x4){0.f, 0.f, 0.f, 0.f};
    bf16x8 At[4][2], B0[2][2], B1[2][2];
    const char* cA = (const char*)g.A + (size_t)cur.pm * tstep; const char* cB = (const char*)g.Bt + (size_t)cur.pn * tstep;
    PG8_STAGE(PG8_SB(0, 0), cB, voffB); PG8_STAGE(PG8_SA(0, 0), cA, voffA); PG8_STAGE(PG8_SB(0, 1), cB + hstep, voffB); PG8_STAGE(PG8_SA(0, 1), cA + hstep, voffA);
    if (wr == 1) PG8_BAR;
    PG8_WAIT_V(4); PG8_BAR;
    PG8_STAGE(PG8_SB(1, 0), cB + kstep, voffB); PG8_STAGE(PG8_SA(1, 0), cA + kstep, voffA); PG8_STAGE(PG8_SB(1, 1), cB + hstep + kstep, voffB);
    PG8_WAIT_V(6); PG8_BAR;
    for (;;) {
        const bool has_next = S.next(ui + 1, nxt);
        const char* nA = has_next ? (const char*)g.A + (size_t)nxt.pm * tstep : cA; const char* nB = has_next ? (const char*)g.Bt + (size_t)nxt.pn * tstep : cB;
        for (int t = 0; t < nt; t += 2) {
            const bool last = (t == nt - 2);
            const char* a1 = cA + (size_t)(t + 1) * kstep;
            const char* a2 = last ? nA : cA + (size_t)(t + 2) * kstep; const char* b2 = last ? nB : cB + (size_t)(t + 2) * kstep;
            const char* a3 = a2 + kstep; const char* b3 = b2 + kstep;
            PG8_LDB(B0, 0, 0); PG8_SCHED; PG8_LDA(At, 0, 0); PG8_STAGE(PG8_SA(1, 1), a1 + hstep, voffA);
            PG8_WAIT_L(8); PG8_BAR; PG8_WAIT_L(0); PG8_MMA(0, 0, At, B0); PG8_BAR; PG8_SCHED;
            PG8_LDB(B1, 0, 1); PG8_STAGE(PG8_SB(0, 0), b2, voffB);
            PG8_BAR; PG8_WAIT_L(0); PG8_MMA(0, 1, At, B1); PG8_BAR;
            PG8_LDA(At, 0, 1); PG8_STAGE(PG8_SA(0, 0), a2, voffA);
            PG8_BAR; PG8_WAIT_L(0); PG8_MMA(1, 0, At, B0); PG8_BAR; PG8_SCHED;
            PG8_STAGE(PG8_SB(0, 1), b2 + hstep, voffB);
            PG8_WAIT_V(6); PG8_BAR; PG8_MMA(1, 1, At, B1); PG8_BAR;
            PG8_LDB(B0, 1, 0); PG8_SCHED; PG8_LDA(At, 1, 0); PG8_STAGE(PG8_SA(0, 1), a2 + hstep, voffA);
            PG8_WAIT_L(8); PG8_BAR; PG8_WAIT_L(0); PG8_MMA(0, 0, At, B0); PG8_BAR; PG8_SCHED;
            PG8_LDB(B1, 1, 1); PG8_STAGE(PG8_SB(1, 0), b3, voffB);
            PG8_BAR; PG8_WAIT_L(0); PG8_MMA(0, 1, At, B1); PG8_BAR;
            PG8_LDA(At, 1, 1); PG8_STAGE(PG8_SA(1, 0), a3, voffA);
            PG8_BAR; PG8_WAIT_L(0); PG8_MMA(1, 0, At, B0); PG8_BAR; PG8_SCHED;
            PG8_STAGE(PG8_SB(1, 1), b3 + hstep, voffB);
            PG8_WAIT_V(6); PG8_BAR; PG8_MMA(1, 1, At, B1); PG8_BAR;
        }
        E(acc, cur, wr, wc, fr, fq);
        if (!has_next) break;
#pragma unroll
        for (int a = 0; a < 2; ++a)
#pragma unroll
            for (int b = 0; b < 2; ++b)
#pragma unroll
                for (int m = 0; m < 4; ++m)
#pragma unroll
                    for (int n = 0; n < 2; ++n) acc[a][b][m][n] = (f32x4){0.f, 0.f, 0.f, 0.f};
        cur = nxt; cA = nA; cB = nB; ++ui;
    }
    PG8_WAIT_V(0);
    if (wr == 0) PG8_BAR;
    PG8_BAR;
#undef PG8_SA
#undef PG8_SB
#undef PG8_STAGE
#undef PG8_LDA
#undef PG8_LDB
#undef PG8_MMA
#undef PG8_WAIT_V
#undef PG8_WAIT_L
#undef PG8_BAR
#undef PG8_SCHED
}
}

__device__ __forceinline__ float row_rs(const float* ssp, int row) {
    const f32x4* p = (const f32x4*)(ssp + (size_t)row * 16);
    f32x4 a = p[0], b = p[1], c = p[2], d = p[3];
    float s = (a[0] + a[1] + a[2] + a[3]) + (b[0] + b[1] + b[2] + b[3]) + (c[0] + c[1] + c[2] + c[3]) + (d[0] + d[1] + d[2] + d[3]);
    return rsqrtf(s * (1.0f / 1024.0f) + EPS);
}

__device__ __forceinline__ f32x4 rs_part(const float* ssp, int row, int fq) { return *(const f32x4*)(ssp + (size_t)row * 16 + fq * 4); }
__device__ __forceinline__ float rs_fin(f32x4 a) { float s = (a[0] + a[1]) + (a[2] + a[3]); s += __shfl_xor(s, 16); s += __shfl_xor(s, 32); return rsqrtf(s * (1.0f / 1024.0f) + EPS); }
struct EpiInproj {
    static constexpr bool PERM = true;
    bf16_t* O; const float* ssp;
    __device__ __forceinline__ void operator()(const f32x4 (&acc)[2][2][4][2], const pg8::Unit& u, int wr, int wc, int fr, int fq) const {
        const int row0 = u.pm * 256 + wr * 64 + fr, col0 = u.pn * 256 + wc * 32 + 8 * fq;
        f32x4 rp[2][4];
#pragma unroll
        for (int ai = 0; ai < 2; ++ai)
#pragma unroll
            for (int m = 0; m < 4; ++m) rp[ai][m] = rs_part(ssp, row0 + ai * 128 + m * 16, fq);
#pragma unroll
        for (int ai = 0; ai < 2; ++ai)
#pragma unroll
            for (int m = 0; m < 4; ++m) {
                const int row = row0 + ai * 128 + m * 16; const float rs = rs_fin(rp[ai][m]);
                bf16_t* rowp = O + (size_t)row * DINP + col0;
#pragma unroll
                for (int bj = 0; bj < 2; ++bj) { f32x4 v0 = acc[ai][bj][m][0] * rs, v1 = acc[ai][bj][m][1] * rs;
                    u32x4 w; w.x = pk2(v0[0], v0[1]); w.y = pk2(v0[2], v0[3]); w.z = pk2(v1[0], v1[1]); w.w = pk2(v1[2], v1[3]);
                    __builtin_nontemporal_store(w, (u32x4*)(rowp + bj * 128)); }
            }
    }
};
struct EpiGateUp {
    static constexpr bool PERM = true;
    bf16_t* O; const float* ssp;
    __device__ __forceinline__ void operator()(const f32x4 (&acc)[2][2][4][2], const pg8::Unit& u, int wr, int wc, int fr, int fq) const {
        const int row0 = u.pm * 256 + wr * 64 + fr, col0 = u.pn * 128 + wc * 32 + 8 * fq;
        f32x4 rp[2][4];
#pragma unroll
        for (int ai = 0; ai < 2; ++ai)
#pragma unroll
            for (int m = 0; m < 4; ++m) rp[ai][m] = rs_part(ssp, row0 + ai * 128 + m * 16, fq);
#pragma unroll
        for (int ai = 0; ai < 2; ++ai)
#pragma unroll
            for (int m = 0; m < 4; ++m) {
                const int row = row0 + ai * 128 + m * 16; const float rs = rs_fin(rp[ai][m]);
                float h[8];
#pragma unroll
                for (int n = 0; n < 2; ++n)
#pragma unroll
                    for (int j = 0; j < 4; ++j) h[n * 4 + j] = silu(acc[ai][0][m][n][j] * rs) * (acc[ai][1][m][n][j] * rs);
                u32x4 w; w.x = pk2(h[0], h[1]); w.y = pk2(h[2], h[3]); w.z = pk2(h[4], h[5]); w.w = pk2(h[6], h[7]);
                __builtin_nontemporal_store(w, (u32x4*)(O + (size_t)row * DFF + col0));
            }
    }
};
struct EpiResid {
    static constexpr bool PERM = false;
    bf16_t* XB; float* ssp;
    __device__ __forceinline__ void operator()(const f32x4 (&acc)[2][2][4][2], const pg8::Unit& u, int wr, int wc, int fr, int fq) const {
        const int row0 = u.pm * 256 + wr * 64 + fr, col0 = u.pn * 256 + wc * 32 + 4 * fq;
        u32x2 xnx[4];
        { const bf16_t* xr0 = XB + (size_t)row0 * DM + col0;
#pragma unroll
          for (int e = 0; e < 4; ++e) xnx[e] = *(const u32x2*)(xr0 + (e >> 1) * 128 + (e & 1) * 16); }
#pragma unroll
        for (int ai = 0; ai < 2; ++ai)
#pragma unroll
            for (int m = 0; m < 4; ++m) {
                const int row = row0 + ai * 128 + m * 16;
                bf16_t* br = XB + (size_t)row * DM + col0;
                u32x2 xc[4];
#pragma unroll
                for (int e = 0; e < 4; ++e) xc[e] = xnx[e];
                if (ai * 4 + m < 7) { const int idx = ai * 4 + m + 1; const bf16_t* xrn = XB + (size_t)(row0 + (idx >> 2) * 128 + (idx & 3) * 16) * DM + col0;
#pragma unroll
                    for (int e = 0; e < 4; ++e) xnx[e] = *(const u32x2*)(xrn + (e >> 1) * 128 + (e & 1) * 16); }
                float ss = 0.f;
#pragma unroll
                for (int bj = 0; bj < 2; ++bj)
#pragma unroll
                    for (int n = 0; n < 2; ++n) {
                        const u32x2 xo = xc[bj * 2 + n];
                        f32x4 xn = acc[ai][bj][m][n];
                        xn[0] += __uint_as_float(xo.x << 16); xn[1] += __uint_as_float(xo.x & 0xffff0000u); xn[2] += __uint_as_float(xo.y << 16); xn[3] += __uint_as_float(xo.y & 0xffff0000u);
                        ss += (xn[0] * xn[0] + xn[1] * xn[1]) + (xn[2] * xn[2] + xn[3] * xn[3]);
                        u32x2 w; w.x = pk2(xn[0], xn[1]); w.y = pk2(xn[2], xn[3]);
                        *(u32x2*)(br + bj * 128 + n * 16) = w;
                    }
                ss += __shfl_xor(ss, 16); ss += __shfl_xor(ss, 32);
                if (fq == 0) ssp[(size_t)row * 16 + u.pn * 4 + wc] = ss;
                asm volatile("" ::: "memory");
            }
    }
};

__device__ __forceinline__ void wtile(LAS float* tile, const float* src, int lds_src, const float* gain, bf16_t* dst, int K, int n0, int k0, int c0, int nvalid) {
    const int tid = otid();
    __syncthreads();
#pragma unroll
    for (int i = 0; i < 8; ++i) {
        const int kk = (tid >> 6) + 8 * i, c = tid & 63;
        float v = 0.f;
        if (c0 + c < nvalid) { v = src[(size_t)(k0 + kk) * lds_src + c0 + c]; if (gain) v *= gain[k0 + kk]; }
        tile[kk * 65 + c] = v;
    }
    __syncthreads();
    const int n = tid >> 3, kc = (tid & 7) * 8;
    float f[8];
#pragma unroll
    for (int j = 0; j < 8; ++j) f[j] = tile[(kc + j) * 65 + n];
    u32x4 w; w.x = pk2(f[0], f[1]); w.y = pk2(f[2], f[3]); w.z = pk2(f[4], f[5]); w.w = pk2(f[6], f[7]);
    *(u32x4*)(dst + (size_t)(n0 + n) * K + k0 + kc) = w;
}
__device__ __forceinline__ void phase_weights(LAS unsigned char* lds, const Params& P) {
    LAS float* tile = (LAS float*)lds;
    unsigned char* ws = P.ws;
    constexpr int T_IN = 56 * 16, T_OUT = 16 * 16, T_GU = 88 * 16, T_DN = 16 * 44, T_L = T_IN + T_OUT + T_GU + T_DN;
    for (int t = blockIdx.x; t < 2 * 24; t += gridDim.x) {
        const int l = t / 24, idx = t % 24; bf16_t* sw = (bf16_t*)(ws + WS_SW) + (size_t)l * SW_L;
        if (idx < 16) { const int m = idx >> 2, nb = idx & 3, d = m & 1;
            const float* src = (m < 2 ? P.in[10] : P.in[12]) + (size_t)(l * 2 + d) * 64 * 256;
            wtile(tile, src, 256, nullptr, sw + m * 16384, 64, nb * 64, 0, nb * 64, 256);
        } else { const int nb = (idx - 16) >> 1, kb = (idx - 16) & 1;
            wtile(tile, P.in[13] + (size_t)l * 128 * 256, 256, nullptr, sw + 65536, 128, nb * 64, kb * 64, nb * 64, 256); }
    }
    for (int i = blockIdx.x * 512 + threadIdx.x; i < 2 * 8192; i += gridDim.x * 512) {
        const int l = i >> 13, rem = i & 8191, d = rem >> 12, c = (rem & 4095) >> 5, k = rem & 31;
        const float v = ((k >> 4) == d) ? P.in[5][((size_t)(l * 2 + d) * 16 + (k & 15)) * 128 + c] : 0.f;
        ((bf16_t*)(ws + WS_SW))[(size_t)l * SW_L + 98304 + rem] = (bf16_t)f2bf(v);
    }
    for (int t = blockIdx.x; t < 2 * T_L; t += gridDim.x) {
        const int l = t / T_L; int r = t % T_L;
        if (r < T_IN) { const int nb = r / 16, kb = r % 16;
            wtile(tile, P.in[3] + (size_t)l * DM * DIN, DIN, P.in[2] + l * DM, (bf16_t*)(ws + WS_WIN) + (size_t)l * DINP * DM, DM, nb * 64, kb * 64, nb * 64, DIN);
        } else if ((r -= T_IN) < T_OUT) { const int nb = r / 16, kb = r % 16;
            wtile(tile, P.in[4] + (size_t)l * DM * DM, DM, nullptr, (bf16_t*)(ws + WS_WOUT) + (size_t)l * DM * DM, DM, nb * 64, kb * 64, nb * 64, DM);
        } else if ((r -= T_OUT) < T_GU) { const int nb = r / 16, kb = r % 16;
            const int j = nb >> 2, qd = nb & 3; const float* src = (qd < 2 ? P.in[26] : P.in[27]) + (size_t)l * DM * DFF;
            wtile(tile, src, DFF, P.in[25] + l * DM, (bf16_t*)(ws + WS_WGU) + (size_t)l * 2 * DFF * DM, DM, nb * 64, kb * 64, j * 128 + (qd & 1) * 64, DFF);
        } else { r -= T_GU; const int nb = r / 44, kb = r % 44;
            wtile(tile, P.in[28] + (size_t)l * DFF * DM, DM, nullptr, (bf16_t*)(ws + WS_WDN) + (size_t)l * DM * DFF, DFF, nb * 64, kb * 64, nb * 64, DM);
        }
    }
}

__device__ __forceinline__ void phase_xprep(const Params& P, int g) {
    const float* xin = (g < 2) ? P.in[0] + (size_t)g * TG * DM : P.in[1];
    bf16_t* xb = (bf16_t*)(P.ws + WS_XB); float* ssp = (float*)(P.ws + WS_SSP);
    const int tid_ = otid(); const int lane = tid_ & 63, gw = blockIdx.x * 8 + (tid_ >> 6), nw = gridDim.x * 8;
    for (int row = gw; row < TG; row += nw) {
        float ss = 0.f;
#pragma unroll
        for (int i = 0; i < 4; ++i) {
            const int c = i * 256 + lane * 4;
            f32x4 v = *(const f32x4*)(xin + (size_t)row * DM + c);
            u32x2 w; w.x = pk2(v[0], v[1]); w.y = pk2(v[2], v[3]);
            *(u32x2*)(xb + (size_t)row * DM + c) = w;
            ss += (v[0] * v[0] + v[1] * v[1]) + (v[2] * v[2] + v[3] * v[3]);
        }
        ss = wave_sum(ss);
        if (lane < 16) ssp[(size_t)row * 16 + lane] = (lane == 0) ? ss : 0.f;
    }
}
__device__ __forceinline__ void phase_final(const Params& P, int g) {
    float* xo = P.out + (size_t)g * TG * DM; const bf16_t* xb = (const bf16_t*)(P.ws + WS_XB); const float* ssp = (const float*)(P.ws + WS_SSP); const float* gn = P.in[29];
    const int tid_ = otid(); const int lane = tid_ & 63, gw = blockIdx.x * 8 + (tid_ >> 6), nw = gridDim.x * 8;
    for (int row = gw; row < TG; row += nw) {
        const float rs = row_rs(ssp, row);
#pragma unroll
        for (int i = 0; i < 2; ++i) {
            const int c = i * 512 + lane * 8;
            float v[8]; unpack8(*(const u32x4*)(xb + (size_t)row * DM + c), v);
            const f32x4 g0 = *(const f32x4*)(gn + c), g1 = *(const f32x4*)(gn + c + 4);
            *(f32x4*)(xo + (size_t)row * DM + c) = (f32x4){v[0] * rs * g0[0], v[1] * rs * g0[1], v[2] * rs * g0[2], v[3] * rs * g0[3]};
            *(f32x4*)(xo + (size_t)row * DM + c + 4) = (f32x4){v[4] * rs * g1[0], v[5] * rs * g1[1], v[6] * rs * g1[2], v[7] * rs * g1[3]};
        }
    }
}

struct MixBufs {
    const bf16_t* p; float* gla_la; bf16_t* gla_o; bf16_t* rw; float* rw_s; bf16_t* rw_y; bf16_t* ssd_x; float* ssd_dt; bf16_t* ssd_y; bf16_t* mix;
};
__device__ __forceinline__ MixBufs mixbufs(const Params& P) {
    MixBufs B; unsigned char* ws = P.ws;
    B.p = (const bf16_t*)(ws + WS_P); B.gla_la = (float*)(ws + WS_GLA_LA); B.gla_o = (bf16_t*)(ws + WS_GLA_O); B.rw = (bf16_t*)(ws + WS_RW);
    B.rw_s = (float*)(ws + WS_RW_S); B.rw_y = (bf16_t*)(ws + WS_RW_Y); B.ssd_x = (bf16_t*)(ws + WS_SSD_X); B.ssd_dt = (float*)(ws + WS_SSD_DT);
    B.ssd_y = (bf16_t*)(ws + WS_SSD_Y); B.mix = (bf16_t*)(ws + WS_MIX); return B;
}
constexpr size_t RWA = (size_t)TG * 256;

__device__ __forceinline__ void prep_tile(LAS unsigned char* lds, const Params& P, const MixBufs& B, int layer, int L, int tile) {
    const int tid = otid(), lane = tid & 63;
    const int t0 = tile * 32;
    LAS float* lin = (LAS float*)lds;
    LAS float* gin = (LAS float*)(lds + 49152);
    const bf16_t* p = B.p;
    const float* mu = P.in[8] + layer * 1152;
    __syncthreads();
    for (int idx = tid; idx < 32 * 384; idx += 512) {
        const int t = idx / 384, cc = idx % 384, tl = t0 + t, pos = tl % L, col = PC_RLOW + cc;
        const float cur = bf2f(p[(size_t)tl * DINP + col]);
        const float prv = pos > 0 ? bf2f(p[(size_t)(tl - 1) * DINP + col]) : 0.f;
        const float nxt = pos < L - 1 ? bf2f(p[(size_t)(tl + 1) * DINP + col]) : 0.f;
        float v = cur + mu[col - PC_R] * (0.5f * (prv + nxt) - cur);
        if (cc < 128) { const float e = __expf(2.f * v); v = 1.f - 2.f / (e + 1.f); }
        else if (cc >= 256) v = sigm(v);
        lin[t * 384 + cc] = v;
    }
    for (int idx = tid; idx < 32 * 32; idx += 512) { const int t = idx >> 5, j = idx & 31; gin[idx] = bf2f(p[(size_t)(t0 + t) * DINP + PC_GAF + j]); }
    __syncthreads();
#pragma unroll 1
    for (int i = 0; i < 8; ++i) {
        const int idx = tid + 512 * i, t = idx >> 7, c0 = (idx & 127) * 8, tl = t0 + t, pos = tl % L;
        float acc[8];
        { const f32x4 b0 = *(const f32x4*)(P.in[20] + layer * 1024 + c0), b1 = *(const f32x4*)(P.in[20] + layer * 1024 + c0 + 4);
          acc[0] = b0[0]; acc[1] = b0[1]; acc[2] = b0[2]; acc[3] = b0[3]; acc[4] = b1[0]; acc[5] = b1[1]; acc[6] = b1[2]; acc[7] = b1[3]; }
#pragma unroll
        for (int tap = 0; tap < 5; ++tap) {
            const int pp = pos + tap - 2;
            if (pp >= 0 && pp < L) {
                float x[8]; unpack8(*(const u32x4*)(p + (size_t)(tl + tap - 2) * DINP + PC_XBC + c0), x);
                const float* w = P.in[19] + (size_t)(layer * 5 + tap) * 1024 + c0;
                const f32x4 w0 = *(const f32x4*)w, w1 = *(const f32x4*)(w + 4);
                acc[0] += w0[0] * x[0]; acc[1] += w0[1] * x[1]; acc[2] += w0[2] * x[2]; acc[3] += w0[3] * x[3];
                acc[4] += w1[0] * x[4]; acc[5] += w1[1] * x[5]; acc[6] += w1[2] * x[6]; acc[7] += w1[3] * x[7];
            }
        }
        u32x4 o; o.x = pk2(silu(acc[0]), silu(acc[1])); o.y = pk2(silu(acc[2]), silu(acc[3])); o.z = pk2(silu(acc[4]), silu(acc[5])); o.w = pk2(silu(acc[6]), silu(acc[7]));
        *(u32x4*)(B.ssd_x + (size_t)tl * 1024 + c0) = o;
    }
    { const int t = tid >> 4, j = tid & 15, tl = t0 + t;
      B.ssd_dt[(size_t)tl * 16 + j] = softplus(bf2f(p[(size_t)tl * DINP + PC_DT + j]) + P.in[21][layer * 16 + j]); }
    if (tid < 256) {
        const int d = tid >> 7, c = tid & 127;
        float ac[16];
#pragma unroll
        for (int j = 0; j < 16; ++j) ac[j] = P.in[5][((size_t)(layer * 2 + d) * 16 + j) * 128 + c];
        const float bias = P.in[6][(layer * 2 + d) * 128 + c];
#pragma unroll 4
        for (int t = 0; t < 32; ++t) {
            float a = bias;
#pragma unroll
            for (int j = 0; j < 16; ++j) a += gin[t * 32 + d * 16 + j] * ac[j];
            B.gla_la[((size_t)d * TG + t0 + t) * 128 + c] = -softplus(-a) * (1.0f / 16.0f);
        }
    }
    asm volatile("" ::: "memory");
    {
        const int h2 = __builtin_amdgcn_readfirstlane(tid >> 8), c = tid & 255, head = c >> 6;
        float wcol[64];
        const float kkc = P.in[14][layer * 256 + c], kac = P.in[15][layer * 256 + c], rkc = P.in[16][layer * 256 + c];
        const float mur = mu[c], muk = mu[256 + c], muv = mu[512 + c];
        {
            { const float* wsrc = P.in[10] + (size_t)(layer * 2 + h2) * 64 * 256;
#pragma unroll
            for (int k = 0; k < 64; ++k) wcol[k] = wsrc[k * 256 + c]; }
            const float w0c = P.in[9][(layer * 2 + h2) * 256 + c];
#pragma unroll 1
            for (int t = 0; t < 32; ++t) {
                float aw = w0c;
                const LAS f32x4* lw = (const LAS f32x4*)(lin + t * 384 + h2 * 64);
#pragma unroll
                for (int k4 = 0; k4 < 16; ++k4) { const f32x4 x = lw[k4];
                    aw += x[0] * wcol[k4 * 4] + x[1] * wcol[k4 * 4 + 1] + x[2] * wcol[k4 * 4 + 2] + x[3] * wcol[k4 * 4 + 3]; }
                B.rw[(4 + h2) * RWA + (size_t)(t0 + t) * 256 + c] = (bf16_t)f2bf(sigm(aw) * 0.60653066f);
            }
        }
        asm volatile("" ::: "memory");
        {
            { const float* wsrc = P.in[12] + (size_t)(layer * 2 + h2) * 64 * 256;
#pragma unroll
            for (int k = 0; k < 64; ++k) wcol[k] = wsrc[k * 256 + c]; }
            const float a0c = P.in[11][(layer * 2 + h2) * 256 + c];
#pragma unroll 1
            for (int t = 0; t < 32; ++t) {
                const int tl = t0 + t, pos = tl % L;
                const bf16_t* pc = p + (size_t)tl * DINP;
                const bool hp = pos > 0, hn = pos < L - 1;
                const float rc = bf2f(pc[PC_R + c]), kc = bf2f(pc[PC_RK + c]), vc = bf2f(pc[PC_RV + c]);
                const float rp = hp ? bf2f(pc[PC_R + c - DINP]) : 0.f, kp = hp ? bf2f(pc[PC_RK + c - DINP]) : 0.f, vp = hp ? bf2f(pc[PC_RV + c - DINP]) : 0.f;
                const float rn = hn ? bf2f(pc[PC_R + c + DINP]) : 0.f, kn = hn ? bf2f(pc[PC_RK + c + DINP]) : 0.f, vn = hn ? bf2f(pc[PC_RV + c + DINP]) : 0.f;
                const float r = rc + mur * (0.5f * (rp + rn) - rc), k = kc + muk * (0.5f * (kp + kn) - kc), v = vc + muv * (0.5f * (vp + vn) - vc);
                float aa = a0c;
                const LAS f32x4* la = (const LAS f32x4*)(lin + t * 384 + 128 + h2 * 64);
#pragma unroll
                for (int k4 = 0; k4 < 16; ++k4) { const f32x4 y = la[k4];
                    aa += y[0] * wcol[k4 * 4] + y[1] * wcol[k4 * 4 + 1] + y[2] * wcol[k4 * 4 + 2] + y[3] * wcol[k4 * 4 + 3]; }
                const float asg = sigm(aa);
                const float kr = k * kkc; const float kk = kr * rsqrtf(wave_sum(kr * kr) + 1e-12f);
                const float kd = k * (1.f + (asg - 1.f) * kac), bb = kk * asg;
                const size_t o = (size_t)tl * 256 + c;
                B.rw[(6 + h2) * RWA + o] = (bf16_t)f2bf(kd); B.rw[(8 + h2) * RWA + o] = (bf16_t)f2bf(bb);
                if (h2 == 0) {
                    B.rw[0 * RWA + o] = (bf16_t)f2bf(r); B.rw[1 * RWA + o] = (bf16_t)f2bf(v); B.rw[2 * RWA + o] = (bf16_t)f2bf(kk);
                    const float s = wave_sum(r * k * rkc); if (lane == 0) B.rw_s[(size_t)tl * 4 + head] = s;
                } else {
                    const float s = wave_sum(bf2f((bf16_t)f2bf(kd)) * bf2f((bf16_t)f2bf(r))); if (lane == 0) B.rw_s[(size_t)TG * 4 + (size_t)tl * 4 + head] = s;
                }
            }
        }
        asm volatile("" ::: "memory");
        float ga[16];
#pragma unroll
        for (int i = 0; i < 16; ++i) ga[i] = 0.f;
#pragma unroll 1
        for (int sub = 0; sub < 2; ++sub) {
            asm volatile("" ::: "memory");
            { const float* wsrc = P.in[13] + (size_t)(layer * 128 + sub * 64) * 256;
#pragma unroll
            for (int k = 0; k < 64; ++k) wcol[k] = wsrc[k * 256 + c]; }
#pragma unroll
            for (int tt = 0; tt < 16; ++tt) {
                const LAS f32x4* lg = (const LAS f32x4*)(lin + (h2 * 16 + tt) * 384 + 256 + sub * 64);
                float a = ga[tt];
#pragma unroll
                for (int k4 = 0; k4 < 16; ++k4) { const f32x4 x = lg[k4]; a += x[0] * wcol[k4 * 4] + x[1] * wcol[k4 * 4 + 1] + x[2] * wcol[k4 * 4 + 2] + x[3] * wcol[k4 * 4 + 3]; }
                ga[tt] = a;
            }
        }
#pragma unroll
        for (int tt = 0; tt < 16; ++tt) B.rw[3 * RWA + (size_t)(t0 + h2 * 16 + tt) * 256 + c] = (bf16_t)f2bf(ga[tt]);
    }
}

__device__ __forceinline__ f32x4 mfma16(bf16x8 a, bf16x8 b, f32x4 c) { return __builtin_amdgcn_mfma_f32_16x16x32_bf16(a, b, c, 0, 0, 0); }
__device__ __forceinline__ void prep_tile64(LAS unsigned char* lds, const Params& P, const MixBufs& B, const bf16_t* sw, int layer, int L, int tile) {
    const int tid = otid(), w = tid >> 6, lane = tid & 63, r = lane & 15, q = lane >> 4;
    const int t0 = tile * 64;
    constexpr int LL = 392, LA = 264;
    LAS bf16_t* lin = (LAS bf16_t*)lds;
    LAS bf16_t* gin = (LAS bf16_t*)(lds + 50176);
    LAS bf16_t* AS = (LAS bf16_t*)(lds + 55296);
    const bf16_t* p = B.p;
    const float* mu = P.in[8] + layer * 1152;
    __syncthreads();
#pragma unroll 3
    for (int i6 = 0; i6 < 6; ++i6) {
        const int it = tid + 512 * i6;
        const int t = it / 48, cg8 = it % 48, tl = t0 + t, pos = tl % L, col = PC_RLOW + cg8 * 8;
        float cur[8], prv[8], nxt[8], v[8];
        unpack8(*(const u32x4*)(p + (size_t)tl * DINP + col), cur);
        if (pos > 0) unpack8(*(const u32x4*)(p + (size_t)(tl - 1) * DINP + col), prv); else {
#pragma unroll
            for (int j = 0; j < 8; ++j) prv[j] = 0.f; }
        if (pos < L - 1) unpack8(*(const u32x4*)(p + (size_t)(tl + 1) * DINP + col), nxt); else {
#pragma unroll
            for (int j = 0; j < 8; ++j) nxt[j] = 0.f; }
        const f32x4 m0 = *(const f32x4*)(mu + col - PC_R), m1 = *(const f32x4*)(mu + col - PC_R + 4);
#pragma unroll
        for (int j = 0; j < 8; ++j) { const float m = j < 4 ? m0[j] : m1[j - 4]; v[j] = cur[j] + m * (0.5f * (prv[j] + nxt[j]) - cur[j]); }
        if (cg8 < 16) {
#pragma unroll
            for (int j = 0; j < 8; ++j) { const float e = __expf(2.f * v[j]); v[j] = 1.f - 2.f * __builtin_amdgcn_rcpf(e + 1.f); }
        } else if (cg8 >= 32) {
#pragma unroll
            for (int j = 0; j < 8; ++j) v[j] = sigm(v[j]);
        }
        u32x4 o; o.x = pk2(v[0], v[1]); o.y = pk2(v[2], v[3]); o.z = pk2(v[4], v[5]); o.w = pk2(v[6], v[7]);
        *(LAS u32x4*)(lin + t * LL + cg8 * 8) = o;
    }
    if (tid < 256) { const int t = tid >> 2, g4 = tid & 3; *(LAS u32x4*)(gin + t * 40 + g4 * 8) = *(const u32x4*)(p + (size_t)(t0 + t) * DINP + PC_GAF + g4 * 8); }
    __syncthreads();
#pragma unroll 1
    for (int d = 0; d < 2; ++d)
#pragma unroll 1
        for (int tt = 0; tt < 2; ++tt) {
            const int tn = 2 * w + tt, c = tn * 16 + r;
            const float a0c = P.in[11][(layer * 2 + d) * 256 + c];
            const bf16_t* wb = sw + 32768 + d * 16384 + (size_t)(tn * 16 + r) * 64 + q * 8;
            const bf16x8 b0 = *(const bf16x8*)wb, b1 = *(const bf16x8*)(wb + 32);
#pragma unroll
            for (int tm = 0; tm < 4; ++tm) {
                const LAS bf16_t* ap = lin + (tm * 16 + r) * LL + 128 + d * 64 + q * 8;
                f32x4 acc = (f32x4){0.f, 0.f, 0.f, 0.f};
                acc = mfma16(*(const LAS bf16x8*)ap, b0, acc); acc = mfma16(*(const LAS bf16x8*)(ap + 32), b1, acc);
#pragma unroll
                for (int jj = 0; jj < 4; ++jj) AS[(d * 64 + tm * 16 + q * 4 + jj) * LA + c] = (bf16_t)f2bf(sigm(a0c + acc[jj]));
            }
        }
    __syncthreads();
    {
        const int c0 = (tid & 31) * 8, head = (tid & 31) >> 3;
        float mr_[8], mk_[8], mv_[8], kkc[8], kac[8], rkc[8];
#define LD8F(dst, ptr) do { const f32x4 a_ = *(const f32x4*)(ptr), b_ = *(const f32x4*)((ptr) + 4); dst[0] = a_[0]; dst[1] = a_[1]; dst[2] = a_[2]; dst[3] = a_[3]; dst[4] = b_[0]; dst[5] = b_[1]; dst[6] = b_[2]; dst[7] = b_[3]; } while (0)
        LD8F(mr_, mu + c0); LD8F(mk_, mu + 256 + c0); LD8F(mv_, mu + 512 + c0);
        LD8F(kkc, P.in[14] + layer * 256 + c0); LD8F(kac, P.in[15] + layer * 256 + c0); LD8F(rkc, P.in[16] + layer * 256 + c0);
#undef LD8F
        u32x4 nx[9], cu[9];
        const u32x4 Z = (u32x4){0u, 0u, 0u, 0u};
#define EL_LOAD(dst, ii) do { const int t_ = (tid + 512 * (ii)) >> 5, tl_ = t0 + t_, pos_ = tl_ % L; const bf16_t* pc_ = p + (size_t)tl_ * DINP + c0; \
            const bool hp_ = pos_ > 0, hn_ = pos_ < L - 1; \
            dst[0] = *(const u32x4*)(pc_ + PC_R); dst[1] = *(const u32x4*)(pc_ + PC_RK); dst[2] = *(const u32x4*)(pc_ + PC_RV); \
            dst[3] = hp_ ? *(const u32x4*)(pc_ + PC_R - DINP) : Z; dst[4] = hp_ ? *(const u32x4*)(pc_ + PC_RK - DINP) : Z; dst[5] = hp_ ? *(const u32x4*)(pc_ + PC_RV - DINP) : Z; \
            dst[6] = hn_ ? *(const u32x4*)(pc_ + PC_R + DINP) : Z; dst[7] = hn_ ? *(const u32x4*)(pc_ + PC_RK + DINP) : Z; dst[8] = hn_ ? *(const u32x4*)(pc_ + PC_RV + DINP) : Z; } while (0)
        EL_LOAD(nx, 0);
#pragma unroll 1
        for (int i = 0; i < 4; ++i) {
#pragma unroll
            for (int e = 0; e < 9; ++e) cu[e] = nx[e];
            if (i < 3) EL_LOAD(nx, i + 1);
            const int t = (tid + 512 * i) >> 5, tl = t0 + t;
            float rr[8], kx[8], vx[8], c_[8], p_[8], n_[8];
            unpack8(cu[0], c_); unpack8(cu[3], p_); unpack8(cu[6], n_);
#pragma unroll
            for (int j = 0; j < 8; ++j) rr[j] = c_[j] + mr_[j] * (0.5f * (p_[j] + n_[j]) - c_[j]);
            unpack8(cu[1], c_); unpack8(cu[4], p_); unpack8(cu[7], n_);
#pragma unroll
            for (int j = 0; j < 8; ++j) kx[j] = c_[j] + mk_[j] * (0.5f * (p_[j] + n_[j]) - c_[j]);
            unpack8(cu[2], c_); unpack8(cu[5], p_); unpack8(cu[8], n_);
#pragma unroll
            for (int j = 0; j < 8; ++j) vx[j] = c_[j] + mv_[j] * (0.5f * (p_[j] + n_[j]) - c_[j]);
            float as0[8], as1[8];
            unpack8(*(const LAS u32x4*)(AS + (0 * 64 + t) * LA + c0), as0); unpack8(*(const LAS u32x4*)(AS + (1 * 64 + t) * LA + c0), as1);
            float kr[8], ss = 0.f, srk = 0.f;
#pragma unroll
            for (int j = 0; j < 8; ++j) { kr[j] = kx[j] * kkc[j]; ss += kr[j] * kr[j]; srk += rr[j] * kx[j] * rkc[j]; }
            ss += __shfl_xor(ss, 1); ss += __shfl_xor(ss, 2); ss += __shfl_xor(ss, 4);
            const float inv = rsqrtf(ss + 1e-12f);
            float kkv[8], kd0[8], kd1[8], b0v[8], b1v[8], skr = 0.f;
#pragma unroll
            for (int j = 0; j < 8; ++j) {
                kkv[j] = kr[j] * inv; kd0[j] = kx[j] * (1.f + (as0[j] - 1.f) * kac[j]); kd1[j] = kx[j] * (1.f + (as1[j] - 1.f) * kac[j]);
                b0v[j] = kkv[j] * as0[j]; b1v[j] = kkv[j] * as1[j];
                skr += bf2f((bf16_t)f2bf(kd1[j])) * bf2f((bf16_t)f2bf(rr[j])); }
            srk += __shfl_xor(srk, 1); srk += __shfl_xor(srk, 2); srk += __shfl_xor(srk, 4);
            skr += __shfl_xor(skr, 1); skr += __shfl_xor(skr, 2); skr += __shfl_xor(skr, 4);
            const size_t o = (size_t)tl * 256 + c0;
#define ST8(arr, f) do { u32x4 o4; o4.x = pk2(f[0], f[1]); o4.y = pk2(f[2], f[3]); o4.z = pk2(f[4], f[5]); o4.w = pk2(f[6], f[7]); *(u32x4*)(B.rw + (size_t)(arr) * RWA + o) = o4; } while (0)
            ST8(0, rr); ST8(1, vx); ST8(2, kkv); ST8(6, kd0); ST8(7, kd1); ST8(8, b0v); ST8(9, b1v);
#undef ST8
            if ((lane & 7) == 0) { B.rw_s[(size_t)tl * 4 + head] = srk; B.rw_s[(size_t)TG * 4 + (size_t)tl * 4 + head] = skr; }
        }
#undef EL_LOAD
    }
#pragma unroll 1
    for (int d = 0; d < 2; ++d)
#pragma unroll 1
        for (int tt = 0; tt < 2; ++tt) {
            const int tn = 2 * w + tt, c = tn * 16 + r;
            const float w0c = P.in[9][(layer * 2 + d) * 256 + c];
            const bf16_t* wb = sw + d * 16384 + (size_t)(tn * 16 + r) * 64 + q * 8;
            const bf16x8 b0 = *(const bf16x8*)wb, b1 = *(const bf16x8*)(wb + 32);
#pragma unroll
            for (int tm = 0; tm < 4; ++tm) {
                const LAS bf16_t* ap = lin + (tm * 16 + r) * LL + d * 64 + q * 8;
                f32x4 acc = (f32x4){0.f, 0.f, 0.f, 0.f};
                acc = mfma16(*(const LAS bf16x8*)ap, b0, acc); acc = mfma16(*(const LAS bf16x8*)(ap + 32), b1, acc);
#pragma unroll
                for (int jj = 0; jj < 4; ++jj) B.rw[(size_t)(4 + d) * RWA + (size_t)(t0 + tm * 16 + q * 4 + jj) * 256 + c] = (bf16_t)f2bf(sigm(w0c + acc[jj]) * 0.60653066f);
            }
        }
#pragma unroll 1
    for (int tt = 0; tt < 2; ++tt) {
        const int tn = 2 * w + tt, c = tn * 16 + r;
        const bf16_t* wb = sw + 65536 + (size_t)(tn * 16 + r) * 128 + q * 8;
        const bf16x8 b0 = *(const bf16x8*)wb, b1 = *(const bf16x8*)(wb + 32), b2 = *(const bf16x8*)(wb + 64), b3 = *(const bf16x8*)(wb + 96);
#pragma unroll
        for (int tm = 0; tm < 4; ++tm) {
            const LAS bf16_t* ap = lin + (tm * 16 + r) * LL + 256 + q * 8;
            f32x4 acc = (f32x4){0.f, 0.f, 0.f, 0.f};
            acc = mfma16(*(const LAS bf16x8*)ap, b0, acc); acc = mfma16(*(const LAS bf16x8*)(ap + 32), b1, acc);
            acc = mfma16(*(const LAS bf16x8*)(ap + 64), b2, acc); acc = mfma16(*(const LAS bf16x8*)(ap + 96), b3, acc);
#pragma unroll
            for (int jj = 0; jj < 4; ++jj) B.rw[(size_t)3 * RWA + (size_t)(t0 + tm * 16 + q * 4 + jj) * 256 + c] = (bf16_t)f2bf(acc[jj]);
        }
    }
#pragma unroll 1
    for (int d = 0; d < 2; ++d) {
        const int c = w * 16 + r;
        const float bias = P.in[6][(layer * 2 + d) * 128 + c];
        const bf16x8 b0 = *(const bf16x8*)(sw + 98304 + d * 4096 + (size_t)(w * 16 + r) * 32 + q * 8);
#pragma unroll
        for (int tm = 0; tm < 4; ++tm) {
            f32x4 acc = (f32x4){0.f, 0.f, 0.f, 0.f};
            acc = mfma16(*(const LAS bf16x8*)(gin + (tm * 16 + r) * 40 + q * 8), b0, acc);
#pragma unroll
            for (int jj = 0; jj < 4; ++jj) B.gla_la[((size_t)d * TG + t0 + tm * 16 + q * 4 + jj) * 128 + c] = -softplus(-(acc[jj] + bias)) * (1.0f / 16.0f);
        }
    }
    {
        const int c0 = (tid & 127) * 8;
        float wt[5][8], bs[8];
        { const f32x4 b0 = *(const f32x4*)(P.in[20] + layer * 1024 + c0), b1 = *(const f32x4*)(P.in[20] + layer * 1024 + c0 + 4);
          bs[0] = b0[0]; bs[1] = b0[1]; bs[2] = b0[2]; bs[3] = b0[3]; bs[4] = b1[0]; bs[5] = b1[1]; bs[6] = b1[2]; bs[7] = b1[3]; }
#pragma unroll
        for (int tap = 0; tap < 5; ++tap) { const float* wp = P.in[19] + (size_t)(layer * 5 + tap) * 1024 + c0;
            const f32x4 w0 = *(const f32x4*)wp, w1 = *(const f32x4*)(wp + 4);
            wt[tap][0] = w0[0]; wt[tap][1] = w0[1]; wt[tap][2] = w0[2]; wt[tap][3] = w0[3]; wt[tap][4] = w1[0]; wt[tap][5] = w1[1]; wt[tap][6] = w1[2]; wt[tap][7] = w1[3]; }
        u32x4 xr[5], xn[5];
#define CONV_LOAD(dst, ii) do { const int t_ = (tid + 512 * (ii)) >> 7, tl_ = t0 + t_, pos_ = tl_ % L; \
            _Pragma("unroll") for (int tap = 0; tap < 5; ++tap) { const int pp = pos_ + tap - 2; \
                dst[tap] = (pp >= 0 && pp < L) ? *(const u32x4*)(p + (size_t)(tl_ + tap - 2) * DINP + PC_XBC + c0) : (u32x4){0u, 0u, 0u, 0u}; } } while (0)
        CONV_LOAD(xn, 0);
#pragma unroll 1
        for (int i = 0; i < 16; ++i) {
#pragma unroll
            for (int tap = 0; tap < 5; ++tap) xr[tap] = xn[tap];
            if (i < 15) CONV_LOAD(xn, i + 1);
            float acc[8];
#pragma unroll
            for (int j = 0; j < 8; ++j) acc[j] = bs[j];
#pragma unroll
            for (int tap = 0; tap < 5; ++tap) { float x[8]; unpack8(xr[tap], x);
#pragma unroll
                for (int j = 0; j < 8; ++j) acc[j] += wt[tap][j] * x[j]; }
            const int tl = t0 + ((tid + 512 * i) >> 7);
            u32x4 o; o.x = pk2(silu(acc[0]), silu(acc[1])); o.y = pk2(silu(acc[2]), silu(acc[3])); o.z = pk2(silu(acc[4]), silu(acc[5])); o.w = pk2(silu(acc[6]), silu(acc[7]));
            *(u32x4*)(B.ssd_x + (size_t)tl * 1024 + c0) = o;
        }
#undef CONV_LOAD
    }
#pragma unroll
    for (int i = 0; i < 2; ++i) { const int idx = tid + 512 * i, t = idx >> 4, j = idx & 15, tl = t0 + t;
        B.ssd_dt[(size_t)tl * 16 + j] = softplus(bf2f(p[(size_t)tl * DINP + PC_DT + j]) + P.in[21][layer * 16 + j]); }
}

__device__ __forceinline__ f32x4 mma_nt(f32x4 acc, const LAS bf16_t* A, int lda, const LAS bf16_t* Bt, int ldb, int K, int lane) {
    const int r = lane & 15, q = lane >> 4;
    for (int k = 0; k < K; k += 32) {
        const bf16x8 a = *(const LAS bf16x8*)(A + r * lda + k + q * 8);
        const bf16x8 b = *(const LAS bf16x8*)(Bt + r * ldb + k + q * 8);
        acc = __builtin_amdgcn_mfma_f32_16x16x32_bf16(a, b, acc, 0, 0, 0);
    }
    return acc;
}
__device__ __forceinline__ f32x4 mma_nt_x(f32x4 acc, const LAS bf16_t* A, int lda, const LAS bf16_t* Bt, int ldb, int K, int lane, int xa, int xb) {
    const int r = lane & 15, q = lane >> 4;
    for (int k = 0; k < K; k += 32) {
        const bf16x8 a = *(const LAS bf16x8*)(A + r * lda + ((((k >> 3) + q) ^ xa) << 3));
        const bf16x8 b = *(const LAS bf16x8*)(Bt + r * ldb + ((((k >> 3) + q) ^ xb) << 3));
        acc = __builtin_amdgcn_mfma_f32_16x16x32_bf16(a, b, acc, 0, 0, 0);
    }
    return acc;
}
__device__ __forceinline__ f32x4 mma_tn_x(f32x4 acc, const LAS bf16_t* A, int lda, const LAS bf16_t* Bt, int ldb, int K, int lane, int xa, int xb) {
    const int r = lane & 15, q = lane >> 4;
    for (int k = 0; k < K; k += 32) {
        const bf16x8 a = *(const LAS bf16x8*)(A + r * lda + ((((k >> 3) + q) ^ xa) << 3));
        const bf16x8 b = *(const LAS bf16x8*)(Bt + r * ldb + ((((k >> 3) + q) ^ xb) << 3));
        acc = __builtin_amdgcn_mfma_f32_16x16x32_bf16(b, a, acc, 0, 0, 0);
    }
    return acc;
}
template <int DK> struct CL {
    static constexpr int LQ = DK + 8, LT = 72;
    static constexpr int QA = 0, KA = QA + 64 * LQ * 2, KBT = KA + 64 * LQ * 2, VT = KBT + DK * LT * 2, SC = VT + 64 * LT * 2, STT = SC + 64 * LT * 2;
    static constexpr int FA = STT + 64 * LQ * 2;
};

__device__ __forceinline__ void ssd_unit(LAS unsigned char* lds, const Params& P, const MixBufs& B, float* segst, int layer, int L, int seq, int h, int d, int seg, bool state_only) {
    typedef CL<128> C;
    const int tid = otid(), w = tid >> 6, lane = tid & 63, r = lane & 15, q = lane >> 4;
    LAS bf16_t* Qa = (LAS bf16_t*)(lds + C::QA); LAS bf16_t* Ka = (LAS bf16_t*)(lds + C::KA); LAS bf16_t* KbT = (LAS bf16_t*)(lds + C::KBT);
    LAS bf16_t* VT = (LAS bf16_t*)(lds + C::VT); LAS bf16_t* Sc = (LAS bf16_t*)(lds + C::SC); LAS bf16_t* StT = (LAS bf16_t*)(lds + C::STT);
    LAS float* acum = (LAS float*)(lds + C::FA); LAS float* dtl = acum + 64;
    const int grp = h >> 2;
    const float Aneg = -__expf(P.in[22][layer * 16 + d * 8 + h]);
    const int base = seq * L, cbeg = seg * 32, cend = cbeg + 32;
    __syncthreads();
    f32x4 st[4];
#pragma unroll
    for (int i = 0; i < 4; ++i) st[i] = (f32x4){0.f, 0.f, 0.f, 0.f};
    const int kidx = h * 2 + d;
    if (!state_only) {
        for (int ps = 0; ps < seg; ++ps) {
            const float* sp = segst + (size_t)((seq * 8 + ps) * 24 + kidx) * 8256;
            const float dcy = __expf(sp[8192]);
#pragma unroll
            for (int tv = 0; tv < 4; ++tv)
#pragma unroll
                for (int jj = 0; jj < 4; ++jj) st[tv][jj] = st[tv][jj] * dcy + sp[(tv * 4 + jj) * 512 + tid];
        }
#pragma unroll
        for (int tv = 0; tv < 4; ++tv) {
            u32x2 o; o.x = pk2(st[tv][0], st[tv][1]); o.y = pk2(st[tv][2], st[tv][3]);
            *(LAS u32x2*)(StT + (tv * 16 + r) * C::LQ + w * 16 + q * 4) = o;
        }
    }
    float asum = 0.f;
    const int row = tid >> 3, part = tid & 7;
    const int tm = w >> 1, tn0 = (w & 1) * 2;
    bf16_t* yout = B.ssd_y + (size_t)d * TG * 512;
    u32x4 c0, c1, b0, b1, x0; float dtv;
#define SSD_LOAD(cc) do { const int n0_ = (cc) * 64; \
        const int tok = d == 0 ? base + n0_ + row : base + L - 1 - (n0_ + row); \
        const bf16_t* xr = B.ssd_x + (size_t)tok * 1024; \
        c0 = *(const u32x4*)(xr + 768 + grp * 128 + part * 16); c1 = *(const u32x4*)(xr + 768 + grp * 128 + part * 16 + 8); \
        b0 = *(const u32x4*)(xr + 512 + grp * 128 + part * 16); b1 = *(const u32x4*)(xr + 512 + grp * 128 + part * 16 + 8); \
        x0 = *(const u32x4*)(xr + h * 64 + part * 8); \
        const int tl_ = d == 0 ? base + n0_ + lane : base + L - 1 - (n0_ + lane); \
        dtv = B.ssd_dt[(size_t)tl_ * 16 + d * 8 + h]; } while (0)
    SSD_LOAD(cbeg);
    for (int c = cbeg; c < cend; ++c) {
        const int n0 = c * 64;
        const float ac = wave_incl_scan(dtv * Aneg, lane);
        const float alast = lane_bcast(ac, 63);
        asum += alast;
        if (w == 0) { acum[lane] = ac; dtl[lane] = dtv; }
        {
            const float ks = __shfl(dtv, row) * __expf(alast - __shfl(ac, row));
            *(LAS u32x4*)(Qa + row * C::LQ + part * 16) = c0; *(LAS u32x4*)(Qa + row * C::LQ + part * 16 + 8) = c1;
            *(LAS u32x4*)(Ka + row * C::LQ + part * 16) = b0; *(LAS u32x4*)(Ka + row * C::LQ + part * 16 + 8) = b1;
            float bf[16]; unpack8(b0, bf); unpack8(b1, bf + 8);
            const int rsw = row ^ (part << 3);
#pragma unroll
            for (int j = 0; j < 16; ++j) KbT[(part * 16 + j) * C::LT + rsw] = (bf16_t)f2bf(bf[j] * ks);
            const unsigned xs[4] = {x0.x, x0.y, x0.z, x0.w};
#pragma unroll
            for (int j = 0; j < 4; ++j) { VT[(part * 8 + 2 * j) * C::LT + rsw] = (bf16_t)(xs[j] & 0xffffu); VT[(part * 8 + 2 * j + 1) * C::LT + rsw] = (bf16_t)(xs[j] >> 16); }
        }
        if (c + 1 < cend) SSD_LOAD(c + 1);
        lds_barrier();
        if (!state_only) {
#pragma unroll
        for (int tt = 0; tt < 2; ++tt) {
            const int tn = tn0 + tt;
            f32x4 s = (f32x4){0.f, 0.f, 0.f, 0.f};
            s = mma_tn_x(s, Qa + tm * 16 * C::LQ, C::LQ, Ka + tn * 16 * C::LQ, C::LQ, 128, lane, 0, 0);
            const int i = tm * 16 + r, j0 = tn * 16 + q * 4;
            const float ai = acum[i];
            const f32x4 aj = *(const LAS f32x4*)(acum + j0), dj = *(const LAS f32x4*)(dtl + j0);
            float v[4];
#pragma unroll
            for (int jj = 0; jj < 4; ++jj) {
                const int j = j0 + jj;
                const bool on = d == 0 ? (i >= j) : (i > j);
                v[jj] = on ? s[jj] * __expf(ai - aj[jj]) * dj[jj] : 0.f;
            }
            u32x2 o; o.x = pk2(v[0], v[1]); o.y = pk2(v[2], v[3]);
            *(LAS u32x2*)(Sc + i * C::LT + j0) = o;
        }
        lds_barrier();
#pragma unroll
        for (int tt = 0; tt < 2; ++tt) {
            const int tn = tn0 + tt;
            f32x4 o1 = (f32x4){0.f, 0.f, 0.f, 0.f}, o2 = (f32x4){0.f, 0.f, 0.f, 0.f};
            o1 = mma_tn_x(o1, Sc + tm * 16 * C::LT, C::LT, VT + tn * 16 * C::LT, C::LT, 64, lane, 0, (tn * 2 + (r >> 3)) & 7);
            o2 = mma_tn_x(o2, Qa + tm * 16 * C::LQ, C::LQ, StT + tn * 16 * C::LQ, C::LQ, 128, lane, 0, 0);
            const int i = tm * 16 + r;
            const int tl = d == 0 ? base + n0 + i : base + L - 1 - (n0 + i);
            const float ei = __expf(acum[i]);
            { const f32x4 ov = o1 + o2 * ei; u32x2 o; o.x = pk2(ov[0], ov[1]); o.y = pk2(ov[2], ov[3]); *(u32x2*)(yout + (size_t)tl * 512 + h * 64 + tn * 16 + q * 4) = o; }
        }
        }
        {
            const float ds = __expf(alast);
#pragma unroll
            for (int tv = 0; tv < 4; ++tv) {
                st[tv] = st[tv] * ds;
                st[tv] = mma_nt_x(st[tv], KbT + w * 16 * C::LT, C::LT, VT + tv * 16 * C::LT, C::LT, 64, lane, w, (tv * 2 + (r >> 3)) & 7);
            }
        }
        lds_barrier();
        if (!state_only) {
#pragma unroll
        for (int tv = 0; tv < 4; ++tv) {
            u32x2 o; o.x = pk2(st[tv][0], st[tv][1]); o.y = pk2(st[tv][2], st[tv][3]);
            *(LAS u32x2*)(StT + (tv * 16 + r) * C::LQ + w * 16 + q * 4) = o;
        }
        }
    }
    if (state_only) {
        float* sp = segst + (size_t)((seq * 8 + seg) * 24 + kidx) * 8256;
#pragma unroll
        for (int tv = 0; tv < 4; ++tv)
#pragma unroll
            for (int jj = 0; jj < 4; ++jj) sp[(tv * 4 + jj) * 512 + tid] = st[tv][jj];
        if (tid == 0) sp[8192] = asum;
    }
#undef SSD_LOAD
}

__device__ __forceinline__ void gla_unit(LAS unsigned char* lds, const Params& P, const MixBufs& B, float* segst, int layer, int L, int seq, int h, int d, int seg, bool state_only) {
    typedef CL<32> C;
    const int tid = otid(), w = tid >> 6, lane = tid & 63, r = lane & 15, q = lane >> 4;
    LAS bf16_t* Qa = (LAS bf16_t*)(lds + C::QA); LAS bf16_t* Ka = (LAS bf16_t*)(lds + C::KA); LAS bf16_t* KbT = (LAS bf16_t*)(lds + C::KBT);
    LAS bf16_t* VT = (LAS bf16_t*)(lds + C::VT); LAS bf16_t* Sc = (LAS bf16_t*)(lds + C::SC); LAS bf16_t* StT = (LAS bf16_t*)(lds + C::STT);
    LAS float* dstate = (LAS float*)(lds + C::FA);
    const int base = seq * L, cbeg = seg * 32, cend = cbeg + 32;
    __syncthreads();
    f32x4 st = (f32x4){0.f, 0.f, 0.f, 0.f};
    const int row = tid >> 3, part = tid & 7;
    const int tm = w >> 1, tn0 = (w & 1) * 2;
    const int tk = w >> 2, tv = w & 3;
    const int kidx = 16 + h * 2 + d;
    if (!state_only) {
        for (int ps = 0; ps < seg; ++ps) {
            const float* sp = segst + (size_t)((seq * 8 + ps) * 24 + kidx) * 8256;
#pragma unroll
            for (int jj = 0; jj < 4; ++jj) st[jj] = st[jj] * __expf(sp[8192 + tk * 16 + q * 4 + jj]) + sp[jj * 512 + tid];
        }
        { u32x2 o; o.x = pk2(st[0], st[1]); o.y = pk2(st[2], st[3]); *(LAS u32x2*)(StT + (tv * 16 + r) * C::LQ + tk * 16 + q * 4) = o; }
    }
    float blsum[4] = {0.f, 0.f, 0.f, 0.f};
    const float* la = B.gla_la + (size_t)d * TG * 128;
    bf16_t* oout = B.gla_o + (size_t)d * TG * 256;
    const float qscale = 0.17677669529663687f;
    f32x4 lv; u32x2 qr, kr; u32x4 x0;
#define GLA_LOAD(cc) do { const int n0_ = (cc) * 64; \
        const int tl_ = d == 0 ? base + n0_ + lane : base + L - 1 - (n0_ + lane); \
        lv = *(const f32x4*)(la + (size_t)tl_ * 128 + h * 32 + 4 * w); \
        qr = *(const u32x2*)(B.p + (size_t)tl_ * DINP + PC_GQ + h * 32 + 4 * w); \
        kr = *(const u32x2*)(B.p + (size_t)tl_ * DINP + PC_GK + h * 32 + 4 * w); \
        const int tr_ = d == 0 ? base + n0_ + row : base + L - 1 - (n0_ + row); \
        x0 = *(const u32x4*)(B.p + (size_t)tr_ * DINP + PC_GV + h * 64 + part * 8); } while (0)
    GLA_LOAD(cbeg);
    for (int c = cbeg; c < cend; ++c) {
        const int n0 = c * 64;
        {
            const float qf[4] = {__uint_as_float(qr.x << 16), __uint_as_float(qr.x & 0xffff0000u), __uint_as_float(qr.y << 16), __uint_as_float(qr.y & 0xffff0000u)};
            const float kf[4] = {__uint_as_float(kr.x << 16), __uint_as_float(kr.x & 0xffff0000u), __uint_as_float(kr.y << 16), __uint_as_float(kr.y & 0xffff0000u)};
            float qd[4], kd[4];
#pragma unroll
            for (int kk = 0; kk < 4; ++kk) {
                const float b = wave_incl_scan(lv[kk], lane);
                const float bl = lane_bcast(b, 63);
                blsum[kk] += bl;
                qd[kk] = qf[kk] * qscale * __expf(b); kd[kk] = kf[kk] * __expf(-b);
                KbT[(4 * w + kk) * C::LT + lane] = (bf16_t)f2bf(kf[kk] * __expf(bl - b));
                if (lane == 63) dstate[4 * w + kk] = __expf(bl);
            }
            u32x2 o; o.x = pk2(qd[0], qd[1]); o.y = pk2(qd[2], qd[3]); *(LAS u32x2*)(Qa + lane * C::LQ + 4 * w) = o;
            o.x = pk2(kd[0], kd[1]); o.y = pk2(kd[2], kd[3]); *(LAS u32x2*)(Ka + lane * C::LQ + 4 * w) = o;
            const unsigned xs[4] = {x0.x, x0.y, x0.z, x0.w};
            const int rsw = row ^ (part << 3);
#pragma unroll
            for (int j = 0; j < 4; ++j) { VT[(part * 8 + 2 * j) * C::LT + rsw] = (bf16_t)(xs[j] & 0xffffu); VT[(part * 8 + 2 * j + 1) * C::LT + rsw] = (bf16_t)(xs[j] >> 16); }
        }
        if (c + 1 < cend) GLA_LOAD(c + 1);
        lds_barrier();
        if (!state_only) {
#pragma unroll
        for (int tt = 0; tt < 2; ++tt) {
            const int tn = tn0 + tt;
            f32x4 s = (f32x4){0.f, 0.f, 0.f, 0.f};
            s = mma_tn_x(s, Qa + tm * 16 * C::LQ, C::LQ, Ka + tn * 16 * C::LQ, C::LQ, 32, lane, 0, 0);
            const int i = tm * 16 + r, j0 = tn * 16 + q * 4;
            float v[4];
#pragma unroll
            for (int jj = 0; jj < 4; ++jj) { const int j = j0 + jj; const bool on = d == 0 ? (i >= j) : (i > j); v[jj] = on ? s[jj] : 0.f; }
            u32x2 o; o.x = pk2(v[0], v[1]); o.y = pk2(v[2], v[3]);
            *(LAS u32x2*)(Sc + i * C::LT + j0) = o;
        }
        lds_barrier();
#pragma unroll
        for (int tt = 0; tt < 2; ++tt) {
            const int tn = tn0 + tt;
            f32x4 o1 = (f32x4){0.f, 0.f, 0.f, 0.f};
            o1 = mma_tn_x(o1, Sc + tm * 16 * C::LT, C::LT, VT + tn * 16 * C::LT, C::LT, 64, lane, 0, (tn * 2 + (r >> 3)) & 7);
            o1 = mma_tn_x(o1, Qa + tm * 16 * C::LQ, C::LQ, StT + tn * 16 * C::LQ, C::LQ, 32, lane, 0, 0);
            const int i = tm * 16 + r;
            const int tl = d == 0 ? base + n0 + i : base + L - 1 - (n0 + i);
            { u32x2 o; o.x = pk2(o1[0], o1[1]); o.y = pk2(o1[2], o1[3]); *(u32x2*)(oout + (size_t)tl * 256 + h * 64 + tn * 16 + q * 4) = o; }
        }
        }
        {
#pragma unroll
            for (int jj = 0; jj < 4; ++jj) st[jj] *= dstate[tk * 16 + q * 4 + jj];
            st = mma_nt_x(st, KbT + tk * 16 * C::LT, C::LT, VT + tv * 16 * C::LT, C::LT, 64, lane, 0, (tv * 2 + (r >> 3)) & 7);
        }
        lds_barrier();
        if (!state_only) { u32x2 o; o.x = pk2(st[0], st[1]); o.y = pk2(st[2], st[3]); *(LAS u32x2*)(StT + (tv * 16 + r) * C::LQ + tk * 16 + q * 4) = o; }
    }
    if (state_only) {
        float* sp = segst + (size_t)((seq * 8 + seg) * 24 + kidx) * 8256;
#pragma unroll
        for (int jj = 0; jj < 4; ++jj) sp[jj * 512 + tid] = st[jj];
        if (lane == 0) {
#pragma unroll
            for (int kk = 0; kk < 4; ++kk) sp[8192 + 4 * w + kk] = blsum[kk];
        }
    }
#undef GLA_LOAD
}

constexpr int RL = 72;
struct RwRaw { u32x4 e, kk, bb, kd, rr, v; };
__device__ __forceinline__ void rwkv_pre_load(RwRaw& R, const MixBufs& B, int L, int u, int tid) {
    const int w = tid >> 6, lane = tid & 63, nch = L / 64, hd = u & 7, ch = u >> 3, h = hd >> 1, d = hd & 1;
    const int base = (ch / nch) * L, n0 = (ch % nch) * 64;
    const int tl = d == 0 ? base + n0 + lane : base + L - 1 - (n0 + lane);
    const size_t o = (size_t)tl * 256 + h * 64 + 8 * w;
    R.e = *(const u32x4*)(B.rw + (4 + d) * RWA + o); R.kk = *(const u32x4*)(B.rw + 2 * RWA + o);
    R.bb = *(const u32x4*)(B.rw + (8 + d) * RWA + o); R.kd = *(const u32x4*)(B.rw + (6 + d) * RWA + o);
    R.rr = *(const u32x4*)(B.rw + 0 * RWA + o);
    const int row = tid >> 3, part = tid & 7;
    const int tr = d == 0 ? base + n0 + row : base + L - 1 - (n0 + row);
    R.v = *(const u32x4*)(B.rw + 1 * RWA + (size_t)tr * 256 + h * 64 + part * 8);
}
__device__ __forceinline__ void rwkv_pre(LAS unsigned char* lds, const MixBufs& B, bf16_t* rq, int L, int u, int unext, RwRaw& R) {
    const int tid = otid(), w = tid >> 6, lane = tid & 63, r = lane & 15, q = lane >> 4;
#define RG(i) ((LAS bf16_t*)(lds + (i) * 9216))
    LAS bf16_t* At = RG(0); LAS bf16_t* Bt_ = RG(1); LAS bf16_t* Kt = RG(2); LAS bf16_t* Rt = RG(3); LAS bf16_t* AtT = RG(4); LAS bf16_t* BhT = RG(5);
    LAS bf16_t* KhT = RG(6); LAS bf16_t* VT = RG(7); LAS bf16_t* Lak = RG(8); LAS bf16_t* Mrb = RG(9); LAS bf16_t* Mrk = RG(10); LAS bf16_t* WT = RG(11);
    LAS bf16_t* Tm = RG(0); LAS bf16_t* XT = RG(1); LAS bf16_t* UT = RG(2);
#undef RG
    LAS float* Lf = (LAS float*)(lds + 12 * 9216);
    LAS float* gC = (LAS float*)(lds + 12 * 9216 + 17408);
    LAS bf16_t* L21b = (LAS bf16_t*)(lds + 12 * 9216 + 17408 + 512);
    LAS bf16_t* T11T = WT;
    LAS bf16_t* X1T = WT + 32 * 40;
    const int nch = L / 64, hd = u & 7, ch = u >> 3, h = hd >> 1, d = hd & 1, seq = ch / nch, c = ch % nch;
    const int base = seq * L, n0 = c * 64;
    const int cu = (((seq * nch + c) * 4 + h) * 2 + d);
    bf16_t* gq = rq + (size_t)cu * 3 * 4096;
    lds_barrier();
    {
        float e[8], kk[8], bb[8], kd[8], rr[8];
        unpack8(R.e, e); unpack8(R.kk, kk); unpack8(R.bb, bb); unpack8(R.kd, kd); unpack8(R.rr, rr);
        float at[8], bt[8], kt[8], rt[8];
#pragma unroll
        for (int j = 0; j < 8; ++j) {
            const float cum = wave_incl_scan(e[j], lane);
            const float cmid = lane_bcast(cum, 31), clast = lane_bcast(cum, 63);
            const float ea = __expf(-(cum - e[j] - cmid)), eb = __expf(cum - cmid), er = __expf(-(cum - cmid)), eh = __expf(-(clast - cum));
            at[j] = -kk[j] * ea; bt[j] = bb[j] * eb; kt[j] = kd[j] * eb; rt[j] = rr[j] * er;
            AtT[(8 * w + j) * RL + lane] = (bf16_t)f2bf(at[j]);
            BhT[(8 * w + j) * RL + lane] = (bf16_t)f2bf(bb[j] * eh);
            KhT[(8 * w + j) * RL + lane] = (bf16_t)f2bf(kd[j] * eh);
            if (lane == 63) { gC[8 * w + j] = __expf(-clast); gC[64 + 8 * w + j] = __expf(-cmid); }
        }
        u32x4 o4;
        o4.x = pk2(at[0], at[1]); o4.y = pk2(at[2], at[3]); o4.z = pk2(at[4], at[5]); o4.w = pk2(at[6], at[7]); *(LAS u32x4*)(At + lane * RL + 8 * w) = o4;
        o4.x = pk2(bt[0], bt[1]); o4.y = pk2(bt[2], bt[3]); o4.z = pk2(bt[4], bt[5]); o4.w = pk2(bt[6], bt[7]); *(LAS u32x4*)(Bt_ + lane * RL + 8 * w) = o4;
        o4.x = pk2(kt[0], kt[1]); o4.y = pk2(kt[2], kt[3]); o4.z = pk2(kt[4], kt[5]); o4.w = pk2(kt[6], kt[7]); *(LAS u32x4*)(Kt + lane * RL + 8 * w) = o4;
        o4.x = pk2(rt[0], rt[1]); o4.y = pk2(rt[2], rt[3]); o4.z = pk2(rt[4], rt[5]); o4.w = pk2(rt[6], rt[7]); *(LAS u32x4*)(Rt + lane * RL + 8 * w) = o4;
        const int row = tid >> 3, part = tid & 7;
        const unsigned xs[4] = {R.v.x, R.v.y, R.v.z, R.v.w};
#pragma unroll
        for (int j = 0; j < 4; ++j) { VT[(part * 8 + 2 * j) * RL + row] = (bf16_t)(xs[j] & 0xffffu); VT[(part * 8 + 2 * j + 1) * RL + row] = (bf16_t)(xs[j] >> 16); }
    }
    if (unext >= 0) rwkv_pre_load(R, B, L, unext, tid);
    lds_barrier();
    const int tm = w >> 1, tn0 = (w & 1) * 2;
    const f32x4 Z4 = (f32x4){0.f, 0.f, 0.f, 0.f};
#pragma unroll
    for (int tt = 0; tt < 2; ++tt) {
        const int tn = tn0 + tt;
        const f32x4 lab = mma_tn_x(Z4, At + tm * 16 * RL, RL, Bt_ + tn * 16 * RL, RL, 64, lane, 0, 0);
        const f32x4 lak = mma_tn_x(Z4, At + tm * 16 * RL, RL, Kt + tn * 16 * RL, RL, 64, lane, 0, 0);
        const f32x4 mrb = mma_tn_x(Z4, Rt + tm * 16 * RL, RL, Bt_ + tn * 16 * RL, RL, 64, lane, 0, 0);
        const f32x4 mrk = mma_tn_x(Z4, Rt + tm * 16 * RL, RL, Kt + tn * 16 * RL, RL, 64, lane, 0, 0);
        const int i = tm * 16 + r, j0 = tn * 16 + q * 4;
        f32x4 lf; float vk[4], vb[4], vm[4];
#pragma unroll
        for (int jj = 0; jj < 4; ++jj) {
            const int j = j0 + jj; const bool st_ = j < i, in_ = j <= i;
            lf[jj] = st_ ? lab[jj] : 0.f; vk[jj] = st_ ? lak[jj] : 0.f; vb[jj] = in_ ? mrb[jj] : 0.f; vm[jj] = in_ ? mrk[jj] : 0.f;
        }
        *(LAS f32x4*)(Lf + i * 68 + j0) = lf;
        u32x2 o;
        if (tm >= 2 && tn < 2) { o.x = pk2(lab[0], lab[1]); o.y = pk2(lab[2], lab[3]); *(LAS u32x2*)(L21b + (i - 32) * 40 + j0) = o; }
        o.x = pk2(vk[0], vk[1]); o.y = pk2(vk[2], vk[3]); *(LAS u32x2*)(Lak + i * RL + j0) = o;
        o.x = pk2(vb[0], vb[1]); o.y = pk2(vb[2], vb[3]); *(LAS u32x2*)(Mrb + i * RL + j0) = o;
        o.x = pk2(vm[0], vm[1]); o.y = pk2(vm[2], vm[3]); *(LAS u32x2*)(Mrk + i * RL + j0) = o;
    }
    lds_barrier();
#pragma unroll
    for (int tt = 0; tt < 2; ++tt) {
        const int tn = tn0 + tt;
        const f32x4 x = mma_nt(Z4, Lak + tm * 16 * RL, RL, VT + tn * 16 * RL, RL, 64, lane);
        u32x2 o; o.x = pk2(x[0], x[1]); o.y = pk2(x[2], x[3]);
        *(LAS u32x2*)(XT + (tn * 16 + r) * RL + tm * 16 + q * 4) = o;
    }
    if (w < 2) {
        const int ob = w * 32, j = lane & 31;
        float T[32];
        int zv = 0; asm volatile("" : "+v"(zv));
        const LAS float* Lfz = Lf + zv + ob * 68 + ob;
#pragma unroll
        for (int t = 0; t < 32; ++t) {
            float a0 = (t == j) ? 1.f : 0.f, a1 = 0.f;
#pragma unroll
            for (int s4 = 0; s4 < (t + 3) / 4; ++s4) {
                const f32x4 l = *(const LAS f32x4*)(Lfz + t * 68 + s4 * 4);
#pragma unroll
                for (int e2 = 0; e2 < 4; ++e2) { const int s_ = s4 * 4 + e2; if (s_ < t) { if (e2 & 1) a1 += l[e2] * T[s_]; else a0 += l[e2] * T[s_]; } }
            }
            T[t] = a0 + a1;
            if (lane < 32) {
                Tm[(ob + t) * RL + ob + j] = (bf16_t)f2bf(T[t]);
                if (w == 0) T11T[j * 40 + t] = (bf16_t)f2bf(T[t]);
            }
        }
    } else if (w == 2) {
        for (int i = lane; i < 32 * 16; i += 64) { const int t = i >> 4, c2 = (i & 15) * 2; *(LAS unsigned*)(Tm + t * RL + 32 + c2) = 0u; }
    }
    lds_barrier();
    if (w < 4) {
        const int mi = w >> 1, ni = w & 1;
        const f32x4 x1 = mma_nt(Z4, L21b + mi * 16 * 40, 40, T11T + ni * 16 * 40, 40, 32, lane);
        u32x2 o; o.x = pk2(x1[0], x1[1]); o.y = pk2(x1[2], x1[3]);
        *(LAS u32x2*)(X1T + (ni * 16 + r) * 40 + mi * 16 + q * 4) = o;
    }
    lds_barrier();
    if (w < 4) {
        const int mi = w >> 1, ni = w & 1;
        const f32x4 t21 = mma_tn_x(Z4, Tm + (32 + mi * 16) * RL + 32, RL, X1T + ni * 16 * 40, 40, 32, lane, 0, 0);
        u32x2 o; o.x = pk2(t21[0], t21[1]); o.y = pk2(t21[2], t21[3]);
        *(LAS u32x2*)(Tm + (32 + mi * 16 + r) * RL + ni * 16 + q * 4) = o;
    }
    lds_barrier();
    f32x4 uu[2], ww[2];
#pragma unroll
    for (int tt = 0; tt < 2; ++tt) {
        const int tn = tn0 + tt;
        uu[tt] = mma_nt(Z4, Tm + tm * 16 * RL, RL, XT + tn * 16 * RL, RL, 64, lane);
        ww[tt] = mma_nt(Z4, Tm + tm * 16 * RL, RL, AtT + tn * 16 * RL, RL, 64, lane);
    }
#pragma unroll
    for (int tt = 0; tt < 2; ++tt) {
        const int tn = tn0 + tt;
        u32x2 o; o.x = pk2(uu[tt][0], uu[tt][1]); o.y = pk2(uu[tt][2], uu[tt][3]);
        *(LAS u32x2*)(UT + (tn * 16 + r) * RL + tm * 16 + q * 4) = o;
        o.x = pk2(ww[tt][0], ww[tt][1]); o.y = pk2(ww[tt][2], ww[tt][3]);
        *(LAS u32x2*)(WT + (tn * 16 + r) * RL + tm * 16 + q * 4) = o;
    }
    lds_barrier();
    bf16_t* yout = B.rw_y + (size_t)d * TG * 256;
#pragma unroll
    for (int tt = 0; tt < 2; ++tt) {
        const int tn = tn0 + tt;
        const f32x4 qe = mma_tn_x(Z4, Mrb + tm * 16 * RL, RL, WT + tn * 16 * RL, RL, 64, lane, 0, 0);
        f32x4 yl = mma_tn_x(Z4, Mrb + tm * 16 * RL, RL, UT + tn * 16 * RL, RL, 64, lane, 0, 0);
        yl = mma_tn_x(yl, Mrk + tm * 16 * RL, RL, VT + tn * 16 * RL, RL, 64, lane, 0, 0);
        const f32x4 pe = mma_tn_x(Z4, BhT + tm * 16 * RL, RL, WT + tn * 16 * RL, RL, 64, lane, 0, 0);
        f32x4 hl = mma_nt(Z4, BhT + tm * 16 * RL, RL, UT + tn * 16 * RL, RL, 64, lane);
        hl = mma_nt(hl, KhT + tm * 16 * RL, RL, VT + tn * 16 * RL, RL, 64, lane);
        const int i = tm * 16 + r, n0c = tn * 16 + q * 4;
        const f32x4 um = *(const LAS f32x4*)(gC + 64 + n0c);
        const u32x2 rtp = *(const LAS u32x2*)(Rt + i * RL + n0c);
        const float rt4[4] = {__uint_as_float(rtp.x << 16), __uint_as_float(rtp.x & 0xffff0000u), __uint_as_float(rtp.y << 16), __uint_as_float(rtp.y & 0xffff0000u)};
        const float gci = gC[i];
        float qv[4], pv[4];
#pragma unroll
        for (int jj = 0; jj < 4; ++jj) { qv[jj] = (qe[jj] + rt4[jj]) * um[jj]; pv[jj] = pe[jj] * um[jj] + ((n0c + jj) == i ? gci : 0.f); }
        u32x2 o; o.x = pk2(qv[0], qv[1]); o.y = pk2(qv[2], qv[3]); *(u32x2*)(gq + i * 64 + n0c) = o;
        o.x = pk2(pv[0], pv[1]); o.y = pk2(pv[2], pv[3]); *(u32x2*)(gq + 4096 + i * 64 + n0c) = o;
        const int tl = d == 0 ? base + n0 + i : base + L - 1 - (n0 + i);
        o.x = pk2(yl[0], yl[1]); o.y = pk2(yl[2], yl[3]); *(u32x2*)(yout + (size_t)tl * 256 + h * 64 + n0c) = o;
        o.x = pk2(hl[0], hl[1]); o.y = pk2(hl[2], hl[3]);
        *(u32x2*)(gq + 8192 + (tn * 16 + r) * 64 + tm * 16 + q * 4) = o;
    }
}

__device__ __forceinline__ void rwkv_seq(LAS unsigned char* lds, const MixBufs& B, const bf16_t* rq, int L, int seq, int h, int d) {
    const int tid = otid(), w = tid >> 6, lane = tid & 63, r = lane & 15, q = lane >> 4;
    const int tm = w >> 1, tn0 = (w & 1) * 2;
    const int base = seq * L, nch = L / 64;
    __syncthreads();
    for (int i = tid; i < 64 * RL / 2; i += 512) ((LAS unsigned*)lds)[i] = 0u;
    bf16_t* yout = B.rw_y + (size_t)d * TG * 256;
    const size_t custride = (size_t)8 * 3 * 4096;
    const bf16_t* g = rq + (size_t)(((seq * nch) * 4 + h) * 2 + d) * 3 * 4096;
    const int aoff = (tm * 16 + r) * 64 + q * 8;
    bf16x8 qa0 = *(const bf16x8*)(g + aoff), qa1 = *(const bf16x8*)(g + aoff + 32);
    bf16x8 pa0 = *(const bf16x8*)(g + 4096 + aoff), pa1 = *(const bf16x8*)(g + 4096 + aoff + 32);
    u32x2 hl0 = *(const u32x2*)(g + 8192 + (tn0 * 16 + r) * 64 + tm * 16 + q * 4), hl1 = *(const u32x2*)(g + 8192 + ((tn0 + 1) * 16 + r) * 64 + tm * 16 + q * 4);
    for (int c = 0; c < nch; ++c) {
        const bf16_t* gn = g + (c + 1 < nch ? custride : 0);
        const bf16x8 nqa0 = *(const bf16x8*)(gn + aoff), nqa1 = *(const bf16x8*)(gn + aoff + 32);
        const bf16x8 npa0 = *(const bf16x8*)(gn + 4096 + aoff), npa1 = *(const bf16x8*)(gn + 4096 + aoff + 32);
        const u32x2 nhl0 = *(const u32x2*)(gn + 8192 + (tn0 * 16 + r) * 64 + tm * 16 + q * 4), nhl1 = *(const u32x2*)(gn + 8192 + ((tn0 + 1) * 16 + r) * 64 + tm * 16 + q * 4);
        u32x2 yl[2];
        const int ti_ = tm * 16 + r;
        bf16_t* yrow = yout + (size_t)(d == 0 ? base + c * 64 + ti_ : base + L - 1 - (c * 64 + ti_)) * 256 + h * 64 + q * 4;
#pragma unroll
        for (int tt = 0; tt < 2; ++tt) yl[tt] = *(const u32x2*)(yrow + (tn0 + tt) * 16);
        lds_barrier();
        const LAS bf16_t* cur = (const LAS bf16_t*)(lds + (c & 1) * 9216);
        LAS bf16_t* nxt = (LAS bf16_t*)(lds + ((c + 1) & 1) * 9216);
#pragma unroll
        for (int tt = 0; tt < 2; ++tt) {
            const int tn = tn0 + tt;
            const bf16x8 b0 = *(const LAS bf16x8*)(cur + (tn * 16 + r) * RL + q * 8), b1 = *(const LAS bf16x8*)(cur + (tn * 16 + r) * RL + 32 + q * 8);
            f32x4 y = (f32x4){0.f, 0.f, 0.f, 0.f}, hn = (f32x4){0.f, 0.f, 0.f, 0.f};
            y = __builtin_amdgcn_mfma_f32_16x16x32_bf16(b0, qa0, y, 0, 0, 0); y = __builtin_amdgcn_mfma_f32_16x16x32_bf16(b1, qa1, y, 0, 0, 0);
            hn = __builtin_amdgcn_mfma_f32_16x16x32_bf16(pa0, b0, hn, 0, 0, 0); hn = __builtin_amdgcn_mfma_f32_16x16x32_bf16(pa1, b1, hn, 0, 0, 0);
            const u32x2 hl = tt == 0 ? hl0 : hl1;
            hn[0] += __uint_as_float(hl.x << 16); hn[1] += __uint_as_float(hl.x & 0xffff0000u); hn[2] += __uint_as_float(hl.y << 16); hn[3] += __uint_as_float(hl.y & 0xffff0000u);
            u32x2 o; o.x = pk2(hn[0], hn[1]); o.y = pk2(hn[2], hn[3]);
            *(LAS u32x2*)(nxt + (tn * 16 + r) * RL + tm * 16 + q * 4) = o;
            { const u32x2 yo = yl[tt];
              y[0] += __uint_as_float(yo.x << 16); y[1] += __uint_as_float(yo.x & 0xffff0000u); y[2] += __uint_as_float(yo.y << 16); y[3] += __uint_as_float(yo.y & 0xffff0000u);
              u32x2 o2; o2.x = pk2(y[0], y[1]); o2.y = pk2(y[2], y[3]); *(u32x2*)(yrow + tn * 16) = o2; }
        }
        g = gn; qa0 = nqa0; qa1 = nqa1; pa0 = npa0; pa1 = npa1; hl0 = nhl0; hl1 = nhl1;
    }
}

__device__ __forceinline__ void phase_post(const Params& P, const MixBufs& B, int layer) {
    const int tid_ = otid(); const int lane = tid_ & 63, gw = blockIdx.x * 8 + (tid_ >> 6), nw = gridDim.x * 8;
    const float gng = P.in[7][layer * 64 + lane];
    const float* ssdn = P.in[24] + layer * 512;
    float lng[4], lnb[4];
#pragma unroll
    for (int h = 0; h < 4; ++h) { lng[h] = P.in[17][layer * 256 + h * 64 + lane]; lnb[h] = P.in[18][layer * 256 + h * 64 + lane]; }
    const int c0 = lane * 8;
    const f32x4 sg0 = *(const f32x4*)(ssdn + c0), sg1 = *(const f32x4*)(ssdn + c0 + 4);
    const float Dh = P.in[23][layer * 8 + (lane >> 3)];
    for (int tl = gw; tl < TG; tl += nw) {
        const bf16_t* pr = B.p + (size_t)tl * DINP;
        bf16_t* mr = B.mix + (size_t)tl * DM;
        bf16_t go0[4], go1[4], ry0[4], ry1[4]; bf16_t ggt[4], rvv[4], rgg[4];
#pragma unroll
        for (int h = 0; h < 4; ++h) {
            const size_t o = (size_t)tl * 256 + h * 64 + lane;
            go0[h] = B.gla_o[o]; go1[h] = B.gla_o[(size_t)TG * 256 + o]; ggt[h] = pr[PC_GG + h * 64 + lane];
            ry0[h] = B.rw_y[o]; ry1[h] = B.rw_y[(size_t)TG * 256 + o]; rvv[h] = B.rw[1 * RWA + o]; rgg[h] = B.rw[3 * RWA + o];
        }
        const f32x4 srk = *(const f32x4*)(B.rw_s + (size_t)tl * 4), skr = *(const f32x4*)(B.rw_s + (size_t)TG * 4 + (size_t)tl * 4);
        const u32x4 ya = *(const u32x4*)(B.ssd_y + (size_t)tl * 512 + c0), yb = *(const u32x4*)(B.ssd_y + (size_t)TG * 512 + (size_t)tl * 512 + c0);
        const u32x4 xsr = *(const u32x4*)(B.ssd_x + (size_t)tl * 1024 + c0), zr = *(const u32x4*)(pr + PC_Z + c0);
#pragma unroll
        for (int h = 0; h < 4; ++h) {
            const float o = bf2f(go0[h]) + bf2f(go1[h]);
            const float ms = wave_sum(o * o) * (1.0f / 64.0f);
            mr[h * 64 + lane] = (bf16_t)f2bf(o * rsqrtf(ms + EPS) * gng * silu(bf2f(ggt[h])));
        }
#pragma unroll
        for (int h = 0; h < 4; ++h) {
            const float v = bf2f(rvv[h]);
            const float y = bf2f(ry0[h]) + bf2f(ry1[h]) - v * skr[h];
            const float mean = wave_sum(y) * (1.0f / 64.0f);
            const float dv = y - mean; const float var = wave_sum(dv * dv) * (1.0f / 64.0f);
            float oo = dv * rsqrtf(var + 64e-5f) * lng[h] + lnb[h];
            oo += srk[h] * v;
            mr[256 + h * 64 + lane] = (bf16_t)f2bf(oo * bf2f(rgg[h]));
        }
        {
            float xs[8], z[8], yfa[8], yfb[8]; unpack8(xsr, xs); unpack8(zr, z); unpack8(ya, yfa); unpack8(yb, yfb);
            float yv[8]; float ss = 0.f;
#pragma unroll
            for (int j = 0; j < 8; ++j) { const float yy = (yfa[j] + yfb[j]) + Dh * xs[j]; yv[j] = yy * silu(z[j]); ss += yv[j] * yv[j]; }
            ss = wave_sum(ss);
            const float rs = rsqrtf(ss * (1.0f / 512.0f) + EPS);
            u32x4 o; o.x = pk2(yv[0] * rs * sg0[0], yv[1] * rs * sg0[1]); o.y = pk2(yv[2] * rs * sg0[2], yv[3] * rs * sg0[3]);
            o.z = pk2(yv[4] * rs * sg1[0], yv[5] * rs * sg1[1]); o.w = pk2(yv[6] * rs * sg1[2], yv[7] * rs * sg1[3]);
            *(u32x4*)(mr + 512 + c0) = o;
        }
    }
}

#define RWKV_PRE_QUEUE(pool_base) do { \
        unsigned* qctr_ = (unsigned*)(ws + WS_CTL) + 4096 + 16 * (g * 2 + layer); \
        volatile LAS unsigned* qs_ = (volatile LAS unsigned*)(lds + 131072 + 1024 + 64); \
        unsigned tick_ = 0u; \
        if (threadIdx.x == 0) tick_ = __hip_atomic_fetch_add(qctr_, 1u, __ATOMIC_RELAXED, __HIP_MEMORY_SCOPE_AGENT); \
        for (;;) { \
            if (threadIdx.x == 0) qs_[0] = tick_; \
            __syncthreads(); \
            const int uq_ = (pool_base) + (int)qs_[0]; \
            __syncthreads(); \
            if (uq_ >= 4096) break; \
            if (threadIdx.x == 0) tick_ = __hip_atomic_fetch_add(qctr_, 1u, __ATOMIC_RELAXED, __HIP_MEMORY_SCOPE_AGENT); \
            RwRaw Rq_; rwkv_pre_load(Rq_, B, L, uq_, otid()); rwkv_pre(lds, B, rq, L, uq_, -1, Rq_); \
        } } while (0)

__global__ void __launch_bounds__(512, 2) fwd_megakernel(Params P) {
    extern __shared__ __attribute__((aligned(16))) unsigned char shm[];
    LAS unsigned char* lds = (LAS unsigned char*)shm;
    unsigned char* ws = P.ws;
    volatile LAS unsigned* bst = (volatile LAS unsigned*)(lds + 131072 + 1024);
    if (threadIdx.x == 0) { bst[0] = 0u; bst[1] = 0u; }
    __syncthreads();
    const XcdBarrier xbar = xcd_barrier_post((unsigned*)(ws + WS_CTL), bst);
    bf16_t* xb = (bf16_t*)(ws + WS_XB); float* ssp = (float*)(ws + WS_SSP); bf16_t* pbuf = (bf16_t*)(ws + WS_P);

    phase_weights(lds, P);
    for (int g = 0; g < NGROUP; ++g) {
        const int L = g < 2 ? 2048 : 16384, nseq = TG / L;
        phase_xprep(P, g);
        if (g == 0) cg::this_grid().sync(); else xcd_barrier(xbar);
        for (int layer = 0; layer < 2; ++layer) {
            pg8::StaticOrder S;
            {
                pg8::Gemm gm; gm.A = xb; gm.Bt = (const bf16_t*)(ws + WS_WIN) + (size_t)layer * DINP * DM; gm.M = TG; gm.N = DINP; gm.K = DM;
                S.init(TG, DINP, gridDim.x, blockIdx.x);
                EpiInproj E; E.O = pbuf; E.ssp = ssp;
                pg8::gemm_phase(lds, gm, S, E);
            }
            xcd_barrier(xbar);
            { const MixBufs B = mixbufs(P); const bf16_t* sw = (const bf16_t*)(ws + WS_SW) + (size_t)layer * SW_L;
              for (int t = blockIdx.x; t < TG / 64; t += gridDim.x) prep_tile64(lds, P, B, sw, layer, L, t); }
            xcd_barrier(xbar);
            {
                const MixBufs B = mixbufs(P);
                bf16_t* rq = (bf16_t*)(ws + WS_RWQ); float* segst = P.out + (size_t)g * TG * DM;
                const int nseg = L / 2048, nch = L / 64;
                const int nchain = nseg == 1 ? nseq * 24 : nseq * (nseg - 1) * 24;
                if (nseg == 1 && gridDim.x == 256) {
                    const int b = blockIdx.x;
                    ssd_unit(lds, P, B, segst, layer, L, b / 24 * 0 + (b >> 4), (b >> 1) & 7, b & 1, 0, false);
                    const int p0 = b * 13, pn = 13;
                    __syncthreads();
                    { RwRaw R; rwkv_pre_load(R, B, L, p0, otid());
                      for (int u = p0; u < p0 + pn; ++u) rwkv_pre(lds, B, rq, L, u, u + 1 < p0 + pn ? u + 1 : -1, R); }
                    RWKV_PRE_QUEUE(256 * 13);
                } else if (nseg == 8 && nseq == 2 && gridDim.x == 256) {
                    const int b = blockIdx.x;
                    for (int rep = 0; rep < 2; ++rep) {
                        const int it = b + rep * 256;
                        if (it < nchain) {
                            const int k = it % 24, sg = it / 24, seq = sg / (nseg - 1), seg = sg % (nseg - 1);
                            if (k < 16) ssd_unit(lds, P, B, segst, layer, L, seq, k >> 1, k & 1, seg, true);
                            else gla_unit(lds, P, B, segst, layer, L, seq, (k - 16) >> 1, k & 1, seg, true);
                        }
                    }
                    const int kx = b - 80;
                    const int p0 = b < 80 ? b * 7 : 560 + kx * 16, pn = b < 80 ? 7 : 16;
                    __syncthreads();
                    { RwRaw R; rwkv_pre_load(R, B, L, p0, otid());
                      for (int u = p0; u < p0 + pn; ++u) rwkv_pre(lds, B, rq, L, u, u + 1 < p0 + pn ? u + 1 : -1, R); }
                    RWKV_PRE_QUEUE(560 + 176 * 16);
                } else
                for (int it = blockIdx.x; it < nchain + 4096; it += gridDim.x) {
                    if (it < nchain) {
                        const int k = it % 24, sg = it / 24, seq = nseg == 1 ? sg : sg / (nseg - 1), seg = nseg == 1 ? 0 : sg % (nseg - 1);
                        if (k < 16) ssd_unit(lds, P, B, segst, layer, L, seq, k >> 1, k & 1, seg, nseg > 1);
                        else gla_unit(lds, P, B, segst, layer, L, seq, (k - 16) >> 1, k & 1, seg, nseg > 1);
                    } else { const int u = it - nchain; __syncthreads(); RwRaw R; rwkv_pre_load(R, B, L, u, otid()); rwkv_pre(lds, B, rq, L, u, -1, R); }
                }
            }
            xcd_barrier(xbar);
            {
                const MixBufs B = mixbufs(P);
                const bf16_t* rq = (const bf16_t*)(ws + WS_RWQ); float* segst = P.out + (size_t)g * TG * DM;
                const int nseg = L / 2048;
                const int nchain = nseg == 1 ? 0 : nseq * nseg * 24;
                const int nrs = nseq * 8, G = gridDim.x;
                if (nseg == 1 && G == 256) {
                    const int b = blockIdx.x;
                    if (b < 128) rwkv_seq(lds, B, rq, L, b >> 3, (b >> 1) & 3, b & 1);
                    else { const int u = b - 128; gla_unit(lds, P, B, segst, layer, L, u >> 3, (u >> 1) & 3, u & 1, 0, false); }
                } else
                for (int rnd = 0; rnd * G < nchain + nrs; ++rnd) {
                    const int it = rnd * G + ((rnd & 1) ? (G - 1 - (int)blockIdx.x) : (int)blockIdx.x);
                    if (it >= nchain + nrs) continue;
                    if (it >= nrs) {
                        const int ci = it - nrs, k = ci % 24, sg = ci / 24, seq = sg / nseg, seg = sg % nseg;
                        if (k < 16) ssd_unit(lds, P, B, segst, layer, L, seq, k >> 1, k & 1, seg, false);
                        else gla_unit(lds, P, B, segst, layer, L, seq, (k - 16) >> 1, k & 1, seg, false);
                    } else { rwkv_seq(lds, B, rq, L, it >> 3, (it >> 1) & 3, it & 1); }
                }
            }
            xcd_barrier(xbar);
            { const MixBufs B = mixbufs(P); phase_post(P, B, layer); }
            xcd_barrier(xbar);
            {
                pg8::Gemm gm; gm.A = (const bf16_t*)(ws + WS_MIX); gm.Bt = (const bf16_t*)(ws + WS_WOUT) + (size_t)layer * DM * DM; gm.M = TG; gm.N = DM; gm.K = DM;
                S.init(TG, DM, gridDim.x, blockIdx.x);
                EpiResid E; E.XB = xb; E.ssp = ssp;
                pg8::gemm_phase(lds, gm, S, E);
            }
            xcd_barrier(xbar);
            {
                pg8::Gemm gm; gm.A = xb; gm.Bt = (const bf16_t*)(ws + WS_WGU) + (size_t)layer * 2 * DFF * DM; gm.M = TG; gm.N = 2 * DFF; gm.K = DM;
                S.init(TG, 2 * DFF, gridDim.x, blockIdx.x);
                EpiGateUp E; E.O = pbuf; E.ssp = ssp;
                pg8::gemm_phase(lds, gm, S, E);
            }
            xcd_barrier(xbar);
            {
                pg8::Gemm gm; gm.A = pbuf; gm.Bt = (const bf16_t*)(ws + WS_WDN) + (size_t)layer * DM * DFF; gm.M = TG; gm.N = DM; gm.K = DFF;
                S.init(TG, DM, gridDim.x, blockIdx.x);
                EpiResid E; E.XB = xb; E.ssp = ssp;
                pg8::gemm_phase(lds, gm, S, E);
            }
            xcd_barrier(xbar);
        }
        phase_final(P, g);
        xcd_barrier(xbar);
    }
}

extern "C" void kernel_launch(void* const* d_in, const int* in_sizes, int n_in, void* d_out, int out_size, void* d_ws, size_t ws_size, hipStream_t stream) {
    static int grid = 0;
    if (grid == 0) {
        if (n_in != 30 || ws_size < WS_END) { fprintf(stderr, "kernel_launch: need 30 inputs and %zu ws bytes; got %d, %zu\n", (size_t)WS_END, n_in, ws_size); grid = -1; return; }
        int dev = 0, cus = 0, per_cu = 0;
        hipGetDevice(&dev);
        hipDeviceGetAttribute(&cus, hipDeviceAttributeMultiprocessorCount, dev);
        hipFuncSetAttribute((const void*)fwd_megakernel, hipFuncAttributeMaxDynamicSharedMemorySize, LDS_BYTES);
        hipOccupancyMaxActiveBlocksPerMultiprocessor(&per_cu, (const void*)fwd_megakernel, 512, LDS_BYTES);
        if (per_cu < 1) per_cu = 1;
        grid = cus * 1;
        if (grid > 256) grid = 256;
    }
    if (grid < 0) return;
    if (hipMemsetAsync((char*)d_ws + WS_CTL, 0, 65536, stream) != hipSuccess) { fprintf(stderr, "memset failed\n"); return; }
    Params p{};
    for (int i = 0; i < 30; ++i) p.in[i] = (const float*)d_in[i];
    p.out = (float*)d_out; p.ws = (unsigned char*)d_ws;
    void* args[] = {&p};
    hipError_t e = hipLaunchCooperativeKernel((const void*)fwd_megakernel, dim3(grid), dim3(512), args, LDS_BYTES, stream);
    if (e != hipSuccess) fprintf(stderr, "cooperative launch failed: %s (grid %d)\n", hipGetErrorString(e), grid);
}
```

```cpp
#include <hip/hip_runtime.h>
#include <hip/hip_cooperative_groups.h>
#include <cstdio>
namespace cg = cooperative_groups;

#define LAS __attribute__((address_space(3)))
typedef unsigned short bf16_t;
typedef short bf16x8 __attribute__((ext_vector_type(8)));
typedef float f32x4 __attribute__((ext_vector_type(4)));
typedef float f32x2 __attribute__((ext_vector_type(2)));
typedef unsigned u32x4 __attribute__((ext_vector_type(4)));
typedef unsigned u32x2 __attribute__((ext_vector_type(2)));

constexpr int DM = 1024, TALL = 98304, TG = 32768, NGROUP = 3;
constexpr int DINP = 3584, DIN = 3504, DFF = 2816;
constexpr int LDS_BYTES = 131072 + 2048;
constexpr float EPS = 1e-6f;
constexpr int PC_GQ = 0, PC_GK = 128, PC_GV = 256, PC_GG = 512, PC_GAF = 768;
constexpr int PC_R = 800, PC_RK = 1056, PC_RV = 1312, PC_RLOW = 1568;
constexpr int PC_Z = 1952, PC_XBC = 2464, PC_DT = 3488;

constexpr size_t WS_CTL = 0;
constexpr size_t WS_SW = 65536;
constexpr int SW_L = 106496;
constexpr size_t WS_WIN = WS_SW + 524288;
constexpr size_t WS_WOUT = WS_WIN + (size_t)2 * DINP * DM * 2;
constexpr size_t WS_WGU = WS_WOUT + (size_t)2 * DM * DM * 2;
constexpr size_t WS_WDN = WS_WGU + (size_t)2 * 2 * DFF * DM * 2;
constexpr size_t WS_XB = WS_WDN + (size_t)2 * DM * DFF * 2;
constexpr size_t WS_P = WS_XB + (size_t)TG * DM * 2;
constexpr size_t WS_MIX = WS_P + (size_t)TG * DINP * 2;
constexpr size_t WS_SSP = WS_MIX + (size_t)TG * DM * 2;
constexpr size_t WS_GLA_LA = WS_SSP + (size_t)TG * 16 * 4;
constexpr size_t WS_GLA_O = WS_GLA_LA + (size_t)2 * TG * 128 * 4;
constexpr size_t WS_RW = WS_GLA_O + (size_t)2 * TG * 256 * 4;
constexpr size_t WS_RW_S = WS_RW + (size_t)10 * TG * 256 * 2;
constexpr size_t WS_RW_Y = WS_RW_S + (size_t)2 * TG * 4 * 4;
constexpr size_t WS_SSD_X = WS_RW_Y + (size_t)2 * TG * 256 * 4;
constexpr size_t WS_SSD_DT = WS_SSD_X + (size_t)TG * 1024 * 2;
constexpr size_t WS_SSD_Y = WS_SSD_DT + (size_t)TG * 16 * 4;
constexpr size_t WS_RWQ = WS_SSD_Y + (size_t)2 * TG * 512 * 4;
constexpr size_t WS_END = WS_RWQ + (size_t)4096 * 3 * 4096 * 2;
static_assert(WS_END <= ((size_t)1 << 30), "workspace over 1 GiB");

struct Params { const float* in[30]; float* out; unsigned char* ws; };

__device__ __forceinline__ int otid() { int t = threadIdx.x; asm volatile("" : "+v"(t)); return t; }
__device__ __forceinline__ float bf2f(bf16_t b) { return __uint_as_float(((unsigned)b) << 16); }
typedef __bf16 bf16x2_t __attribute__((ext_vector_type(2)));
__device__ __forceinline__ unsigned pk2(float lo, float hi) { f32x2 f = {lo, hi}; bf16x2_t v = __builtin_convertvector(f, bf16x2_t); return __builtin_bit_cast(unsigned, v); }
__device__ __forceinline__ unsigned f2bf(float f) { return (unsigned)__builtin_bit_cast(unsigned short, (__bf16)f); }
__device__ __forceinline__ float sigm(float x) { return __builtin_amdgcn_rcpf(1.0f + __expf(-x)); }
__device__ __forceinline__ float silu(float x) { return x * __builtin_amdgcn_rcpf(1.0f + __expf(-x)); }
__device__ __forceinline__ float softplus(float x) { return fmaxf(x, 0.f) + __logf(1.0f + __expf(-fabsf(x))); }
__device__ __forceinline__ void lds_barrier() { asm volatile("s_waitcnt lgkmcnt(0)" ::: "memory"); __builtin_amdgcn_s_barrier(); asm volatile("" ::: "memory"); }

__device__ __forceinline__ float dpp_add(float v, float src_carrier) { return v + src_carrier; }
#define DPPF(x, ctrl, rmask) __int_as_float(__builtin_amdgcn_update_dpp(0, __float_as_int(x), (ctrl), (rmask), 0xf, false))
__device__ __forceinline__ float wave_incl_scan(float v, int lane) {
    v += DPPF(v, 0x111, 0xf);
    v += DPPF(v, 0x112, 0xf);
    v += DPPF(v, 0x114, 0xf);
    v += DPPF(v, 0x118, 0xf);
    v += DPPF(v, 0x142, 0xa);
    v += DPPF(v, 0x143, 0xc);
    return v;
}
__device__ __forceinline__ float lane_bcast(float v, int l) { return __int_as_float(__builtin_amdgcn_readlane(__float_as_int(v), l)); }
__device__ __forceinline__ float wave_sum(float v) { return lane_bcast(wave_incl_scan(v, 0), 63); }
__device__ __forceinline__ void unpack8(u32x4 v, float* f) {
    f[0] = __uint_as_float(v.x << 16); f[1] = __uint_as_float(v.x & 0xffff0000u);
    f[2] = __uint_as_float(v.y << 16); f[3] = __uint_as_float(v.y & 0xffff0000u);
    f[4] = __uint_as_float(v.z << 16); f[5] = __uint_as_float(v.z & 0xffff0000u);
    f[6] = __uint_as_float(v.w << 16); f[7] = __uint_as_float(v.w & 0xffff0000u);
}


#define XB_TMO      128
#define XB_XCNT(j)  (256  + 64 * (j))
#define XB_XSUB(j)  (1280 + 64 * (j))
#define XB_XGEN(j)  (2304 + 64 * (j))
#define XB_TOP      3328
#define XB_TOPGEN   3392
#define XB_SPIN_CAP (1u << 22)
__device__ __forceinline__ unsigned xb_ld(unsigned* p)              { return __hip_atomic_load(p, __ATOMIC_RELAXED, __HIP_MEMORY_SCOPE_AGENT); }
__device__ __forceinline__ unsigned xb_add(unsigned* p, unsigned v) { return __hip_atomic_fetch_add(p, v, __ATOMIC_RELAXED, __HIP_MEMORY_SCOPE_AGENT); }
__device__ __forceinline__ unsigned xb_xcc_id() { return (unsigned)__builtin_amdgcn_s_getreg((3 << 11) | 20) & 0xFu; }
#define XB_SPIN(cond, bar) do { unsigned _sp = 0; while (cond) { __builtin_amdgcn_s_sleep(1); \
    if ((++_sp & 255u) == 0u) { if (xb_ld(&(bar)[XB_TMO])) break; if (_sp > XB_SPIN_CAP) { atomicAdd(&(bar)[XB_TMO], 1u); break; } } } } while (0)
struct XcdBarrier { unsigned* bar; unsigned x; volatile LAS unsigned* st; };
__device__ __forceinline__ XcdBarrier xcd_barrier_post(unsigned* bar, volatile LAS unsigned* st) {
    XcdBarrier b; b.bar = bar; b.x = xb_xcc_id(); b.st = st;
    if (threadIdx.x == 0) (void)xb_add(&bar[XB_XCNT(b.x)], 1u);
    return b;
}
__device__ __forceinline__ void xcd_barrier_complete(unsigned* bar, unsigned x, unsigned& nloc, unsigned& nx) {
    const unsigned G = gridDim.x * gridDim.y * gridDim.z;
    unsigned sum, cnt, mine, sp = 0u;
    for (;;) {
        sum = 0u; cnt = 0u; mine = 0u;
#pragma unroll
        for (unsigned j = 0; j < 16; ++j) { const unsigned c = xb_ld(&bar[XB_XCNT(j)]); sum += c; cnt += (c > 0u) ? 1u : 0u; mine = (j == x) ? c : mine; }
        if (sum == G) break;
        __builtin_amdgcn_s_sleep(1);
        if ((++sp & 255u) == 0u) { if (xb_ld(&bar[XB_TMO])) break; if (sp > XB_SPIN_CAP) { atomicAdd(&bar[XB_TMO], 1u); break; } }
    }
    nloc = mine > 0u ? mine : 1u; nx = cnt > 0u ? cnt : 1u;
}
__device__ __forceinline__ void xcd_barrier(const XcdBarrier& b) {
    asm volatile("s_waitcnt vmcnt(0)" ::: "memory");
    __syncthreads();
    if (threadIdx.x == 0) {
        unsigned* bar = b.bar;
        __builtin_amdgcn_s_waitcnt(0);
        unsigned nloc = b.st[0], nx = b.st[1];
        if (nloc == 0u) { xcd_barrier_complete(bar, b.x, nloc, nx); b.st[0] = nloc; b.st[1] = nx; }
        const unsigned old = xb_add(&bar[XB_XSUB(b.x)], 1u);
        const unsigned gen = old / nloc;
        if (old + 1u == (gen + 1u) * nloc) {
            __builtin_amdgcn_fence(__ATOMIC_RELEASE, "agent");
            asm volatile("s_waitcnt vmcnt(0)" ::: "memory");
            const unsigned og = xb_add(&bar[XB_TOP], 1u);
            const unsigned tg = og / nx;
            if (og + 1u == (tg + 1u) * nx) xb_add(&bar[XB_TOPGEN], 1u);
            else XB_SPIN(xb_ld(&bar[XB_TOPGEN]) == tg, bar);
            __builtin_amdgcn_fence(__ATOMIC_ACQUIRE, "agent");
            xb_add(&bar[XB_XGEN(b.x)], 1u);
            asm volatile("s_waitcnt vmcnt(0)" ::: "memory");
        } else {
            XB_SPIN(xb_ld(&bar[XB_XGEN(b.x)]) == gen, bar);
            __builtin_amdgcn_fence(__ATOMIC_ACQUIRE, "agent");
            asm volatile("s_waitcnt vmcnt(0)" ::: "memory");
        }
    }
    __syncthreads();
}

namespace pg8 {
constexpr int BM = 256, BK = 64, HALF = 128, HTB = HALF * BK * 2, NXCD = 8, WGM = 8;
__device__ __forceinline__ int lds_byte(int r, int c) { const int st = (r >> 4) * 2 + (c >> 5), rr = r & 15, cc = c & 31, ob = rr * 64 + cc * 2; return st * 1024 + (ob ^ (((ob >> 9) & 1) << 5)); }
__device__ __forceinline__ void stage_rc(int b, int& R, int& C) { const int st = b / 1024, sb = b % 1024, swz = sb ^ (((sb >> 9) & 1) << 5); R = (st >> 1) * 16 + swz / 64; C = (st & 1) * 32 + (swz % 64) / 2; }
__device__ __forceinline__ int perm32(int rho) { const int n = rho >> 4, i = rho & 15; return 8 * (i >> 2) + 4 * n + (i & 3); }
struct Unit { int pm, pn; };
struct Gemm { const bf16_t* A; const bf16_t* Bt; int M, N, K; };
struct StaticOrder {
    int nM, nN, nwg, G, c;
    __device__ void init(int M, int N, int G_, int c_) { nM = M / BM; nN = N / BM; nwg = nM * nN; G = G_; c = c_; }
    __device__ bool next(int i, Unit& u) const {
        const long L = (long)i * G + c; if (L >= nwg) return false;
        int wgid = (int)L; { const int q = nwg / NXCD, r = nwg % NXCD, xcd = wgid % NXCD, off = wgid / NXCD; wgid = (xcd < r ? xcd * (q + 1) : r * (q + 1) + (xcd - r) * q) + off; }
        const int nig = WGM * nN, gid = wgid / nig, fm = gid * WGM, gsz = (nM - fm) < WGM ? (nM - fm) : WGM;
        u.pm = fm + ((wgid % nig) % gsz); u.pn = (wgid % nig) / gsz; return true;
    }
};

template <class Epi>
__device__ __forceinline__ void gemm_phase(LAS unsigned char* lds, const Gemm g, const StaticOrder& S, const Epi& E) {
    const int tid = otid(), wid = __builtin_amdgcn_readfirstlane(tid >> 6), lane = tid & 63, wr = wid >> 2, wc = wid & 3, fr = lane & 15, fq = lane >> 4;
    const int K = g.K, nt = K / BK;
    unsigned voffA[2], voffB[2];
#pragma unroll
    for (int i = 0; i < 2; ++i) { int R, C; stage_rc(tid * 16 + i * 8192, R, C); const int Rb = Epi::PERM ? ((R & ~31) + perm32(R & 31)) : R;
        voffA[i] = (unsigned)(R * K + C) * 2u; voffB[i] = (unsigned)(Rb * K + C) * 2u; }
    const size_t kstep = (size_t)(BK * 2);
    const size_t hstep = (size_t)HALF * K * 2;
    const size_t tstep = 2 * hstep;
    const unsigned ldsw = (unsigned)wid * 1024u;
    const int aoff = lds_byte(wr * 64 + fr, fq * 8), boff = lds_byte(wc * 32 + fr, fq * 8);
#define PG8_SA(b, h) (((b) * 2 + (h)) * HTB)
#define PG8_SB(b, h) ((4 + (b) * 2 + (h)) * HTB)
#define PG8_STAGE(bufoff, gbase, voff) do { _Pragma("unroll") for (int _i = 0; _i < 2; ++_i) \
        __builtin_amdgcn_global_load_lds((const unsigned*)((const char*)(gbase) + (voff)[_i]), (LAS unsigned*)(lds + (bufoff) + ldsw + _i * 8192), 16, 0, 0); } while (0)
#define PG8_LDA(dst, b, h) do { _Pragma("unroll") for (int m = 0; m < 4; ++m) _Pragma("unroll") for (int k = 0; k < 2; ++k) dst[m][k] = *(const LAS bf16x8*)(lds + PG8_SA(b, h) + aoff + m * 2048 + k * 1024); } while (0)
#define PG8_LDB(dst, b, h) do { _Pragma("unroll") for (int n = 0; n < 2; ++n) _Pragma("unroll") for (int k = 0; k < 2; ++k) dst[n][k] = *(const LAS bf16x8*)(lds + PG8_SB(b, h) + boff + n * 2048 + k * 1024); } while (0)
#define PG8_MMA(ai, bj, At, Bt) do { __builtin_amdgcn_s_setprio(1); _Pragma("unroll") for (int m = 0; m < 4; ++m) _Pragma("unroll") for (int n = 0; n < 2; ++n) _Pragma("unroll") for (int k = 0; k < 2; ++k) \
        acc[ai][bj][m][n] = __builtin_amdgcn_mfma_f32_16x16x32_bf16(Bt[n][k], At[m][k], acc[ai][bj][m][n], 0, 0, 0); __builtin_amdgcn_s_setprio(0); } while (0)
#define PG8_WAIT_V(n) asm volatile("s_waitcnt vmcnt(" #n ")" ::: "memory")
#define PG8_WAIT_L(n) asm volatile("s_waitcnt lgkmcnt(" #n ")" ::: "memory")
#define PG8_BAR __builtin_amdgcn_s_barrier()
#define PG8_SCHED __builtin_amdgcn_sched_barrier(0)
    Unit cur, nxt; int ui = 0;
    if (!S.next(0, cur)) return;
    f32x4 acc[2][2][4][2];
#pragma unroll
    for (int a = 0; a < 2; ++a)
#pragma unroll
        for (int b = 0; b < 2; ++b)
#pragma unroll
            for (int m = 0; m < 4; ++m)
#pragma unroll
                for (int n = 0; n < 2; ++n) acc[a][b][m][n] = (f32x4){0.f, 0.f, 0.f, 0.f};
    bf16x8 At[4][2], B0[2][2], B1[2][2];
    const char* cA = (const char*)g.A + (size_t)cur.pm * tstep; const char* cB = (const char*)g.Bt + (size_t)cur.pn * tstep;
    PG8_STAGE(PG8_SB(0, 0), cB, voffB); PG8_STAGE(PG8_SA(0, 0), cA, voffA); PG8_STAGE(PG8_SB(0, 1), cB + hstep, voffB); PG8_STAGE(PG8_SA(0, 1), cA + hstep, voffA);
    if (wr == 1) PG8_BAR;
    PG8_WAIT_V(4); PG8_BAR;
    PG8_STAGE(PG8_SB(1, 0), cB + kstep, voffB); PG8_STAGE(PG8_SA(1, 0), cA + kstep, voffA); PG8_STAGE(PG8_SB(1, 1), cB + hstep + kstep, voffB);
    PG8_WAIT_V(6); PG8_BAR;
    for (;;) {
        const bool has_next = S.next(ui + 1, nxt);
        const char* nA = has_next ? (const char*)g.A + (size_t)nxt.pm * tstep : cA; const char* nB = has_next ? (const char*)g.Bt + (size_t)nxt.pn * tstep : cB;
        for (int t = 0; t < nt; t += 2) {
            const bool last = (t == nt - 2);
            const char* a1 = cA + (size_t)(t + 1) * kstep;
            const char* a2 = last ? nA : cA + (size_t)(t + 2) * kstep; const char* b2 = last ? nB : cB + (size_t)(t + 2) * kstep;
            const char* a3 = a2 + kstep; const char* b3 = b2 + kstep;
            PG8_LDB(B0, 0, 0); PG8_SCHED; PG8_LDA(At, 0, 0); PG8_STAGE(PG8_SA(1, 1), a1 + hstep, voffA);
            PG8_WAIT_L(8); PG8_BAR; PG8_WAIT_L(0); PG8_MMA(0, 0, At, B0); PG8_BAR; PG8_SCHED;
            PG8_LDB(B1, 0, 1); PG8_STAGE(PG8_SB(0, 0), b2, voffB);
            PG8_BAR; PG8_WAIT_L(0); PG8_MMA(0, 1, At, B1); PG8_BAR;
            PG8_LDA(At, 0, 1); PG8_STAGE(PG8_SA(0, 0), a2, voffA);
            PG8_BAR; PG8_WAIT_L(0); PG8_MMA(1, 0, At, B0); PG8_BAR; PG8_SCHED;
            PG8_STAGE(PG8_SB(0, 1), b2 + hstep, voffB);
            PG8_WAIT_V(6); PG8_BAR; PG8_MMA(1, 1, At, B1); PG8_BAR;
            PG8_LDB(B0, 1, 0); PG8_SCHED; PG8_LDA(At, 1, 0); PG8_STAGE(PG8_SA(0, 1), a2 + hstep, voffA);
            PG8_WAIT_L(8); PG8_BAR; PG8_WAIT_L(0); PG8_MMA(0, 0, At, B0); PG8_BAR; PG8_SCHED;
            PG8_LDB(B1, 1, 1); PG8_STAGE(PG8_SB(1, 0), b3, voffB);
            PG8_BAR; PG8_WAIT_L(0); PG8_MMA(0, 1, At, B1); PG8_BAR;
            PG8_LDA(At, 1, 1); PG8_STAGE(PG8_SA(1, 0), a3, voffA);
            PG8_BAR; PG8_WAIT_L(0); PG8_MMA(1, 0, At, B0); PG8_BAR; PG8_SCHED;
            PG8_STAGE(PG8_SB(1, 1), b3 + hstep, voffB);
            PG8_WAIT_V(6); PG8_BAR; PG8_MMA(1, 1, At, B1); PG8_BAR;
        }
        E(acc, cur, wr, wc, fr, fq);
        if (!has_next) break;
#pragma unroll
        for (int a = 0; a < 2; ++a)
#pragma unroll
            for (int b = 0; b < 2; ++b)
#pragma unroll
                for (int m = 0; m < 4; ++m)
#pragma unroll
                    for (int n = 0; n < 2; ++n) acc[a][b][m][n] = (f32x4){0.f, 0.f, 0.f, 0.f};
        cur = nxt; cA = nA; cB = nB; ++ui;
    }
    PG8_WAIT_V(0);
    if (wr == 0) PG8_BAR;
    PG8_BAR;
#undef PG8_SA
#undef PG8_SB
#undef PG8_STAGE
#undef PG8_LDA
#undef PG8_LDB
#undef PG8_MMA
#undef PG8_WAIT_V
#undef PG8_WAIT_L
#undef PG8_BAR
#undef PG8_SCHED
}
}

__device__ __forceinline__ float row_rs(const float* ssp, int row) {
    const f32x4* p = (const f32x4*)(ssp + (size_t)row * 16);
    f32x4 a = p[0], b = p[1], c = p[2], d = p[3];
    float s = (a[0] + a[1] + a[2] + a[3]) + (b[0] + b[1] + b[2] + b[3]) + (c[0] + c[1] + c[2] + c[3]) + (d[0] + d[1] + d[2] + d[3]);
    return rsqrtf(s * (1.0f / 1024.0f) + EPS);
}

__device__ __forceinline__ f32x4 rs_part(const float* ssp, int row, int fq) { return *(const f32x4*)(ssp + (size_t)row * 16 + fq * 4); }
__device__ __forceinline__ float rs_fin(f32x4 a) { float s = (a[0] + a[1]) + (a[2] + a[3]); s += __shfl_xor(s, 16); s += __shfl_xor(s, 32); return rsqrtf(s * (1.0f / 1024.0f) + EPS); }
struct EpiInproj {
    static constexpr bool PERM = true;
    bf16_t* O; const float* ssp;
    __device__ __forceinline__ void operator()(const f32x4 (&acc)[2][2][4][2], const pg8::Unit& u, int wr, int wc, int fr, int fq) const {
        const int row0 = u.pm * 256 + wr * 64 + fr, col0 = u.pn * 256 + wc * 32 + 8 * fq;
        f32x4 rp[2][4];
#pragma unroll
        for (int ai = 0; ai < 2; ++ai)
#pragma unroll
            for (int m = 0; m < 4; ++m) rp[ai][m] = rs_part(ssp, row0 + ai * 128 + m * 16, fq);
#pragma unroll
        for (int ai = 0; ai < 2; ++ai)
#pragma unroll
            for (int m = 0; m < 4; ++m) {
                const int row = row0 + ai * 128 + m * 16; const float rs = rs_fin(rp[ai][m]);
                bf16_t* rowp = O + (size_t)row * DINP + col0;
#pragma unroll
                for (int bj = 0; bj < 2; ++bj) { f32x4 v0 = acc[ai][bj][m][0] * rs, v1 = acc[ai][bj][m][1] * rs;
                    u32x4 w; w.x = pk2(v0[0], v0[1]); w.y = pk2(v0[2], v0[3]); w.z = pk2(v1[0], v1[1]); w.w = pk2(v1[2], v1[3]);
                    __builtin_nontemporal_store(w, (u32x4*)(rowp + bj * 128)); }
            }
    }
};
struct EpiGateUp {
    static constexpr bool PERM = true;
    bf16_t* O; const float* ssp;
    __device__ __forceinline__ void operator()(const f32x4 (&acc)[2][2][4][2], const pg8::Unit& u, int wr, int wc, int fr, int fq) const {
        const int row0 = u.pm * 256 + wr * 64 + fr, col0 = u.pn * 128 + wc * 32 + 8 * fq;
        f32x4 rp[2][4];
#pragma unroll
        for (int ai = 0; ai < 2; ++ai)
#pragma unroll
            for (int m = 0; m < 4; ++m) rp[ai][m] = rs_part(ssp, row0 + ai * 128 + m * 16, fq);
#pragma unroll
        for (int ai = 0; ai < 2; ++ai)
#pragma unroll
            for (int m = 0; m < 4; ++m) {
                const int row = row0 + ai * 128 + m * 16; const float rs = rs_fin(rp[ai][m]);
                float h[8];
#pragma unroll
                for (int n = 0; n < 2; ++n)
#pragma unroll
                    for (int j = 0; j < 4; ++j) h[n * 4 + j] = silu(acc[ai][0][m][n][j] * rs) * (acc[ai][1][m][n][j] * rs);
                u32x4 w; w.x = pk2(h[0], h[1]); w.y = pk2(h[2], h[3]); w.z = pk2(h[4], h[5]); w.w = pk2(h[6], h[7]);
                __builtin_nontemporal_store(w, (u32x4*)(O + (size_t)row * DFF + col0));
            }
    }
};
struct EpiResid {
    static constexpr bool PERM = false;
    bf16_t* XB; float* ssp;
    __device__ __forceinline__ void operator()(const f32x4 (&acc)[2][2][4][2], const pg8::Unit& u, int wr, int wc, int fr, int fq) const {
        const int row0 = u.pm * 256 + wr * 64 + fr, col0 = u.pn * 256 + wc * 32 + 4 * fq;
        u32x2 xnx[4];
        { const bf16_t* xr0 = XB + (size_t)row0 * DM + col0;
#pragma unroll
          for (int e = 0; e < 4; ++e) xnx[e] = *(const u32x2*)(xr0 + (e >> 1) * 128 + (e & 1) * 16); }
#pragma unroll
        for (int ai = 0; ai < 2; ++ai)
#pragma unroll
            for (int m = 0; m < 4; ++m) {
                const int row = row0 + ai * 128 + m * 16;
                bf16_t* br = XB + (size_t)row * DM + col0;
                u32x2 xc[4];
#pragma unroll
                for (int e = 0; e < 4; ++e) xc[e] = xnx[e];
                if (ai * 4 + m < 7) { const int idx = ai * 4 + m + 1; const bf16_t* xrn = XB + (size_t)(row0 + (idx >> 2) * 128 + (idx & 3) * 16) * DM + col0;
#pragma unroll
                    for (int e = 0; e < 4; ++e) xnx[e] = *(const u32x2*)(xrn + (e >> 1) * 128 + (e & 1) * 16); }
                float ss = 0.f;
#pragma unroll
                for (int bj = 0; bj < 2; ++bj)
#pragma unroll
                    for (int n = 0; n < 2; ++n) {
                        const u32x2 xo = xc[bj * 2 + n];
                        f32x4 xn = acc[ai][bj][m][n];
                        xn[0] += __uint_as_float(xo.x << 16); xn[1] += __uint_as_float(xo.x & 0xffff0000u); xn[2] += __uint_as_float(xo.y << 16); xn[3] += __uint_as_float(xo.y & 0xffff0000u);
                        ss += (xn[0] * xn[0] + xn[1] * xn[1]) + (xn[2] * xn[2] + xn[3] * xn[3]);
                        u32x2 w; w.x = pk2(xn[0], xn[1]); w.y = pk2(xn[2], xn[3]);
                        *(u32x2*)(br + bj * 128 + n * 16) = w;
                    }
                ss += __shfl_xor(ss, 16); ss += __shfl_xor(ss, 32);
                if (fq == 0) ssp[(size_t)row * 16 + u.pn * 4 + wc] = ss;
                asm volatile("" ::: "memory");
            }
    }
};

__device__ __forceinline__ void wtile(LAS float* tile, const float* src, int lds_src, const float* gain, bf16_t* dst, int K, int n0, int k0, int c0, int nvalid) {
    const int tid = otid();
    __syncthreads();
#pragma unroll
    for (int i = 0; i < 8; ++i) {
        const int kk = (tid >> 6) + 8 * i, c = tid & 63;
        float v = 0.f;
        if (c0 + c < nvalid) { v = src[(size_t)(k0 + kk) * lds_src + c0 + c]; if (gain) v *= gain[k0 + kk]; }
        tile[kk * 65 + c] = v;
    }
    __syncthreads();
    const int n = tid >> 3, kc = (tid & 7) * 8;
    float f[8];
#pragma unroll
    for (int j = 0; j < 8; ++j) f[j] = tile[(kc + j) * 65 + n];
    u32x4 w; w.x = pk2(f[0], f[1]); w.y = pk2(f[2], f[3]); w.z = pk2(f[4], f[5]); w.w = pk2(f[6], f[7]);
    *(u32x4*)(dst + (size_t)(n0 + n) * K + k0 + kc) = w;
}
__device__ __forceinline__ void phase_weights(LAS unsigned char* lds, const Params& P) {
    LAS float* tile = (LAS float*)lds;
    unsigned char* ws = P.ws;
    constexpr int T_IN = 56 * 16, T_OUT = 16 * 16, T_GU = 88 * 16, T_DN = 16 * 44, T_L = T_IN + T_OUT + T_GU + T_DN;
    for (int t = blockIdx.x; t < 2 * 24; t += gridDim.x) {
        const int l = t / 24, idx = t % 24; bf16_t* sw = (bf16_t*)(ws + WS_SW) + (size_t)l * SW_L;
        if (idx < 16) { const int m = idx >> 2, nb = idx & 3, d = m & 1;
            const float* src = (m < 2 ? P.in[10] : P.in[12]) + (size_t)(l * 2 + d) * 64 * 256;
            wtile(tile, src, 256, nullptr, sw + m * 16384, 64, nb * 64, 0, nb * 64, 256);
        } else { const int nb = (idx - 16) >> 1, kb = (idx - 16) & 1;
            wtile(tile, P.in[13] + (size_t)l * 128 * 256, 256, nullptr, sw + 65536, 128, nb * 64, kb * 64, nb * 64, 256); }
    }
    for (int i = blockIdx.x * 512 + threadIdx.x; i < 2 * 8192; i += gridDim.x * 512) {
        const int l = i >> 13, rem = i & 8191, d = rem >> 12, c = (rem & 4095) >> 5, k = rem & 31;
        const float v = ((k >> 4) == d) ? P.in[5][((size_t)(l * 2 + d) * 16 + (k & 15)) * 128 + c] : 0.f;
        ((bf16_t*)(ws + WS_SW))[(size_t)l * SW_L + 98304 + rem] = (bf16_t)f2bf(v);
    }
    for (int t = blockIdx.x; t < 2 * T_L; t += gridDim.x) {
        const int l = t / T_L; int r = t % T_L;
        if (r < T_IN) { const int nb = r / 16, kb = r % 16;
            wtile(tile, P.in[3] + (size_t)l * DM * DIN, DIN, P.in[2] + l * DM, (bf16_t*)(ws + WS_WIN) + (size_t)l * DINP * DM, DM, nb * 64, kb * 64, nb * 64, DIN);
        } else if ((r -= T_IN) < T_OUT) { const int nb = r / 16, kb = r % 16;
            wtile(tile, P.in[4] + (size_t)l * DM * DM, DM, nullptr, (bf16_t*)(ws + WS_WOUT) + (size_t)l * DM * DM, DM, nb * 64, kb * 64, nb * 64, DM);
        } else if ((r -= T_OUT) < T_GU) { const int nb = r / 16, kb = r % 16;
            const int j = nb >> 2, qd = nb & 3; const float* src = (qd < 2 ? P.in[26] : P.in[27]) + (size_t)l * DM * DFF;
            wtile(tile, src, DFF, P.in[25] + l * DM, (bf16_t*)(ws + WS_WGU) + (size_t)l * 2 * DFF * DM, DM, nb * 64, kb * 64, j * 128 + (qd & 1) * 64, DFF);
        } else { r -= T_GU; const int nb = r / 44, kb = r % 44;
            wtile(tile, P.in[28] + (size_t)l * DFF * DM, DM, nullptr, (bf16_t*)(ws + WS_WDN) + (size_t)l * DM * DFF, DFF, nb * 64, kb * 64, nb * 64, DM);
        }
    }
}

__device__ __forceinline__ void phase_xprep(const Params& P, int g) {
    const float* xin = (g < 2) ? P.in[0] + (size_t)g * TG * DM : P.in[1];
    bf16_t* xb = (bf16_t*)(P.ws + WS_XB); float* ssp = (float*)(P.ws + WS_SSP);
    const int tid_ = otid(); const int lane = tid_ & 63, gw = blockIdx.x * 8 + (tid_ >> 6), nw = gridDim.x * 8;
    for (int row = gw; row < TG; row += nw) {
        float ss = 0.f;
#pragma unroll
        for (int i = 0; i < 4; ++i) {
            const int c = i * 256 + lane * 4;
            f32x4 v = *(const f32x4*)(xin + (size_t)row * DM + c);
            u32x2 w; w.x = pk2(v[0], v[1]); w.y = pk2(v[2], v[3]);
            *(u32x2*)(xb + (size_t)row * DM + c) = w;
            ss += (v[0] * v[0] + v[1] * v[1]) + (v[2] * v[2] + v[3] * v[3]);
        }
        ss = wave_sum(ss);
        if (lane < 16) ssp[(size_t)row * 16 + lane] = (lane == 0) ? ss : 0.f;
    }
}
__device__ __forceinline__ void phase_final(const Params& P, int g) {
    float* xo = P.out + (size_t)g * TG * DM; const bf16_t* xb = (const bf16_t*)(P.ws + WS_XB); const float* ssp = (const float*)(P.ws + WS_SSP); const float* gn = P.in[29];
    const int tid_ = otid(); const int lane = tid_ & 63, gw = blockIdx.x * 8 + (tid_ >> 6), nw = gridDim.x * 8;
    for (int row = gw; row < TG; row += nw) {
        const float rs = row_rs(ssp, row);
#pragma unroll
        for (int i = 0; i < 2; ++i) {
            const int c = i * 512 + lane * 8;
            float v[8]; unpack8(*(const u32x4*)(xb + (size_t)row * DM + c), v);
            const f32x4 g0 = *(const f32x4*)(gn + c), g1 = *(const f32x4*)(gn + c + 4);
            *(f32x4*)(xo + (size_t)row * DM + c) = (f32x4){v[0] * rs * g0[0], v[1] * rs * g0[1], v[2] * rs * g0[2], v[3] * rs * g0[3]};
            *(f32x4*)(xo + (size_t)row * DM + c + 4) = (f32x4){v[4] * rs * g1[0], v[5] * rs * g1[1], v[6] * rs * g1[2], v[7] * rs * g1[3]};
        }
    }
}

struct MixBufs {
    const bf16_t* p; float* gla_la; bf16_t* gla_o; bf16_t* rw; float* rw_s; bf16_t* rw_y; bf16_t* ssd_x; float* ssd_dt; bf16_t* ssd_y; bf16_t* mix;
};
__device__ __forceinline__ MixBufs mixbufs(const Params& P) {
    MixBufs B; unsigned char* ws = P.ws;
    B.p = (const bf16_t*)(ws + WS_P); B.gla_la = (float*)(ws + WS_GLA_LA); B.gla_o = (bf16_t*)(ws + WS_GLA_O); B.rw = (bf16_t*)(ws + WS_RW);
    B.rw_s = (float*)(ws + WS_RW_S); B.rw_y = (bf16_t*)(ws + WS_RW_Y); B.ssd_x = (bf16_t*)(ws + WS_SSD_X); B.ssd_dt = (float*)(ws + WS_SSD_DT);
    B.ssd_y = (bf16_t*)(ws + WS_SSD_Y); B.mix = (bf16_t*)(ws + WS_MIX); return B;
}
constexpr size_t RWA = (size_t)TG * 256;

__device__ __forceinline__ void prep_tile(LAS unsigned char* lds, const Params& P, const MixBufs& B, int layer, int L, int tile) {
    const int tid = otid(), lane = tid & 63;
    const int t0 = tile * 32;
    LAS float* lin = (LAS float*)lds;
    LAS float* gin = (LAS float*)(lds + 49152);
    const bf16_t* p = B.p;
    const float* mu = P.in[8] + layer * 1152;
    __syncthreads();
    for (int idx = tid; idx < 32 * 384; idx += 512) {
        const int t = idx / 384, cc = idx % 384, tl = t0 + t, pos = tl % L, col = PC_RLOW + cc;
        const float cur = bf2f(p[(size_t)tl * DINP + col]);
        const float prv = pos > 0 ? bf2f(p[(size_t)(tl - 1) * DINP + col]) : 0.f;
        const float nxt = pos < L - 1 ? bf2f(p[(size_t)(tl + 1) * DINP + col]) : 0.f;
        float v = cur + mu[col - PC_R] * (0.5f * (prv + nxt) - cur);
        if (cc < 128) { const float e = __expf(2.f * v); v = 1.f - 2.f / (e + 1.f); }
        else if (cc >= 256) v = sigm(v);
        lin[t * 384 + cc] = v;
    }
    for (int idx = tid; idx < 32 * 32; idx += 512) { const int t = idx >> 5, j = idx & 31; gin[idx] = bf2f(p[(size_t)(t0 + t) * DINP + PC_GAF + j]); }
    __syncthreads();
#pragma unroll 1
    for (int i = 0; i < 8; ++i) {
        const int idx = tid + 512 * i, t = idx >> 7, c0 = (idx & 127) * 8, tl = t0 + t, pos = tl % L;
        float acc[8];
        { const f32x4 b0 = *(const f32x4*)(P.in[20] + layer * 1024 + c0), b1 = *(const f32x4*)(P.in[20] + layer * 1024 + c0 + 4);
          acc[0] = b0[0]; acc[1] = b0[1]; acc[2] = b0[2]; acc[3] = b0[3]; acc[4] = b1[0]; acc[5] = b1[1]; acc[6] = b1[2]; acc[7] = b1[3]; }
#pragma unroll
        for (int tap = 0; tap < 5; ++tap) {
            const int pp = pos + tap - 2;
            if (pp >= 0 && pp < L) {
                float x[8]; unpack8(*(const u32x4*)(p + (size_t)(tl + tap - 2) * DINP + PC_XBC + c0), x);
                const float* w = P.in[19] + (size_t)(layer * 5 + tap) * 1024 + c0;
                const f32x4 w0 = *(const f32x4*)w, w1 = *(const f32x4*)(w + 4);
                acc[0] += w0[0] * x[0]; acc[1] += w0[1] * x[1]; acc[2] += w0[2] * x[2]; acc[3] += w0[3] * x[3];
                acc[4] += w1[0] * x[4]; acc[5] += w1[1] * x[5]; acc[6] += w1[2] * x[6]; acc[7] += w1[3] * x[7];
            }
        }
        u32x4 o; o.x = pk2(silu(acc[0]), silu(acc[1])); o.y = pk2(silu(acc[2]), silu(acc[3])); o.z = pk2(silu(acc[4]), silu(acc[5])); o.w = pk2(silu(acc[6]), silu(acc[7]));
        *(u32x4*)(B.ssd_x + (size_t)tl * 1024 + c0) = o;
    }
    { const int t = tid >> 4, j = tid & 15, tl = t0 + t;
      B.ssd_dt[(size_t)tl * 16 + j] = softplus(bf2f(p[(size_t)tl * DINP + PC_DT + j]) + P.in[21][layer * 16 + j]); }
    if (tid < 256) {
        const int d = tid >> 7, c = tid & 127;
        float ac[16];
#pragma unroll
        for (int j = 0; j < 16; ++j) ac[j] = P.in[5][((size_t)(layer * 2 + d) * 16 + j) * 128 + c];
        const float bias = P.in[6][(layer * 2 + d) * 128 + c];
#pragma unroll 4
        for (int t = 0; t < 32; ++t) {
            float a = bias;
#pragma unroll
            for (int j = 0; j < 16; ++j) a += gin[t * 32 + d * 16 + j] * ac[j];
            B.gla_la[((size_t)d * TG + t0 + t) * 128 + c] = -softplus(-a) * (1.0f / 16.0f);
        }
    }
    asm volatile("" ::: "memory");
    {
        const int h2 = __builtin_amdgcn_readfirstlane(tid >> 8), c = tid & 255, head = c >> 6;
        float wcol[64];
        const float kkc = P.in[14][layer * 256 + c], kac = P.in[15][layer * 256 + c], rkc = P.in[16][layer * 256 + c];
        const float mur = mu[c], muk = mu[256 + c], muv = mu[512 + c];
        {
            { const float* wsrc = P.in[10] + (size_t)(layer * 2 + h2) * 64 * 256;
#pragma unroll
            for (int k = 0; k < 64; ++k) wcol[k] = wsrc[k * 256 + c]; }
            const float w0c = P.in[9][(layer * 2 + h2) * 256 + c];
#pragma unroll 1
            for (int t = 0; t < 32; ++t) {
                float aw = w0c;
                const LAS f32x4* lw = (const LAS f32x4*)(lin + t * 384 + h2 * 64);
#pragma unroll
                for (int k4 = 0; k4 < 16; ++k4) { const f32x4 x = lw[k4];
                    aw += x[0] * wcol[k4 * 4] + x[1] * wcol[k4 * 4 + 1] + x[2] * wcol[k4 * 4 + 2] + x[3] * wcol[k4 * 4 + 3]; }
                B.rw[(4 + h2) * RWA + (size_t)(t0 + t) * 256 + c] = (bf16_t)f2bf(sigm(aw) * 0.60653066f);
            }
        }
        asm volatile("" ::: "memory");
        {
            { const float* wsrc = P.in[12] + (size_t)(layer * 2 + h2) * 64 * 256;
#pragma unroll
            for (int k = 0; k < 64; ++k) wcol[k] = wsrc[k * 256 + c]; }
            const float a0c = P.in[11][(layer * 2 + h2) * 256 + c];
#pragma unroll 1
            for (int t = 0; t < 32; ++t) {
                const int tl = t0 + t, pos = tl % L;
                const bf16_t* pc = p + (size_t)tl * DINP;
                const bool hp = pos > 0, hn = pos < L - 1;
                const float rc = bf2f(pc[PC_R + c]), kc = bf2f(pc[PC_RK + c]), vc = bf2f(pc[PC_RV + c]);
                const float rp = hp ? bf2f(pc[PC_R + c - DINP]) : 0.f, kp = hp ? bf2f(pc[PC_RK + c - DINP]) : 0.f, vp = hp ? bf2f(pc[PC_RV + c - DINP]) : 0.f;
                const float rn = hn ? bf2f(pc[PC_R + c + DINP]) : 0.f, kn = hn ? bf2f(pc[PC_RK + c + DINP]) : 0.f, vn = hn ? bf2f(pc[PC_RV + c + DINP]) : 0.f;
                const float r = rc + mur * (0.5f * (rp + rn) - rc), k = kc + muk * (0.5f * (kp + kn) - kc), v = vc + muv * (0.5f * (vp + vn) - vc);
                float aa = a0c;
                const LAS f32x4* la = (const LAS f32x4*)(lin + t * 384 + 128 + h2 * 64);
#pragma unroll
                for (int k4 = 0; k4 < 16; ++k4) { const f32x4 y = la[k4];
                    aa += y[0] * wcol[k4 * 4] + y[1] * wcol[k4 * 4 + 1] + y[2] * wcol[k4 * 4 + 2] + y[3] * wcol[k4 * 4 + 3]; }
                const float asg = sigm(aa);
                const float kr = k * kkc; const float kk = kr * rsqrtf(wave_sum(kr * kr) + 1e-12f);
                const float kd = k * (1.f + (asg - 1.f) * kac), bb = kk * asg;
                const size_t o = (size_t)tl * 256 + c;
                B.rw[(6 + h2) * RWA + o] = (bf16_t)f2bf(kd); B.rw[(8 + h2) * RWA + o] = (bf16_t)f2bf(bb);
                if (h2 == 0) {
                    B.rw[0 * RWA + o] = (bf16_t)f2bf(r); B.rw[1 * RWA + o] = (bf16_t)f2bf(v); B.rw[2 * RWA + o] = (bf16_t)f2bf(kk);
                    const float s = wave_sum(r * k * rkc); if (lane == 0) B.rw_s[(size_t)tl * 4 + head] = s;
                } else {
                    const float s = wave_sum(bf2f((bf16_t)f2bf(kd)) * bf2f((bf16_t)f2bf(r))); if (lane == 0) B.rw_s[(size_t)TG * 4 + (size_t)tl * 4 + head] = s;
                }
            }
        }
        asm volatile("" ::: "memory");
        float ga[16];
#pragma unroll
        for (int i = 0; i < 16; ++i) ga[i] = 0.f;
#pragma unroll 1
        for (int sub = 0; sub < 2; ++sub) {
            asm volatile("" ::: "memory");
            { const float* wsrc = P.in[13] + (size_t)(layer * 128 + sub * 64) * 256;
#pragma unroll
            for (int k = 0; k < 64; ++k) wcol[k] = wsrc[k * 256 + c]; }
#pragma unroll
            for (int tt = 0; tt < 16; ++tt) {
                const LAS f32x4* lg = (const LAS f32x4*)(lin + (h2 * 16 + tt) * 384 + 256 + sub * 64);
                float a = ga[tt];
#pragma unroll
                for (int k4 = 0; k4 < 16; ++k4) { const f32x4 x = lg[k4]; a += x[0] * wcol[k4 * 4] + x[1] * wcol[k4 * 4 + 1] + x[2] * wcol[k4 * 4 + 2] + x[3] * wcol[k4 * 4 + 3]; }
                ga[tt] = a;
            }
        }
#pragma unroll
        for (int tt = 0; tt < 16; ++tt) B.rw[3 * RWA + (size_t)(t0 + h2 * 16 + tt) * 256 + c] = (bf16_t)f2bf(ga[tt]);
    }
}

__device__ __forceinline__ f32x4 mfma16(bf16x8 a, bf16x8 b, f32x4 c) { return __builtin_amdgcn_mfma_f32_16x16x32_bf16(a, b, c, 0, 0, 0); }
__device__ __forceinline__ void prep_tile64(LAS unsigned char* lds, const Params& P, const MixBufs& B, const bf16_t* sw, int layer, int L, int tile) {
    const int tid = otid(), w = tid >> 6, lane = tid & 63, r = lane & 15, q = lane >> 4;
    const int t0 = tile * 64;
    constexpr int LL = 392, LA = 264;
    LAS bf16_t* lin = (LAS bf16_t*)lds;
    LAS bf16_t* gin = (LAS bf16_t*)(lds + 50176);
    LAS bf16_t* AS = (LAS bf16_t*)(lds + 55296);
    const bf16_t* p = B.p;
    const float* mu = P.in[8] + layer * 1152;
    __syncthreads();
#pragma unroll 3
    for (int i6 = 0; i6 < 6; ++i6) {
        const int it = tid + 512 * i6;
        const int t = it / 48, cg8 = it % 48, tl = t0 + t, pos = tl % L, col = PC_RLOW + cg8 * 8;
        float cur[8], prv[8], nxt[8], v[8];
        unpack8(*(const u32x4*)(p + (size_t)tl * DINP + col), cur);
        if (pos > 0) unpack8(*(const u32x4*)(p + (size_t)(tl - 1) * DINP + col), prv); else {
#pragma unroll
            for (int j = 0; j < 8; ++j) prv[j] = 0.f; }
        if (pos < L - 1) unpack8(*(const u32x4*)(p + (size_t)(tl + 1) * DINP + col), nxt); else {
#pragma unroll
            for (int j = 0; j < 8; ++j) nxt[j] = 0.f; }
        const f32x4 m0 = *(const f32x4*)(mu + col - PC_R), m1 = *(const f32x4*)(mu + col - PC_R + 4);
#pragma unroll
        for (int j = 0; j < 8; ++j) { const float m = j < 4 ? m0[j] : m1[j - 4]; v[j] = cur[j] + m * (0.5f * (prv[j] + nxt[j]) - cur[j]); }
        if (cg8 < 16) {
#pragma unroll
            for (int j = 0; j < 8; ++j) { const float e = __expf(2.f * v[j]); v[j] = 1.f - 2.f * __builtin_amdgcn_rcpf(e + 1.f); }
        } else if (cg8 >= 32) {
#pragma unroll
            for (int j = 0; j < 8; ++j) v[j] = sigm(v[j]);
        }
        u32x4 o; o.x = pk2(v[0], v[1]); o.y = pk2(v[2], v[3]); o.z = pk2(v[4], v[5]); o.w = pk2(v[6], v[7]);
        *(LAS u32x4*)(lin + t * LL + cg8 * 8) = o;
    }
    if (tid < 256) { const int t = tid >> 2, g4 = tid & 3; *(LAS u32x4*)(gin + t * 40 + g4 * 8) = *(const u32x4*)(p + (size_t)(t0 + t) * DINP + PC_GAF + g4 * 8); }
    __syncthreads();
#pragma unroll 1
    for (int d = 0; d < 2; ++d)
#pragma unroll 1
        for (int tt = 0; tt < 2; ++tt) {
            const int tn = 2 * w + tt, c = tn * 16 + r;
            const float a0c = P.in[11][(layer * 2 + d) * 256 + c];
            const bf16_t* wb = sw + 32768 + d * 16384 + (size_t)(tn * 16 + r) * 64 + q * 8;
            const bf16x8 b0 = *(const bf16x8*)wb, b1 = *(const bf16x8*)(wb + 32);
#pragma unroll
            for (int tm = 0; tm < 4; ++tm) {
                const LAS bf16_t* ap = lin + (tm * 16 + r) * LL + 128 + d * 64 + q * 8;
                f32x4 acc = (f32x4){0.f, 0.f, 0.f, 0.f};
                acc = mfma16(*(const LAS bf16x8*)ap, b0, acc); acc = mfma16(*(const LAS bf16x8*)(ap + 32), b1, acc);
#pragma unroll
                for (int jj = 0; jj < 4; ++jj) AS[(d * 64 + tm * 16 + q * 4 + jj) * LA + c] = (bf16_t)f2bf(sigm(a0c + acc[jj]));
            }
        }
    __syncthreads();
    {
        const int c0 = (tid & 31) * 8, head = (tid & 31) >> 3;
        float mr_[8], mk_[8], mv_[8], kkc[8], kac[8], rkc[8];
#define LD8F(dst, ptr) do { const f32x4 a_ = *(const f32x4*)(ptr), b_ = *(const f32x4*)((ptr) + 4); dst[0] = a_[0]; dst[1] = a_[1]; dst[2] = a_[2]; dst[3] = a_[3]; dst[4] = b_[0]; dst[5] = b_[1]; dst[6] = b_[2]; dst[7] = b_[3]; } while (0)
        LD8F(mr_, mu + c0); LD8F(mk_, mu + 256 + c0); LD8F(mv_, mu + 512 + c0);
        LD8F(kkc, P.in[14] + layer * 256 + c0); LD8F(kac, P.in[15] + layer * 256 + c0); LD8F(rkc, P.in[16] + layer * 256 + c0);
#undef LD8F
        u32x4 nx[9], cu[9];
        const u32x4 Z = (u32x4){0u, 0u, 0u, 0u};
#define EL_LOAD(dst, ii) do { const int t_ = (tid + 512 * (ii)) >> 5, tl_ = t0 + t_, pos_ = tl_ % L; const bf16_t* pc_ = p + (size_t)tl_ * DINP + c0; \
            const bool hp_ = pos_ > 0, hn_ = pos_ < L - 1; \
            dst[0] = *(const u32x4*)(pc_ + PC_R); dst[1] = *(const u32x4*)(pc_ + PC_RK); dst[2] = *(const u32x4*)(pc_ + PC_RV); \
            dst[3] = hp_ ? *(const u32x4*)(pc_ + PC_R - DINP) : Z; dst[4] = hp_ ? *(const u32x4*)(pc_ + PC_RK - DINP) : Z; dst[5] = hp_ ? *(const u32x4*)(pc_ + PC_RV - DINP) : Z; \
            dst[6] = hn_ ? *(const u32x4*)(pc_ + PC_R + DINP) : Z; dst[7] = hn_ ? *(const u32x4*)(pc_ + PC_RK + DINP) : Z; dst[8] = hn_ ? *(const u32x4*)(pc_ + PC_RV + DINP) : Z; } while (0)
        EL_LOAD(nx, 0);
#pragma unroll 1
        for (int i = 0; i < 4; ++i) {
#pragma unroll
            for (int e = 0; e < 9; ++e) cu[e] = nx[e];
            if (i < 3) EL_LOAD(nx, i + 1);
            const int t = (tid + 512 * i) >> 5, tl = t0 + t;
            float rr[8], kx[8], vx[8], c_[8], p_[8], n_[8];
            unpack8(cu[0], c_); unpack8(cu[3], p_); unpack8(cu[6], n_);
#pragma unroll
            for (int j = 0; j < 8; ++j) rr[j] = c_[j] + mr_[j] * (0.5f * (p_[j] + n_[j]) - c_[j]);
            unpack8(cu[1], c_); unpack8(cu[4], p_); unpack8(cu[7], n_);
#pragma unroll
            for (int j = 0; j < 8; ++j) kx[j] = c_[j] + mk_[j] * (0.5f * (p_[j] + n_[j]) - c_[j]);
            unpack8(cu[2], c_); unpack8(cu[5], p_); unpack8(cu[8], n_);
#pragma unroll
            for (int j = 0; j < 8; ++j) vx[j] = c_[j] + mv_[j] * (0.5f * (p_[j] + n_[j]) - c_[j]);
            float as0[8], as1[8];
            unpack8(*(const LAS u32x4*)(AS + (0 * 64 + t) * LA + c0), as0); unpack8(*(const LAS u32x4*)(AS + (1 * 64 + t) * LA + c0), as1);
            float kr[8], ss = 0.f, srk = 0.f;
#pragma unroll
            for (int j = 0; j < 8; ++j) { kr[j] = kx[j] * kkc[j]; ss += kr[j] * kr[j]; srk += rr[j] * kx[j] * rkc[j]; }
            ss += __shfl_xor(ss, 1); ss += __shfl_xor(ss, 2); ss += __shfl_xor(ss, 4);
            const float inv = rsqrtf(ss + 1e-12f);
            float kkv[8], kd0[8], kd1[8], b0v[8], b1v[8], skr = 0.f;
#pragma unroll
            for (int j = 0; j < 8; ++j) {
                kkv[j] = kr[j] * inv; kd0[j] = kx[j] * (1.f + (as0[j] - 1.f) * kac[j]); kd1[j] = kx[j] * (1.f + (as1[j] - 1.f) * kac[j]);
                b0v[j] = kkv[j] * as0[j]; b1v[j] = kkv[j] * as1[j];
                skr += bf2f((bf16_t)f2bf(kd1[j])) * bf2f((bf16_t)f2bf(rr[j])); }
            srk += __shfl_xor(srk, 1); srk += __shfl_xor(srk, 2); srk += __shfl_xor(srk, 4);
            skr += __shfl_xor(skr, 1); skr += __shfl_xor(skr, 2); skr += __shfl_xor(skr, 4);
            const size_t o = (size_t)tl * 256 + c0;
#define ST8(arr, f) do { u32x4 o4; o4.x = pk2(f[0], f[1]); o4.y = pk2(f[2], f[3]); o4.z = pk2(f[4], f[5]); o4.w = pk2(f[6], f[7]); *(u32x4*)(B.rw + (size_t)(arr) * RWA + o) = o4; } while (0)
            ST8(0, rr); ST8(1, vx); ST8(2, kkv); ST8(6, kd0); ST8(7, kd1); ST8(8, b0v); ST8(9, b1v);
#undef ST8
            if ((lane & 7) == 0) { B.rw_s[(size_t)tl * 4 + head] = srk; B.rw_s[(size_t)TG * 4 + (size_t)tl * 4 + head] = skr; }
        }
#undef EL_LOAD
    }
#pragma unroll 1
    for (int d = 0; d < 2; ++d)
#pragma unroll 1
        for (int tt = 0; tt < 2; ++tt) {
            const int tn = 2 * w + tt, c = tn * 16 + r;
            const float w0c = P.in[9][(layer * 2 + d) * 256 + c];
            const bf16_t* wb = sw + d * 16384 + (size_t)(tn * 16 + r) * 64 + q * 8;
            const bf16x8 b0 = *(const bf16x8*)wb, b1 = *(const bf16x8*)(wb + 32);
#pragma unroll
            for (int tm = 0; tm < 4; ++tm) {
                const LAS bf16_t* ap = lin + (tm * 16 + r) * LL + d * 64 + q * 8;
                f32x4 acc = (f32x4){0.f, 0.f, 0.f, 0.f};
                acc = mfma16(*(const LAS bf16x8*)ap, b0, acc); acc = mfma16(*(const LAS bf16x8*)(ap + 32), b1, acc);
#pragma unroll
                for (int jj = 0; jj < 4; ++jj) B.rw[(size_t)(4 + d) * RWA + (size_t)(t0 + tm * 16 + q * 4 + jj) * 256 + c] = (bf16_t)f2bf(sigm(w0c + acc[jj]) * 0.60653066f);
            }
        }
#pragma unroll 1
    for (int tt = 0; tt < 2; ++tt) {
        const int tn = 2 * w + tt, c = tn * 16 + r;
        const bf16_t* wb = sw + 65536 + (size_t)(tn * 16 + r) * 128 + q * 8;
        const bf16x8 b0 = *(const bf16x8*)wb, b1 = *(const bf16x8*)(wb + 32), b2 = *(const bf16x8*)(wb + 64), b3 = *(const bf16x8*)(wb + 96);
#pragma unroll
        for (int tm = 0; tm < 4; ++tm) {
            const LAS bf16_t* ap = lin + (tm * 16 + r) * LL + 256 + q * 8;
            f32x4 acc = (f32x4){0.f, 0.f, 0.f, 0.f};
            acc = mfma16(*(const LAS bf16x8*)ap, b0, acc); acc = mfma16(*(const LAS bf16x8*)(ap + 32), b1, acc);
            acc = mfma16(*(const LAS bf16x8*)(ap + 64), b2, acc); acc = mfma16(*(const LAS bf16x8*)(ap + 96), b3, acc);
#pragma unroll
            for (int jj = 0; jj < 4; ++jj) B.rw[(size_t)3 * RWA + (size_t)(t0 + tm * 16 + q * 4 + jj) * 256 + c] = (bf16_t)f2bf(acc[jj]);
        }
    }
#pragma unroll 1
    for (int d = 0; d < 2; ++d) {
        const int c = w * 16 + r;
        const float bias = P.in[6][(layer * 2 + d) * 128 + c];
        const bf16x8 b0 = *(const bf16x8*)(sw + 98304 + d * 4096 + (size_t)(w * 16 + r) * 32 + q * 8);
#pragma unroll
        for (int tm = 0; tm < 4; ++tm) {
            f32x4 acc = (f32x4){0.f, 0.f, 0.f, 0.f};
            acc = mfma16(*(const LAS bf16x8*)(gin + (tm * 16 + r) * 40 + q * 8), b0, acc);
#pragma unroll
            for (int jj = 0; jj < 4; ++jj) B.gla_la[((size_t)d * TG + t0 + tm * 16 + q * 4 + jj) * 128 + c] = -softplus(-(acc[jj] + bias)) * (1.0f / 16.0f);
        }
    }
    {
        const int c0 = (tid & 127) * 8;
        float wt[5][8], bs[8];
        { const f32x4 b0 = *(const f32x4*)(P.in[20] + layer * 1024 + c0), b1 = *(const f32x4*)(P.in[20] + layer * 1024 + c0 + 4);
          bs[0] = b0[0]; bs[1] = b0[1]; bs[2] = b0[2]; bs[3] = b0[3]; bs[4] = b1[0]; bs[5] = b1[1]; bs[6] = b1[2]; bs[7] = b1[3]; }
#pragma unroll
        for (int tap = 0; tap < 5; ++tap) { const float* wp = P.in[19] + (size_t)(layer * 5 + tap) * 1024 + c0;
            const f32x4 w0 = *(const f32x4*)wp, w1 = *(const f32x4*)(wp + 4);
            wt[tap][0] = w0[0]; wt[tap][1] = w0[1]; wt[tap][2] = w0[2]; wt[tap][3] = w0[3]; wt[tap][4] = w1[0]; wt[tap][5] = w1[1]; wt[tap][6] = w1[2]; wt[tap][7] = w1[3]; }
        u32x4 xr[5], xn[5];
#define CONV_LOAD(dst, ii) do { const int t_ = (tid + 512 * (ii)) >> 7, tl_ = t0 + t_, pos_ = tl_ % L; \
            _Pragma("unroll") for (int tap = 0; tap < 5; ++tap) { const int pp = pos_ + tap - 2; \
                dst[tap] = (pp >= 0 && pp < L) ? *(const u32x4*)(p + (size_t)(tl_ + tap - 2) * DINP + PC_XBC + c0) : (u32x4){0u, 0u, 0u, 0u}; } } while (0)
        CONV_LOAD(xn, 0);
#pragma unroll 1
        for (int i = 0; i < 16; ++i) {
#pragma unroll
            for (int tap = 0; tap < 5; ++tap) xr[tap] = xn[tap];
            if (i < 15) CONV_LOAD(xn, i + 1);
            float acc[8];
#pragma unroll
            for (int j = 0; j < 8; ++j) acc[j] = bs[j];
#pragma unroll
            for (int tap = 0; tap < 5; ++tap) { float x[8]; unpack8(xr[tap], x);
#pragma unroll
                for (int j = 0; j < 8; ++j) acc[j] += wt[tap][j] * x[j]; }
            const int tl = t0 + ((tid + 512 * i) >> 7);
            u32x4 o; o.x = pk2(silu(acc[0]), silu(acc[1])); o.y = pk2(silu(acc[2]), silu(acc[3])); o.z = pk2(silu(acc[4]), silu(acc[5])); o.w = pk2(silu(acc[6]), silu(acc[7]));
            *(u32x4*)(B.ssd_x + (size_t)tl * 1024 + c0) = o;
        }
#undef CONV_LOAD
    }
#pragma unroll
    for (int i = 0; i < 2; ++i) { const int idx = tid + 512 * i, t = idx >> 4, j = idx & 15, tl = t0 + t;
        B.ssd_dt[(size_t)tl * 16 + j] = softplus(bf2f(p[(size_t)tl * DINP + PC_DT + j]) + P.in[21][layer * 16 + j]); }
}

__device__ __forceinline__ f32x4 mma_nt(f32x4 acc, const LAS bf16_t* A, int lda, const LAS bf16_t* Bt, int ldb, int K, int lane) {
    const int r = lane & 15, q = lane >> 4;
    for (int k = 0; k < K; k += 32) {
        const bf16x8 a = *(const LAS bf16x8*)(A + r * lda + k + q * 8);
        const bf16x8 b = *(const LAS bf16x8*)(Bt + r * ldb + k + q * 8);
        acc = __builtin_amdgcn_mfma_f32_16x16x32_bf16(a, b, acc, 0, 0, 0);
    }
    return acc;
}
__device__ __forceinline__ f32x4 mma_nt_x(f32x4 acc, const LAS bf16_t* A, int lda, const LAS bf16_t* Bt, int ldb, int K, int lane, int xa, int xb) {
    const int r = lane & 15, q = lane >> 4;
    for (int k = 0; k < K; k += 32) {
        const bf16x8 a = *(const LAS bf16x8*)(A + r * lda + ((((k >> 3) + q) ^ xa) << 3));
        const bf16x8 b = *(const LAS bf16x8*)(Bt + r * ldb + ((((k >> 3) + q) ^ xb) << 3));
        acc = __builtin_amdgcn_mfma_f32_16x16x32_bf16(a, b, acc, 0, 0, 0);
    }
    return acc;
}
__device__ __forceinline__ f32x4 mma_tn_x(f32x4 acc, const LAS bf16_t* A, int lda, const LAS bf16_t* Bt, int ldb, int K, int lane, int xa, int xb) {
    const int r = lane & 15, q = lane >> 4;
    for (int k = 0; k < K; k += 32) {
        const bf16x8 a = *(const LAS bf16x8*)(A + r * lda + ((((k >> 3) + q) ^ xa) << 3));
        const bf16x8 b = *(const LAS bf16x8*)(Bt + r * ldb + ((((k >> 3) + q) ^ xb) << 3));
        acc = __builtin_amdgcn_mfma_f32_16x16x32_bf16(b, a, acc, 0, 0, 0);
    }
    return acc;
}
template <int DK> struct CL {
    static constexpr int LQ = DK + 8, LT = 72;
    static constexpr int QA = 0, KA = QA + 64 * LQ * 2, KBT = KA + 64 * LQ * 2, VT = KBT + DK * LT * 2, SC = VT + 64 * LT * 2, STT = SC + 64 * LT * 2;
    static constexpr int FA = STT + 64 * LQ * 2;
};

__device__ __forceinline__ void ssd_unit(LAS unsigned char* lds, const Params& P, const MixBufs& B, float* segst, int layer, int L, int seq, int h, int d, int seg, bool state_only) {
    typedef CL<128> C;
    const int tid = otid(), w = tid >> 6, lane = tid & 63, r = lane & 15, q = lane >> 4;
    LAS bf16_t* Qa = (LAS bf16_t*)(lds + C::QA); LAS bf16_t* Ka = (LAS bf16_t*)(lds + C::KA); LAS bf16_t* KbT = (LAS bf16_t*)(lds + C::KBT);
    LAS bf16_t* VT = (LAS bf16_t*)(lds + C::VT); LAS bf16_t* Sc = (LAS bf16_t*)(lds + C::SC); LAS bf16_t* StT = (LAS bf16_t*)(lds + C::STT);
    LAS float* acum = (LAS float*)(lds + C::FA); LAS float* dtl = acum + 64;
    const int grp = h >> 2;
    const float Aneg = -__expf(P.in[22][layer * 16 + d * 8 + h]);
    const int base = seq * L, cbeg = seg * 32, cend = cbeg + 32;
    __syncthreads();
    f32x4 st[4];
#pragma unroll
    for (int i = 0; i < 4; ++i) st[i] = (f32x4){0.f, 0.f, 0.f, 0.f};
    const int kidx = h * 2 + d;
    if (!state_only) {
        for (int ps = 0; ps < seg; ++ps) {
            const float* sp = segst + (size_t)((seq * 8 + ps) * 24 + kidx) * 8256;
            const float dcy = __expf(sp[8192]);
#pragma unroll
            for (int tv = 0; tv < 4; ++tv)
#pragma unroll
                for (int jj = 0; jj < 4; ++jj) st[tv][jj] = st[tv][jj] * dcy + sp[(tv * 4 + jj) * 512 + tid];
        }
#pragma unroll
        for (int tv = 0; tv < 4; ++tv) {
            u32x2 o; o.x = pk2(st[tv][0], st[tv][1]); o.y = pk2(st[tv][2], st[tv][3]);
            *(LAS u32x2*)(StT + (tv * 16 + r) * C::LQ + w * 16 + q * 4) = o;
        }
    }
    float asum = 0.f;
    const int row = tid >> 3, part = tid & 7;
    const int tm = w >> 1, tn0 = (w & 1) * 2;
    bf16_t* yout = B.ssd_y + (size_t)d * TG * 512;
    u32x4 c0, c1, b0, b1, x0; float dtv;
#define SSD_LOAD(cc) do { const int n0_ = (cc) * 64; \
        const int tok = d == 0 ? base + n0_ + row : base + L - 1 - (n0_ + row); \
        const bf16_t* xr = B.ssd_x + (size_t)tok * 1024; \
        c0 = *(const u32x4*)(xr + 768 + grp * 128 + part * 16); c1 = *(const u32x4*)(xr + 768 + grp * 128 + part * 16 + 8); \
        b0 = *(const u32x4*)(xr + 512 + grp * 128 + part * 16); b1 = *(const u32x4*)(xr + 512 + grp * 128 + part * 16 + 8); \
        x0 = *(const u32x4*)(xr + h * 64 + part * 8); \
        const int tl_ = d == 0 ? base + n0_ + lane : base + L - 1 - (n0_ + lane); \
        dtv = B.ssd_dt[(size_t)tl_ * 16 + d * 8 + h]; } while (0)
    SSD_LOAD(cbeg);
    for (int c = cbeg; c < cend; ++c) {
        const int n0 = c * 64;
        const float ac = wave_incl_scan(dtv * Aneg, lane);
        const float alast = lane_bcast(ac, 63);
        asum += alast;
        if (w == 0) { acum[lane] = ac; dtl[lane] = dtv; }
        {
            const float ks = __shfl(dtv, row) * __expf(alast - __shfl(ac, row));
            *(LAS u32x4*)(Qa + row * C::LQ + part * 16) = c0; *(LAS u32x4*)(Qa + row * C::LQ + part * 16 + 8) = c1;
            *(LAS u32x4*)(Ka + row * C::LQ + part * 16) = b0; *(LAS u32x4*)(Ka + row * C::LQ + part * 16 + 8) = b1;
            float bf[16]; unpack8(b0, bf); unpack8(b1, bf + 8);
            const int rsw = row ^ (part << 3);
#pragma unroll
            for (int j = 0; j < 16; ++j) KbT[(part * 16 + j) * C::LT + rsw] = (bf16_t)f2bf(bf[j] * ks);
            const unsigned xs[4] = {x0.x, x0.y, x0.z, x0.w};
#pragma unroll
            for (int j = 0; j < 4; ++j) { VT[(part * 8 + 2 * j) * C::LT + rsw] = (bf16_t)(xs[j] & 0xffffu); VT[(part * 8 + 2 * j + 1) * C::LT + rsw] = (bf16_t)(xs[j] >> 16); }
        }
        if (c + 1 < cend) SSD_LOAD(c + 1);
        lds_barrier();
        if (!state_only) {
#pragma unroll
        for (int tt = 0; tt < 2; ++tt) {
            const int tn = tn0 + tt;
            f32x4 s = (f32x4){0.f, 0.f, 0.f, 0.f};
            s = mma_tn_x(s, Qa + tm * 16 * C::LQ, C::LQ, Ka + tn * 16 * C::LQ, C::LQ, 128, lane, 0, 0);
            const int i = tm * 16 + r, j0 = tn * 16 + q * 4;
            const float ai = acum[i];
            const f32x4 aj = *(const LAS f32x4*)(acum + j0), dj = *(const LAS f32x4*)(dtl + j0);
            float v[4];
#pragma unroll
            for (int jj = 0; jj < 4; ++jj) {
                const int j = j0 + jj;
                const bool on = d == 0 ? (i >= j) : (i > j);
                v[jj] = on ? s[jj] * __expf(ai - aj[jj]) * dj[jj] : 0.f;
            }
            u32x2 o; o.x = pk2(v[0], v[1]); o.y = pk2(v[2], v[3]);
            *(LAS u32x2*)(Sc + i * C::LT + j0) = o;
        }
        lds_barrier();
#pragma unroll
        for (int tt = 0; tt < 2; ++tt) {
            const int tn = tn0 + tt;
            f32x4 o1 = (f32x4){0.f, 0.f, 0.f, 0.f}, o2 = (f32x4){0.f, 0.f, 0.f, 0.f};
            o1 = mma_tn_x(o1, Sc + tm * 16 * C::LT, C::LT, VT + tn * 16 * C::LT, C::LT, 64, lane, 0, (tn * 2 + (r >> 3)) & 7);
            o2 = mma_tn_x(o2, Qa + tm * 16 * C::LQ, C::LQ, StT + tn * 16 * C::LQ, C::LQ, 128, lane, 0, 0);
            const int i = tm * 16 + r;
            const int tl = d == 0 ? base + n0 + i : base + L - 1 - (n0 + i);
            const float ei = __expf(acum[i]);
            { const f32x4 ov = o1 + o2 * ei; u32x2 o; o.x = pk2(ov[0], ov[1]); o.y = pk2(ov[2], ov[3]); *(u32x2*)(yout + (size_t)tl * 512 + h * 64 + tn * 16 + q * 4) = o; }
        }
        }
        {
            const float ds = __expf(alast);
#pragma unroll
            for (int tv = 0; tv < 4; ++tv) {
                st[tv] = st[tv] * ds;
                st[tv] = mma_nt_x(st[tv], KbT + w * 16 * C::LT, C::LT, VT + tv * 16 * C::LT, C::LT, 64, lane, w, (tv * 2 + (r >> 3)) & 7);
            }
        }
        lds_barrier();
        if (!state_only) {
#pragma unroll
        for (int tv = 0; tv < 4; ++tv) {
            u32x2 o; o.x = pk2(st[tv][0], st[tv][1]); o.y = pk2(st[tv][2], st[tv][3]);
            *(LAS u32x2*)(StT + (tv * 16 + r) * C::LQ + w * 16 + q * 4) = o;
        }
        }
    }
    if (state_only) {
        float* sp = segst + (size_t)((seq * 8 + seg) * 24 + kidx) * 8256;
#pragma unroll
        for (int tv = 0; tv < 4; ++tv)
#pragma unroll
            for (int jj = 0; jj < 4; ++jj) sp[(tv * 4 + jj) * 512 + tid] = st[tv][jj];
        if (tid == 0) sp[8192] = asum;
    }
#undef SSD_LOAD
}

__device__ __forceinline__ void gla_unit(LAS unsigned char* lds, const Params& P, const MixBufs& B, float* segst, int layer, int L, int seq, int h, int d, int seg, bool state_only) {
    typedef CL<32> C;
    const int tid = otid(), w = tid >> 6, lane = tid & 63, r = lane & 15, q = lane >> 4;
    LAS bf16_t* Qa = (LAS bf16_t*)(lds + C::QA); LAS bf16_t* Ka = (LAS bf16_t*)(lds + C::KA); LAS bf16_t* KbT = (LAS bf16_t*)(lds + C::KBT);
    LAS bf16_t* VT = (LAS bf16_t*)(lds + C::VT); LAS bf16_t* Sc = (LAS bf16_t*)(lds + C::SC); LAS bf16_t* StT = (LAS bf16_t*)(lds + C::STT);
    LAS float* dstate = (LAS float*)(lds + C::FA);
    const int base = seq * L, cbeg = seg * 32, cend = cbeg + 32;
    __syncthreads();
    f32x4 st = (f32x4){0.f, 0.f, 0.f, 0.f};
    const int row = tid >> 3, part = tid & 7;
    const int tm = w >> 1, tn0 = (w & 1) * 2;
    const int tk = w >> 2, tv = w & 3;
    const int kidx = 16 + h * 2 + d;
    if (!state_only) {
        for (int ps = 0; ps < seg; ++ps) {
            const float* sp = segst + (size_t)((seq * 8 + ps) * 24 + kidx) * 8256;
#pragma unroll
            for (int jj = 0; jj < 4; ++jj) st[jj] = st[jj] * __expf(sp[8192 + tk * 16 + q * 4 + jj]) + sp[jj * 512 + tid];
        }
        { u32x2 o; o.x = pk2(st[0], st[1]); o.y = pk2(st[2], st[3]); *(LAS u32x2*)(StT + (tv * 16 + r) * C::LQ + tk * 16 + q * 4) = o; }
    }
    float blsum[4] = {0.f, 0.f, 0.f, 0.f};
    const float* la = B.gla_la + (size_t)d * TG * 128;
    bf16_t* oout = B.gla_o + (size_t)d * TG * 256;
    const float qscale = 0.17677669529663687f;
    f32x4 lv; u32x2 qr, kr; u32x4 x0;
#define GLA_LOAD(cc) do { const int n0_ = (cc) * 64; \
        const int tl_ = d == 0 ? base + n0_ + lane : base + L - 1 - (n0_ + lane); \
        lv = *(const f32x4*)(la + (size_t)tl_ * 128 + h * 32 + 4 * w); \
        qr = *(const u32x2*)(B.p + (size_t)tl_ * DINP + PC_GQ + h * 32 + 4 * w); \
        kr = *(const u32x2*)(B.p + (size_t)tl_ * DINP + PC_GK + h * 32 + 4 * w); \
        const int tr_ = d == 0 ? base + n0_ + row : base + L - 1 - (n0_ + row); \
        x0 = *(const u32x4*)(B.p + (size_t)tr_ * DINP + PC_GV + h * 64 + part * 8); } while (0)
    GLA_LOAD(cbeg);
    for (int c = cbeg; c < cend; ++c) {
        const int n0 = c * 64;
        {
            const float qf[4] = {__uint_as_float(qr.x << 16), __uint_as_float(qr.x & 0xffff0000u), __uint_as_float(qr.y << 16), __uint_as_float(qr.y & 0xffff0000u)};
            const float kf[4] = {__uint_as_float(kr.x << 16), __uint_as_float(kr.x & 0xffff0000u), __uint_as_float(kr.y << 16), __uint_as_float(kr.y & 0xffff0000u)};
            float qd[4], kd[4];
#pragma unroll
            for (int kk = 0; kk < 4; ++kk) {
                const float b = wave_incl_scan(lv[kk], lane);
                const float bl = lane_bcast(b, 63);
                blsum[kk] += bl;
                qd[kk] = qf[kk] * qscale * __expf(b); kd[kk] = kf[kk] * __expf(-b);
                KbT[(4 * w + kk) * C::LT + lane] = (bf16_t)f2bf(kf[kk] * __expf(bl - b));
                if (lane == 63) dstate[4 * w + kk] = __expf(bl);
            }
            u32x2 o; o.x = pk2(qd[0], qd[1]); o.y = pk2(qd[2], qd[3]); *(LAS u32x2*)(Qa + lane * C::LQ + 4 * w) = o;
            o.x = pk2(kd[0], kd[1]); o.y = pk2(kd[2], kd[3]); *(LAS u32x2*)(Ka + lane * C::LQ + 4 * w) = o;
            const unsigned xs[4] = {x0.x, x0.y, x0.z, x0.w};
            const int rsw = row ^ (part << 3);
#pragma unroll
            for (int j = 0; j < 4; ++j) { VT[(part * 8 + 2 * j) * C::LT + rsw] = (bf16_t)(xs[j] & 0xffffu); VT[(part * 8 + 2 * j + 1) * C::LT + rsw] = (bf16_t)(xs[j] >> 16); }
        }
        if (c + 1 < cend) GLA_LOAD(c + 1);
        lds_barrier();
        if (!state_only) {
#pragma unroll
        for (int tt = 0; tt < 2; ++tt) {
            const int tn = tn0 + tt;
            f32x4 s = (f32x4){0.f, 0.f, 0.f, 0.f};
            s = mma_tn_x(s, Qa + tm * 16 * C::LQ, C::LQ, Ka + tn * 16 * C::LQ, C::LQ, 32, lane, 0, 0);
            const int i = tm * 16 + r, j0 = tn * 16 + q * 4;
            float v[4];
#pragma unroll
            for (int jj = 0; jj < 4; ++jj) { const int j = j0 + jj; const bool on = d == 0 ? (i >= j) : (i > j); v[jj] = on ? s[jj] : 0.f; }
            u32x2 o; o.x = pk2(v[0], v[1]); o.y = pk2(v[2], v[3]);
            *(LAS u32x2*)(Sc + i * C::LT + j0) = o;
        }
        lds_barrier();
#pragma unroll
        for (int tt = 0; tt < 2; ++tt) {
            const int tn = tn0 + tt;
            f32x4 o1 = (f32x4){0.f, 0.f, 0.f, 0.f};
            o1 = mma_tn_x(o1, Sc + tm * 16 * C::LT, C::LT, VT + tn * 16 * C::LT, C::LT, 64, lane, 0, (tn * 2 + (r >> 3)) & 7);
            o1 = mma_tn_x(o1, Qa + tm * 16 * C::LQ, C::LQ, StT + tn * 16 * C::LQ, C::LQ, 32, lane, 0, 0);
            const int i = tm * 16 + r;
            const int tl = d == 0 ? base + n0 + i : base + L - 1 - (n0 + i);
            { u32x2 o; o.x = pk2(o1[0], o1[1]); o.y = pk2(o1[2], o1[3]); *(u32x2*)(oout + (size_t)tl * 256 + h * 64 + tn * 16 + q * 4) = o; }
        }
        }
        {
#pragma unroll
            for (int jj = 0; jj < 4; ++jj) st[jj] *= dstate[tk * 16 + q * 4 + jj];
            st = mma_nt_x(st, KbT + tk * 16 * C::LT, C::LT, VT + tv * 16 * C::LT, C::LT, 64, lane, 0, (tv * 2 + (r >> 3)) & 7);
        }
        lds_barrier();
        if (!state_only) { u32x2 o; o.x = pk2(st[0], st[1]); o.y = pk2(st[2], st[3]); *(LAS u32x2*)(StT + (tv * 16 + r) * C::LQ + tk * 16 + q * 4) = o; }
    }
    if (state_only) {
        float* sp = segst + (size_t)((seq * 8 + seg) * 24 + kidx) * 8256;
#pragma unroll
        for (int jj = 0; jj < 4; ++jj) sp[jj * 512 + tid] = st[jj];
        if (lane == 0) {
#pragma unroll
            for (int kk = 0; kk < 4; ++kk) sp[8192 + 4 * w + kk] = blsum[kk];
        }
    }
#undef GLA_LOAD
}

constexpr int RL = 72;
struct RwRaw { u32x4 e, kk, bb, kd, rr, v; };
__device__ __forceinline__ void rwkv_pre_load(RwRaw& R, const MixBufs& B, int L, int u, int tid) {
    const int w = tid >> 6, lane = tid & 63, nch = L / 64, hd = u & 7, ch = u >> 3, h = hd >> 1, d = hd & 1;
    const int base = (ch / nch) * L, n0 = (ch % nch) * 64;
    const int tl = d == 0 ? base + n0 + lane : base + L - 1 - (n0 + lane);
    const size_t o = (size_t)tl * 256 + h * 64 + 8 * w;
    R.e = *(const u32x4*)(B.rw + (4 + d) * RWA + o); R.kk = *(const u32x4*)(B.rw + 2 * RWA + o);
    R.bb = *(const u32x4*)(B.rw + (8 + d) * RWA + o); R.kd = *(const u32x4*)(B.rw + (6 + d) * RWA + o);
    R.rr = *(const u32x4*)(B.rw + 0 * RWA + o);
    const int row = tid >> 3, part = tid & 7;
    const int tr = d == 0 ? base + n0 + row : base + L - 1 - (n0 + row);
    R.v = *(const u32x4*)(B.rw + 1 * RWA + (size_t)tr * 256 + h * 64 + part * 8);
}
__device__ __forceinline__ void rwkv_pre(LAS unsigned char* lds, const MixBufs& B, bf16_t* rq, int L, int u, int unext, RwRaw& R) {
    const int tid = otid(), w = tid >> 6, lane = tid & 63, r = lane & 15, q = lane >> 4;
#define RG(i) ((LAS bf16_t*)(lds + (i) * 9216))
    LAS bf16_t* At = RG(0); LAS bf16_t* Bt_ = RG(1); LAS bf16_t* Kt = RG(2); LAS bf16_t* Rt = RG(3); LAS bf16_t* AtT = RG(4); LAS bf16_t* BhT = RG(5);
    LAS bf16_t* KhT = RG(6); LAS bf16_t* VT = RG(7); LAS bf16_t* Lak = RG(8); LAS bf16_t* Mrb = RG(9); LAS bf16_t* Mrk = RG(10); LAS bf16_t* WT = RG(11);
    LAS bf16_t* Tm = RG(0); LAS bf16_t* XT = RG(1); LAS bf16_t* UT = RG(2);
#undef RG
    LAS float* Lf = (LAS float*)(lds + 12 * 9216);
    LAS float* gC = (LAS float*)(lds + 12 * 9216 + 17408);
    LAS bf16_t* L21b = (LAS bf16_t*)(lds + 12 * 9216 + 17408 + 512);
    LAS bf16_t* T11T = WT;
    LAS bf16_t* X1T = WT + 32 * 40;
    const int nch = L / 64, hd = u & 7, ch = u >> 3, h = hd >> 1, d = hd & 1, seq = ch / nch, c = ch % nch;
    const int base = seq * L, n0 = c * 64;
    const int cu = (((seq * nch + c) * 4 + h) * 2 + d);
    bf16_t* gq = rq + (size_t)cu * 3 * 4096;
    lds_barrier();
    {
        float e[8], kk[8], bb[8], kd[8], rr[8];
        unpack8(R.e, e); unpack8(R.kk, kk); unpack8(R.bb, bb); unpack8(R.kd, kd); unpack8(R.rr, rr);
        float at[8], bt[8], kt[8], rt[8];
#pragma unroll
        for (int j = 0; j < 8; ++j) {
            const float cum = wave_incl_scan(e[j], lane);
            const float cmid = lane_bcast(cum, 31), clast = lane_bcast(cum, 63);
            const float ea = __expf(-(cum - e[j] - cmid)), eb = __expf(cum - cmid), er = __expf(-(cum - cmid)), eh = __expf(-(clast - cum));
            at[j] = -kk[j] * ea; bt[j] = bb[j] * eb; kt[j] = kd[j] * eb; rt[j] = rr[j] * er;
            AtT[(8 * w + j) * RL + lane] = (bf16_t)f2bf(at[j]);
            BhT[(8 * w + j) * RL + lane] = (bf16_t)f2bf(bb[j] * eh);
            KhT[(8 * w + j) * RL + lane] = (bf16_t)f2bf(kd[j] * eh);
            if (lane == 63) { gC[8 * w + j] = __expf(-clast); gC[64 + 8 * w + j] = __expf(-cmid); }
        }
        u32x4 o4;
        o4.x = pk2(at[0], at[1]); o4.y = pk2(at[2], at[3]); o4.z = pk2(at[4], at[5]); o4.w = pk2(at[6], at[7]); *(LAS u32x4*)(At + lane * RL + 8 * w) = o4;
        o4.x = pk2(bt[0], bt[1]); o4.y = pk2(bt[2], bt[3]); o4.z = pk2(bt[4], bt[5]); o4.w = pk2(bt[6], bt[7]); *(LAS u32x4*)(Bt_ + lane * RL + 8 * w) = o4;
        o4.x = pk2(kt[0], kt[1]); o4.y = pk2(kt[2], kt[3]); o4.z = pk2(kt[4], kt[5]); o4.w = pk2(kt[6], kt[7]); *(LAS u32x4*)(Kt + lane * RL + 8 * w) = o4;
        o4.x = pk2(rt[0], rt[1]); o4.y = pk2(rt[2], rt[3]); o4.z = pk2(rt[4], rt[5]); o4.w = pk2(rt[6], rt[7]); *(LAS u32x4*)(Rt + lane * RL + 8 * w) = o4;
        const int row = tid >> 3, part = tid & 7;
        const unsigned xs[4] = {R.v.x, R.v.y, R.v.z, R.v.w};
#pragma unroll
        for (int j = 0; j < 4; ++j) { VT[(part * 8 + 2 * j) * RL + row] = (bf16_t)(xs[j] & 0xffffu); VT[(part * 8 + 2 * j + 1) * RL + row] = (bf16_t)(xs[j] >> 16); }
    }
    if (unext >= 0) rwkv_pre_load(R, B, L, unext, tid);
    lds_barrier();
    const int tm = w >> 1, tn0 = (w & 1) * 2;
    const f32x4 Z4 = (f32x4){0.f, 0.f, 0.f, 0.f};
#pragma unroll
    for (int tt = 0; tt < 2; ++tt) {
        const int tn = tn0 + tt;
        const f32x4 lab = mma_tn_x(Z4, At + tm * 16 * RL, RL, Bt_ + tn * 16 * RL, RL, 64, lane, 0, 0);
        const f32x4 lak = mma_tn_x(Z4, At + tm * 16 * RL, RL, Kt + tn * 16 * RL, RL, 64, lane, 0, 0);
        const f32x4 mrb = mma_tn_x(Z4, Rt + tm * 16 * RL, RL, Bt_ + tn * 16 * RL, RL, 64, lane, 0, 0);
        const f32x4 mrk = mma_tn_x(Z4, Rt + tm * 16 * RL, RL, Kt + tn * 16 * RL, RL, 64, lane, 0, 0);
        const int i = tm * 16 + r, j0 = tn * 16 + q * 4;
        f32x4 lf; float vk[4], vb[4], vm[4];
#pragma unroll
        for (int jj = 0; jj < 4; ++jj) {
            const int j = j0 + jj; const bool st_ = j < i, in_ = j <= i;
            lf[jj] = st_ ? lab[jj] : 0.f; vk[jj] = st_ ? lak[jj] : 0.f; vb[jj] = in_ ? mrb[jj] : 0.f; vm[jj] = in_ ? mrk[jj] : 0.f;
        }
        *(LAS f32x4*)(Lf + i * 68 + j0) = lf;
        u32x2 o;
        if (tm >= 2 && tn < 2) { o.x = pk2(lab[0], lab[1]); o.y = pk2(lab[2], lab[3]); *(LAS u32x2*)(L21b + (i - 32) * 40 + j0) = o; }
        o.x = pk2(vk[0], vk[1]); o.y = pk2(vk[2], vk[3]); *(LAS u32x2*)(Lak + i * RL + j0) = o;
        o.x = pk2(vb[0], vb[1]); o.y = pk2(vb[2], vb[3]); *(LAS u32x2*)(Mrb + i * RL + j0) = o;
        o.x = pk2(vm[0], vm[1]); o.y = pk2(vm[2], vm[3]); *(LAS u32x2*)(Mrk + i * RL + j0) = o;
    }
    lds_barrier();
#pragma unroll
    for (int tt = 0; tt < 2; ++tt) {
        const int tn = tn0 + tt;
        const f32x4 x = mma_nt(Z4, Lak + tm * 16 * RL, RL, VT + tn * 16 * RL, RL, 64, lane);
        u32x2 o; o.x = pk2(x[0], x[1]); o.y = pk2(x[2], x[3]);
        *(LAS u32x2*)(XT + (tn * 16 + r) * RL + tm * 16 + q * 4) = o;
    }
    if (w < 2) {
        const int ob = w * 32, j = lane & 31;
        float T[32];
        int zv = 0; asm volatile("" : "+v"(zv));
        const LAS float* Lfz = Lf + zv + ob * 68 + ob;
#pragma unroll
        for (int t = 0; t < 32; ++t) {
            float a0 = (t == j) ? 1.f : 0.f, a1 = 0.f;
#pragma unroll
            for (int s4 = 0; s4 < (t + 3) / 4; ++s4) {
                const f32x4 l = *(const LAS f32x4*)(Lfz + t * 68 + s4 * 4);
#pragma unroll
                for (int e2 = 0; e2 < 4; ++e2) { const int s_ = s4 * 4 + e2; if (s_ < t) { if (e2 & 1) a1 += l[e2] * T[s_]; else a0 += l[e2] * T[s_]; } }
            }
            T[t] = a0 + a1;
            if (lane < 32) {
                Tm[(ob + t) * RL + ob + j] = (bf16_t)f2bf(T[t]);
                if (w == 0) T11T[j * 40 + t] = (bf16_t)f2bf(T[t]);
            }
        }
    } else if (w == 2) {
        for (int i = lane; i < 32 * 16; i += 64) { const int t = i >> 4, c2 = (i & 15) * 2; *(LAS unsigned*)(Tm + t * RL + 32 + c2) = 0u; }
    }
    lds_barrier();
    if (w < 4) {
        const int mi = w >> 1, ni = w & 1;
        const f32x4 x1 = mma_nt(Z4, L21b + mi * 16 * 40, 40, T11T + ni * 16 * 40, 40, 32, lane);
        u32x2 o; o.x = pk2(x1[0], x1[1]); o.y = pk2(x1[2], x1[3]);
        *(LAS u32x2*)(X1T + (ni * 16 + r) * 40 + mi * 16 + q * 4) = o;
    }
    lds_barrier();
    if (w < 4) {
        const int mi = w >> 1, ni = w & 1;
        const f32x4 t21 = mma_tn_x(Z4, Tm + (32 + mi * 16) * RL + 32, RL, X1T + ni * 16 * 40, 40, 32, lane, 0, 0);
        u32x2 o; o.x = pk2(t21[0], t21[1]); o.y = pk2(t21[2], t21[3]);
        *(LAS u32x2*)(Tm + (32 + mi * 16 + r) * RL + ni * 16 + q * 4) = o;
    }
    lds_barrier();
    f32x4 uu[2], ww[2];
#pragma unroll
    for (int tt = 0; tt < 2; ++tt) {
        const int tn = tn0 + tt;
        uu[tt] = mma_nt(Z4, Tm + tm * 16 * RL, RL, XT + tn * 16 * RL, RL, 64, lane);
        ww[tt] = mma_nt(Z4, Tm + tm * 16 * RL, RL, AtT + tn * 16 * RL, RL, 64, lane);
    }
#pragma unroll
    for (int tt = 0; tt < 2; ++tt) {
        const int tn = tn0 + tt;
        u32x2 o; o.x = pk2(uu[tt][0], uu[tt][1]); o.y = pk2(uu[tt][2], uu[tt][3]);
        *(LAS u32x2*)(UT + (tn * 16 + r) * RL + tm * 16 + q * 4) = o;
        o.x = pk2(ww[tt][0], ww[tt][1]); o.y = pk2(ww[tt][2], ww[tt][3]);
        *(LAS u32x2*)(WT + (tn * 16 + r) * RL + tm * 16 + q * 4) = o;
    }
    lds_barrier();
    bf16_t* yout = B.rw_y + (size_t)d * TG * 256;
#pragma unroll
    for (int tt = 0; tt < 2; ++tt) {
        const int tn = tn0 + tt;
        const f32x4 qe = mma_tn_x(Z4, Mrb + tm * 16 * RL, RL, WT + tn * 16 * RL, RL, 64, lane, 0, 0);
        f32x4 yl = mma_tn_x(Z4, Mrb + tm * 16 * RL, RL, UT + tn * 16 * RL, RL, 64, lane, 0, 0);
        yl = mma_tn_x(yl, Mrk + tm * 16 * RL, RL, VT + tn * 16 * RL, RL, 64, lane, 0, 0);
        const f32x4 pe = mma_tn_x(Z4, BhT + tm * 16 * RL, RL, WT + tn * 16 * RL, RL, 64, lane, 0, 0);
        f32x4 hl = mma_nt(Z4, BhT + tm * 16 * RL, RL, UT + tn * 16 * RL, RL, 64, lane);
        hl = mma_nt(hl, KhT + tm * 16 * RL, RL, VT + tn * 16 * RL, RL, 64, lane);
        const int i = tm * 16 + r, n0c = tn * 16 + q * 4;
        const f32x4 um = *(const LAS f32x4*)(gC + 64 + n0c);
        const u32x2 rtp = *(const LAS u32x2*)(Rt + i * RL + n0c);
        const float rt4[4] = {__uint_as_float(rtp.x << 16), __uint_as_float(rtp.x & 0xffff0000u), __uint_as_float(rtp.y << 16), __uint_as_float(rtp.y & 0xffff0000u)};
        const float gci = gC[i];
        float qv[4], pv[4];
#pragma unroll
        for (int jj = 0; jj < 4; ++jj) { qv[jj] = (qe[jj] + rt4[jj]) * um[jj]; pv[jj] = pe[jj] * um[jj] + ((n0c + jj) == i ? gci : 0.f); }
        u32x2 o; o.x = pk2(qv[0], qv[1]); o.y = pk2(qv[2], qv[3]); *(u32x2*)(gq + i * 64 + n0c) = o;
        o.x = pk2(pv[0], pv[1]); o.y = pk2(pv[2], pv[3]); *(u32x2*)(gq + 4096 + i * 64 + n0c) = o;
        const int tl = d == 0 ? base + n0 + i : base + L - 1 - (n0 + i);
        o.x = pk2(yl[0], yl[1]); o.y = pk2(yl[2], yl[3]); *(u32x2*)(yout + (size_t)tl * 256 + h * 64 + n0c) = o;
        o.x = pk2(hl[0], hl[1]); o.y = pk2(hl[2], hl[3]);
        *(u32x2*)(gq + 8192 + (tn * 16 + r) * 64 + tm * 16 + q * 4) = o;
    }
}

__device__ __forceinline__ void rwkv_seq(LAS unsigned char* lds, const MixBufs& B, const bf16_t* rq, int L, int seq, int h, int d) {
    const int tid = otid(), w = tid >> 6, lane = tid & 63, r = lane & 15, q = lane >> 4;
    const int tm = w >> 1, tn0 = (w & 1) * 2;
    const int base = seq * L, nch = L / 64;
    __syncthreads();
    for (int i = tid; i < 64 * RL / 2; i += 512) ((LAS unsigned*)lds)[i] = 0u;
    bf16_t* yout = B.rw_y + (size_t)d * TG * 256;
    const size_t custride = (size_t)8 * 3 * 4096;
    const bf16_t* g = rq + (size_t)(((seq * nch) * 4 + h) * 2 + d) * 3 * 4096;
    const int aoff = (tm * 16 + r) * 64 + q * 8;
    bf16x8 qa0 = *(const bf16x8*)(g + aoff), qa1 = *(const bf16x8*)(g + aoff + 32);
    bf16x8 pa0 = *(const bf16x8*)(g + 4096 + aoff), pa1 = *(const bf16x8*)(g + 4096 + aoff + 32);
    u32x2 hl0 = *(const u32x2*)(g + 8192 + (tn0 * 16 + r) * 64 + tm * 16 + q * 4), hl1 = *(const u32x2*)(g + 8192 + ((tn0 + 1) * 16 + r) * 64 + tm * 16 + q * 4);
    for (int c = 0; c < nch; ++c) {
        const bf16_t* gn = g + (c + 1 < nch ? custride : 0);
        const bf16x8 nqa0 = *(const bf16x8*)(gn + aoff), nqa1 = *(const bf16x8*)(gn + aoff + 32);
        const bf16x8 npa0 = *(const bf16x8*)(gn + 4096 + aoff), npa1 = *(const bf16x8*)(gn + 4096 + aoff + 32);
        const u32x2 nhl0 = *(const u32x2*)(gn + 8192 + (tn0 * 16 + r) * 64 + tm * 16 + q * 4), nhl1 = *(const u32x2*)(gn + 8192 + ((tn0 + 1) * 16 + r) * 64 + tm * 16 + q * 4);
        u32x2 yl[2];
        const int ti_ = tm * 16 + r;
        bf16_t* yrow = yout + (size_t)(d == 0 ? base + c * 64 + ti_ : base + L - 1 - (c * 64 + ti_)) * 256 + h * 64 + q * 4;
#pragma unroll
        for (int tt = 0; tt < 2; ++tt) yl[tt] = *(const u32x2*)(yrow + (tn0 + tt) * 16);
        lds_barrier();
        const LAS bf16_t* cur = (const LAS bf16_t*)(lds + (c & 1) * 9216);
        LAS bf16_t* nxt = (LAS bf16_t*)(lds + ((c + 1) & 1) * 9216);
#pragma unroll
        for (int tt = 0; tt < 2; ++tt) {
            const int tn = tn0 + tt;
            const bf16x8 b0 = *(const LAS bf16x8*)(cur + (tn * 16 + r) * RL + q * 8), b1 = *(const LAS bf16x8*)(cur + (tn * 16 + r) * RL + 32 + q * 8);
            f32x4 y = (f32x4){0.f, 0.f, 0.f, 0.f}, hn = (f32x4){0.f, 0.f, 0.f, 0.f};
            y = __builtin_amdgcn_mfma_f32_16x16x32_bf16(b0, qa0, y, 0, 0, 0); y = __builtin_amdgcn_mfma_f32_16x16x32_bf16(b1, qa1, y, 0, 0, 0);
            hn = __builtin_amdgcn_mfma_f32_16x16x32_bf16(pa0, b0, hn, 0, 0, 0); hn = __builtin_amdgcn_mfma_f32_16x16x32_bf16(pa1, b1, hn, 0, 0, 0);
            const u32x2 hl = tt == 0 ? hl0 : hl1;
            hn[0] += __uint_as_float(hl.x << 16); hn[1] += __uint_as_float(hl.x & 0xffff0000u); hn[2] += __uint_as_float(hl.y << 16); hn[3] += __uint_as_float(hl.y & 0xffff0000u);
            u32x2 o; o.x = pk2(hn[0], hn[1]); o.y = pk2(hn[2], hn[3]);
            *(LAS u32x2*)(nxt + (tn * 16 + r) * RL + tm * 16 + q * 4) = o;
            { const u32x2 yo = yl[tt];
              y[0] += __uint_as_float(yo.x << 16); y[1] += __uint_as_float(yo.x & 0xffff0000u); y[2] += __uint_as_float(yo.y << 16); y[3] += __uint_as_float(yo.y & 0xffff0000u);
              u32x2 o2; o2.x = pk2(y[0], y[1]); o2.y = pk2(y[2], y[3]); *(u32x2*)(yrow + tn * 16) = o2; }
        }
        g = gn; qa0 = nqa0; qa1 = nqa1; pa0 = npa0; pa1 = npa1; hl0 = nhl0; hl1 = nhl1;
    }
}

__device__ __forceinline__ void phase_post(const Params& P, const MixBufs& B, int layer) {
    const int tid_ = otid(); const int lane = tid_ & 63, gw = blockIdx.x * 8 + (tid_ >> 6), nw = gridDim.x * 8;
    const float gng = P.in[7][layer * 64 + lane];
    const float* ssdn = P.in[24] + layer * 512;
    float lng[4], lnb[4];
#pragma unroll
    for (int h = 0; h < 4; ++h) { lng[h] = P.in[17][layer * 256 + h * 64 + lane]; lnb[h] = P.in[18][layer * 256 + h * 64 + lane]; }
    const int c0 = lane * 8;
    const f32x4 sg0 = *(const f32x4*)(ssdn + c0), sg1 = *(const f32x4*)(ssdn + c0 + 4);
    const float Dh = P.in[23][layer * 8 + (lane >> 3)];
    for (int tl = gw; tl < TG; tl += nw) {
        const bf16_t* pr = B.p + (size_t)tl * DINP;
        bf16_t* mr = B.mix + (size_t)tl * DM;
        bf16_t go0[4], go1[4], ry0[4], ry1[4]; bf16_t ggt[4], rvv[4], rgg[4];
#pragma unroll
        for (int h = 0; h < 4; ++h) {
            const size_t o = (size_t)tl * 256 + h * 64 + lane;
            go0[h] = B.gla_o[o]; go1[h] = B.gla_o[(size_t)TG * 256 + o]; ggt[h] = pr[PC_GG + h * 64 + lane];
            ry0[h] = B.rw_y[o]; ry1[h] = B.rw_y[(size_t)TG * 256 + o]; rvv[h] = B.rw[1 * RWA + o]; rgg[h] = B.rw[3 * RWA + o];
        }
        const f32x4 srk = *(const f32x4*)(B.rw_s + (size_t)tl * 4), skr = *(const f32x4*)(B.rw_s + (size_t)TG * 4 + (size_t)tl * 4);
        const u32x4 ya = *(const u32x4*)(B.ssd_y + (size_t)tl * 512 + c0), yb = *(const u32x4*)(B.ssd_y + (size_t)TG * 512 + (size_t)tl * 512 + c0);
        const u32x4 xsr = *(const u32x4*)(B.ssd_x + (size_t)tl * 1024 + c0), zr = *(const u32x4*)(pr + PC_Z + c0);
#pragma unroll
        for (int h = 0; h < 4; ++h) {
            const float o = bf2f(go0[h]) + bf2f(go1[h]);
            const float ms = wave_sum(o * o) * (1.0f / 64.0f);
            mr[h * 64 + lane] = (bf16_t)f2bf(o * rsqrtf(ms + EPS) * gng * silu(bf2f(ggt[h])));
        }
#pragma unroll
        for (int h = 0; h < 4; ++h) {
            const float v = bf2f(rvv[h]);
            const float y = bf2f(ry0[h]) + bf2f(ry1[h]) - v * skr[h];
            const float mean = wave_sum(y) * (1.0f / 64.0f);
            const float dv = y - mean; const float var = wave_sum(dv * dv) * (1.0f / 64.0f);
            float oo = dv * rsqrtf(var + 64e-5f) * lng[h] + lnb[h];
            oo += srk[h] * v;
            mr[256 + h * 64 + lane] = (bf16_t)f2bf(oo * bf2f(rgg[h]));
        }
        {
            float xs[8], z[8], yfa[8], yfb[8]; unpack8(xsr, xs); unpack8(zr, z); unpack8(ya, yfa); unpack8(yb, yfb);
            float yv[8]; float ss = 0.f;
#pragma unroll
            for (int j = 0; j < 8; ++j) { const float yy = (yfa[j] + yfb[j]) + Dh * xs[j]; yv[j] = yy * silu(z[j]); ss += yv[j] * yv[j]; }
            ss = wave_sum(ss);
            const float rs = rsqrtf(ss * (1.0f / 512.0f) + EPS);
            u32x4 o; o.x = pk2(yv[0] * rs * sg0[0], yv[1] * rs * sg0[1]); o.y = pk2(yv[2] * rs * sg0[2], yv[3] * rs * sg0[3]);
            o.z = pk2(yv[4] * rs * sg1[0], yv[5] * rs * sg1[1]); o.w = pk2(yv[6] * rs * sg1[2], yv[7] * rs * sg1[3]);
            *(u32x4*)(mr + 512 + c0) = o;
        }
    }
}

#define RWKV_PRE_QUEUE(pool_base) do { \
        unsigned* qctr_ = (unsigned*)(ws + WS_CTL) + 4096 + 16 * (g * 2 + layer); \
        volatile LAS unsigned* qs_ = (volatile LAS unsigned*)(lds + 131072 + 1024 + 64); \
        unsigned tick_ = 0u; \
        if (threadIdx.x == 0) tick_ = __hip_atomic_fetch_add(qctr_, 1u, __ATOMIC_RELAXED, __HIP_MEMORY_SCOPE_AGENT); \
        for (;;) { \
            if (threadIdx.x == 0) qs_[0] = tick_; \
            __syncthreads(); \
            const int uq_ = (pool_base) + (int)qs_[0]; \
            __syncthreads(); \
            if (uq_ >= 4096) break; \
            if (threadIdx.x == 0) tick_ = __hip_atomic_fetch_add(qctr_, 1u, __ATOMIC_RELAXED, __HIP_MEMORY_SCOPE_AGENT); \
            RwRaw Rq_; rwkv_pre_load(Rq_, B, L, uq_, otid()); rwkv_pre(lds, B, rq, L, uq_, -1, Rq_); \
        } } while (0)

__global__ void __launch_bounds__(512, 2) fwd_megakernel(Params P) {
    extern __shared__ __attribute__((aligned(16))) unsigned char shm[];
    LAS unsigned char* lds = (LAS unsigned char*)shm;
    unsigned char* ws = P.ws;
    volatile LAS unsigned* bst = (volatile LAS unsigned*)(lds + 131072 + 1024);
    if (threadIdx.x == 0) { bst[0] = 0u; bst[1] = 0u; }
    __syncthreads();
    const XcdBarrier xbar = xcd_barrier_post((unsigned*)(ws + WS_CTL), bst);
    bf16_t* xb = (bf16_t*)(ws + WS_XB); float* ssp = (float*)(ws + WS_SSP); bf16_t* pbuf = (bf16_t*)(ws + WS_P);

    phase_weights(lds, P);
    for (int g = 0; g < NGROUP; ++g) {
        const int L = g < 2 ? 2048 : 16384, nseq = TG / L;
        phase_xprep(P, g);
        if (g == 0) cg::this_grid().sync(); else xcd_barrier(xbar);
        for (int layer = 0; layer < 2; ++layer) {
            pg8::StaticOrder S;
            {
                pg8::Gemm gm; gm.A = xb; gm.Bt = (const bf16_t*)(ws + WS_WIN) + (size_t)layer * DINP * DM; gm.M = TG; gm.N = DINP; gm.K = DM;
                S.init(TG, DINP, gridDim.x, blockIdx.x);
                EpiInproj E; E.O = pbuf; E.ssp = ssp;
                pg8::gemm_phase(lds, gm, S, E);
            }
            xcd_barrier(xbar);
            { const MixBufs B = mixbufs(P); const bf16_t* sw = (const bf16_t*)(ws + WS_SW) + (size_t)layer * SW_L;
              for (int t = blockIdx.x; t < TG / 64; t += gridDim.x) prep_tile64(lds, P, B, sw, layer, L, t); }
            xcd_barrier(xbar);
            {
                const MixBufs B = mixbufs(P);
                bf16_t* rq = (bf16_t*)(ws + WS_RWQ); float* segst = P.out + (size_t)g * TG * DM;
                const int nseg = L / 2048, nch = L / 64;
                const int nchain = nseg == 1 ? nseq * 24 : nseq * (nseg - 1) * 24;
                if (nseg == 1 && gridDim.x == 256) {
                    const int b = blockIdx.x;
                    ssd_unit(lds, P, B, segst, layer, L, b / 24 * 0 + (b >> 4), (b >> 1) & 7, b & 1, 0, false);
                    const int p0 = b * 10, pn = 10;
                    __syncthreads();
                    { RwRaw R; rwkv_pre_load(R, B, L, p0, otid());
                      for (int u = p0; u < p0 + pn; ++u) rwkv_pre(lds, B, rq, L, u, u + 1 < p0 + pn ? u + 1 : -1, R); }
                    RWKV_PRE_QUEUE(256 * 10);
                } else if (nseg == 8 && nseq == 2 && gridDim.x == 256) {
                    const int b = blockIdx.x;
                    for (int rep = 0; rep < 2; ++rep) {
                        const int it = b + rep * 256;
                        if (it < nchain) {
                            const int k = it % 24, sg = it / 24, seq = sg / (nseg - 1), seg = sg % (nseg - 1);
                            if (k < 16) ssd_unit(lds, P, B, segst, layer, L, seq, k >> 1, k & 1, seg, true);
                            else gla_unit(lds, P, B, segst, layer, L, seq, (k - 16) >> 1, k & 1, seg, true);
                        }
                    }
                    const int kx = b - 80;
                    const int p0 = b < 80 ? b * 5 : 400 + kx * 13, pn = b < 80 ? 5 : 13;
                    __syncthreads();
                    { RwRaw R; rwkv_pre_load(R, B, L, p0, otid());
                      for (int u = p0; u < p0 + pn; ++u) rwkv_pre(lds, B, rq, L, u, u + 1 < p0 + pn ? u + 1 : -1, R); }
                    RWKV_PRE_QUEUE(400 + 176 * 13);
                } else
                for (int it = blockIdx.x; it < nchain + 4096; it += gridDim.x) {
                    if (it < nchain) {
                        const int k = it % 24, sg = it / 24, seq = nseg == 1 ? sg : sg / (nseg - 1), seg = nseg == 1 ? 0 : sg % (nseg - 1);
                        if (k < 16) ssd_unit(lds, P, B, segst, layer, L, seq, k >> 1, k & 1, seg, nseg > 1);
                        else gla_unit(lds, P, B, segst, layer, L, seq, (k - 16) >> 1, k & 1, seg, nseg > 1);
                    } else { const int u = it - nchain; __syncthreads(); RwRaw R; rwkv_pre_load(R, B, L, u, otid()); rwkv_pre(lds, B, rq, L, u, -1, R); }
                }
            }
            xcd_barrier(xbar);
            {
                const MixBufs B = mixbufs(P);
                const bf16_t* rq = (const bf16_t*)(ws + WS_RWQ); float* segst = P.out + (size_t)g * TG * DM;
                const int nseg = L / 2048;
                const int nchain = nseg == 1 ? 0 : nseq * nseg * 24;
                const int nrs = nseq * 8, G = gridDim.x;
                if (nseg == 1 && G == 256) {
                    const int b = blockIdx.x;
                    if (b < 128) rwkv_seq(lds, B, rq, L, b >> 3, (b >> 1) & 3, b & 1);
                    else { const int u = b - 128; gla_unit(lds, P, B, segst, layer, L, u >> 3, (u >> 1) & 3, u & 1, 0, false); }
                } else
                for (int rnd = 0; rnd * G < nchain + nrs; ++rnd) {
                    const int it = rnd * G + ((rnd & 1) ? (G - 1 - (int)blockIdx.x) : (int)blockIdx.x);
                    if (it >= nchain + nrs) continue;
                    if (it >= nrs) {
                        const int ci = it - nrs, k = ci % 24, sg = ci / 24, seq = sg / nseg, seg = sg % nseg;
                        if (k < 16) ssd_unit(lds, P, B, segst, layer, L, seq, k >> 1, k & 1, seg, false);
                        else gla_unit(lds, P, B, segst, layer, L, seq, (k - 16) >> 1, k & 1, seg, false);
                    } else { rwkv_seq(lds, B, rq, L, it >> 3, (it >> 1) & 3, it & 1); }
                }
            }
            xcd_barrier(xbar);
            { const MixBufs B = mixbufs(P); phase_post(P, B, layer); }
            xcd_barrier(xbar);
            {
                pg8::Gemm gm; gm.A = (const bf16_t*)(ws + WS_MIX); gm.Bt = (const bf16_t*)(ws + WS_WOUT) + (size_t)layer * DM * DM; gm.M = TG; gm.N = DM; gm.K = DM;
                S.init(TG, DM, gridDim.x, blockIdx.x);
                EpiResid E; E.XB = xb; E.ssp = ssp;
                pg8::gemm_phase(lds, gm, S, E);
            }
            xcd_barrier(xbar);
            {
                pg8::Gemm gm; gm.A = xb; gm.Bt = (const bf16_t*)(ws + WS_WGU) + (size_t)layer * 2 * DFF * DM; gm.M = TG; gm.N = 2 * DFF; gm.K = DM;
                S.init(TG, 2 * DFF, gridDim.x, blockIdx.x);
                EpiGateUp E; E.O = pbuf; E.ssp = ssp;
                pg8::gemm_phase(lds, gm, S, E);
            }
            xcd_barrier(xbar);
            {
                pg8::Gemm gm; gm.A = pbuf; gm.Bt = (const bf16_t*)(ws + WS_WDN) + (size_t)layer * DM * DFF; gm.M = TG; gm.N = DM; gm.K = DFF;
                S.init(TG, DM, gridDim.x, blockIdx.x);
                EpiResid E; E.XB = xb; E.ssp = ssp;
                pg8::gemm_phase(lds, gm, S, E);
            }
            xcd_barrier(xbar);
        }
        phase_final(P, g);
        xcd_barrier(xbar);
    }
}

extern "C" void kernel_launch(void* const* d_in, const int* in_sizes, int n_in, void* d_out, int out_size, void* d_ws, size_t ws_size, hipStream_t stream) {
    static int grid = 0;
    if (grid == 0) {
        if (n_in != 30 || ws_size < WS_END) { fprintf(stderr, "kernel_launch: need 30 inputs and %zu ws bytes; got %d, %zu\n", (size_t)WS_END, n_in, ws_size); grid = -1; return; }
        int dev = 0, cus = 0, per_cu = 0;
        hipGetDevice(&dev);
        hipDeviceGetAttribute(&cus, hipDeviceAttributeMultiprocessorCount, dev);
        hipFuncSetAttribute((const void*)fwd_megakernel, hipFuncAttributeMaxDynamicSharedMemorySize, LDS_BYTES);
        hipOccupancyMaxActiveBlocksPerMultiprocessor(&per_cu, (const void*)fwd_megakernel, 512, LDS_BYTES);
        if (per_cu < 1) per_cu = 1;
        grid = cus * 1;
        if (grid > 256) grid = 256;
    }
    if (grid < 0) return;
    if (hipMemsetAsync((char*)d_ws + WS_CTL, 0, 65536, stream) != hipSuccess) { fprintf(stderr, "memset failed\n"); return; }
    Params p{};
    for (int i = 0; i < 30; ++i) p.in[i] = (const float*)d_in[i];
    p.out = (float*)d_out; p.ws = (unsigned char*)d_ws;
    void* args[] = {&p};
    hipError_t e = hipLaunchCooperativeKernel((const void*)fwd_megakernel, dim3(grid), dim3(512), args, LDS_BYTES, stream);
    if (e != hipSuccess) fprintf(stderr, "cooperative launch failed: %s (grid %d)\n", hipGetErrorString(e), grid);
}
```

```cpp
#include <hip/hip_runtime.h>
#include <hip/hip_cooperative_groups.h>
#include <cstdio>
namespace cg = cooperative_groups;

#define LAS __attribute__((address_space(3)))
typedef unsigned short bf16_t;
typedef short bf16x8 __attribute__((ext_vector_type(8)));
typedef float f32x4 __attribute__((ext_vector_type(4)));
typedef float f32x2 __attribute__((ext_vector_type(2)));
typedef unsigned u32x4 __attribute__((ext_vector_type(4)));
typedef unsigned u32x2 __attribute__((ext_vector_type(2)));

constexpr int DM = 1024, TALL = 98304, TG = 32768, NGROUP = 3;
constexpr int DINP = 3584, DIN = 3504, DFF = 2816;
constexpr int LDS_BYTES = 131072 + 2048;
constexpr float EPS = 1e-6f;
constexpr int PC_GQ = 0, PC_GK = 128, PC_GV = 256, PC_GG = 512, PC_GAF = 768;
constexpr int PC_R = 800, PC_RK = 1056, PC_RV = 1312, PC_RLOW = 1568;
constexpr int PC_Z = 1952, PC_XBC = 2464, PC_DT = 3488;

constexpr size_t WS_CTL = 0;
constexpr size_t WS_SW = 65536;
constexpr int SW_L = 106496;
constexpr size_t WS_WIN = WS_SW + 524288;
constexpr size_t WS_WOUT = WS_WIN + (size_t)2 * DINP * DM * 2;
constexpr size_t WS_WGU = WS_WOUT + (size_t)2 * DM * DM * 2;
constexpr size_t WS_WDN = WS_WGU + (size_t)2 * 2 * DFF * DM * 2;
constexpr size_t WS_XB = WS_WDN + (size_t)2 * DM * DFF * 2;
constexpr size_t WS_P = WS_XB + (size_t)TG * DM * 2;
constexpr size_t WS_MIX = WS_P + (size_t)TG * DINP * 2;
constexpr size_t WS_SSP = WS_MIX + (size_t)TG * DM * 2;
constexpr size_t WS_GLA_LA = WS_SSP + (size_t)TG * 16 * 4;
constexpr size_t WS_GLA_O = WS_GLA_LA + (size_t)2 * TG * 128 * 4;
constexpr size_t WS_RW = WS_GLA_O + (size_t)2 * TG * 256 * 4;
constexpr size_t WS_RW_S = WS_RW + (size_t)10 * TG * 256 * 2;
constexpr size_t WS_RW_Y = WS_RW_S + (size_t)2 * TG * 4 * 4;
constexpr size_t WS_SSD_X = WS_RW_Y + (size_t)2 * TG * 256 * 4;
constexpr size_t WS_SSD_DT = WS_SSD_X + (size_t)TG * 1024 * 2;
constexpr size_t WS_SSD_Y = WS_SSD_DT + (size_t)TG * 16 * 4;
constexpr size_t WS_RWQ = WS_SSD_Y + (size_t)2 * TG * 512 * 4;
constexpr size_t WS_END = WS_RWQ + (size_t)4096 * 3 * 4096 * 2;
static_assert(WS_END <= ((size_t)1 << 30), "workspace over 1 GiB");

struct Params { const float* in[30]; float* out; unsigned char* ws; };

__device__ __forceinline__ int otid() { int t = threadIdx.x; asm volatile("" : "+v"(t)); return t; }
__device__ __forceinline__ float bf2f(bf16_t b) { return __uint_as_float(((unsigned)b) << 16); }
typedef __bf16 bf16x2_t __attribute__((ext_vector_type(2)));
__device__ __forceinline__ unsigned pk2(float lo, float hi) { f32x2 f = {lo, hi}; bf16x2_t v = __builtin_convertvector(f, bf16x2_t); return __builtin_bit_cast(unsigned, v); }
__device__ __forceinline__ unsigned f2bf(float f) { return (unsigned)__builtin_bit_cast(unsigned short, (__bf16)f); }
__device__ __forceinline__ float sigm(float x) { return __builtin_amdgcn_rcpf(1.0f + __expf(-x)); }
__device__ __forceinline__ float silu(float x) { return x * __builtin_amdgcn_rcpf(1.0f + __expf(-x)); }
__device__ __forceinline__ float softplus(float x) { return fmaxf(x, 0.f) + __logf(1.0f + __expf(-fabsf(x))); }
__device__ __forceinline__ void lds_barrier() { asm volatile("s_waitcnt lgkmcnt(0)" ::: "memory"); __builtin_amdgcn_s_barrier(); asm volatile("" ::: "memory"); }

__device__ __forceinline__ float dpp_add(float v, float src_carrier) { return v + src_carrier; }
#define DPPF(x, ctrl, rmask) __int_as_float(__builtin_amdgcn_update_dpp(0, __float_as_int(x), (ctrl), (rmask), 0xf, false))
__device__ __forceinline__ float wave_incl_scan(float v, int lane) {
    v += DPPF(v, 0x111, 0xf);
    v += DPPF(v, 0x112, 0xf);
    v += DPPF(v, 0x114, 0xf);
    v += DPPF(v, 0x118, 0xf);
    v += DPPF(v, 0x142, 0xa);
    v += DPPF(v, 0x143, 0xc);
    return v;
}
__device__ __forceinline__ float lane_bcast(float v, int l) { return __int_as_float(__builtin_amdgcn_readlane(__float_as_int(v), l)); }
__device__ __forceinline__ float wave_sum(float v) { return lane_bcast(wave_incl_scan(v, 0), 63); }
__device__ __forceinline__ void unpack8(u32x4 v, float* f) {
    f[0] = __uint_as_float(v.x << 16); f[1] = __uint_as_float(v.x & 0xffff0000u);
    f[2] = __uint_as_float(v.y << 16); f[3] = __uint_as_float(v.y & 0xffff0000u);
    f[4] = __uint_as_float(v.z << 16); f[5] = __uint_as_float(v.z & 0xffff0000u);
    f[6] = __uint_as_float(v.w << 16); f[7] = __uint_as_float(v.w & 0xffff0000u);
}


#define XB_TMO      128
#define XB_XCNT(j)  (256  + 64 * (j))
#define XB_XSUB(j)  (1280 + 64 * (j))
#define XB_XGEN(j)  (2304 + 64 * (j))
#define XB_TOP      3328
#define XB_TOPGEN   3392
#define XB_SPIN_CAP (1u << 22)
__device__ __forceinline__ unsigned xb_ld(unsigned* p)              { return __hip_atomic_load(p, __ATOMIC_RELAXED, __HIP_MEMORY_SCOPE_AGENT); }
__device__ __forceinline__ unsigned xb_add(unsigned* p, unsigned v) { return __hip_atomic_fetch_add(p, v, __ATOMIC_RELAXED, __HIP_MEMORY_SCOPE_AGENT); }
__device__ __forceinline__ unsigned xb_xcc_id() { return (unsigned)__builtin_amdgcn_s_getreg((3 << 11) | 20) & 0xFu; }
#define XB_SPIN(cond, bar) do { unsigned _sp = 0; while (cond) { __builtin_amdgcn_s_sleep(1); \
    if ((++_sp & 255u) == 0u) { if (xb_ld(&(bar)[XB_TMO])) break; if (_sp > XB_SPIN_CAP) { atomicAdd(&(bar)[XB_TMO], 1u); break; } } } } while (0)
struct XcdBarrier { unsigned* bar; unsigned x; volatile LAS unsigned* st; };
__device__ __forceinline__ XcdBarrier xcd_barrier_post(unsigned* bar, volatile LAS unsigned* st) {
    XcdBarrier b; b.bar = bar; b.x = xb_xcc_id(); b.st = st;
    if (threadIdx.x == 0) (void)xb_add(&bar[XB_XCNT(b.x)], 1u);
    return b;
}
__device__ __forceinline__ void xcd_barrier_complete(unsigned* bar, unsigned x, unsigned& nloc, unsigned& nx) {
    const unsigned G = gridDim.x * gridDim.y * gridDim.z;
    unsigned sum, cnt, mine, sp = 0u;
    for (;;) {
        sum = 0u; cnt = 0u; mine = 0u;
#pragma unroll
        for (unsigned j = 0; j < 16; ++j) { const unsigned c = xb_ld(&bar[XB_XCNT(j)]); sum += c; cnt += (c > 0u) ? 1u : 0u; mine = (j == x) ? c : mine; }
        if (sum == G) break;
        __builtin_amdgcn_s_sleep(1);
        if ((++sp & 255u) == 0u) { if (xb_ld(&bar[XB_TMO])) break; if (sp > XB_SPIN_CAP) { atomicAdd(&bar[XB_TMO], 1u); break; } }
    }
    nloc = mine > 0u ? mine : 1u; nx = cnt > 0u ? cnt : 1u;
}
__device__ __forceinline__ void xcd_barrier(const XcdBarrier& b) {
    asm volatile("s_waitcnt vmcnt(0)" ::: "memory");
    __syncthreads();
    if (threadIdx.x == 0) {
        unsigned* bar = b.bar;
        __builtin_amdgcn_s_waitcnt(0);
        unsigned nloc = b.st[0], nx = b.st[1];
        if (nloc == 0u) { xcd_barrier_complete(bar, b.x, nloc, nx); b.st[0] = nloc; b.st[1] = nx; }
        const unsigned old = xb_add(&bar[XB_XSUB(b.x)], 1u);
        const unsigned gen = old / nloc;
        if (old + 1u == (gen + 1u) * nloc) {
            __builtin_amdgcn_fence(__ATOMIC_RELEASE, "agent");
            asm volatile("s_waitcnt vmcnt(0)" ::: "memory");
            const unsigned og = xb_add(&bar[XB_TOP], 1u);
            const unsigned tg = og / nx;
            if (og + 1u == (tg + 1u) * nx) xb_add(&bar[XB_TOPGEN], 1u);
            else XB_SPIN(xb_ld(&bar[XB_TOPGEN]) == tg, bar);
            __builtin_amdgcn_fence(__ATOMIC_ACQUIRE, "agent");
            xb_add(&bar[XB_XGEN(b.x)], 1u);
            asm volatile("s_waitcnt vmcnt(0)" ::: "memory");
        } else {
            XB_SPIN(xb_ld(&bar[XB_XGEN(b.x)]) == gen, bar);
            __builtin_amdgcn_fence(__ATOMIC_ACQUIRE, "agent");
            asm volatile("s_waitcnt vmcnt(0)" ::: "memory");
        }
    }
    __syncthreads();
}

namespace pg8 {
constexpr int BM = 256, BK = 64, HALF = 128, HTB = HALF * BK * 2, NXCD = 8, WGM = 8;
__device__ __forceinline__ int lds_byte(int r, int c) { const int st = (r >> 4) * 2 + (c >> 5), rr = r & 15, cc = c & 31, ob = rr * 64 + cc * 2; return st * 1024 + (ob ^ (((ob >> 9) & 1) << 5)); }
__device__ __forceinline__ void stage_rc(int b, int& R, int& C) { const int st = b / 1024, sb = b % 1024, swz = sb ^ (((sb >> 9) & 1) << 5); R = (st >> 1) * 16 + swz / 64; C = (st & 1) * 32 + (swz % 64) / 2; }
__device__ __forceinline__ int perm32(int rho) { const int n = rho >> 4, i = rho & 15; return 8 * (i >> 2) + 4 * n + (i & 3); }
struct Unit { int pm, pn; };
struct Gemm { const bf16_t* A; const bf16_t* Bt; int M, N, K; };
struct StaticOrder {
    int nM, nN, nwg, G, c;
    __device__ void init(int M, int N, int G_, int c_) { nM = M / BM; nN = N / BM; nwg = nM * nN; G = G_; c = c_; }
    __device__ bool next(int i, Unit& u) const {
        const long L = (long)i * G + c; if (L >= nwg) return false;
        int wgid = (int)L; { const int q = nwg / NXCD, r = nwg % NXCD, xcd = wgid % NXCD, off = wgid / NXCD; wgid = (xcd < r ? xcd * (q + 1) : r * (q + 1) + (xcd - r) * q) + off; }
        const int nig = WGM * nN, gid = wgid / nig, fm = gid * WGM, gsz = (nM - fm) < WGM ? (nM - fm) : WGM;
        u.pm = fm + ((wgid % nig) % gsz); u.pn = (wgid % nig) / gsz; return true;
    }
};

template <class Epi>
__device__ __forceinline__ void gemm_phase(LAS unsigned char* lds, const Gemm g, const StaticOrder& S, const Epi& E) {
    const int tid = otid(), wid = __builtin_amdgcn_readfirstlane(tid >> 6), lane = tid & 63, wr = wid >> 2, wc = wid & 3, fr = lane & 15, fq = lane >> 4;
    const int K = g.K, nt = K / BK;
    unsigned voffA[2], voffB[2];
#pragma unroll
    for (int i = 0; i < 2; ++i) { int R, C; stage_rc(tid * 16 + i * 8192, R, C); const int Rb = Epi::PERM ? ((R & ~31) + perm32(R & 31)) : R;
        voffA[i] = (unsigned)(R * K + C) * 2u; voffB[i] = (unsigned)(Rb * K + C) * 2u; }
    const size_t kstep = (size_t)(BK * 2);
    const size_t hstep = (size_t)HALF * K * 2;
    const size_t tstep = 2 * hstep;
    const unsigned ldsw = (unsigned)wid * 1024u;
    const int aoff = lds_byte(wr * 64 + fr, fq * 8), boff = lds_byte(wc * 32 + fr, fq * 8);
#define PG8_SA(b, h) (((b) * 2 + (h)) * HTB)
#define PG8_SB(b, h) ((4 + (b) * 2 + (h)) * HTB)
#define PG8_STAGE(bufoff, gbase, voff) do { _Pragma("unroll") for (int _i = 0; _i < 2; ++_i) \
        __builtin_amdgcn_global_load_lds((const unsigned*)((const char*)(gbase) + (voff)[_i]), (LAS unsigned*)(lds + (bufoff) + ldsw + _i * 8192), 16, 0, 0); } while (0)
#define PG8_LDA(dst, b, h) do { _Pragma("unroll") for (int m = 0; m < 4; ++m) _Pragma("unroll") for (int k = 0; k < 2; ++k) dst[m][k] = *(const LAS bf16x8*)(lds + PG8_SA(b, h) + aoff + m * 2048 + k * 1024); } while (0)
#define PG8_LDB(dst, b, h) do { _Pragma("unroll") for (int n = 0; n < 2; ++n) _Pragma("unroll") for (int k = 0; k < 2; ++k) dst[n][k] = *(const LAS bf16x8*)(lds + PG8_SB(b, h) + boff + n * 2048 + k * 1024); } while (0)
#define PG8_MMA(ai, bj, At, Bt) do { __builtin_amdgcn_s_setprio(1); _Pragma("unroll") for (int m = 0; m < 4; ++m) _Pragma("unroll") for (int n = 0; n < 2; ++n) _Pragma("unroll") for (int k = 0; k < 2; ++k) \
        acc[ai][bj][m][n] = __builtin_amdgcn_mfma_f32_16x16x32_bf16(Bt[n][k], At[m][k], acc[ai][bj][m][n], 0, 0, 0); __builtin_amdgcn_s_setprio(0); } while (0)
#define PG8_WAIT_V(n) asm volatile("s_waitcnt vmcnt(" #n ")" ::: "memory")
#define PG8_WAIT_L(n) asm volatile("s_waitcnt lgkmcnt(" #n ")" ::: "memory")
#define PG8_BAR __builtin_amdgcn_s_barrier()
#define PG8_SCHED __builtin_amdgcn_sched_barrier(0)
    Unit cur, nxt; int ui = 0;
    if (!S.next(0, cur)) return;
    f32x4 acc[2][2][4][2];
#pragma unroll
    for (int a = 0; a < 2; ++a)
#pragma unroll
        for (int b = 0; b < 2; ++b)
#pragma unroll
            for (int m = 0; m < 4; ++m)
#pragma unroll
                for (int n = 0; n < 2; ++n) acc[a][b][m][n] = (f32x4){0.f, 0.f, 0.f, 0.f};
    bf16x8 At[4][2], B0[2][2], B1[2][2];
    const char* cA = (const char*)g.A + (size_t)cur.pm * tstep; const char* cB = (const char*)g.Bt + (size_t)cur.pn * tstep;
    PG8_STAGE(PG8_SB(0, 0), cB, voffB); PG8_STAGE(PG8_SA(0, 0), cA, voffA); PG8_STAGE(PG8_SB(0, 1), cB + hstep, voffB); PG8_STAGE(PG8_SA(0, 1), cA + hstep, voffA);
    if (wr == 1) PG8_BAR;
    PG8_WAIT_V(4); PG8_BAR;
    PG8_STAGE(PG8_SB(1, 0), cB + kstep, voffB); PG8_STAGE(PG8_SA(1, 0), cA + kstep, voffA); PG8_STAGE(PG8_SB(1, 1), cB + hstep + kstep, voffB);
    PG8_WAIT_V(6); PG8_BAR;
    for (;;) {
        const bool has_next = S.next(ui + 1, nxt);
        const char* nA = has_next ? (const char*)g.A + (size_t)nxt.pm * tstep : cA; const char* nB = has_next ? (const char*)g.Bt + (size_t)nxt.pn * tstep : cB;
        for (int t = 0; t < nt; t += 2) {
            const bool last = (t == nt - 2);
            const char* a1 = cA + (size_t)(t + 1) * kstep;
            const char* a2 = last ? nA : cA + (size_t)(t + 2) * kstep; const char* b2 = last ? nB : cB + (size_t)(t + 2) * kstep;
            const char* a3 = a2 + kstep; const char* b3 = b2 + kstep;
            PG8_LDB(B0, 0, 0); PG8_SCHED; PG8_LDA(At, 0, 0); PG8_STAGE(PG8_SA(1, 1), a1 + hstep, voffA);
            PG8_WAIT_L(8); PG8_BAR; PG8_WAIT_L(0); PG8_MMA(0, 0, At, B0); PG8_BAR; PG8_SCHED;
            PG8_LDB(B1, 0, 1); PG8_STAGE(PG8_SB(0, 0), b2, voffB);
            PG8_BAR; PG8_WAIT_L(0); PG8_MMA(0, 1, At, B1); PG8_BAR;
            PG8_LDA(At, 0, 1); PG8_STAGE(PG8_SA(0, 0), a2, voffA);
            PG8_BAR; PG8_WAIT_L(0); PG8_MMA(1, 0, At, B0); PG8_BAR; PG8_SCHED;
            PG8_STAGE(PG8_SB(0, 1), b2 + hstep, voffB);
            PG8_WAIT_V(6); PG8_BAR; PG8_MMA(1, 1, At, B1); PG8_BAR;
            PG8_LDB(B0, 1, 0); PG8_SCHED; PG8_LDA(At, 1, 0); PG8_STAGE(PG8_SA(0, 1), a2 + hstep, voffA);
            PG8_WAIT_L(8); PG8_BAR; PG8_WAIT_L(0); PG8_MMA(0, 0, At, B0); PG8_BAR; PG8_SCHED;
            PG8_LDB(B1, 1, 1); PG8_STAGE(PG8_SB(1, 0), b3, voffB);
            PG8_BAR; PG8_WAIT_L(0); PG8_MMA(0, 1, At, B1); PG8_BAR;
            PG8_LDA(At, 1, 1); PG8_STAGE(PG8_SA(1, 0), a3, voffA);
            PG8_BAR; PG8_WAIT_L(0); PG8_MMA(1, 0, At, B0); PG8_BAR; PG8_SCHED;
            PG8_STAGE(PG8_SB(1, 1), b3 + hstep, voffB);
            PG8_WAIT_V(6); PG8_BAR; PG8_MMA(1, 1, At, B1); PG8_BAR;
        }
        E(acc, cur, wr, wc, fr, fq);
        if (!has_next) break;
#pragma unroll
        for (int a = 0; a < 2; ++a)
#pragma unroll
            for (int b = 0; b < 2; ++b)
#pragma unroll
                for (int m = 0; m < 4; ++m)
#pragma unroll
                    for (int n = 0; n < 2; ++n) acc[a][b][m][n] = (f32x4){0.f, 0.f, 0.f, 0.f};
        cur = nxt; cA = nA; cB = nB; ++ui;
    }
    PG8_WAIT_V(0);
    if (wr == 0) PG8_BAR;
    PG8_BAR;
#undef PG8_SA
#undef PG8_SB
#undef PG8_STAGE
#undef PG8_LDA
#undef PG8_LDB
#undef PG8_MMA
#undef PG8_WAIT_V
#undef PG8_WAIT_L
#undef PG8_BAR
#undef PG8_SCHED
}
}

__device__ __forceinline__ float row_rs(const float* ssp, int row) {
    const f32x4* p = (const f32x4*)(ssp + (size_t)row * 16);
    f32x4 a = p[0], b = p[1], c = p[2], d = p[3];
    float s = (a[0] + a[1] + a[2] + a[3]) + (b[0] + b[1] + b[2] + b[3]) + (c[0] + c[1] + c[2] + c[3]) + (d[0] + d[1] + d[2] + d[3]);
    return rsqrtf(s * (1.0f / 1024.0f) + EPS);
}

__device__ __forceinline__ f32x4 rs_part(const float* ssp, int row, int fq) { return *(const f32x4*)(ssp + (size_t)row * 16 + fq * 4); }
__device__ __forceinline__ float rs_fin(f32x4 a) { float s = (a[0] + a[1]) + (a[2] + a[3]); s += __shfl_xor(s, 16); s += __shfl_xor(s, 32); return rsqrtf(s * (1.0f / 1024.0f) + EPS); }
struct EpiInproj {
    static constexpr bool PERM = true;
    bf16_t* O; const float* ssp;
    __device__ __forceinline__ void operator()(const f32x4 (&acc)[2][2][4][2], const pg8::Unit& u, int wr, int wc, int fr, int fq) const {
        const int row0 = u.pm * 256 + wr * 64 + fr, col0 = u.pn * 256 + wc * 32 + 8 * fq;
        f32x4 rp[2][4];
#pragma unroll
        for (int ai = 0; ai < 2; ++ai)
#pragma unroll
            for (int m = 0; m < 4; ++m) rp[ai][m] = rs_part(ssp, row0 + ai * 128 + m * 16, fq);
#pragma unroll
        for (int ai = 0; ai < 2; ++ai)
#pragma unroll
            for (int m = 0; m < 4; ++m) {
                const int row = row0 + ai * 128 + m * 16; const float rs = rs_fin(rp[ai][m]);
                bf16_t* rowp = O + (size_t)row * DINP + col0;
#pragma unroll
                for (int bj = 0; bj < 2; ++bj) { f32x4 v0 = acc[ai][bj][m][0] * rs, v1 = acc[ai][bj][m][1] * rs;
                    u32x4 w; w.x = pk2(v0[0], v0[1]); w.y = pk2(v0[2], v0[3]); w.z = pk2(v1[0], v1[1]); w.w = pk2(v1[2], v1[3]);
                    __builtin_nontemporal_store(w, (u32x4*)(rowp + bj * 128)); }
            }
    }
};
struct EpiGateUp {
    static constexpr bool PERM = true;
    bf16_t* O; const float* ssp;
    __device__ __forceinline__ void operator()(const f32x4 (&acc)[2][2][4][2], const pg8::Unit& u, int wr, int wc, int fr, int fq) const {
        const int row0 = u.pm * 256 + wr * 64 + fr, col0 = u.pn * 128 + wc * 32 + 8 * fq;
        f32x4 rp[2][4];
#pragma unroll
        for (int ai = 0; ai < 2; ++ai)
#pragma unroll
            for (int m = 0; m < 4; ++m) rp[ai][m] = rs_part(ssp, row0 + ai * 128 + m * 16, fq);
#pragma unroll
        for (int ai = 0; ai < 2; ++ai)
#pragma unroll
            for (int m = 0; m < 4; ++m) {
                const int row = row0 + ai * 128 + m * 16; const float rs = rs_fin(rp[ai][m]);
                float h[8];
#pragma unroll
                for (int n = 0; n < 2; ++n)
#pragma unroll
                    for (int j = 0; j < 4; ++j) h[n * 4 + j] = silu(acc[ai][0][m][n][j] * rs) * (acc[ai][1][m][n][j] * rs);
                u32x4 w; w.x = pk2(h[0], h[1]); w.y = pk2(h[2], h[3]); w.z = pk2(h[4], h[5]); w.w = pk2(h[6], h[7]);
                __builtin_nontemporal_store(w, (u32x4*)(O + (size_t)row * DFF + col0));
            }
    }
};
struct EpiResid {
    static constexpr bool PERM = true;
    bf16_t* XB; float* ssp;
    __device__ __forceinline__ void operator()(const f32x4 (&acc)[2][2][4][2], const pg8::Unit& u, int wr, int wc, int fr, int fq) const {
        const int row0 = u.pm * 256 + wr * 64 + fr, col0 = u.pn * 256 + wc * 32 + 8 * fq;
        u32x4 xnx[2];
        { const bf16_t* xr0 = XB + (size_t)row0 * DM + col0; xnx[0] = *(const u32x4*)xr0; xnx[1] = *(const u32x4*)(xr0 + 128); }
#pragma unroll
        for (int ai = 0; ai < 2; ++ai)
#pragma unroll
            for (int m = 0; m < 4; ++m) {
                const int row = row0 + ai * 128 + m * 16;
                bf16_t* br = XB + (size_t)row * DM + col0;
                const u32x4 xc0 = xnx[0], xc1 = xnx[1];
                if (ai * 4 + m < 7) { const int idx = ai * 4 + m + 1; const bf16_t* xrn = XB + (size_t)(row0 + (idx >> 2) * 128 + (idx & 3) * 16) * DM + col0;
                    xnx[0] = *(const u32x4*)xrn; xnx[1] = *(const u32x4*)(xrn + 128); }
                float ss = 0.f;
#pragma unroll
                for (int bj = 0; bj < 2; ++bj) {
                    float xo[8]; unpack8(bj == 0 ? xc0 : xc1, xo);
                    const f32x4 a0 = acc[ai][bj][m][0], a1 = acc[ai][bj][m][1];
                    float v[8];
#pragma unroll
                    for (int j = 0; j < 4; ++j) { v[j] = xo[j] + a0[j]; v[4 + j] = xo[4 + j] + a1[j]; }
#pragma unroll
                    for (int j = 0; j < 8; ++j) ss += v[j] * v[j];
                    u32x4 w; w.x = pk2(v[0], v[1]); w.y = pk2(v[2], v[3]); w.z = pk2(v[4], v[5]); w.w = pk2(v[6], v[7]);
                    *(u32x4*)(br + bj * 128) = w;
                }
                ss += __shfl_xor(ss, 16); ss += __shfl_xor(ss, 32);
                if (fq == 0) ssp[(size_t)row * 16 + u.pn * 4 + wc] = ss;
                asm volatile("" ::: "memory");
            }
    }
};

__device__ __forceinline__ void wtile(LAS float* tile, const float* src, int lds_src, const float* gain, bf16_t* dst, int K, int n0, int k0, int c0, int nvalid) {
    const int tid = otid();
    __syncthreads();
#pragma unroll
    for (int i = 0; i < 8; ++i) {
        const int kk = (tid >> 6) + 8 * i, c = tid & 63;
        float v = 0.f;
        if (c0 + c < nvalid) { v = src[(size_t)(k0 + kk) * lds_src + c0 + c]; if (gain) v *= gain[k0 + kk]; }
        tile[kk * 65 + c] = v;
    }
    __syncthreads();
    const int n = tid >> 3, kc = (tid & 7) * 8;
    float f[8];
#pragma unroll
    for (int j = 0; j < 8; ++j) f[j] = tile[(kc + j) * 65 + n];
    u32x4 w; w.x = pk2(f[0], f[1]); w.y = pk2(f[2], f[3]); w.z = pk2(f[4], f[5]); w.w = pk2(f[6], f[7]);
    *(u32x4*)(dst + (size_t)(n0 + n) * K + k0 + kc) = w;
}
__device__ __forceinline__ void phase_weights(LAS unsigned char* lds, const Params& P) {
    LAS float* tile = (LAS float*)lds;
    unsigned char* ws = P.ws;
    constexpr int T_IN = 56 * 16, T_OUT = 16 * 16, T_GU = 88 * 16, T_DN = 16 * 44, T_L = T_IN + T_OUT + T_GU + T_DN;
    for (int t = blockIdx.x; t < 2 * 24; t += gridDim.x) {
        const int l = t / 24, idx = t % 24; bf16_t* sw = (bf16_t*)(ws + WS_SW) + (size_t)l * SW_L;
        if (idx < 16) { const int m = idx >> 2, nb = idx & 3, d = m & 1;
            const float* src = (m < 2 ? P.in[10] : P.in[12]) + (size_t)(l * 2 + d) * 64 * 256;
            wtile(tile, src, 256, nullptr, sw + m * 16384, 64, nb * 64, 0, nb * 64, 256);
        } else { const int nb = (idx - 16) >> 1, kb = (idx - 16) & 1;
            wtile(tile, P.in[13] + (size_t)l * 128 * 256, 256, nullptr, sw + 65536, 128, nb * 64, kb * 64, nb * 64, 256); }
    }
    for (int i = blockIdx.x * 512 + threadIdx.x; i < 2 * 8192; i += gridDim.x * 512) {
        const int l = i >> 13, rem = i & 8191, d = rem >> 12, c = (rem & 4095) >> 5, k = rem & 31;
        const float v = ((k >> 4) == d) ? P.in[5][((size_t)(l * 2 + d) * 16 + (k & 15)) * 128 + c] : 0.f;
        ((bf16_t*)(ws + WS_SW))[(size_t)l * SW_L + 98304 + rem] = (bf16_t)f2bf(v);
    }
    for (int t = blockIdx.x; t < 2 * T_L; t += gridDim.x) {
        const int l = t / T_L; int r = t % T_L;
        if (r < T_IN) { const int nb = r / 16, kb = r % 16;
            wtile(tile, P.in[3] + (size_t)l * DM * DIN, DIN, P.in[2] + l * DM, (bf16_t*)(ws + WS_WIN) + (size_t)l * DINP * DM, DM, nb * 64, kb * 64, nb * 64, DIN);
        } else if ((r -= T_IN) < T_OUT) { const int nb = r / 16, kb = r % 16;
            wtile(tile, P.in[4] + (size_t)l * DM * DM, DM, nullptr, (bf16_t*)(ws + WS_WOUT) + (size_t)l * DM * DM, DM, nb * 64, kb * 64, nb * 64, DM);
        } else if ((r -= T_OUT) < T_GU) { const int nb = r / 16, kb = r % 16;
            const int j = nb >> 2, qd = nb & 3; const float* src = (qd < 2 ? P.in[26] : P.in[27]) + (size_t)l * DM * DFF;
            wtile(tile, src, DFF, P.in[25] + l * DM, (bf16_t*)(ws + WS_WGU) + (size_t)l * 2 * DFF * DM, DM, nb * 64, kb * 64, j * 128 + (qd & 1) * 64, DFF);
        } else { r -= T_GU; const int nb = r / 44, kb = r % 44;
            wtile(tile, P.in[28] + (size_t)l * DFF * DM, DM, nullptr, (bf16_t*)(ws + WS_WDN) + (size_t)l * DM * DFF, DFF, nb * 64, kb * 64, nb * 64, DM);
        }
    }
}

__device__ __forceinline__ void phase_xprep(const Params& P, int g) {
    const float* xin = (g < 2) ? P.in[0] + (size_t)g * TG * DM : P.in[1];
    bf16_t* xb = (bf16_t*)(P.ws + WS_XB); float* ssp = (float*)(P.ws + WS_SSP);
    const int tid_ = otid(); const int lane = tid_ & 63, gw = blockIdx.x * 8 + (tid_ >> 6), nw = gridDim.x * 8;
    for (int row = gw; row < TG; row += nw) {
        float ss = 0.f;
#pragma unroll
        for (int i = 0; i < 4; ++i) {
            const int c = i * 256 + lane * 4;
            f32x4 v = *(const f32x4*)(xin + (size_t)row * DM + c);
            u32x2 w; w.x = pk2(v[0], v[1]); w.y = pk2(v[2], v[3]);
            *(u32x2*)(xb + (size_t)row * DM + c) = w;
            ss += (v[0] * v[0] + v[1] * v[1]) + (v[2] * v[2] + v[3] * v[3]);
        }
        ss = wave_sum(ss);
        if (lane < 16) ssp[(size_t)row * 16 + lane] = (lane == 0) ? ss : 0.f;
    }
}
__device__ __forceinline__ void phase_final(const Params& P, int g) {
    float* xo = P.out + (size_t)g * TG * DM; const bf16_t* xb = (const bf16_t*)(P.ws + WS_XB); const float* ssp = (const float*)(P.ws + WS_SSP); const float* gn = P.in[29];
    const int tid_ = otid(); const int lane = tid_ & 63, gw = blockIdx.x * 8 + (tid_ >> 6), nw = gridDim.x * 8;
    for (int row = gw; row < TG; row += nw) {
        const float rs = row_rs(ssp, row);
#pragma unroll
        for (int i = 0; i < 2; ++i) {
            const int c = i * 512 + lane * 8;
            float v[8]; unpack8(*(const u32x4*)(xb + (size_t)row * DM + c), v);
            const f32x4 g0 = *(const f32x4*)(gn + c), g1 = *(const f32x4*)(gn + c + 4);
            *(f32x4*)(xo + (size_t)row * DM + c) = (f32x4){v[0] * rs * g0[0], v[1] * rs * g0[1], v[2] * rs * g0[2], v[3] * rs * g0[3]};
            *(f32x4*)(xo + (size_t)row * DM + c + 4) = (f32x4){v[4] * rs * g1[0], v[5] * rs * g1[1], v[6] * rs * g1[2], v[7] * rs * g1[3]};
        }
    }
}

struct MixBufs {
    const bf16_t* p; float* gla_la; bf16_t* gla_o; bf16_t* rw; float* rw_s; bf16_t* rw_y; bf16_t* ssd_x; float* ssd_dt; bf16_t* ssd_y; bf16_t* mix;
};
__device__ __forceinline__ MixBufs mixbufs(const Params& P) {
    MixBufs B; unsigned char* ws = P.ws;
    B.p = (const bf16_t*)(ws + WS_P); B.gla_la = (float*)(ws + WS_GLA_LA); B.gla_o = (bf16_t*)(ws + WS_GLA_O); B.rw = (bf16_t*)(ws + WS_RW);
    B.rw_s = (float*)(ws + WS_RW_S); B.rw_y = (bf16_t*)(ws + WS_RW_Y); B.ssd_x = (bf16_t*)(ws + WS_SSD_X); B.ssd_dt = (float*)(ws + WS_SSD_DT);
    B.ssd_y = (bf16_t*)(ws + WS_SSD_Y); B.mix = (bf16_t*)(ws + WS_MIX); return B;
}
constexpr size_t RWA = (size_t)TG * 256;

__device__ __forceinline__ void prep_tile(LAS unsigned char* lds, const Params& P, const MixBufs& B, int layer, int L, int tile) {
    const int tid = otid(), lane = tid & 63;
    const int t0 = tile * 32;
    LAS float* lin = (LAS float*)lds;
    LAS float* gin = (LAS float*)(lds + 49152);
    const bf16_t* p = B.p;
    const float* mu = P.in[8] + layer * 1152;
    __syncthreads();
    for (int idx = tid; idx < 32 * 384; idx += 512) {
        const int t = idx / 384, cc = idx % 384, tl = t0 + t, pos = tl % L, col = PC_RLOW + cc;
        const float cur = bf2f(p[(size_t)tl * DINP + col]);
        const float prv = pos > 0 ? bf2f(p[(size_t)(tl - 1) * DINP + col]) : 0.f;
        const float nxt = pos < L - 1 ? bf2f(p[(size_t)(tl + 1) * DINP + col]) : 0.f;
        float v = cur + mu[col - PC_R] * (0.5f * (prv + nxt) - cur);
        if (cc < 128) { const float e = __expf(2.f * v); v = 1.f - 2.f / (e + 1.f); }
        else if (cc >= 256) v = sigm(v);
        lin[t * 384 + cc] = v;
    }
    for (int idx = tid; idx < 32 * 32; idx += 512) { const int t = idx >> 5, j = idx & 31; gin[idx] = bf2f(p[(size_t)(t0 + t) * DINP + PC_GAF + j]); }
    __syncthreads();
#pragma unroll 1
    for (int i = 0; i < 8; ++i) {
        const int idx = tid + 512 * i, t = idx >> 7, c0 = (idx & 127) * 8, tl = t0 + t, pos = tl % L;
        float acc[8];
        { const f32x4 b0 = *(const f32x4*)(P.in[20] + layer * 1024 + c0), b1 = *(const f32x4*)(P.in[20] + layer * 1024 + c0 + 4);
          acc[0] = b0[0]; acc[1] = b0[1]; acc[2] = b0[2]; acc[3] = b0[3]; acc[4] = b1[0]; acc[5] = b1[1]; acc[6] = b1[2]; acc[7] = b1[3]; }
#pragma unroll
        for (int tap = 0; tap < 5; ++tap) {
            const int pp = pos + tap - 2;
            if (pp >= 0 && pp < L) {
                float x[8]; unpack8(*(const u32x4*)(p + (size_t)(tl + tap - 2) * DINP + PC_XBC + c0), x);
                const float* w = P.in[19] + (size_t)(layer * 5 + tap) * 1024 + c0;
                const f32x4 w0 = *(const f32x4*)w, w1 = *(const f32x4*)(w + 4);
                acc[0] += w0[0] * x[0]; acc[1] += w0[1] * x[1]; acc[2] += w0[2] * x[2]; acc[3] += w0[3] * x[3];
                acc[4] += w1[0] * x[4]; acc[5] += w1[1] * x[5]; acc[6] += w1[2] * x[6]; acc[7] += w1[3] * x[7];
            }
        }
        u32x4 o; o.x = pk2(silu(acc[0]), silu(acc[1])); o.y = pk2(silu(acc[2]), silu(acc[3])); o.z = pk2(silu(acc[4]), silu(acc[5])); o.w = pk2(silu(acc[6]), silu(acc[7]));
        *(u32x4*)(B.ssd_x + (size_t)tl * 1024 + c0) = o;
    }
    { const int t = tid >> 4, j = tid & 15, tl = t0 + t;
      B.ssd_dt[(size_t)tl * 16 + j] = softplus(bf2f(p[(size_t)tl * DINP + PC_DT + j]) + P.in[21][layer * 16 + j]); }
    if (tid < 256) {
        const int d = tid >> 7, c = tid & 127;
        float ac[16];
#pragma unroll
        for (int j = 0; j < 16; ++j) ac[j] = P.in[5][((size_t)(layer * 2 + d) * 16 + j) * 128 + c];
        const float bias = P.in[6][(layer * 2 + d) * 128 + c];
#pragma unroll 4
        for (int t = 0; t < 32; ++t) {
            float a = bias;
#pragma unroll
            for (int j = 0; j < 16; ++j) a += gin[t * 32 + d * 16 + j] * ac[j];
            B.gla_la[((size_t)d * TG + t0 + t) * 128 + c] = -softplus(-a) * (1.0f / 16.0f);
        }
    }
    asm volatile("" ::: "memory");
    {
        const int h2 = __builtin_amdgcn_readfirstlane(tid >> 8), c = tid & 255, head = c >> 6;
        float wcol[64];
        const float kkc = P.in[14][layer * 256 + c], kac = P.in[15][layer * 256 + c], rkc = P.in[16][layer * 256 + c];
        const float mur = mu[c], muk = mu[256 + c], muv = mu[512 + c];
        {
            { const float* wsrc = P.in[10] + (size_t)(layer * 2 + h2) * 64 * 256;
#pragma unroll
            for (int k = 0; k < 64; ++k) wcol[k] = wsrc[k * 256 + c]; }
            const float w0c = P.in[9][(layer * 2 + h2) * 256 + c];
#pragma unroll 1
            for (int t = 0; t < 32; ++t) {
                float aw = w0c;
                const LAS f32x4* lw = (const LAS f32x4*)(lin + t * 384 + h2 * 64);
#pragma unroll
                for (int k4 = 0; k4 < 16; ++k4) { const f32x4 x = lw[k4];
                    aw += x[0] * wcol[k4 * 4] + x[1] * wcol[k4 * 4 + 1] + x[2] * wcol[k4 * 4 + 2] + x[3] * wcol[k4 * 4 + 3]; }
                B.rw[(4 + h2) * RWA + (size_t)(t0 + t) * 256 + c] = (bf16_t)f2bf(sigm(aw) * 0.60653066f);
            }
        }
        asm volatile("" ::: "memory");
        {
            { const float* wsrc = P.in[12] + (size_t)(layer * 2 + h2) * 64 * 256;
#pragma unroll
            for (int k = 0; k < 64; ++k) wcol[k] = wsrc[k * 256 + c]; }
            const float a0c = P.in[11][(layer * 2 + h2) * 256 + c];
#pragma unroll 1
            for (int t = 0; t < 32; ++t) {
                const int tl = t0 + t, pos = tl % L;
                const bf16_t* pc = p + (size_t)tl * DINP;
                const bool hp = pos > 0, hn = pos < L - 1;
                const float rc = bf2f(pc[PC_R + c]), kc = bf2f(pc[PC_RK + c]), vc = bf2f(pc[PC_RV + c]);
                const float rp = hp ? bf2f(pc[PC_R + c - DINP]) : 0.f, kp = hp ? bf2f(pc[PC_RK + c - DINP]) : 0.f, vp = hp ? bf2f(pc[PC_RV + c - DINP]) : 0.f;
                const float rn = hn ? bf2f(pc[PC_R + c + DINP]) : 0.f, kn = hn ? bf2f(pc[PC_RK + c + DINP]) : 0.f, vn = hn ? bf2f(pc[PC_RV + c + DINP]) : 0.f;
                const float r = rc + mur * (0.5f * (rp + rn) - rc), k = kc + muk * (0.5f * (kp + kn) - kc), v = vc + muv * (0.5f * (vp + vn) - vc);
                float aa = a0c;
                const LAS f32x4* la = (const LAS f32x4*)(lin + t * 384 + 128 + h2 * 64);
#pragma unroll
                for (int k4 = 0; k4 < 16; ++k4) { const f32x4 y = la[k4];
                    aa += y[0] * wcol[k4 * 4] + y[1] * wcol[k4 * 4 + 1] + y[2] * wcol[k4 * 4 + 2] + y[3] * wcol[k4 * 4 + 3]; }
                const float asg = sigm(aa);
                const float kr = k * kkc; const float kk = kr * rsqrtf(wave_sum(kr * kr) + 1e-12f);
                const float kd = k * (1.f + (asg - 1.f) * kac), bb = kk * asg;
                const size_t o = (size_t)tl * 256 + c;
                B.rw[(6 + h2) * RWA + o] = (bf16_t)f2bf(kd); B.rw[(8 + h2) * RWA + o] = (bf16_t)f2bf(bb);
                if (h2 == 0) {
                    B.rw[0 * RWA + o] = (bf16_t)f2bf(r); B.rw[1 * RWA + o] = (bf16_t)f2bf(v); B.rw[2 * RWA + o] = (bf16_t)f2bf(kk);
                    const float s = wave_sum(r * k * rkc); if (lane == 0) B.rw_s[(size_t)tl * 4 + head] = s;
                } else {
                    const float s = wave_sum(bf2f((bf16_t)f2bf(kd)) * bf2f((bf16_t)f2bf(r))); if (lane == 0) B.rw_s[(size_t)TG * 4 + (size_t)tl * 4 + head] = s;
                }
            }
        }
        asm volatile("" ::: "memory");
        float ga[16];
#pragma unroll
        for (int i = 0; i < 16; ++i) ga[i] = 0.f;
#pragma unroll 1
        for (int sub = 0; sub < 2; ++sub) {
            asm volatile("" ::: "memory");
            { const float* wsrc = P.in[13] + (size_t)(layer * 128 + sub * 64) * 256;
#pragma unroll
            for (int k = 0; k < 64; ++k) wcol[k] = wsrc[k * 256 + c]; }
#pragma unroll
            for (int tt = 0; tt < 16; ++tt) {
                const LAS f32x4* lg = (const LAS f32x4*)(lin + (h2 * 16 + tt) * 384 + 256 + sub * 64);
                float a = ga[tt];
#pragma unroll
                for (int k4 = 0; k4 < 16; ++k4) { const f32x4 x = lg[k4]; a += x[0] * wcol[k4 * 4] + x[1] * wcol[k4 * 4 + 1] + x[2] * wcol[k4 * 4 + 2] + x[3] * wcol[k4 * 4 + 3]; }
                ga[tt] = a;
            }
        }
#pragma unroll
        for (int tt = 0; tt < 16; ++tt) B.rw[3 * RWA + (size_t)(t0 + h2 * 16 + tt) * 256 + c] = (bf16_t)f2bf(ga[tt]);
    }
}

__device__ __forceinline__ f32x4 mfma16(bf16x8 a, bf16x8 b, f32x4 c) { return __builtin_amdgcn_mfma_f32_16x16x32_bf16(a, b, c, 0, 0, 0); }
__device__ __forceinline__ void prep_tile64(LAS unsigned char* lds, const Params& P, const MixBufs& B, const bf16_t* sw, int layer, int L, int tile) {
    const int tid = otid(), w = tid >> 6, lane = tid & 63, r = lane & 15, q = lane >> 4;
    const int t0 = tile * 64;
    constexpr int LL = 392, LA = 264;
    LAS bf16_t* lin = (LAS bf16_t*)lds;
    LAS bf16_t* gin = (LAS bf16_t*)(lds + 50176);
    LAS bf16_t* AS = (LAS bf16_t*)(lds + 55296);
    const bf16_t* p = B.p;
    const float* mu = P.in[8] + layer * 1152;
    __syncthreads();
#pragma unroll 3
    for (int i6 = 0; i6 < 6; ++i6) {
        const int it = tid + 512 * i6;
        const int t = it / 48, cg8 = it % 48, tl = t0 + t, pos = tl % L, col = PC_RLOW + cg8 * 8;
        float cur[8], prv[8], nxt[8], v[8];
        unpack8(*(const u32x4*)(p + (size_t)tl * DINP + col), cur);
        if (pos > 0) unpack8(*(const u32x4*)(p + (size_t)(tl - 1) * DINP + col), prv); else {
#pragma unroll
            for (int j = 0; j < 8; ++j) prv[j] = 0.f; }
        if (pos < L - 1) unpack8(*(const u32x4*)(p + (size_t)(tl + 1) * DINP + col), nxt); else {
#pragma unroll
            for (int j = 0; j < 8; ++j) nxt[j] = 0.f; }
        const f32x4 m0 = *(const f32x4*)(mu + col - PC_R), m1 = *(const f32x4*)(mu + col - PC_R + 4);
#pragma unroll
        for (int j = 0; j < 8; ++j) { const float m = j < 4 ? m0[j] : m1[j - 4]; v[j] = cur[j] + m * (0.5f * (prv[j] + nxt[j]) - cur[j]); }
        if (cg8 < 16) {
#pragma unroll
            for (int j = 0; j < 8; ++j) { const float e = __expf(2.f * v[j]); v[j] = 1.f - 2.f * __builtin_amdgcn_rcpf(e + 1.f); }
        } else if (cg8 >= 32) {
#pragma unroll
            for (int j = 0; j < 8; ++j) v[j] = sigm(v[j]);
        }
        u32x4 o; o.x = pk2(v[0], v[1]); o.y = pk2(v[2], v[3]); o.z = pk2(v[4], v[5]); o.w = pk2(v[6], v[7]);
        *(LAS u32x4*)(lin + t * LL + cg8 * 8) = o;
    }
    if (tid < 256) { const int t = tid >> 2, g4 = tid & 3; *(LAS u32x4*)(gin + t * 40 + g4 * 8) = *(const u32x4*)(p + (size_t)(t0 + t) * DINP + PC_GAF + g4 * 8); }
    __syncthreads();
#pragma unroll 1
    for (int d = 0; d < 2; ++d)
#pragma unroll 1
        for (int tt = 0; tt < 2; ++tt) {
            const int tn = 2 * w + tt, c = tn * 16 + r;
            const float a0c = P.in[11][(layer * 2 + d) * 256 + c];
            const bf16_t* wb = sw + 32768 + d * 16384 + (size_t)(tn * 16 + r) * 64 + q * 8;
            const bf16x8 b0 = *(const bf16x8*)wb, b1 = *(const bf16x8*)(wb + 32);
#pragma unroll
            for (int tm = 0; tm < 4; ++tm) {
                const LAS bf16_t* ap = lin + (tm * 16 + r) * LL + 128 + d * 64 + q * 8;
                f32x4 acc = (f32x4){0.f, 0.f, 0.f, 0.f};
                acc = mfma16(*(const LAS bf16x8*)ap, b0, acc); acc = mfma16(*(const LAS bf16x8*)(ap + 32), b1, acc);
#pragma unroll
                for (int jj = 0; jj < 4; ++jj) AS[(d * 64 + tm * 16 + q * 4 + jj) * LA + c] = (bf16_t)f2bf(sigm(a0c + acc[jj]));
            }
        }
    __syncthreads();
    {
        const int c0 = (tid & 31) * 8, head = (tid & 31) >> 3;
        float mr_[8], mk_[8], mv_[8], kkc[8], kac[8], rkc[8];
#define LD8F(dst, ptr) do { const f32x4 a_ = *(const f32x4*)(ptr), b_ = *(const f32x4*)((ptr) + 4); dst[0] = a_[0]; dst[1] = a_[1]; dst[2] = a_[2]; dst[3] = a_[3]; dst[4] = b_[0]; dst[5] = b_[1]; dst[6] = b_[2]; dst[7] = b_[3]; } while (0)
        LD8F(mr_, mu + c0); LD8F(mk_, mu + 256 + c0); LD8F(mv_, mu + 512 + c0);
        LD8F(kkc, P.in[14] + layer * 256 + c0); LD8F(kac, P.in[15] + layer * 256 + c0); LD8F(rkc, P.in[16] + layer * 256 + c0);
#undef LD8F
        u32x4 nx[9], cu[9];
        const u32x4 Z = (u32x4){0u, 0u, 0u, 0u};
#define EL_LOAD(dst, ii) do { const int t_ = (tid + 512 * (ii)) >> 5, tl_ = t0 + t_, pos_ = tl_ % L; const bf16_t* pc_ = p + (size_t)tl_ * DINP + c0; \
            const bool hp_ = pos_ > 0, hn_ = pos_ < L - 1; \
            dst[0] = *(const u32x4*)(pc_ + PC_R); dst[1] = *(const u32x4*)(pc_ + PC_RK); dst[2] = *(const u32x4*)(pc_ + PC_RV); \
            dst[3] = hp_ ? *(const u32x4*)(pc_ + PC_R - DINP) : Z; dst[4] = hp_ ? *(const u32x4*)(pc_ + PC_RK - DINP) : Z; dst[5] = hp_ ? *(const u32x4*)(pc_ + PC_RV - DINP) : Z; \
            dst[6] = hn_ ? *(const u32x4*)(pc_ + PC_R + DINP) : Z; dst[7] = hn_ ? *(const u32x4*)(pc_ + PC_RK + DINP) : Z; dst[8] = hn_ ? *(const u32x4*)(pc_ + PC_RV + DINP) : Z; } while (0)
        EL_LOAD(nx, 0);
#pragma unroll 1
        for (int i = 0; i < 4; ++i) {
#pragma unroll
            for (int e = 0; e < 9; ++e) cu[e] = nx[e];
            if (i < 3) EL_LOAD(nx, i + 1);
            const int t = (tid + 512 * i) >> 5, tl = t0 + t;
            float rr[8], kx[8], vx[8], c_[8], p_[8], n_[8];
            unpack8(cu[0], c_); unpack8(cu[3], p_); unpack8(cu[6], n_);
#pragma unroll
            for (int j = 0; j < 8; ++j) rr[j] = c_[j] + mr_[j] * (0.5f * (p_[j] + n_[j]) - c_[j]);
            unpack8(cu[1], c_); unpack8(cu[4], p_); unpack8(cu[7], n_);
#pragma unroll
            for (int j = 0; j < 8; ++j) kx[j] = c_[j] + mk_[j] * (0.5f * (p_[j] + n_[j]) - c_[j]);
            unpack8(cu[2], c_); unpack8(cu[5], p_); unpack8(cu[8], n_);
#pragma unroll
            for (int j = 0; j < 8; ++j) vx[j] = c_[j] + mv_[j] * (0.5f * (p_[j] + n_[j]) - c_[j]);
            float as0[8], as1[8];
            unpack8(*(const LAS u32x4*)(AS + (0 * 64 + t) * LA + c0), as0); unpack8(*(const LAS u32x4*)(AS + (1 * 64 + t) * LA + c0), as1);
            float kr[8], ss = 0.f, srk = 0.f;
#pragma unroll
            for (int j = 0; j < 8; ++j) { kr[j] = kx[j] * kkc[j]; ss += kr[j] * kr[j]; srk += rr[j] * kx[j] * rkc[j]; }
            ss += __shfl_xor(ss, 1); ss += __shfl_xor(ss, 2); ss += __shfl_xor(ss, 4);
            const float inv = rsqrtf(ss + 1e-12f);
            float kkv[8], kd0[8], kd1[8], b0v[8], b1v[8], skr = 0.f;
#pragma unroll
            for (int j = 0; j < 8; ++j) {
                kkv[j] = kr[j] * inv; kd0[j] = kx[j] * (1.f + (as0[j] - 1.f) * kac[j]); kd1[j] = kx[j] * (1.f + (as1[j] - 1.f) * kac[j]);
                b0v[j] = kkv[j] * as0[j]; b1v[j] = kkv[j] * as1[j];
                skr += bf2f((bf16_t)f2bf(kd1[j])) * bf2f((bf16_t)f2bf(rr[j])); }
            srk += __shfl_xor(srk, 1); srk += __shfl_xor(srk, 2); srk += __shfl_xor(srk, 4);
            skr += __shfl_xor(skr, 1); skr += __shfl_xor(skr, 2); skr += __shfl_xor(skr, 4);
            const size_t o = (size_t)tl * 256 + c0;
#define ST8(arr, f) do { u32x4 o4; o4.x = pk2(f[0], f[1]); o4.y = pk2(f[2], f[3]); o4.z = pk2(f[4], f[5]); o4.w = pk2(f[6], f[7]); *(u32x4*)(B.rw + (size_t)(arr) * RWA + o) = o4; } while (0)
            ST8(0, rr); ST8(1, vx); ST8(2, kkv); ST8(6, kd0); ST8(7, kd1); ST8(8, b0v); ST8(9, b1v);
#undef ST8
            if ((lane & 7) == 0) { B.rw_s[(size_t)tl * 4 + head] = srk; B.rw_s[(size_t)TG * 4 + (size_t)tl * 4 + head] = skr; }
        }
#undef EL_LOAD
    }
#pragma unroll 1
    for (int d = 0; d < 2; ++d)
#pragma unroll 1
        for (int tt = 0; tt < 2; ++tt) {
            const int tn = 2 * w + tt, c = tn * 16 + r;
            const float w0c = P.in[9][(layer * 2 + d) * 256 + c];
            const bf16_t* wb = sw + d * 16384 + (size_t)(tn * 16 + r) * 64 + q * 8;
            const bf16x8 b0 = *(const bf16x8*)wb, b1 = *(const bf16x8*)(wb + 32);
#pragma unroll
            for (int tm = 0; tm < 4; ++tm) {
                const LAS bf16_t* ap = lin + (tm * 16 + r) * LL + d * 64 + q * 8;
                f32x4 acc = (f32x4){0.f, 0.f, 0.f, 0.f};
                acc = mfma16(*(const LAS bf16x8*)ap, b0, acc); acc = mfma16(*(const LAS bf16x8*)(ap + 32), b1, acc);
#pragma unroll
                for (int jj = 0; jj < 4; ++jj) B.rw[(size_t)(4 + d) * RWA + (size_t)(t0 + tm * 16 + q * 4 + jj) * 256 + c] = (bf16_t)f2bf(sigm(w0c + acc[jj]) * 0.60653066f);
            }
        }
#pragma unroll 1
    for (int tt = 0; tt < 2; ++tt) {
        const int tn = 2 * w + tt, c = tn * 16 + r;
        const bf16_t* wb = sw + 65536 + (size_t)(tn * 16 + r) * 128 + q * 8;
        const bf16x8 b0 = *(const bf16x8*)wb, b1 = *(const bf16x8*)(wb + 32), b2 = *(const bf16x8*)(wb + 64), b3 = *(const bf16x8*)(wb + 96);
#pragma unroll
        for (int tm = 0; tm < 4; ++tm) {
            const LAS bf16_t* ap = lin + (tm * 16 + r) * LL + 256 + q * 8;
            f32x4 acc = (f32x4){0.f, 0.f, 0.f, 0.f};
            acc = mfma16(*(const LAS bf16x8*)ap, b0, acc); acc = mfma16(*(const LAS bf16x8*)(ap + 32), b1, acc);
            acc = mfma16(*(const LAS bf16x8*)(ap + 64), b2, acc); acc = mfma16(*(const LAS bf16x8*)(ap + 96), b3, acc);
#pragma unroll
            for (int jj = 0; jj < 4; ++jj) B.rw[(size_t)3 * RWA + (size_t)(t0 + tm * 16 + q * 4 + jj) * 256 + c] = (bf16_t)f2bf(acc[jj]);
        }
    }
#pragma unroll 1
    for (int d = 0; d < 2; ++d) {
        const int c = w * 16 + r;
        const float bias = P.in[6][(layer * 2 + d) * 128 + c];
        const bf16x8 b0 = *(const bf16x8*)(sw + 98304 + d * 4096 + (size_t)(w * 16 + r) * 32 + q * 8);
#pragma unroll
        for (int tm = 0; tm < 4; ++tm) {
            f32x4 acc = (f32x4){0.f, 0.f, 0.f, 0.f};
            acc = mfma16(*(const LAS bf16x8*)(gin + (tm * 16 + r) * 40 + q * 8), b0, acc);
#pragma unroll
            for (int jj = 0; jj < 4; ++jj) B.gla_la[((size_t)d * TG + t0 + tm * 16 + q * 4 + jj) * 128 + c] = -softplus(-(acc[jj] + bias)) * (1.0f / 16.0f);
        }
    }
    {
        const int c0 = (tid & 127) * 8;
        float wt[5][8], bs[8];
        { const f32x4 b0 = *(const f32x4*)(P.in[20] + layer * 1024 + c0), b1 = *(const f32x4*)(P.in[20] + layer * 1024 + c0 + 4);
          bs[0] = b0[0]; bs[1] = b0[1]; bs[2] = b0[2]; bs[3] = b0[3]; bs[4] = b1[0]; bs[5] = b1[1]; bs[6] = b1[2]; bs[7] = b1[3]; }
#pragma unroll
        for (int tap = 0; tap < 5; ++tap) { const float* wp = P.in[19] + (size_t)(layer * 5 + tap) * 1024 + c0;
            const f32x4 w0 = *(const f32x4*)wp, w1 = *(const f32x4*)(wp + 4);
            wt[tap][0] = w0[0]; wt[tap][1] = w0[1]; wt[tap][2] = w0[2]; wt[tap][3] = w0[3]; wt[tap][4] = w1[0]; wt[tap][5] = w1[1]; wt[tap][6] = w1[2]; wt[tap][7] = w1[3]; }
        u32x4 xr[5], xn[5];
#define CONV_LOAD(dst, ii) do { const int t_ = (tid + 512 * (ii)) >> 7, tl_ = t0 + t_, pos_ = tl_ % L; \
            _Pragma("unroll") for (int tap = 0; tap < 5; ++tap) { const int pp = pos_ + tap - 2; \
                dst[tap] = (pp >= 0 && pp < L) ? *(const u32x4*)(p + (size_t)(tl_ + tap - 2) * DINP + PC_XBC + c0) : (u32x4){0u, 0u, 0u, 0u}; } } while (0)
        CONV_LOAD(xn, 0);
#pragma unroll 1
        for (int i = 0; i < 16; ++i) {
#pragma unroll
            for (int tap = 0; tap < 5; ++tap) xr[tap] = xn[tap];
            if (i < 15) CONV_LOAD(xn, i + 1);
            float acc[8];
#pragma unroll
            for (int j = 0; j < 8; ++j) acc[j] = bs[j];
#pragma unroll
            for (int tap = 0; tap < 5; ++tap) { float x[8]; unpack8(xr[tap], x);
#pragma unroll
                for (int j = 0; j < 8; ++j) acc[j] += wt[tap][j] * x[j]; }
            const int tl = t0 + ((tid + 512 * i) >> 7);
            u32x4 o; o.x = pk2(silu(acc[0]), silu(acc[1])); o.y = pk2(silu(acc[2]), silu(acc[3])); o.z = pk2(silu(acc[4]), silu(acc[5])); o.w = pk2(silu(acc[6]), silu(acc[7]));
            *(u32x4*)(B.ssd_x + (size_t)tl * 1024 + c0) = o;
        }
#undef CONV_LOAD
    }
#pragma unroll
    for (int i = 0; i < 2; ++i) { const int idx = tid + 512 * i, t = idx >> 4, j = idx & 15, tl = t0 + t;
        B.ssd_dt[(size_t)tl * 16 + j] = softplus(bf2f(p[(size_t)tl * DINP + PC_DT + j]) + P.in[21][layer * 16 + j]); }
}

__device__ __forceinline__ f32x4 mma_nt(f32x4 acc, const LAS bf16_t* A, int lda, const LAS bf16_t* Bt, int ldb, int K, int lane) {
    const int r = lane & 15, q = lane >> 4;
    for (int k = 0; k < K; k += 32) {
        const bf16x8 a = *(const LAS bf16x8*)(A + r * lda + k + q * 8);
        const bf16x8 b = *(const LAS bf16x8*)(Bt + r * ldb + k + q * 8);
        acc = __builtin_amdgcn_mfma_f32_16x16x32_bf16(a, b, acc, 0, 0, 0);
    }
    return acc;
}
__device__ __forceinline__ f32x4 mma_nt_x(f32x4 acc, const LAS bf16_t* A, int lda, const LAS bf16_t* Bt, int ldb, int K, int lane, int xa, int xb) {
    const int r = lane & 15, q = lane >> 4;
    for (int k = 0; k < K; k += 32) {
        const bf16x8 a = *(const LAS bf16x8*)(A + r * lda + ((((k >> 3) + q) ^ xa) << 3));
        const bf16x8 b = *(const LAS bf16x8*)(Bt + r * ldb + ((((k >> 3) + q) ^ xb) << 3));
        acc = __builtin_amdgcn_mfma_f32_16x16x32_bf16(a, b, acc, 0, 0, 0);
    }
    return acc;
}
__device__ __forceinline__ f32x4 mma_tn_x(f32x4 acc, const LAS bf16_t* A, int lda, const LAS bf16_t* Bt, int ldb, int K, int lane, int xa, int xb) {
    const int r = lane & 15, q = lane >> 4;
    for (int k = 0; k < K; k += 32) {
        const bf16x8 a = *(const LAS bf16x8*)(A + r * lda + ((((k >> 3) + q) ^ xa) << 3));
        const bf16x8 b = *(const LAS bf16x8*)(Bt + r * ldb + ((((k >> 3) + q) ^ xb) << 3));
        acc = __builtin_amdgcn_mfma_f32_16x16x32_bf16(b, a, acc, 0, 0, 0);
    }
    return acc;
}
template <int DK> struct CL {
    static constexpr int LQ = DK + 8, LT = 72;
    static constexpr int QA = 0, KA = QA + 64 * LQ * 2, KBT = KA + 64 * LQ * 2, VT = KBT + DK * LT * 2, SC = VT + 64 * LT * 2, STT = SC + 64 * LT * 2;
    static constexpr int FA = STT + 64 * LQ * 2;
};

__device__ __forceinline__ void ssd_unit(LAS unsigned char* lds, const Params& P, const MixBufs& B, float* segst, int layer, int L, int seq, int h, int d, int seg, bool state_only) {
    typedef CL<128> C;
    const int tid = otid(), w = tid >> 6, lane = tid & 63, r = lane & 15, q = lane >> 4;
    LAS bf16_t* Qa = (LAS bf16_t*)(lds + C::QA); LAS bf16_t* Ka = (LAS bf16_t*)(lds + C::KA); LAS bf16_t* KbT = (LAS bf16_t*)(lds + C::KBT);
    LAS bf16_t* VT = (LAS bf16_t*)(lds + C::VT); LAS bf16_t* Sc = (LAS bf16_t*)(lds + C::SC); LAS bf16_t* StT = (LAS bf16_t*)(lds + C::STT);
    LAS float* acum = (LAS float*)(lds + C::FA); LAS float* dtl = acum + 64;
    const int grp = h >> 2;
    const float Aneg = -__expf(P.in[22][layer * 16 + d * 8 + h]);
    const int base = seq * L, cbeg = seg * 32, cend = cbeg + 32;
    __syncthreads();
    f32x4 st[4];
#pragma unroll
    for (int i = 0; i < 4; ++i) st[i] = (f32x4){0.f, 0.f, 0.f, 0.f};
    const int kidx = h * 2 + d;
    if (!state_only) {
        for (int ps = 0; ps < seg; ++ps) {
            const float* sp = segst + (size_t)((seq * 8 + ps) * 24 + kidx) * 8256;
            const float dcy = __expf(sp[8192]);
#pragma unroll
            for (int tv = 0; tv < 4; ++tv)
#pragma unroll
                for (int jj = 0; jj < 4; ++jj) st[tv][jj] = st[tv][jj] * dcy + sp[(tv * 4 + jj) * 512 + tid];
        }
#pragma unroll
        for (int tv = 0; tv < 4; ++tv) {
            u32x2 o; o.x = pk2(st[tv][0], st[tv][1]); o.y = pk2(st[tv][2], st[tv][3]);
            *(LAS u32x2*)(StT + (tv * 16 + r) * C::LQ + w * 16 + q * 4) = o;
        }
    }
    float asum = 0.f;
    const int row = tid >> 3, part = tid & 7;
    const int tm = w >> 1, tn0 = (w & 1) * 2;
    bf16_t* yout = B.ssd_y + (size_t)d * TG * 512;
    u32x4 c0, c1, b0, b1, x0; float dtv;
#define SSD_LOAD(cc) do { const int n0_ = (cc) * 64; \
        const int tok = d == 0 ? base + n0_ + row : base + L - 1 - (n0_ + row); \
        const bf16_t* xr = B.ssd_x + (size_t)tok * 1024; \
        c0 = *(const u32x4*)(xr + 768 + grp * 128 + part * 16); c1 = *(const u32x4*)(xr + 768 + grp * 128 + part * 16 + 8); \
        b0 = *(const u32x4*)(xr + 512 + grp * 128 + part * 16); b1 = *(const u32x4*)(xr + 512 + grp * 128 + part * 16 + 8); \
        x0 = *(const u32x4*)(xr + h * 64 + part * 8); \
        const int tl_ = d == 0 ? base + n0_ + lane : base + L - 1 - (n0_ + lane); \
        dtv = B.ssd_dt[(size_t)tl_ * 16 + d * 8 + h]; } while (0)
    SSD_LOAD(cbeg);
    for (int c = cbeg; c < cend; ++c) {
        const int n0 = c * 64;
        const float ac = wave_incl_scan(dtv * Aneg, lane);
        const float alast = lane_bcast(ac, 63);
        asum += alast;
        if (w == 0) { acum[lane] = ac; dtl[lane] = dtv; }
        {
            const float ks = __shfl(dtv, row) * __expf(alast - __shfl(ac, row));
            *(LAS u32x4*)(Qa + row * C::LQ + part * 16) = c0; *(LAS u32x4*)(Qa + row * C::LQ + part * 16 + 8) = c1;
            *(LAS u32x4*)(Ka + row * C::LQ + part * 16) = b0; *(LAS u32x4*)(Ka + row * C::LQ + part * 16 + 8) = b1;
            float bf[16]; unpack8(b0, bf); unpack8(b1, bf + 8);
            const int rsw = row ^ (part << 3);
#pragma unroll
            for (int j = 0; j < 16; ++j) KbT[(part * 16 + j) * C::LT + rsw] = (bf16_t)f2bf(bf[j] * ks);
            const unsigned xs[4] = {x0.x, x0.y, x0.z, x0.w};
#pragma unroll
            for (int j = 0; j < 4; ++j) { VT[(part * 8 + 2 * j) * C::LT + rsw] = (bf16_t)(xs[j] & 0xffffu); VT[(part * 8 + 2 * j + 1) * C::LT + rsw] = (bf16_t)(xs[j] >> 16); }
        }
        if (c + 1 < cend) SSD_LOAD(c + 1);
        lds_barrier();
        if (!state_only) {
#pragma unroll
        for (int tt = 0; tt < 2; ++tt) {
            const int tn = tn0 + tt;
            f32x4 s = (f32x4){0.f, 0.f, 0.f, 0.f};
            s = mma_tn_x(s, Qa + tm * 16 * C::LQ, C::LQ, Ka + tn * 16 * C::LQ, C::LQ, 128, lane, 0, 0);
            const int i = tm * 16 + r, j0 = tn * 16 + q * 4;
            const float ai = acum[i];
            const f32x4 aj = *(const LAS f32x4*)(acum + j0), dj = *(const LAS f32x4*)(dtl + j0);
            float v[4];
#pragma unroll
            for (int jj = 0; jj < 4; ++jj) {
                const int j = j0 + jj;
                const bool on = d == 0 ? (i >= j) : (i > j);
                v[jj] = on ? s[jj] * __expf(ai - aj[jj]) * dj[jj] : 0.f;
            }
            u32x2 o; o.x = pk2(v[0], v[1]); o.y = pk2(v[2], v[3]);
            *(LAS u32x2*)(Sc + i * C::LT + j0) = o;
        }
        lds_barrier();
#pragma unroll
        for (int tt = 0; tt < 2; ++tt) {
            const int tn = tn0 + tt;
            f32x4 o1 = (f32x4){0.f, 0.f, 0.f, 0.f}, o2 = (f32x4){0.f, 0.f, 0.f, 0.f};
            o1 = mma_tn_x(o1, Sc + tm * 16 * C::LT, C::LT, VT + tn * 16 * C::LT, C::LT, 64, lane, 0, (tn * 2 + (r >> 3)) & 7);
            o2 = mma_tn_x(o2, Qa + tm * 16 * C::LQ, C::LQ, StT + tn * 16 * C::LQ, C::LQ, 128, lane, 0, 0);
            const int i = tm * 16 + r;
            const int tl = d == 0 ? base + n0 + i : base + L - 1 - (n0 + i);
            const float ei = __expf(acum[i]);
            { const f32x4 ov = o1 + o2 * ei; u32x2 o; o.x = pk2(ov[0], ov[1]); o.y = pk2(ov[2], ov[3]); *(u32x2*)(yout + (size_t)tl * 512 + h * 64 + tn * 16 + q * 4) = o; }
        }
        }
        {
            const float ds = __expf(alast);
#pragma unroll
            for (int tv = 0; tv < 4; ++tv) {
                st[tv] = st[tv] * ds;
                st[tv] = mma_nt_x(st[tv], KbT + w * 16 * C::LT, C::LT, VT + tv * 16 * C::LT, C::LT, 64, lane, w, (tv * 2 + (r >> 3)) & 7);
            }
        }
        lds_barrier();
        if (!state_only) {
#pragma unroll
        for (int tv = 0; tv < 4; ++tv) {
            u32x2 o; o.x = pk2(st[tv][0], st[tv][1]); o.y = pk2(st[tv][2], st[tv][3]);
            *(LAS u32x2*)(StT + (tv * 16 + r) * C::LQ + w * 16 + q * 4) = o;
        }
        }
    }
    if (state_only) {
        float* sp = segst + (size_t)((seq * 8 + seg) * 24 + kidx) * 8256;
#pragma unroll
        for (int tv = 0; tv < 4; ++tv)
#pragma unroll
            for (int jj = 0; jj < 4; ++jj) sp[(tv * 4 + jj) * 512 + tid] = st[tv][jj];
        if (tid == 0) sp[8192] = asum;
    }
#undef SSD_LOAD
}

__device__ __forceinline__ void gla_unit(LAS unsigned char* lds, const Params& P, const MixBufs& B, float* segst, int layer, int L, int seq, int h, int d, int seg, bool state_only) {
    typedef CL<32> C;
    const int tid = otid(), w = tid >> 6, lane = tid & 63, r = lane & 15, q = lane >> 4;
    LAS bf16_t* Qa = (LAS bf16_t*)(lds + C::QA); LAS bf16_t* Ka = (LAS bf16_t*)(lds + C::KA); LAS bf16_t* KbT = (LAS bf16_t*)(lds + C::KBT);
    LAS bf16_t* VT = (LAS bf16_t*)(lds + C::VT); LAS bf16_t* Sc = (LAS bf16_t*)(lds + C::SC); LAS bf16_t* StT = (LAS bf16_t*)(lds + C::STT);
    LAS float* dstate = (LAS float*)(lds + C::FA);
    const int base = seq * L, cbeg = seg * 32, cend = cbeg + 32;
    __syncthreads();
    f32x4 st = (f32x4){0.f, 0.f, 0.f, 0.f};
    const int row = tid >> 3, part = tid & 7;
    const int tm = w >> 1, tn0 = (w & 1) * 2;
    const int tk = w >> 2, tv = w & 3;
    const int kidx = 16 + h * 2 + d;
    if (!state_only) {
        for (int ps = 0; ps < seg; ++ps) {
            const float* sp = segst + (size_t)((seq * 8 + ps) * 24 + kidx) * 8256;
#pragma unroll
            for (int jj = 0; jj < 4; ++jj) st[jj] = st[jj] * __expf(sp[8192 + tk * 16 + q * 4 + jj]) + sp[jj * 512 + tid];
        }
        { u32x2 o; o.x = pk2(st[0], st[1]); o.y = pk2(st[2], st[3]); *(LAS u32x2*)(StT + (tv * 16 + r) * C::LQ + tk * 16 + q * 4) = o; }
    }
    float blsum[4] = {0.f, 0.f, 0.f, 0.f};
    const float* la = B.gla_la + (size_t)d * TG * 128;
    bf16_t* oout = B.gla_o + (size_t)d * TG * 256;
    const float qscale = 0.17677669529663687f;
    f32x4 lv; u32x2 qr, kr; u32x4 x0;
#define GLA_LOAD(cc) do { const int n0_ = (cc) * 64; \
        const int tl_ = d == 0 ? base + n0_ + lane : base + L - 1 - (n0_ + lane); \
        lv = *(const f32x4*)(la + (size_t)tl_ * 128 + h * 32 + 4 * w); \
        qr = *(const u32x2*)(B.p + (size_t)tl_ * DINP + PC_GQ + h * 32 + 4 * w); \
        kr = *(const u32x2*)(B.p + (size_t)tl_ * DINP + PC_GK + h * 32 + 4 * w); \
        const int tr_ = d == 0 ? base + n0_ + row : base + L - 1 - (n0_ + row); \
        x0 = *(const u32x4*)(B.p + (size_t)tr_ * DINP + PC_GV + h * 64 + part * 8); } while (0)
    GLA_LOAD(cbeg);
    for (int c = cbeg; c < cend; ++c) {
        const int n0 = c * 64;
        {
            const float qf[4] = {__uint_as_float(qr.x << 16), __uint_as_float(qr.x & 0xffff0000u), __uint_as_float(qr.y << 16), __uint_as_float(qr.y & 0xffff0000u)};
            const float kf[4] = {__uint_as_float(kr.x << 16), __uint_as_float(kr.x & 0xffff0000u), __uint_as_float(kr.y << 16), __uint_as_float(kr.y & 0xffff0000u)};
            float qd[4], kd[4];
#pragma unroll
            for (int kk = 0; kk < 4; ++kk) {
                const float b = wave_incl_scan(lv[kk], lane);
                const float bl = lane_bcast(b, 63);
                blsum[kk] += bl;
                qd[kk] = qf[kk] * qscale * __expf(b); kd[kk] = kf[kk] * __expf(-b);
                KbT[(4 * w + kk) * C::LT + lane] = (bf16_t)f2bf(kf[kk] * __expf(bl - b));
                if (lane == 63) dstate[4 * w + kk] = __expf(bl);
            }
            u32x2 o; o.x = pk2(qd[0], qd[1]); o.y = pk2(qd[2], qd[3]); *(LAS u32x2*)(Qa + lane * C::LQ + 4 * w) = o;
            o.x = pk2(kd[0], kd[1]); o.y = pk2(kd[2], kd[3]); *(LAS u32x2*)(Ka + lane * C::LQ + 4 * w) = o;
            const unsigned xs[4] = {x0.x, x0.y, x0.z, x0.w};
            const int rsw = row ^ (part << 3);
#pragma unroll
            for (int j = 0; j < 4; ++j) { VT[(part * 8 + 2 * j) * C::LT + rsw] = (bf16_t)(xs[j] & 0xffffu); VT[(part * 8 + 2 * j + 1) * C::LT + rsw] = (bf16_t)(xs[j] >> 16); }
        }
        if (c + 1 < cend) GLA_LOAD(c + 1);
        lds_barrier();
        if (!state_only) {
#pragma unroll
        for (int tt = 0; tt < 2; ++tt) {
            const int tn = tn0 + tt;
            f32x4 s = (f32x4){0.f, 0.f, 0.f, 0.f};
            s = mma_tn_x(s, Qa + tm * 16 * C::LQ, C::LQ, Ka + tn * 16 * C::LQ, C::LQ, 32, lane, 0, 0);
            const int i = tm * 16 + r, j0 = tn * 16 + q * 4;
            float v[4];
#pragma unroll
            for (int jj = 0; jj < 4; ++jj) { const int j = j0 + jj; const bool on = d == 0 ? (i >= j) : (i > j); v[jj] = on ? s[jj] : 0.f; }
            u32x2 o; o.x = pk2(v[0], v[1]); o.y = pk2(v[2], v[3]);
            *(LAS u32x2*)(Sc + i * C::LT + j0) = o;
        }
        lds_barrier();
#pragma unroll
        for (int tt = 0; tt < 2; ++tt) {
            const int tn = tn0 + tt;
            f32x4 o1 = (f32x4){0.f, 0.f, 0.f, 0.f};
            o1 = mma_tn_x(o1, Sc + tm * 16 * C::LT, C::LT, VT + tn * 16 * C::LT, C::LT, 64, lane, 0, (tn * 2 + (r >> 3)) & 7);
            o1 = mma_tn_x(o1, Qa + tm * 16 * C::LQ, C::LQ, StT + tn * 16 * C::LQ, C::LQ, 32, lane, 0, 0);
            const int i = tm * 16 + r;
            const int tl = d == 0 ? base + n0 + i : base + L - 1 - (n0 + i);
            { u32x2 o; o.x = pk2(o1[0], o1[1]); o.y = pk2(o1[2], o1[3]); *(u32x2*)(oout + (size_t)tl * 256 + h * 64 + tn * 16 + q * 4) = o; }
        }
        }
        {
#pragma unroll
            for (int jj = 0; jj < 4; ++jj) st[jj] *= dstate[tk * 16 + q * 4 + jj];
            st = mma_nt_x(st, KbT + tk * 16 * C::LT, C::LT, VT + tv * 16 * C::LT, C::LT, 64, lane, 0, (tv * 2 + (r >> 3)) & 7);
        }
        lds_barrier();
        if (!state_only) { u32x2 o; o.x = pk2(st[0], st[1]); o.y = pk2(st[2], st[3]); *(LAS u32x2*)(StT + (tv * 16 + r) * C::LQ + tk * 16 + q * 4) = o; }
    }
    if (state_only) {
        float* sp = segst + (size_t)((seq * 8 + seg) * 24 + kidx) * 8256;
#pragma unroll
        for (int jj = 0; jj < 4; ++jj) sp[jj * 512 + tid] = st[jj];
        if (lane == 0) {
#pragma unroll
            for (int kk = 0; kk < 4; ++kk) sp[8192 + 4 * w + kk] = blsum[kk];
        }
    }
#undef GLA_LOAD
}

constexpr int RL = 72;
struct RwRaw { u32x4 e, kk, bb, kd, rr, v; };
__device__ __forceinline__ void rwkv_pre_load(RwRaw& R, const MixBufs& B, int L, int u, int tid) {
    const int w = tid >> 6, lane = tid & 63, nch = L / 64, hd = u & 7, ch = u >> 3, h = hd >> 1, d = hd & 1;
    const int base = (ch / nch) * L, n0 = (ch % nch) * 64;
    const int tl = d == 0 ? base + n0 + lane : base + L - 1 - (n0 + lane);
    const size_t o = (size_t)tl * 256 + h * 64 + 8 * w;
    R.e = *(const u32x4*)(B.rw + (4 + d) * RWA + o); R.kk = *(const u32x4*)(B.rw + 2 * RWA + o);
    R.bb = *(const u32x4*)(B.rw + (8 + d) * RWA + o); R.kd = *(const u32x4*)(B.rw + (6 + d) * RWA + o);
    R.rr = *(const u32x4*)(B.rw + 0 * RWA + o);
    const int row = tid >> 3, part = tid & 7;
    const int tr = d == 0 ? base + n0 + row : base + L - 1 - (n0 + row);
    R.v = *(const u32x4*)(B.rw + 1 * RWA + (size_t)tr * 256 + h * 64 + part * 8);
}
__device__ __forceinline__ void rwkv_pre(LAS unsigned char* lds, const MixBufs& B, bf16_t* rq, int L, int u, int unext, RwRaw& R) {
    const int tid = otid(), w = tid >> 6, lane = tid & 63, r = lane & 15, q = lane >> 4;
#define RG(i) ((LAS bf16_t*)(lds + (i) * 9216))
    LAS bf16_t* At = RG(0); LAS bf16_t* Bt_ = RG(1); LAS bf16_t* Kt = RG(2); LAS bf16_t* Rt = RG(3); LAS bf16_t* AtT = RG(4); LAS bf16_t* BhT = RG(5);
    LAS bf16_t* KhT = RG(6); LAS bf16_t* VT = RG(7); LAS bf16_t* Lak = RG(8); LAS bf16_t* Mrb = RG(9); LAS bf16_t* Mrk = RG(10); LAS bf16_t* WT = RG(11);
    LAS bf16_t* Tm = RG(0); LAS bf16_t* XT = RG(1); LAS bf16_t* UT = RG(2);
#undef RG
    LAS float* Lf = (LAS float*)(lds + 12 * 9216);
    LAS float* gC = (LAS float*)(lds + 12 * 9216 + 17408);
    LAS bf16_t* L21b = (LAS bf16_t*)(lds + 12 * 9216 + 17408 + 512);
    LAS bf16_t* T11T = WT;
    LAS bf16_t* X1T = WT + 32 * 40;
    const int nch = L / 64, hd = u & 7, ch = u >> 3, h = hd >> 1, d = hd & 1, seq = ch / nch, c = ch % nch;
    const int base = seq * L, n0 = c * 64;
    const int cu = (((seq * nch + c) * 4 + h) * 2 + d);
    bf16_t* gq = rq + (size_t)cu * 3 * 4096;
    lds_barrier();
    {
        float e[8], kk[8], bb[8], kd[8], rr[8];
        unpack8(R.e, e); unpack8(R.kk, kk); unpack8(R.bb, bb); unpack8(R.kd, kd); unpack8(R.rr, rr);
        float at[8], bt[8], kt[8], rt[8];
#pragma unroll
        for (int j = 0; j < 8; ++j) {
            const float cum = wave_incl_scan(e[j], lane);
            const float cmid = lane_bcast(cum, 31), clast = lane_bcast(cum, 63);
            const float ea = __expf(-(cum - e[j] - cmid)), eb = __expf(cum - cmid), er = __expf(-(cum - cmid)), eh = __expf(-(clast - cum));
            at[j] = -kk[j] * ea; bt[j] = bb[j] * eb; kt[j] = kd[j] * eb; rt[j] = rr[j] * er;
            AtT[(8 * w + j) * RL + lane] = (bf16_t)f2bf(at[j]);
            BhT[(8 * w + j) * RL + lane] = (bf16_t)f2bf(bb[j] * eh);
            KhT[(8 * w + j) * RL + lane] = (bf16_t)f2bf(kd[j] * eh);
            if (lane == 63) { gC[8 * w + j] = __expf(-clast); gC[64 + 8 * w + j] = __expf(-cmid); }
        }
        u32x4 o4;
        o4.x = pk2(at[0], at[1]); o4.y = pk2(at[2], at[3]); o4.z = pk2(at[4], at[5]); o4.w = pk2(at[6], at[7]); *(LAS u32x4*)(At + lane * RL + 8 * w) = o4;
        o4.x = pk2(bt[0], bt[1]); o4.y = pk2(bt[2], bt[3]); o4.z = pk2(bt[4], bt[5]); o4.w = pk2(bt[6], bt[7]); *(LAS u32x4*)(Bt_ + lane * RL + 8 * w) = o4;
        o4.x = pk2(kt[0], kt[1]); o4.y = pk2(kt[2], kt[3]); o4.z = pk2(kt[4], kt[5]); o4.w = pk2(kt[6], kt[7]); *(LAS u32x4*)(Kt + lane * RL + 8 * w) = o4;
        o4.x = pk2(rt[0], rt[1]); o4.y = pk2(rt[2], rt[3]); o4.z = pk2(rt[4], rt[5]); o4.w = pk2(rt[6], rt[7]); *(LAS u32x4*)(Rt + lane * RL + 8 * w) = o4;
        const int row = tid >> 3, part = tid & 7;
        const unsigned xs[4] = {R.v.x, R.v.y, R.v.z, R.v.w};
#pragma unroll
        for (int j = 0; j < 4; ++j) { VT[(part * 8 + 2 * j) * RL + row] = (bf16_t)(xs[j] & 0xffffu); VT[(part * 8 + 2 * j + 1) * RL + row] = (bf16_t)(xs[j] >> 16); }
    }
    if (unext >= 0) rwkv_pre_load(R, B, L, unext, tid);
    lds_barrier();
    const int tm = w >> 1, tn0 = (w & 1) * 2;
    const f32x4 Z4 = (f32x4){0.f, 0.f, 0.f, 0.f};
#pragma unroll
    for (int tt = 0; tt < 2; ++tt) {
        const int tn = tn0 + tt;
        const f32x4 lab = mma_tn_x(Z4, At + tm * 16 * RL, RL, Bt_ + tn * 16 * RL, RL, 64, lane, 0, 0);
        const f32x4 lak = mma_tn_x(Z4, At + tm * 16 * RL, RL, Kt + tn * 16 * RL, RL, 64, lane, 0, 0);
        const f32x4 mrb = mma_tn_x(Z4, Rt + tm * 16 * RL, RL, Bt_ + tn * 16 * RL, RL, 64, lane, 0, 0);
        const f32x4 mrk = mma_tn_x(Z4, Rt + tm * 16 * RL, RL, Kt + tn * 16 * RL, RL, 64, lane, 0, 0);
        const int i = tm * 16 + r, j0 = tn * 16 + q * 4;
        f32x4 lf; float vk[4], vb[4], vm[4];
#pragma unroll
        for (int jj = 0; jj < 4; ++jj) {
            const int j = j0 + jj; const bool st_ = j < i, in_ = j <= i;
            lf[jj] = st_ ? lab[jj] : 0.f; vk[jj] = st_ ? lak[jj] : 0.f; vb[jj] = in_ ? mrb[jj] : 0.f; vm[jj] = in_ ? mrk[jj] : 0.f;
        }
        *(LAS f32x4*)(Lf + i * 68 + j0) = lf;
        u32x2 o;
        if (tm >= 2 && tn < 2) { o.x = pk2(lab[0], lab[1]); o.y = pk2(lab[2], lab[3]); *(LAS u32x2*)(L21b + (i - 32) * 40 + j0) = o; }
        o.x = pk2(vk[0], vk[1]); o.y = pk2(vk[2], vk[3]); *(LAS u32x2*)(Lak + i * RL + j0) = o;
        o.x = pk2(vb[0], vb[1]); o.y = pk2(vb[2], vb[3]); *(LAS u32x2*)(Mrb + i * RL + j0) = o;
        o.x = pk2(vm[0], vm[1]); o.y = pk2(vm[2], vm[3]); *(LAS u32x2*)(Mrk + i * RL + j0) = o;
    }
    lds_barrier();
#pragma unroll
    for (int tt = 0; tt < 2; ++tt) {
        const int tn = tn0 + tt;
        const f32x4 x = mma_nt(Z4, Lak + tm * 16 * RL, RL, VT + tn * 16 * RL, RL, 64, lane);
        u32x2 o; o.x = pk2(x[0], x[1]); o.y = pk2(x[2], x[3]);
        *(LAS u32x2*)(XT + (tn * 16 + r) * RL + tm * 16 + q * 4) = o;
    }
    if (w < 2) {
        const int ob = w * 32, j = lane & 31;
        float T[32];
        int zv = 0; asm volatile("" : "+v"(zv));
        const LAS float* Lfz = Lf + zv + ob * 68 + ob;
#pragma unroll
        for (int t = 0; t < 32; ++t) {
            float a0 = (t == j) ? 1.f : 0.f, a1 = 0.f;
#pragma unroll
            for (int s4 = 0; s4 < (t + 3) / 4; ++s4) {
                const f32x4 l = *(const LAS f32x4*)(Lfz + t * 68 + s4 * 4);
#pragma unroll
                for (int e2 = 0; e2 < 4; ++e2) { const int s_ = s4 * 4 + e2; if (s_ < t) { if (e2 & 1) a1 += l[e2] * T[s_]; else a0 += l[e2] * T[s_]; } }
            }
            T[t] = a0 + a1;
            if (lane < 32) {
                Tm[(ob + t) * RL + ob + j] = (bf16_t)f2bf(T[t]);
                if (w == 0) T11T[j * 40 + t] = (bf16_t)f2bf(T[t]);
            }
        }
    } else if (w == 2) {
        for (int i = lane; i < 32 * 16; i += 64) { const int t = i >> 4, c2 = (i & 15) * 2; *(LAS unsigned*)(Tm + t * RL + 32 + c2) = 0u; }
    }
    lds_barrier();
    if (w < 4) {
        const int mi = w >> 1, ni = w & 1;
        const f32x4 x1 = mma_nt(Z4, L21b + mi * 16 * 40, 40, T11T + ni * 16 * 40, 40, 32, lane);
        u32x2 o; o.x = pk2(x1[0], x1[1]); o.y = pk2(x1[2], x1[3]);
        *(LAS u32x2*)(X1T + (ni * 16 + r) * 40 + mi * 16 + q * 4) = o;
    }
    lds_barrier();
    if (w < 4) {
        const int mi = w >> 1, ni = w & 1;
        const f32x4 t21 = mma_tn_x(Z4, Tm + (32 + mi * 16) * RL + 32, RL, X1T + ni * 16 * 40, 40, 32, lane, 0, 0);
        u32x2 o; o.x = pk2(t21[0], t21[1]); o.y = pk2(t21[2], t21[3]);
        *(LAS u32x2*)(Tm + (32 + mi * 16 + r) * RL + ni * 16 + q * 4) = o;
    }
    lds_barrier();
    f32x4 uu[2], ww[2];
#pragma unroll
    for (int tt = 0; tt < 2; ++tt) {
        const int tn = tn0 + tt;
        uu[tt] = mma_nt(Z4, Tm + tm * 16 * RL, RL, XT + tn * 16 * RL, RL, 64, lane);
        ww[tt] = mma_nt(Z4, Tm + tm * 16 * RL, RL, AtT + tn * 16 * RL, RL, 64, lane);
    }
#pragma unroll
    for (int tt = 0; tt < 2; ++tt) {
        const int tn = tn0 + tt;
        u32x2 o; o.x = pk2(uu[tt][0], uu[tt][1]); o.y = pk2(uu[tt][2], uu[tt][3]);
        *(LAS u32x2*)(UT + (tn * 16 + r) * RL + tm * 16 + q * 4) = o;
        o.x = pk2(ww[tt][0], ww[tt][1]); o.y = pk2(ww[tt][2], ww[tt][3]);
        *(LAS u32x2*)(WT + (tn * 16 + r) * RL + tm * 16 + q * 4) = o;
    }
    lds_barrier();
    bf16_t* yout = B.rw_y + (size_t)d * TG * 256;
#pragma unroll
    for (int tt = 0; tt < 2; ++tt) {
        const int tn = tn0 + tt;
        const f32x4 qe = mma_tn_x(Z4, Mrb + tm * 16 * RL, RL, WT + tn * 16 * RL, RL, 64, lane, 0, 0);
        f32x4 yl = mma_tn_x(Z4, Mrb + tm * 16 * RL, RL, UT + tn * 16 * RL, RL, 64, lane, 0, 0);
        yl = mma_tn_x(yl, Mrk + tm * 16 * RL, RL, VT + tn * 16 * RL, RL, 64, lane, 0, 0);
        const f32x4 pe = mma_tn_x(Z4, BhT + tm * 16 * RL, RL, WT + tn * 16 * RL, RL, 64, lane, 0, 0);
        f32x4 hl = mma_nt(Z4, BhT + tm * 16 * RL, RL, UT + tn * 16 * RL, RL, 64, lane);
        hl = mma_nt(hl, KhT + tm * 16 * RL, RL, VT + tn * 16 * RL, RL, 64, lane);
        const int i = tm * 16 + r, n0c = tn * 16 + q * 4;
        const f32x4 um = *(const LAS f32x4*)(gC + 64 + n0c);
        const u32x2 rtp = *(const LAS u32x2*)(Rt + i * RL + n0c);
        const float rt4[4] = {__uint_as_float(rtp.x << 16), __uint_as_float(rtp.x & 0xffff0000u), __uint_as_float(rtp.y << 16), __uint_as_float(rtp.y & 0xffff0000u)};
        const float gci = gC[i];
        float qv[4], pv[4];
#pragma unroll
        for (int jj = 0; jj < 4; ++jj) { qv[jj] = (qe[jj] + rt4[jj]) * um[jj]; pv[jj] = pe[jj] * um[jj] + ((n0c + jj) == i ? gci : 0.f); }
        u32x2 o; o.x = pk2(qv[0], qv[1]); o.y = pk2(qv[2], qv[3]); *(u32x2*)(gq + i * 64 + n0c) = o;
        o.x = pk2(pv[0], pv[1]); o.y = pk2(pv[2], pv[3]); *(u32x2*)(gq + 4096 + i * 64 + n0c) = o;
        const int tl = d == 0 ? base + n0 + i : base + L - 1 - (n0 + i);
        o.x = pk2(yl[0], yl[1]); o.y = pk2(yl[2], yl[3]); *(u32x2*)(yout + (size_t)tl * 256 + h * 64 + n0c) = o;
        o.x = pk2(hl[0], hl[1]); o.y = pk2(hl[2], hl[3]);
        *(u32x2*)(gq + 8192 + (tn * 16 + r) * 64 + tm * 16 + q * 4) = o;
    }
}

__device__ __forceinline__ void rwkv_seq(LAS unsigned char* lds, const MixBufs& B, const bf16_t* rq, int L, int seq, int h, int d) {
    const int tid = otid(), w = tid >> 6, lane = tid & 63, r = lane & 15, q = lane >> 4;
    const int tm = w >> 1, tn0 = (w & 1) * 2;
    const int base = seq * L, nch = L / 64;
    __syncthreads();
    for (int i = tid; i < 64 * RL / 2; i += 512) ((LAS unsigned*)lds)[i] = 0u;
    bf16_t* yout = B.rw_y + (size_t)d * TG * 256;
    const size_t custride = (size_t)8 * 3 * 4096;
    const bf16_t* g = rq + (size_t)(((seq * nch) * 4 + h) * 2 + d) * 3 * 4096;
    const int aoff = (tm * 16 + r) * 64 + q * 8;
    bf16x8 qa0 = *(const bf16x8*)(g + aoff), qa1 = *(const bf16x8*)(g + aoff + 32);
    bf16x8 pa0 = *(const bf16x8*)(g + 4096 + aoff), pa1 = *(const bf16x8*)(g + 4096 + aoff + 32);
    u32x2 hl0 = *(const u32x2*)(g + 8192 + (tn0 * 16 + r) * 64 + tm * 16 + q * 4), hl1 = *(const u32x2*)(g + 8192 + ((tn0 + 1) * 16 + r) * 64 + tm * 16 + q * 4);
    for (int c = 0; c < nch; ++c) {
        const bf16_t* gn = g + (c + 1 < nch ? custride : 0);
        const bf16x8 nqa0 = *(const bf16x8*)(gn + aoff), nqa1 = *(const bf16x8*)(gn + aoff + 32);
        const bf16x8 npa0 = *(const bf16x8*)(gn + 4096 + aoff), npa1 = *(const bf16x8*)(gn + 4096 + aoff + 32);
        const u32x2 nhl0 = *(const u32x2*)(gn + 8192 + (tn0 * 16 + r) * 64 + tm * 16 + q * 4), nhl1 = *(const u32x2*)(gn + 8192 + ((tn0 + 1) * 16 + r) * 64 + tm * 16 + q * 4);
        u32x2 yl[2];
        const int ti_ = tm * 16 + r;
        bf16_t* yrow = yout + (size_t)(d == 0 ? base + c * 64 + ti_ : base + L - 1 - (c * 64 + ti_)) * 256 + h * 64 + q * 4;
#pragma unroll
        for (int tt = 0; tt < 2; ++tt) yl[tt] = *(const u32x2*)(yrow + (tn0 + tt) * 16);
        lds_barrier();
        const LAS bf16_t* cur = (const LAS bf16_t*)(lds + (c & 1) * 9216);
        LAS bf16_t* nxt = (LAS bf16_t*)(lds + ((c + 1) & 1) * 9216);
#pragma unroll
        for (int tt = 0; tt < 2; ++tt) {
            const int tn = tn0 + tt;
            const bf16x8 b0 = *(const LAS bf16x8*)(cur + (tn * 16 + r) * RL + q * 8), b1 = *(const LAS bf16x8*)(cur + (tn * 16 + r) * RL + 32 + q * 8);
            f32x4 y = (f32x4){0.f, 0.f, 0.f, 0.f}, hn = (f32x4){0.f, 0.f, 0.f, 0.f};
            y = __builtin_amdgcn_mfma_f32_16x16x32_bf16(b0, qa0, y, 0, 0, 0); y = __builtin_amdgcn_mfma_f32_16x16x32_bf16(b1, qa1, y, 0, 0, 0);
            hn = __builtin_amdgcn_mfma_f32_16x16x32_bf16(pa0, b0, hn, 0, 0, 0); hn = __builtin_amdgcn_mfma_f32_16x16x32_bf16(pa1, b1, hn, 0, 0, 0);
            const u32x2 hl = tt == 0 ? hl0 : hl1;
            hn[0] += __uint_as_float(hl.x << 16); hn[1] += __uint_as_float(hl.x & 0xffff0000u); hn[2] += __uint_as_float(hl.y << 16); hn[3] += __uint_as_float(hl.y & 0xffff0000u);
            u32x2 o; o.x = pk2(hn[0], hn[1]); o.y = pk2(hn[2], hn[3]);
            *(LAS u32x2*)(nxt + (tn * 16 + r) * RL + tm * 16 + q * 4) = o;
            { const u32x2 yo = yl[tt];
              y[0] += __uint_as_float(yo.x << 16); y[1] += __uint_as_float(yo.x & 0xffff0000u); y[2] += __uint_as_float(yo.y << 16); y[3] += __uint_as_float(yo.y & 0xffff0000u);
              u32x2 o2; o2.x = pk2(y[0], y[1]); o2.y = pk2(y[2], y[3]); *(u32x2*)(yrow + tn * 16) = o2; }
        }
        g = gn; qa0 = nqa0; qa1 = nqa1; pa0 = npa0; pa1 = npa1; hl0 = nhl0; hl1 = nhl1;
    }
}

__device__ __forceinline__ void phase_post(const Params& P, const MixBufs& B, int layer) {
    const int tid_ = otid(); const int lane = tid_ & 63, gw = blockIdx.x * 8 + (tid_ >> 6), nw = gridDim.x * 8;
    const float gng = P.in[7][layer * 64 + lane];
    const float* ssdn = P.in[24] + layer * 512;
    float lng[4], lnb[4];
#pragma unroll
    for (int h = 0; h < 4; ++h) { lng[h] = P.in[17][layer * 256 + h * 64 + lane]; lnb[h] = P.in[18][layer * 256 + h * 64 + lane]; }
    const int c0 = lane * 8;
    const f32x4 sg0 = *(const f32x4*)(ssdn + c0), sg1 = *(const f32x4*)(ssdn + c0 + 4);
    const float Dh = P.in[23][layer * 8 + (lane >> 3)];
    for (int tl = gw; tl < TG; tl += nw) {
        const bf16_t* pr = B.p + (size_t)tl * DINP;
        bf16_t* mr = B.mix + (size_t)tl * DM;
        bf16_t go0[4], go1[4], ry0[4], ry1[4]; bf16_t ggt[4], rvv[4], rgg[4];
#pragma unroll
        for (int h = 0; h < 4; ++h) {
            const size_t o = (size_t)tl * 256 + h * 64 + lane;
            go0[h] = B.gla_o[o]; go1[h] = B.gla_o[(size_t)TG * 256 + o]; ggt[h] = pr[PC_GG + h * 64 + lane];
            ry0[h] = B.rw_y[o]; ry1[h] = B.rw_y[(size_t)TG * 256 + o]; rvv[h] = B.rw[1 * RWA + o]; rgg[h] = B.rw[3 * RWA + o];
        }
        const f32x4 srk = *(const f32x4*)(B.rw_s + (size_t)tl * 4), skr = *(const f32x4*)(B.rw_s + (size_t)TG * 4 + (size_t)tl * 4);
        const u32x4 ya = *(const u32x4*)(B.ssd_y + (size_t)tl * 512 + c0), yb = *(const u32x4*)(B.ssd_y + (size_t)TG * 512 + (size_t)tl * 512 + c0);
        const u32x4 xsr = *(const u32x4*)(B.ssd_x + (size_t)tl * 1024 + c0), zr = *(const u32x4*)(pr + PC_Z + c0);
#pragma unroll
        for (int h = 0; h < 4; ++h) {
            const float o = bf2f(go0[h]) + bf2f(go1[h]);
            const float ms = wave_sum(o * o) * (1.0f / 64.0f);
            mr[h * 64 + lane] = (bf16_t)f2bf(o * rsqrtf(ms + EPS) * gng * silu(bf2f(ggt[h])));
        }
#pragma unroll
        for (int h = 0; h < 4; ++h) {
            const float v = bf2f(rvv[h]);
            const float y = bf2f(ry0[h]) + bf2f(ry1[h]) - v * skr[h];
            const float mean = wave_sum(y) * (1.0f / 64.0f);
            const float dv = y - mean; const float var = wave_sum(dv * dv) * (1.0f / 64.0f);
            float oo = dv * rsqrtf(var + 64e-5f) * lng[h] + lnb[h];
            oo += srk[h] * v;
            mr[256 + h * 64 + lane] = (bf16_t)f2bf(oo * bf2f(rgg[h]));
        }
        {
            float xs[8], z[8], yfa[8], yfb[8]; unpack8(xsr, xs); unpack8(zr, z); unpack8(ya, yfa); unpack8(yb, yfb);
            float yv[8]; float ss = 0.f;
#pragma unroll
            for (int j = 0; j < 8; ++j) { const float yy = (yfa[j] + yfb[j]) + Dh * xs[j]; yv[j] = yy * silu(z[j]); ss += yv[j] * yv[j]; }
            ss = wave_sum(ss);
            const float rs = rsqrtf(ss * (1.0f / 512.0f) + EPS);
            u32x4 o; o.x = pk2(yv[0] * rs * sg0[0], yv[1] * rs * sg0[1]); o.y = pk2(yv[2] * rs * sg0[2], yv[3] * rs * sg0[3]);
            o.z = pk2(yv[4] * rs * sg1[0], yv[5] * rs * sg1[1]); o.w = pk2(yv[6] * rs * sg1[2], yv[7] * rs * sg1[3]);
            *(u32x4*)(mr + 512 + c0) = o;
        }
    }
}

#define RWKV_PRE_QUEUE(pool_base) do { \
        unsigned* qctr_ = (unsigned*)(ws + WS_CTL) + 4096 + 16 * (g * 2 + layer); \
        volatile LAS unsigned* qs_ = (volatile LAS unsigned*)(lds + 131072 + 1024 + 64); \
        unsigned tick_ = 0u; \
        if (threadIdx.x == 0) tick_ = __hip_atomic_fetch_add(qctr_, 1u, __ATOMIC_RELAXED, __HIP_MEMORY_SCOPE_AGENT); \
        for (;;) { \
            if (threadIdx.x == 0) qs_[0] = tick_; \
            __syncthreads(); \
            const int uq_ = (pool_base) + (int)qs_[0]; \
            __syncthreads(); \
            if (uq_ >= 4096) break; \
            if (threadIdx.x == 0) tick_ = __hip_atomic_fetch_add(qctr_, 1u, __ATOMIC_RELAXED, __HIP_MEMORY_SCOPE_AGENT); \
            RwRaw Rq_; rwkv_pre_load(Rq_, B, L, uq_, otid()); rwkv_pre(lds, B, rq, L, uq_, -1, Rq_); \
        } } while (0)

__global__ void __launch_bounds__(512, 2) fwd_megakernel(Params P) {
    extern __shared__ __attribute__((aligned(16))) unsigned char shm[];
    LAS unsigned char* lds = (LAS unsigned char*)shm;
    unsigned char* ws = P.ws;
    volatile LAS unsigned* bst = (volatile LAS unsigned*)(lds + 131072 + 1024);
    if (threadIdx.x == 0) { bst[0] = 0u; bst[1] = 0u; }
    __syncthreads();
    const XcdBarrier xbar = xcd_barrier_post((unsigned*)(ws + WS_CTL), bst);
    bf16_t* xb = (bf16_t*)(ws + WS_XB); float* ssp = (float*)(ws + WS_SSP); bf16_t* pbuf = (bf16_t*)(ws + WS_P);

    phase_weights(lds, P);
    for (int g = 0; g < NGROUP; ++g) {
        const int L = g < 2 ? 2048 : 16384, nseq = TG / L;
        phase_xprep(P, g);
        if (g == 0) cg::this_grid().sync(); else xcd_barrier(xbar);
        for (int layer = 0; layer < 2; ++layer) {
            pg8::StaticOrder S;
            {
                pg8::Gemm gm; gm.A = xb; gm.Bt = (const bf16_t*)(ws + WS_WIN) + (size_t)layer * DINP * DM; gm.M = TG; gm.N = DINP; gm.K = DM;
                S.init(TG, DINP, gridDim.x, blockIdx.x);
                EpiInproj E; E.O = pbuf; E.ssp = ssp;
                pg8::gemm_phase(lds, gm, S, E);
            }
            xcd_barrier(xbar);
            { const MixBufs B = mixbufs(P); const bf16_t* sw = (const bf16_t*)(ws + WS_SW) + (size_t)layer * SW_L;
              for (int t = blockIdx.x; t < TG / 64; t += gridDim.x) prep_tile64(lds, P, B, sw, layer, L, t); }
            xcd_barrier(xbar);
            {
                const MixBufs B = mixbufs(P);
                bf16_t* rq = (bf16_t*)(ws + WS_RWQ); float* segst = P.out + (size_t)g * TG * DM;
                const int nseg = L / 2048, nch = L / 64;
                const int nchain = nseg == 1 ? nseq * 24 : nseq * (nseg - 1) * 24;
                if (nseg == 1 && gridDim.x == 256) {
                    const int b = blockIdx.x;
                    ssd_unit(lds, P, B, segst, layer, L, b / 24 * 0 + (b >> 4), (b >> 1) & 7, b & 1, 0, false);
                    const int p0 = b * 10, pn = 10;
                    __syncthreads();
                    { RwRaw R; rwkv_pre_load(R, B, L, p0, otid());
                      for (int u = p0; u < p0 + pn; ++u) rwkv_pre(lds, B, rq, L, u, u + 1 < p0 + pn ? u + 1 : -1, R); }
                    RWKV_PRE_QUEUE(256 * 10);
                } else if (nseg == 8 && nseq == 2 && gridDim.x == 256) {
                    const int b = blockIdx.x;
                    for (int rep = 0; rep < 2; ++rep) {
                        const int it = b + rep * 256;
                        if (it < nchain) {
                            const int k = it % 24, sg = it / 24, seq = sg / (nseg - 1), seg = sg % (nseg - 1);
                            if (k < 16) ssd_unit(lds, P, B, segst, layer, L, seq, k >> 1, k & 1, seg, true);
                            else gla_unit(lds, P, B, segst, layer, L, seq, (k - 16) >> 1, k & 1, seg, true);
                        }
                    }
                    const int kx = b - 80;
                    const int p0 = b < 80 ? b * 5 : 400 + kx * 13, pn = b < 80 ? 5 : 13;
                    __syncthreads();
                    { RwRaw R; rwkv_pre_load(R, B, L, p0, otid());
                      for (int u = p0; u < p0 + pn; ++u) rwkv_pre(lds, B, rq, L, u, u + 1 < p0 + pn ? u + 1 : -1, R); }
                    RWKV_PRE_QUEUE(400 + 176 * 13);
                } else
                for (int it = blockIdx.x; it < nchain + 4096; it += gridDim.x) {
                    if (it < nchain) {
                        const int k = it % 24, sg = it / 24, seq = nseg == 1 ? sg : sg / (nseg - 1), seg = nseg == 1 ? 0 : sg % (nseg - 1);
                        if (k < 16) ssd_unit(lds, P, B, segst, layer, L, seq, k >> 1, k & 1, seg, nseg > 1);
                        else gla_unit(lds, P, B, segst, layer, L, seq, (k - 16) >> 1, k & 1, seg, nseg > 1);
                    } else { const int u = it - nchain; __syncthreads(); RwRaw R; rwkv_pre_load(R, B, L, u, otid()); rwkv_pre(lds, B, rq, L, u, -1, R); }
                }
            }
            xcd_barrier(xbar);
            {
                const MixBufs B = mixbufs(P);
                const bf16_t* rq = (const bf16_t*)(ws + WS_RWQ); float* segst = P.out + (size_t)g * TG * DM;
                const int nseg = L / 2048;
                const int nchain = nseg == 1 ? 0 : nseq * nseg * 24;
                const int nrs = nseq * 8, G = gridDim.x;
                if (nseg == 1 && G == 256) {
                    const int b = blockIdx.x;
                    if (b < 128) rwkv_seq(lds, B, rq, L, b >> 3, (b >> 1) & 3, b & 1);
                    else { const int u = b - 128; gla_unit(lds, P, B, segst, layer, L, u >> 3, (u >> 1) & 3, u & 1, 0, false); }
                } else
                for (int rnd = 0; rnd * G < nchain + nrs; ++rnd) {
                    const int it = rnd * G + ((rnd & 1) ? (G - 1 - (int)blockIdx.x) : (int)blockIdx.x);
                    if (it >= nchain + nrs) continue;
                    if (it >= nrs) {
                        const int ci = it - nrs, k = ci % 24, sg = ci / 24, seq = sg / nseg, seg = sg % nseg;
                        if (k < 16) ssd_unit(lds, P, B, segst, layer, L, seq, k >> 1, k & 1, seg, false);
                        else gla_unit(lds, P, B, segst, layer, L, seq, (k - 16) >> 1, k & 1, seg, false);
                    } else { rwkv_seq(lds, B, rq, L, it >> 3, (it >> 1) & 3, it & 1); }
                }
            }
            xcd_barrier(xbar);
            { const MixBufs B = mixbufs(P); phase_post(P, B, layer); }
            xcd_barrier(xbar);
            {
                pg8::Gemm gm; gm.A = (const bf16_t*)(ws + WS_MIX); gm.Bt = (const bf16_t*)(ws + WS_WOUT) + (size_t)layer * DM * DM; gm.M = TG; gm.N = DM; gm.K = DM;
                S.init(TG, DM, gridDim.x, blockIdx.x);
                EpiResid E; E.XB = xb; E.ssp = ssp;
                pg8::gemm_phase(lds, gm, S, E);
            }
            xcd_barrier(xbar);
            {
                pg8::Gemm gm; gm.A = xb; gm.Bt = (const bf16_t*)(ws + WS_WGU) + (size_t)layer * 2 * DFF * DM; gm.M = TG; gm.N = 2 * DFF; gm.K = DM;
                S.init(TG, 2 * DFF, gridDim.x, blockIdx.x);
                EpiGateUp E; E.O = pbuf; E.ssp = ssp;
                pg8::gemm_phase(lds, gm, S, E);
            }
            xcd_barrier(xbar);
            {
                pg8::Gemm gm; gm.A = pbuf; gm.Bt = (const bf16_t*)(ws + WS_WDN) + (size_t)layer * DM * DFF; gm.M = TG; gm.N = DM; gm.K = DFF;
                S.init(TG, DM, gridDim.x, blockIdx.x);
                EpiResid E; E.XB = xb; E.ssp = ssp;
                pg8::gemm_phase(lds, gm, S, E);
            }
            xcd_barrier(xbar);
        }
        phase_final(P, g);
        xcd_barrier(xbar);
    }
}

extern "C" void kernel_launch(void* const* d_in, const int* in_sizes, int n_in, void* d_out, int out_size, void* d_ws, size_t ws_size, hipStream_t stream) {
    static int grid = 0;
    if (grid == 0) {
        if (n_in != 30 || ws_size < WS_END) { fprintf(stderr, "kernel_launch: need 30 inputs and %zu ws bytes; got %d, %zu\n", (size_t)WS_END, n_in, ws_size); grid = -1; return; }
        int dev = 0, cus = 0, per_cu = 0;
        hipGetDevice(&dev);
        hipDeviceGetAttribute(&cus, hipDeviceAttributeMultiprocessorCount, dev);
        hipFuncSetAttribute((const void*)fwd_megakernel, hipFuncAttributeMaxDynamicSharedMemorySize, LDS_BYTES);
        hipOccupancyMaxActiveBlocksPerMultiprocessor(&per_cu, (const void*)fwd_megakernel, 512, LDS_BYTES);
        if (per_cu < 1) per_cu = 1;
        grid = cus * 1;
        if (grid > 256) grid = 256;
    }
    if (grid < 0) return;
    if (hipMemsetAsync((char*)d_ws + WS_CTL, 0, 65536, stream) != hipSuccess) { fprintf(stderr, "memset failed\n"); return; }
    Params p{};
    for (int i = 0; i < 30; ++i) p.in[i] = (const float*)d_in[i];
    p.out = (float*)d_out; p.ws = (unsigned char*)d_ws;
    void* args[] = {&p};
    hipError_t e = hipLaunchCooperativeKernel((const void*)fwd_megakernel, dim3(grid), dim3(512), args, LDS_BYTES, stream);
    if (e != hipSuccess) fprintf(stderr, "cooperative launch failed: %s (grid %d)\n", hipGetErrorString(e), grid);
}
```

```cpp
#include <hip/hip_runtime.h>
#include <hip/hip_cooperative_groups.h>
#include <cstdio>
namespace cg = cooperative_groups;

#define LAS __attribute__((address_space(3)))
typedef unsigned short bf16_t;
typedef short bf16x8 __attribute__((ext_vector_type(8)));
typedef float f32x4 __attribute__((ext_vector_type(4)));
typedef float f32x2 __attribute__((ext_vector_type(2)));
typedef unsigned u32x4 __attribute__((ext_vector_type(4)));
typedef unsigned u32x2 __attribute__((ext_vector_type(2)));

constexpr int DM = 1024, TALL = 98304, TG = 32768, NGROUP = 3;
constexpr int DINP = 3584, DIN = 3504, DFF = 2816;
constexpr int LDS_BYTES = 131072 + 2048;
constexpr float EPS = 1e-6f;
constexpr int PC_GQ = 0, PC_GK = 128, PC_GV = 256, PC_GG = 512, PC_GAF = 768;
constexpr int PC_R = 800, PC_RK = 1056, PC_RV = 1312, PC_RLOW = 1568;
constexpr int PC_Z = 1952, PC_XBC = 2464, PC_DT = 3488;

constexpr size_t WS_CTL = 0;
constexpr size_t WS_SW = 65536;
constexpr int SW_L = 106496;
constexpr size_t WS_WIN = WS_SW + 524288;
constexpr size_t WS_WOUT = WS_WIN + (size_t)2 * DINP * DM * 2;
constexpr size_t WS_WGU = WS_WOUT + (size_t)2 * DM * DM * 2;
constexpr size_t WS_WDN = WS_WGU + (size_t)2 * 2 * DFF * DM * 2;
constexpr size_t WS_XB = WS_WDN + (size_t)2 * DM * DFF * 2;
constexpr size_t WS_P = WS_XB + (size_t)TG * DM * 2;
constexpr size_t WS_MIX = WS_P + (size_t)TG * DINP * 2;
constexpr size_t WS_SSP = WS_MIX + (size_t)TG * DM * 2;
constexpr size_t WS_GLA_LA = WS_SSP + (size_t)TG * 16 * 4;
constexpr size_t WS_GLA_O = WS_GLA_LA + (size_t)2 * TG * 128 * 4;
constexpr size_t WS_RW = WS_GLA_O + (size_t)2 * TG * 256 * 4;
constexpr size_t WS_RW_S = WS_RW + (size_t)10 * TG * 256 * 2;
constexpr size_t WS_RW_Y = WS_RW_S + (size_t)2 * TG * 4 * 4;
constexpr size_t WS_SSD_X = WS_RW_Y + (size_t)2 * TG * 256 * 4;
constexpr size_t WS_SSD_DT = WS_SSD_X + (size_t)TG * 1024 * 2;
constexpr size_t WS_SSD_Y = WS_SSD_DT + (size_t)TG * 16 * 4;
constexpr size_t WS_RWQ = WS_SSD_Y + (size_t)2 * TG * 512 * 4;
constexpr size_t WS_END = WS_RWQ + (size_t)4096 * 3 * 4096 * 2;
static_assert(WS_END <= ((size_t)1 << 30), "workspace over 1 GiB");

struct Params { const float* in[30]; float* out; unsigned char* ws; };

__device__ __forceinline__ int otid() { int t = threadIdx.x; asm volatile("" : "+v"(t)); return t; }
__device__ __forceinline__ float bf2f(bf16_t b) { return __uint_as_float(((unsigned)b) << 16); }
typedef __bf16 bf16x2_t __attribute__((ext_vector_type(2)));
__device__ __forceinline__ unsigned pk2(float lo, float hi) { f32x2 f = {lo, hi}; bf16x2_t v = __builtin_convertvector(f, bf16x2_t); return __builtin_bit_cast(unsigned, v); }
__device__ __forceinline__ unsigned f2bf(float f) { return (unsigned)__builtin_bit_cast(unsigned short, (__bf16)f); }
__device__ __forceinline__ float sigm(float x) { return __builtin_amdgcn_rcpf(1.0f + __expf(-x)); }
__device__ __forceinline__ float silu(float x) { return x * __builtin_amdgcn_rcpf(1.0f + __expf(-x)); }
__device__ __forceinline__ float softplus(float x) { return fmaxf(x, 0.f) + __logf(1.0f + __expf(-fabsf(x))); }
__device__ __forceinline__ void lds_barrier() { asm volatile("s_waitcnt lgkmcnt(0)" ::: "memory"); __builtin_amdgcn_s_barrier(); asm volatile("" ::: "memory"); }

__device__ __forceinline__ float dpp_add(float v, float src_carrier) { return v + src_carrier; }
#define DPPF(x, ctrl, rmask) __int_as_float(__builtin_amdgcn_update_dpp(0, __float_as_int(x), (ctrl), (rmask), 0xf, false))
__device__ __forceinline__ float wave_incl_scan(float v, int lane) {
    v += DPPF(v, 0x111, 0xf);
    v += DPPF(v, 0x112, 0xf);
    v += DPPF(v, 0x114, 0xf);
    v += DPPF(v, 0x118, 0xf);
    v += DPPF(v, 0x142, 0xa);
    v += DPPF(v, 0x143, 0xc);
    return v;
}
__device__ __forceinline__ float lane_bcast(float v, int l) { return __int_as_float(__builtin_amdgcn_readlane(__float_as_int(v), l)); }
__device__ __forceinline__ float wave_sum(float v) { return lane_bcast(wave_incl_scan(v, 0), 63); }
__device__ __forceinline__ void unpack8(u32x4 v, float* f) {
    f[0] = __uint_as_float(v.x << 16); f[1] = __uint_as_float(v.x & 0xffff0000u);
    f[2] = __uint_as_float(v.y << 16); f[3] = __uint_as_float(v.y & 0xffff0000u);
    f[4] = __uint_as_float(v.z << 16); f[5] = __uint_as_float(v.z & 0xffff0000u);
    f[6] = __uint_as_float(v.w << 16); f[7] = __uint_as_float(v.w & 0xffff0000u);
}


#define XB_TMO      128
#define XB_XCNT(j)  (256  + 64 * (j))
#define XB_XSUB(j)  (1280 + 64 * (j))
#define XB_XGEN(j)  (2304 + 64 * (j))
#define XB_TOP      3328
#define XB_TOPGEN   3392
#define XB_SPIN_CAP (1u << 22)
__device__ __forceinline__ unsigned xb_ld(unsigned* p)              { return __hip_atomic_load(p, __ATOMIC_RELAXED, __HIP_MEMORY_SCOPE_AGENT); }
__device__ __forceinline__ unsigned xb_add(unsigned* p, unsigned v) { return __hip_atomic_fetch_add(p, v, __ATOMIC_RELAXED, __HIP_MEMORY_SCOPE_AGENT); }
__device__ __forceinline__ unsigned xb_xcc_id() { return (unsigned)__builtin_amdgcn_s_getreg((3 << 11) | 20) & 0xFu; }
#define XB_SPIN(cond, bar) do { unsigned _sp = 0; while (cond) { __builtin_amdgcn_s_sleep(1); \
    if ((++_sp & 255u) == 0u) { if (xb_ld(&(bar)[XB_TMO])) break; if (_sp > XB_SPIN_CAP) { atomicAdd(&(bar)[XB_TMO], 1u); break; } } } } while (0)
struct XcdBarrier { unsigned* bar; unsigned x; volatile LAS unsigned* st; };
__device__ __forceinline__ XcdBarrier xcd_barrier_post(unsigned* bar, volatile LAS unsigned* st) {
    XcdBarrier b; b.bar = bar; b.x = xb_xcc_id(); b.st = st;
    if (threadIdx.x == 0) (void)xb_add(&bar[XB_XCNT(b.x)], 1u);
    return b;
}
__device__ __forceinline__ void xcd_barrier_complete(unsigned* bar, unsigned x, unsigned& nloc, unsigned& nx) {
    const unsigned G = gridDim.x * gridDim.y * gridDim.z;
    unsigned sum, cnt, mine, sp = 0u;
    for (;;) {
        sum = 0u; cnt = 0u; mine = 0u;
#pragma unroll
        for (unsigned j = 0; j < 16; ++j) { const unsigned c = xb_ld(&bar[XB_XCNT(j)]); sum += c; cnt += (c > 0u) ? 1u : 0u; mine = (j == x) ? c : mine; }
        if (sum == G) break;
        __builtin_amdgcn_s_sleep(1);
        if ((++sp & 255u) == 0u) { if (xb_ld(&bar[XB_TMO])) break; if (sp > XB_SPIN_CAP) { atomicAdd(&bar[XB_TMO], 1u); break; } }
    }
    nloc = mine > 0u ? mine : 1u; nx = cnt > 0u ? cnt : 1u;
}
__device__ __forceinline__ void xcd_barrier(const XcdBarrier& b) {
    asm volatile("s_waitcnt vmcnt(0)" ::: "memory");
    __syncthreads();
    if (threadIdx.x == 0) {
        unsigned* bar = b.bar;
        __builtin_amdgcn_s_waitcnt(0);
        unsigned nloc = b.st[0], nx = b.st[1];
        if (nloc == 0u) { xcd_barrier_complete(bar, b.x, nloc, nx); b.st[0] = nloc; b.st[1] = nx; }
        const unsigned old = xb_add(&bar[XB_XSUB(b.x)], 1u);
        const unsigned gen = old / nloc;
        if (old + 1u == (gen + 1u) * nloc) {
            __builtin_amdgcn_fence(__ATOMIC_RELEASE, "agent");
            asm volatile("s_waitcnt vmcnt(0)" ::: "memory");
            const unsigned og = xb_add(&bar[XB_TOP], 1u);
            const unsigned tg = og / nx;
            if (og + 1u == (tg + 1u) * nx) xb_add(&bar[XB_TOPGEN], 1u);
            else XB_SPIN(xb_ld(&bar[XB_TOPGEN]) == tg, bar);
            __builtin_amdgcn_fence(__ATOMIC_ACQUIRE, "agent");
            xb_add(&bar[XB_XGEN(b.x)], 1u);
            asm volatile("s_waitcnt vmcnt(0)" ::: "memory");
        } else {
            XB_SPIN(xb_ld(&bar[XB_XGEN(b.x)]) == gen, bar);
            __builtin_amdgcn_fence(__ATOMIC_ACQUIRE, "agent");
            asm volatile("s_waitcnt vmcnt(0)" ::: "memory");
        }
    }
    __syncthreads();
}

namespace pg8 {
constexpr int BM = 256, BK = 64, HALF = 128, HTB = HALF * BK * 2, NXCD = 8, WGM = 4;
__device__ __forceinline__ int lds_byte(int r, int c) { const int st = (r >> 4) * 2 + (c >> 5), rr = r & 15, cc = c & 31, ob = rr * 64 + cc * 2; return st * 1024 + (ob ^ (((ob >> 9) & 1) << 5)); }
__device__ __forceinline__ void stage_rc(int b, int& R, int& C) { const int st = b / 1024, sb = b % 1024, swz = sb ^ (((sb >> 9) & 1) << 5); R = (st >> 1) * 16 + swz / 64; C = (st & 1) * 32 + (swz % 64) / 2; }
__device__ __forceinline__ int perm32(int rho) { const int n = rho >> 4, i = rho & 15; return 8 * (i >> 2) + 4 * n + (i & 3); }
struct Unit { int pm, pn; };
struct Gemm { const bf16_t* A; const bf16_t* Bt; int M, N, K; };
struct StaticOrder {
    int nM, nN, nwg, G, c;
    __device__ void init(int M, int N, int G_, int c_) { nM = M / BM; nN = N / BM; nwg = nM * nN; G = G_; c = c_; }
    __device__ bool next(int i, Unit& u) const {
        const long L = (long)i * G + c; if (L >= nwg) return false;
        int wgid = (int)L; { const int q = nwg / NXCD, r = nwg % NXCD, xcd = wgid % NXCD, off = wgid / NXCD; wgid = (xcd < r ? xcd * (q + 1) : r * (q + 1) + (xcd - r) * q) + off; }
        const int nig = WGM * nN, gid = wgid / nig, fm = gid * WGM, gsz = (nM - fm) < WGM ? (nM - fm) : WGM;
        u.pm = fm + ((wgid % nig) % gsz); u.pn = (wgid % nig) / gsz; return true;
    }
};

template <class Epi>
__device__ __forceinline__ void gemm_phase(LAS unsigned char* lds, const Gemm g, const StaticOrder& S, const Epi& E) {
    const int tid = otid(), wid = __builtin_amdgcn_readfirstlane(tid >> 6), lane = tid & 63, wr = wid >> 2, wc = wid & 3, fr = lane & 15, fq = lane >> 4;
    const int K = g.K, nt = K / BK;
    unsigned voffA[2], voffB[2];
#pragma unroll
    for (int i = 0; i < 2; ++i) { int R, C; stage_rc(tid * 16 + i * 8192, R, C); const int Rb = Epi::PERM ? ((R & ~31) + perm32(R & 31)) : R;
        voffA[i] = (unsigned)(R * K + C) * 2u; voffB[i] = (unsigned)(Rb * K + C) * 2u; }
    const size_t kstep = (size_t)(BK * 2);
    const size_t hstep = (size_t)HALF * K * 2;
    const size_t tstep = 2 * hstep;
    const unsigned ldsw = (unsigned)wid * 1024u;
    const int aoff = lds_byte(wr * 64 + fr, fq * 8), boff = lds_byte(wc * 32 + fr, fq * 8);
#define PG8_SA(b, h) (((b) * 2 + (h)) * HTB)
#define PG8_SB(b, h) ((4 + (b) * 2 + (h)) * HTB)
#define PG8_STAGE(bufoff, gbase, voff) do { _Pragma("unroll") for (int _i = 0; _i < 2; ++_i) \
        __builtin_amdgcn_global_load_lds((const unsigned*)((const char*)(gbase) + (voff)[_i]), (LAS unsigned*)(lds + (bufoff) + ldsw + _i * 8192), 16, 0, 0); } while (0)
#define PG8_LDA(dst, b, h) do { _Pragma("unroll") for (int m = 0; m < 4; ++m) _Pragma("unroll") for (int k = 0; k < 2; ++k) dst[m][k] = *(const LAS bf16x8*)(lds + PG8_SA(b, h) + aoff + m * 2048 + k * 1024); } while (0)
#define PG8_LDB(dst, b, h) do { _Pragma("unroll") for (int n = 0; n < 2; ++n) _Pragma("unroll") for (int k = 0; k < 2; ++k) dst[n][k] = *(const LAS bf16x8*)(lds + PG8_SB(b, h) + boff + n * 2048 + k * 1024); } while (0)
#define PG8_MMA(ai, bj, At, Bt) do { __builtin_amdgcn_s_setprio(1); _Pragma("unroll") for (int m = 0; m < 4; ++m) _Pragma("unroll") for (int n = 0; n < 2; ++n) _Pragma("unroll") for (int k = 0; k < 2; ++k) \
        acc[ai][bj][m][n] = __builtin_amdgcn_mfma_f32_16x16x32_bf16(Bt[n][k], At[m][k], acc[ai][bj][m][n], 0, 0, 0); __builtin_amdgcn_s_setprio(0); } while (0)
#define PG8_WAIT_V(n) asm volatile("s_waitcnt vmcnt(" #n ")" ::: "memory")
#define PG8_WAIT_L(n) asm volatile("s_waitcnt lgkmcnt(" #n ")" ::: "memory")
#define PG8_BAR __builtin_amdgcn_s_barrier()
#define PG8_SCHED __builtin_amdgcn_sched_barrier(0)
    Unit cur, nxt; int ui = 0;
    if (!S.next(0, cur)) return;
    f32x4 acc[2][2][4][2];
#pragma unroll
    for (int a = 0; a < 2; ++a)
#pragma unroll
        for (int b = 0; b < 2; ++b)
#pragma unroll
            for (int m = 0; m < 4; ++m)
#pragma unroll
                for (int n = 0; n < 2; ++n) acc[a][b][m][n] = (f32x4){0.f, 0.f, 0.f, 0.f};
    bf16x8 At[4][2], B0[2][2], B1[2][2];
    const char* cA = (const char*)g.A + (size_t)cur.pm * tstep; const char* cB = (const char*)g.Bt + (size_t)cur.pn * tstep;
    PG8_STAGE(PG8_SB(0, 0), cB, voffB); PG8_STAGE(PG8_SA(0, 0), cA, voffA); PG8_STAGE(PG8_SB(0, 1), cB + hstep, voffB); PG8_STAGE(PG8_SA(0, 1), cA + hstep, voffA);
    if (wr == 1) PG8_BAR;
    PG8_WAIT_V(4); PG8_BAR;
    PG8_STAGE(PG8_SB(1, 0), cB + kstep, voffB); PG8_STAGE(PG8_SA(1, 0), cA + kstep, voffA); PG8_STAGE(PG8_SB(1, 1), cB + hstep + kstep, voffB);
    PG8_WAIT_V(6); PG8_BAR;
    for (;;) {
        const bool has_next = S.next(ui + 1, nxt);
        const char* nA = has_next ? (const char*)g.A + (size_t)nxt.pm * tstep : cA; const char* nB = has_next ? (const char*)g.Bt + (size_t)nxt.pn * tstep : cB;
        for (int t = 0; t < nt; t += 2) {
            const bool last = (t == nt - 2);
            const char* a1 = cA + (size_t)(t + 1) * kstep;
            const char* a2 = last ? nA : cA + (size_t)(t + 2) * kstep; const char* b2 = last ? nB : cB + (size_t)(t + 2) * kstep;
            const char* a3 = a2 + kstep; const char* b3 = b2 + kstep;
            PG8_LDB(B0, 0, 0); PG8_SCHED; PG8_LDA(At, 0, 0); PG8_STAGE(PG8_SA(1, 1), a1 + hstep, voffA);
            PG8_WAIT_L(8); PG8_BAR; PG8_WAIT_L(0); PG8_MMA(0, 0, At, B0); PG8_BAR; PG8_SCHED;
            PG8_LDB(B1, 0, 1); PG8_STAGE(PG8_SB(0, 0), b2, voffB);
            PG8_BAR; PG8_WAIT_L(0); PG8_MMA(0, 1, At, B1); PG8_BAR;
            PG8_LDA(At, 0, 1); PG8_STAGE(PG8_SA(0, 0), a2, voffA);
            PG8_BAR; PG8_WAIT_L(0); PG8_MMA(1, 0, At, B0); PG8_BAR; PG8_SCHED;
            PG8_STAGE(PG8_SB(0, 1), b2 + hstep, voffB);
            PG8_WAIT_V(6); PG8_BAR; PG8_MMA(1, 1, At, B1); PG8_BAR;
            PG8_LDB(B0, 1, 0); PG8_SCHED; PG8_LDA(At, 1, 0); PG8_STAGE(PG8_SA(0, 1), a2 + hstep, voffA);
            PG8_WAIT_L(8); PG8_BAR; PG8_WAIT_L(0); PG8_MMA(0, 0, At, B0); PG8_BAR; PG8_SCHED;
            PG8_LDB(B1, 1, 1); PG8_STAGE(PG8_SB(1, 0), b3, voffB);
            PG8_BAR; PG8_WAIT_L(0); PG8_MMA(0, 1, At, B1); PG8_BAR;
            PG8_LDA(At, 1, 1); PG8_STAGE(PG8_SA(1, 0), a3, voffA);
            PG8_BAR; PG8_WAIT_L(0); PG8_MMA(1, 0, At, B0); PG8_BAR; PG8_SCHED;
            PG8_STAGE(PG8_SB(1, 1), b3 + hstep, voffB);
            PG8_WAIT_V(6); PG8_BAR; PG8_MMA(1, 1, At, B1); PG8_BAR;
        }
        E(acc, cur, wr, wc, fr, fq);
        if (!has_next) break;
#pragma unroll
        for (int a = 0; a < 2; ++a)
#pragma unroll
            for (int b = 0; b < 2; ++b)
#pragma unroll
                for (int m = 0; m < 4; ++m)
#pragma unroll
                    for (int n = 0; n < 2; ++n) acc[a][b][m][n] = (f32x4){0.f, 0.f, 0.f, 0.f};
        cur = nxt; cA = nA; cB = nB; ++ui;
    }
    PG8_WAIT_V(0);
    if (wr == 0) PG8_BAR;
    PG8_BAR;
#undef PG8_SA
#undef PG8_SB
#undef PG8_STAGE
#undef PG8_LDA
#undef PG8_LDB
#undef PG8_MMA
#undef PG8_WAIT_V
#undef PG8_WAIT_L
#undef PG8_BAR
#undef PG8_SCHED
}
}

__device__ __forceinline__ float row_rs(const float* ssp, int row) {
    const f32x4* p = (const f32x4*)(ssp + (size_t)row * 16);
    f32x4 a = p[0], b = p[1], c = p[2], d = p[3];
    float s = (a[0] + a[1] + a[2] + a[3]) + (b[0] + b[1] + b[2] + b[3]) + (c[0] + c[1] + c[2] + c[3]) + (d[0] + d[1] + d[2] + d[3]);
    return rsqrtf(s * (1.0f / 1024.0f) + EPS);
}

__device__ __forceinline__ f32x4 rs_part(const float* ssp, int row, int fq) { return *(const f32x4*)(ssp + (size_t)row * 16 + fq * 4); }
__device__ __forceinline__ float rs_fin(f32x4 a) { float s = (a[0] + a[1]) + (a[2] + a[3]); s += __shfl_xor(s, 16); s += __shfl_xor(s, 32); return rsqrtf(s * (1.0f / 1024.0f) + EPS); }
struct EpiInproj {
    static constexpr bool PERM = true;
    bf16_t* O; const float* ssp;
    __device__ __forceinline__ void operator()(const f32x4 (&acc)[2][2][4][2], const pg8::Unit& u, int wr, int wc, int fr, int fq) const {
        const int row0 = u.pm * 256 + wr * 64 + fr, col0 = u.pn * 256 + wc * 32 + 8 * fq;
        f32x4 rp[2][4];
#pragma unroll
        for (int ai = 0; ai < 2; ++ai)
#pragma unroll
            for (int m = 0; m < 4; ++m) rp[ai][m] = rs_part(ssp, row0 + ai * 128 + m * 16, fq);
#pragma unroll
        for (int ai = 0; ai < 2; ++ai)
#pragma unroll
            for (int m = 0; m < 4; ++m) {
                const int row = row0 + ai * 128 + m * 16; const float rs = rs_fin(rp[ai][m]);
                bf16_t* rowp = O + (size_t)row * DINP + col0;
#pragma unroll
                for (int bj = 0; bj < 2; ++bj) { f32x4 v0 = acc[ai][bj][m][0] * rs, v1 = acc[ai][bj][m][1] * rs;
                    u32x4 w; w.x = pk2(v0[0], v0[1]); w.y = pk2(v0[2], v0[3]); w.z = pk2(v1[0], v1[1]); w.w = pk2(v1[2], v1[3]);
                    __builtin_nontemporal_store(w, (u32x4*)(rowp + bj * 128)); }
            }
    }
};
struct EpiGateUp {
    static constexpr bool PERM = true;
    bf16_t* O; const float* ssp;
    __device__ __forceinline__ void operator()(const f32x4 (&acc)[2][2][4][2], const pg8::Unit& u, int wr, int wc, int fr, int fq) const {
        const int row0 = u.pm * 256 + wr * 64 + fr, col0 = u.pn * 128 + wc * 32 + 8 * fq;
        f32x4 rp[2][4];
#pragma unroll
        for (int ai = 0; ai < 2; ++ai)
#pragma unroll
            for (int m = 0; m < 4; ++m) rp[ai][m] = rs_part(ssp, row0 + ai * 128 + m * 16, fq);
#pragma unroll
        for (int ai = 0; ai < 2; ++ai)
#pragma unroll
            for (int m = 0; m < 4; ++m) {
                const int row = row0 + ai * 128 + m * 16; const float rs = rs_fin(rp[ai][m]);
                float h[8];
#pragma unroll
                for (int n = 0; n < 2; ++n)
#pragma unroll
                    for (int j = 0; j < 4; ++j) h[n * 4 + j] = silu(acc[ai][0][m][n][j] * rs) * (acc[ai][1][m][n][j] * rs);
                u32x4 w; w.x = pk2(h[0], h[1]); w.y = pk2(h[2], h[3]); w.z = pk2(h[4], h[5]); w.w = pk2(h[6], h[7]);
                __builtin_nontemporal_store(w, (u32x4*)(O + (size_t)row * DFF + col0));
            }
    }
};
struct EpiResid {
    static constexpr bool PERM = true;
    bf16_t* XB; float* ssp;
    __device__ __forceinline__ void operator()(const f32x4 (&acc)[2][2][4][2], const pg8::Unit& u, int wr, int wc, int fr, int fq) const {
        const int row0 = u.pm * 256 + wr * 64 + fr, col0 = u.pn * 256 + wc * 32 + 8 * fq;
        u32x4 xnx[2];
        { const bf16_t* xr0 = XB + (size_t)row0 * DM + col0; xnx[0] = *(const u32x4*)xr0; xnx[1] = *(const u32x4*)(xr0 + 128); }
#pragma unroll
        for (int ai = 0; ai < 2; ++ai)
#pragma unroll
            for (int m = 0; m < 4; ++m) {
                const int row = row0 + ai * 128 + m * 16;
                bf16_t* br = XB + (size_t)row * DM + col0;
                const u32x4 xc0 = xnx[0], xc1 = xnx[1];
                if (ai * 4 + m < 7) { const int idx = ai * 4 + m + 1; const bf16_t* xrn = XB + (size_t)(row0 + (idx >> 2) * 128 + (idx & 3) * 16) * DM + col0;
                    xnx[0] = *(const u32x4*)xrn; xnx[1] = *(const u32x4*)(xrn + 128); }
                float ss = 0.f;
#pragma unroll
                for (int bj = 0; bj < 2; ++bj) {
                    float xo[8]; unpack8(bj == 0 ? xc0 : xc1, xo);
                    const f32x4 a0 = acc[ai][bj][m][0], a1 = acc[ai][bj][m][1];
                    float v[8];
#pragma unroll
                    for (int j = 0; j < 4; ++j) { v[j] = xo[j] + a0[j]; v[4 + j] = xo[4 + j] + a1[j]; }
#pragma unroll
                    for (int j = 0; j < 8; ++j) ss += v[j] * v[j];
                    u32x4 w; w.x = pk2(v[0], v[1]); w.y = pk2(v[2], v[3]); w.z = pk2(v[4], v[5]); w.w = pk2(v[6], v[7]);
                    *(u32x4*)(br + bj * 128) = w;
                }
                ss += __shfl_xor(ss, 16); ss += __shfl_xor(ss, 32);
                if (fq == 0) ssp[(size_t)row * 16 + u.pn * 4 + wc] = ss;
                asm volatile("" ::: "memory");
            }
    }
};

__device__ __forceinline__ void wtile(LAS float* tile, const float* src, int lds_src, const float* gain, bf16_t* dst, int K, int n0, int k0, int c0, int nvalid) {
    const int tid = otid();
    __syncthreads();
#pragma unroll
    for (int i = 0; i < 8; ++i) {
        const int kk = (tid >> 6) + 8 * i, c = tid & 63;
        float v = 0.f;
        if (c0 + c < nvalid) { v = src[(size_t)(k0 + kk) * lds_src + c0 + c]; if (gain) v *= gain[k0 + kk]; }
        tile[kk * 65 + c] = v;
    }
    __syncthreads();
    const int n = tid >> 3, kc = (tid & 7) * 8;
    float f[8];
#pragma unroll
    for (int j = 0; j < 8; ++j) f[j] = tile[(kc + j) * 65 + n];
    u32x4 w; w.x = pk2(f[0], f[1]); w.y = pk2(f[2], f[3]); w.z = pk2(f[4], f[5]); w.w = pk2(f[6], f[7]);
    *(u32x4*)(dst + (size_t)(n0 + n) * K + k0 + kc) = w;
}
__device__ __forceinline__ void phase_weights(LAS unsigned char* lds, const Params& P) {
    LAS float* tile = (LAS float*)lds;
    unsigned char* ws = P.ws;
    constexpr int T_IN = 56 * 16, T_OUT = 16 * 16, T_GU = 88 * 16, T_DN = 16 * 44, T_L = T_IN + T_OUT + T_GU + T_DN;
    for (int t = blockIdx.x; t < 2 * 24; t += gridDim.x) {
        const int l = t / 24, idx = t % 24; bf16_t* sw = (bf16_t*)(ws + WS_SW) + (size_t)l * SW_L;
        if (idx < 16) { const int m = idx >> 2, nb = idx & 3, d = m & 1;
            const float* src = (m < 2 ? P.in[10] : P.in[12]) + (size_t)(l * 2 + d) * 64 * 256;
            wtile(tile, src, 256, nullptr, sw + m * 16384, 64, nb * 64, 0, nb * 64, 256);
        } else { const int nb = (idx - 16) >> 1, kb = (idx - 16) & 1;
            wtile(tile, P.in[13] + (size_t)l * 128 * 256, 256, nullptr, sw + 65536, 128, nb * 64, kb * 64, nb * 64, 256); }
    }
    for (int i = blockIdx.x * 512 + threadIdx.x; i < 2 * 8192; i += gridDim.x * 512) {
        const int l = i >> 13, rem = i & 8191, d = rem >> 12, c = (rem & 4095) >> 5, k = rem & 31;
        const float v = ((k >> 4) == d) ? P.in[5][((size_t)(l * 2 + d) * 16 + (k & 15)) * 128 + c] : 0.f;
        ((bf16_t*)(ws + WS_SW))[(size_t)l * SW_L + 98304 + rem] = (bf16_t)f2bf(v);
    }
    for (int t = blockIdx.x; t < 2 * T_L; t += gridDim.x) {
        const int l = t / T_L; int r = t % T_L;
        if (r < T_IN) { const int nb = r / 16, kb = r % 16;
            wtile(tile, P.in[3] + (size_t)l * DM * DIN, DIN, P.in[2] + l * DM, (bf16_t*)(ws + WS_WIN) + (size_t)l * DINP * DM, DM, nb * 64, kb * 64, nb * 64, DIN);
        } else if ((r -= T_IN) < T_OUT) { const int nb = r / 16, kb = r % 16;
            wtile(tile, P.in[4] + (size_t)l * DM * DM, DM, nullptr, (bf16_t*)(ws + WS_WOUT) + (size_t)l * DM * DM, DM, nb * 64, kb * 64, nb * 64, DM);
        } else if ((r -= T_OUT) < T_GU) { const int nb = r / 16, kb = r % 16;
            const int j = nb >> 2, qd = nb & 3; const float* src = (qd < 2 ? P.in[26] : P.in[27]) + (size_t)l * DM * DFF;
            wtile(tile, src, DFF, P.in[25] + l * DM, (bf16_t*)(ws + WS_WGU) + (size_t)l * 2 * DFF * DM, DM, nb * 64, kb * 64, j * 128 + (qd & 1) * 64, DFF);
        } else { r -= T_GU; const int nb = r / 44, kb = r % 44;
            wtile(tile, P.in[28] + (size_t)l * DFF * DM, DM, nullptr, (bf16_t*)(ws + WS_WDN) + (size_t)l * DM * DFF, DFF, nb * 64, kb * 64, nb * 64, DM);
        }
    }
}

__device__ __forceinline__ void phase_xprep(const Params& P, int g) {
    const float* xin = (g < 2) ? P.in[0] + (size_t)g * TG * DM : P.in[1];
    bf16_t* xb = (bf16_t*)(P.ws + WS_XB); float* ssp = (float*)(P.ws + WS_SSP);
    const int tid_ = otid(); const int lane = tid_ & 63, gw = blockIdx.x * 8 + (tid_ >> 6), nw = gridDim.x * 8;
    for (int row = gw; row < TG; row += nw) {
        float ss = 0.f;
#pragma unroll
        for (int i = 0; i < 4; ++i) {
            const int c = i * 256 + lane * 4;
            f32x4 v = *(const f32x4*)(xin + (size_t)row * DM + c);
            u32x2 w; w.x = pk2(v[0], v[1]); w.y = pk2(v[2], v[3]);
            *(u32x2*)(xb + (size_t)row * DM + c) = w;
            ss += (v[0] * v[0] + v[1] * v[1]) + (v[2] * v[2] + v[3] * v[3]);
        }
        ss = wave_sum(ss);
        if (lane < 16) ssp[(size_t)row * 16 + lane] = (lane == 0) ? ss : 0.f;
    }
}
__device__ __forceinline__ void phase_final(const Params& P, int g) {
    float* xo = P.out + (size_t)g * TG * DM; const bf16_t* xb = (const bf16_t*)(P.ws + WS_XB); const float* ssp = (const float*)(P.ws + WS_SSP); const float* gn = P.in[29];
    const int tid_ = otid(); const int lane = tid_ & 63, gw = blockIdx.x * 8 + (tid_ >> 6), nw = gridDim.x * 8;
    for (int row = gw; row < TG; row += nw) {
        const float rs = row_rs(ssp, row);
#pragma unroll
        for (int i = 0; i < 2; ++i) {
            const int c = i * 512 + lane * 8;
            float v[8]; unpack8(*(const u32x4*)(xb + (size_t)row * DM + c), v);
            const f32x4 g0 = *(const f32x4*)(gn + c), g1 = *(const f32x4*)(gn + c + 4);
            *(f32x4*)(xo + (size_t)row * DM + c) = (f32x4){v[0] * rs * g0[0], v[1] * rs * g0[1], v[2] * rs * g0[2], v[3] * rs * g0[3]};
            *(f32x4*)(xo + (size_t)row * DM + c + 4) = (f32x4){v[4] * rs * g1[0], v[5] * rs * g1[1], v[6] * rs * g1[2], v[7] * rs * g1[3]};
        }
    }
}

struct MixBufs {
    const bf16_t* p; float* gla_la; bf16_t* gla_o; bf16_t* rw; float* rw_s; bf16_t* rw_y; bf16_t* ssd_x; float* ssd_dt; bf16_t* ssd_y; bf16_t* mix;
};
__device__ __forceinline__ MixBufs mixbufs(const Params& P) {
    MixBufs B; unsigned char* ws = P.ws;
    B.p = (const bf16_t*)(ws + WS_P); B.gla_la = (float*)(ws + WS_GLA_LA); B.gla_o = (bf16_t*)(ws + WS_GLA_O); B.rw = (bf16_t*)(ws + WS_RW);
    B.rw_s = (float*)(ws + WS_RW_S); B.rw_y = (bf16_t*)(ws + WS_RW_Y); B.ssd_x = (bf16_t*)(ws + WS_SSD_X); B.ssd_dt = (float*)(ws + WS_SSD_DT);
    B.ssd_y = (bf16_t*)(ws + WS_SSD_Y); B.mix = (bf16_t*)(ws + WS_MIX); return B;
}
constexpr size_t RWA = (size_t)TG * 256;

__device__ __forceinline__ void prep_tile(LAS unsigned char* lds, const Params& P, const MixBufs& B, int layer, int L, int tile) {
    const int tid = otid(), lane = tid & 63;
    const int t0 = tile * 32;
    LAS float* lin = (LAS float*)lds;
    LAS float* gin = (LAS float*)(lds + 49152);
    const bf16_t* p = B.p;
    const float* mu = P.in[8] + layer * 1152;
    __syncthreads();
    for (int idx = tid; idx < 32 * 384; idx += 512) {
        const int t = idx / 384, cc = idx % 384, tl = t0 + t, pos = tl % L, col = PC_RLOW + cc;
        const float cur = bf2f(p[(size_t)tl * DINP + col]);
        const float prv = pos > 0 ? bf2f(p[(size_t)(tl - 1) * DINP + col]) : 0.f;
        const float nxt = pos < L - 1 ? bf2f(p[(size_t)(tl + 1) * DINP + col]) : 0.f;
        float v = cur + mu[col - PC_R] * (0.5f * (prv + nxt) - cur);
        if (cc < 128) { const float e = __expf(2.f * v); v = 1.f - 2.f / (e + 1.f); }
        else if (cc >= 256) v = sigm(v);
        lin[t * 384 + cc] = v;
    }
    for (int idx = tid; idx < 32 * 32; idx += 512) { const int t = idx >> 5, j = idx & 31; gin[idx] = bf2f(p[(size_t)(t0 + t) * DINP + PC_GAF + j]); }
    __syncthreads();
#pragma unroll 1
    for (int i = 0; i < 8; ++i) {
        const int idx = tid + 512 * i, t = idx >> 7, c0 = (idx & 127) * 8, tl = t0 + t, pos = tl % L;
        float acc[8];
        { const f32x4 b0 = *(const f32x4*)(P.in[20] + layer * 1024 + c0), b1 = *(const f32x4*)(P.in[20] + layer * 1024 + c0 + 4);
          acc[0] = b0[0]; acc[1] = b0[1]; acc[2] = b0[2]; acc[3] = b0[3]; acc[4] = b1[0]; acc[5] = b1[1]; acc[6] = b1[2]; acc[7] = b1[3]; }
#pragma unroll
        for (int tap = 0; tap < 5; ++tap) {
            const int pp = pos + tap - 2;
            if (pp >= 0 && pp < L) {
                float x[8]; unpack8(*(const u32x4*)(p + (size_t)(tl + tap - 2) * DINP + PC_XBC + c0), x);
                const float* w = P.in[19] + (size_t)(layer * 5 + tap) * 1024 + c0;
                const f32x4 w0 = *(const f32x4*)w, w1 = *(const f32x4*)(w + 4);
                acc[0] += w0[0] * x[0]; acc[1] += w0[1] * x[1]; acc[2] += w0[2] * x[2]; acc[3] += w0[3] * x[3];
                acc[4] += w1[0] * x[4]; acc[5] += w1[1] * x[5]; acc[6] += w1[2] * x[6]; acc[7] += w1[3] * x[7];
            }
        }
        u32x4 o; o.x = pk2(silu(acc[0]), silu(acc[1])); o.y = pk2(silu(acc[2]), silu(acc[3])); o.z = pk2(silu(acc[4]), silu(acc[5])); o.w = pk2(silu(acc[6]), silu(acc[7]));
        *(u32x4*)(B.ssd_x + (size_t)tl * 1024 + c0) = o;
    }
    { const int t = tid >> 4, j = tid & 15, tl = t0 + t;
      B.ssd_dt[(size_t)tl * 16 + j] = softplus(bf2f(p[(size_t)tl * DINP + PC_DT + j]) + P.in[21][layer * 16 + j]); }
    if (tid < 256) {
        const int d = tid >> 7, c = tid & 127;
        float ac[16];
#pragma unroll
        for (int j = 0; j < 16; ++j) ac[j] = P.in[5][((size_t)(layer * 2 + d) * 16 + j) * 128 + c];
        const float bias = P.in[6][(layer * 2 + d) * 128 + c];
#pragma unroll 4
        for (int t = 0; t < 32; ++t) {
            float a = bias;
#pragma unroll
            for (int j = 0; j < 16; ++j) a += gin[t * 32 + d * 16 + j] * ac[j];
            B.gla_la[((size_t)d * TG + t0 + t) * 128 + c] = -softplus(-a) * (1.0f / 16.0f);
        }
    }
    asm volatile("" ::: "memory");
    {
        const int h2 = __builtin_amdgcn_readfirstlane(tid >> 8), c = tid & 255, head = c >> 6;
        float wcol[64];
        const float kkc = P.in[14][layer * 256 + c], kac = P.in[15][layer * 256 + c], rkc = P.in[16][layer * 256 + c];
        const float mur = mu[c], muk = mu[256 + c], muv = mu[512 + c];
        {
            { const float* wsrc = P.in[10] + (size_t)(layer * 2 + h2) * 64 * 256;
#pragma unroll
            for (int k = 0; k < 64; ++k) wcol[k] = wsrc[k * 256 + c]; }
            const float w0c = P.in[9][(layer * 2 + h2) * 256 + c];
#pragma unroll 1
            for (int t = 0; t < 32; ++t) {
                float aw = w0c;
                const LAS f32x4* lw = (const LAS f32x4*)(lin + t * 384 + h2 * 64);
#pragma unroll
                for (int k4 = 0; k4 < 16; ++k4) { const f32x4 x = lw[k4];
                    aw += x[0] * wcol[k4 * 4] + x[1] * wcol[k4 * 4 + 1] + x[2] * wcol[k4 * 4 + 2] + x[3] * wcol[k4 * 4 + 3]; }
                B.rw[(4 + h2) * RWA + (size_t)(t0 + t) * 256 + c] = (bf16_t)f2bf(sigm(aw) * 0.60653066f);
            }
        }
        asm volatile("" ::: "memory");
        {
            { const float* wsrc = P.in[12] + (size_t)(layer * 2 + h2) * 64 * 256;
#pragma unroll
            for (int k = 0; k < 64; ++k) wcol[k] = wsrc[k * 256 + c]; }
            const float a0c = P.in[11][(layer * 2 + h2) * 256 + c];
#pragma unroll 1
            for (int t = 0; t < 32; ++t) {
                const int tl = t0 + t, pos = tl % L;
                const bf16_t* pc = p + (size_t)tl * DINP;
                const bool hp = pos > 0, hn = pos < L - 1;
                const float rc = bf2f(pc[PC_R + c]), kc = bf2f(pc[PC_RK + c]), vc = bf2f(pc[PC_RV + c]);
                const float rp = hp ? bf2f(pc[PC_R + c - DINP]) : 0.f, kp = hp ? bf2f(pc[PC_RK + c - DINP]) : 0.f, vp = hp ? bf2f(pc[PC_RV + c - DINP]) : 0.f;
                const float rn = hn ? bf2f(pc[PC_R + c + DINP]) : 0.f, kn = hn ? bf2f(pc[PC_RK + c + DINP]) : 0.f, vn = hn ? bf2f(pc[PC_RV + c + DINP]) : 0.f;
                const float r = rc + mur * (0.5f * (rp + rn) - rc), k = kc + muk * (0.5f * (kp + kn) - kc), v = vc + muv * (0.5f * (vp + vn) - vc);
                float aa = a0c;
                const LAS f32x4* la = (const LAS f32x4*)(lin + t * 384 + 128 + h2 * 64);
#pragma unroll
                for (int k4 = 0; k4 < 16; ++k4) { const f32x4 y = la[k4];
                    aa += y[0] * wcol[k4 * 4] + y[1] * wcol[k4 * 4 + 1] + y[2] * wcol[k4 * 4 + 2] + y[3] * wcol[k4 * 4 + 3]; }
                const float asg = sigm(aa);
                const float kr = k * kkc; const float kk = kr * rsqrtf(wave_sum(kr * kr) + 1e-12f);
                const float kd = k * (1.f + (asg - 1.f) * kac), bb = kk * asg;
                const size_t o = (size_t)tl * 256 + c;
                B.rw[(6 + h2) * RWA + o] = (bf16_t)f2bf(kd); B.rw[(8 + h2) * RWA + o] = (bf16_t)f2bf(bb);
                if (h2 == 0) {
                    B.rw[0 * RWA + o] = (bf16_t)f2bf(r); B.rw[1 * RWA + o] = (bf16_t)f2bf(v); B.rw[2 * RWA + o] = (bf16_t)f2bf(kk);
                    const float s = wave_sum(r * k * rkc); if (lane == 0) B.rw_s[(size_t)tl * 4 + head] = s;
                } else {
                    const float s = wave_sum(bf2f((bf16_t)f2bf(kd)) * bf2f((bf16_t)f2bf(r))); if (lane == 0) B.rw_s[(size_t)TG * 4 + (size_t)tl * 4 + head] = s;
                }
            }
        }
        asm volatile("" ::: "memory");
        float ga[16];
#pragma unroll
        for (int i = 0; i < 16; ++i) ga[i] = 0.f;
#pragma unroll 1
        for (int sub = 0; sub < 2; ++sub) {
            asm volatile("" ::: "memory");
            { const float* wsrc = P.in[13] + (size_t)(layer * 128 + sub * 64) * 256;
#pragma unroll
            for (int k = 0; k < 64; ++k) wcol[k] = wsrc[k * 256 + c]; }
#pragma unroll
            for (int tt = 0; tt < 16; ++tt) {
                const LAS f32x4* lg = (const LAS f32x4*)(lin + (h2 * 16 + tt) * 384 + 256 + sub * 64);
                float a = ga[tt];
#pragma unroll
                for (int k4 = 0; k4 < 16; ++k4) { const f32x4 x = lg[k4]; a += x[0] * wcol[k4 * 4] + x[1] * wcol[k4 * 4 + 1] + x[2] * wcol[k4 * 4 + 2] + x[3] * wcol[k4 * 4 + 3]; }
                ga[tt] = a;
            }
        }
#pragma unroll
        for (int tt = 0; tt < 16; ++tt) B.rw[3 * RWA + (size_t)(t0 + h2 * 16 + tt) * 256 + c] = (bf16_t)f2bf(ga[tt]);
    }
}

__device__ __forceinline__ f32x4 mfma16(bf16x8 a, bf16x8 b, f32x4 c) { return __builtin_amdgcn_mfma_f32_16x16x32_bf16(a, b, c, 0, 0, 0); }
__device__ __forceinline__ void prep_tile64(LAS unsigned char* lds, const Params& P, const MixBufs& B, const bf16_t* sw, int layer, int L, int tile) {
    const int tid = otid(), w = tid >> 6, lane = tid & 63, r = lane & 15, q = lane >> 4;
    const int t0 = tile * 64;
    constexpr int LL = 392, LA = 264;
    LAS bf16_t* lin = (LAS bf16_t*)lds;
    LAS bf16_t* gin = (LAS bf16_t*)(lds + 50176);
    LAS bf16_t* AS = (LAS bf16_t*)(lds + 55296);
    const bf16_t* p = B.p;
    const float* mu = P.in[8] + layer * 1152;
    __syncthreads();
#pragma unroll 3
    for (int i6 = 0; i6 < 6; ++i6) {
        const int it = tid + 512 * i6;
        const int t = it / 48, cg8 = it % 48, tl = t0 + t, pos = tl % L, col = PC_RLOW + cg8 * 8;
        float cur[8], prv[8], nxt[8], v[8];
        unpack8(*(const u32x4*)(p + (size_t)tl * DINP + col), cur);
        if (pos > 0) unpack8(*(const u32x4*)(p + (size_t)(tl - 1) * DINP + col), prv); else {
#pragma unroll
            for (int j = 0; j < 8; ++j) prv[j] = 0.f; }
        if (pos < L - 1) unpack8(*(const u32x4*)(p + (size_t)(tl + 1) * DINP + col), nxt); else {
#pragma unroll
            for (int j = 0; j < 8; ++j) nxt[j] = 0.f; }
        const f32x4 m0 = *(const f32x4*)(mu + col - PC_R), m1 = *(const f32x4*)(mu + col - PC_R + 4);
#pragma unroll
        for (int j = 0; j < 8; ++j) { const float m = j < 4 ? m0[j] : m1[j - 4]; v[j] = cur[j] + m * (0.5f * (prv[j] + nxt[j]) - cur[j]); }
        if (cg8 < 16) {
#pragma unroll
            for (int j = 0; j < 8; ++j) { const float e = __expf(2.f * v[j]); v[j] = 1.f - 2.f * __builtin_amdgcn_rcpf(e + 1.f); }
        } else if (cg8 >= 32) {
#pragma unroll
            for (int j = 0; j < 8; ++j) v[j] = sigm(v[j]);
        }
        u32x4 o; o.x = pk2(v[0], v[1]); o.y = pk2(v[2], v[3]); o.z = pk2(v[4], v[5]); o.w = pk2(v[6], v[7]);
        *(LAS u32x4*)(lin + t * LL + cg8 * 8) = o;
    }
    if (tid < 256) { const int t = tid >> 2, g4 = tid & 3; *(LAS u32x4*)(gin + t * 40 + g4 * 8) = *(const u32x4*)(p + (size_t)(t0 + t) * DINP + PC_GAF + g4 * 8); }
    __syncthreads();
#pragma unroll 1
    for (int d = 0; d < 2; ++d)
#pragma unroll 1
        for (int tt = 0; tt < 2; ++tt) {
            const int tn = 2 * w + tt, c = tn * 16 + r;
            const float a0c = P.in[11][(layer * 2 + d) * 256 + c];
            const bf16_t* wb = sw + 32768 + d * 16384 + (size_t)(tn * 16 + r) * 64 + q * 8;
            const bf16x8 b0 = *(const bf16x8*)wb, b1 = *(const bf16x8*)(wb + 32);
#pragma unroll
            for (int tm = 0; tm < 4; ++tm) {
                const LAS bf16_t* ap = lin + (tm * 16 + r) * LL + 128 + d * 64 + q * 8;
                f32x4 acc = (f32x4){0.f, 0.f, 0.f, 0.f};
                acc = mfma16(*(const LAS bf16x8*)ap, b0, acc); acc = mfma16(*(const LAS bf16x8*)(ap + 32), b1, acc);
#pragma unroll
                for (int jj = 0; jj < 4; ++jj) AS[(d * 64 + tm * 16 + q * 4 + jj) * LA + c] = (bf16_t)f2bf(sigm(a0c + acc[jj]));
            }
        }
    __syncthreads();
    {
        const int c0 = (tid & 31) * 8, head = (tid & 31) >> 3;
        float mr_[8], mk_[8], mv_[8], kkc[8], kac[8], rkc[8];
#define LD8F(dst, ptr) do { const f32x4 a_ = *(const f32x4*)(ptr), b_ = *(const f32x4*)((ptr) + 4); dst[0] = a_[0]; dst[1] = a_[1]; dst[2] = a_[2]; dst[3] = a_[3]; dst[4] = b_[0]; dst[5] = b_[1]; dst[6] = b_[2]; dst[7] = b_[3]; } while (0)
        LD8F(mr_, mu + c0); LD8F(mk_, mu + 256 + c0); LD8F(mv_, mu + 512 + c0);
        LD8F(kkc, P.in[14] + layer * 256 + c0); LD8F(kac, P.in[15] + layer * 256 + c0); LD8F(rkc, P.in[16] + layer * 256 + c0);
#undef LD8F
        u32x4 nx[9], cu[9];
        const u32x4 Z = (u32x4){0u, 0u, 0u, 0u};
#define EL_LOAD(dst, ii) do { const int t_ = (tid + 512 * (ii)) >> 5, tl_ = t0 + t_, pos_ = tl_ % L; const bf16_t* pc_ = p + (size_t)tl_ * DINP + c0; \
            const bool hp_ = pos_ > 0, hn_ = pos_ < L - 1; \
            dst[0] = *(const u32x4*)(pc_ + PC_R); dst[1] = *(const u32x4*)(pc_ + PC_RK); dst[2] = *(const u32x4*)(pc_ + PC_RV); \
            dst[3] = hp_ ? *(const u32x4*)(pc_ + PC_R - DINP) : Z; dst[4] = hp_ ? *(const u32x4*)(pc_ + PC_RK - DINP) : Z; dst[5] = hp_ ? *(const u32x4*)(pc_ + PC_RV - DINP) : Z; \
            dst[6] = hn_ ? *(const u32x4*)(pc_ + PC_R + DINP) : Z; dst[7] = hn_ ? *(const u32x4*)(pc_ + PC_RK + DINP) : Z; dst[8] = hn_ ? *(const u32x4*)(pc_ + PC_RV + DINP) : Z; } while (0)
        EL_LOAD(nx, 0);
#pragma unroll 1
        for (int i = 0; i < 4; ++i) {
#pragma unroll
            for (int e = 0; e < 9; ++e) cu[e] = nx[e];
            if (i < 3) EL_LOAD(nx, i + 1);
            const int t = (tid + 512 * i) >> 5, tl = t0 + t;
            float rr[8], kx[8], vx[8], c_[8], p_[8], n_[8];
            unpack8(cu[0], c_); unpack8(cu[3], p_); unpack8(cu[6], n_);
#pragma unroll
            for (int j = 0; j < 8; ++j) rr[j] = c_[j] + mr_[j] * (0.5f * (p_[j] + n_[j]) - c_[j]);
            unpack8(cu[1], c_); unpack8(cu[4], p_); unpack8(cu[7], n_);
#pragma unroll
            for (int j = 0; j < 8; ++j) kx[j] = c_[j] + mk_[j] * (0.5f * (p_[j] + n_[j]) - c_[j]);
            unpack8(cu[2], c_); unpack8(cu[5], p_); unpack8(cu[8], n_);
#pragma unroll
            for (int j = 0; j < 8; ++j) vx[j] = c_[j] + mv_[j] * (0.5f * (p_[j] + n_[j]) - c_[j]);
            float as0[8], as1[8];
            unpack8(*(const LAS u32x4*)(AS + (0 * 64 + t) * LA + c0), as0); unpack8(*(const LAS u32x4*)(AS + (1 * 64 + t) * LA + c0), as1);
            float kr[8], ss = 0.f, srk = 0.f;
#pragma unroll
            for (int j = 0; j < 8; ++j) { kr[j] = kx[j] * kkc[j]; ss += kr[j] * kr[j]; srk += rr[j] * kx[j] * rkc[j]; }
            ss += __shfl_xor(ss, 1); ss += __shfl_xor(ss, 2); ss += __shfl_xor(ss, 4);
            const float inv = rsqrtf(ss + 1e-12f);
            float kkv[8], kd0[8], kd1[8], b0v[8], b1v[8], skr = 0.f;
#pragma unroll
            for (int j = 0; j < 8; ++j) {
                kkv[j] = kr[j] * inv; kd0[j] = kx[j] * (1.f + (as0[j] - 1.f) * kac[j]); kd1[j] = kx[j] * (1.f + (as1[j] - 1.f) * kac[j]);
                b0v[j] = kkv[j] * as0[j]; b1v[j] = kkv[j] * as1[j];
                skr += bf2f((bf16_t)f2bf(kd1[j])) * bf2f((bf16_t)f2bf(rr[j])); }
            srk += __shfl_xor(srk, 1); srk += __shfl_xor(srk, 2); srk += __shfl_xor(srk, 4);
            skr += __shfl_xor(skr, 1); skr += __shfl_xor(skr, 2); skr += __shfl_xor(skr, 4);
            const size_t o = (size_t)tl * 256 + c0;
#define ST8(arr, f) do { u32x4 o4; o4.x = pk2(f[0], f[1]); o4.y = pk2(f[2], f[3]); o4.z = pk2(f[4], f[5]); o4.w = pk2(f[6], f[7]); *(u32x4*)(B.rw + (size_t)(arr) * RWA + o) = o4; } while (0)
            ST8(0, rr); ST8(1, vx); ST8(2, kkv); ST8(6, kd0); ST8(7, kd1); ST8(8, b0v); ST8(9, b1v);
#undef ST8
            if ((lane & 7) == 0) { B.rw_s[(size_t)tl * 4 + head] = srk; B.rw_s[(size_t)TG * 4 + (size_t)tl * 4 + head] = skr; }
        }
#undef EL_LOAD
    }
#pragma unroll 1
    for (int d = 0; d < 2; ++d)
#pragma unroll 1
        for (int tt = 0; tt < 2; ++tt) {
            const int tn = 2 * w + tt, c = tn * 16 + r;
            const float w0c = P.in[9][(layer * 2 + d) * 256 + c];
            const bf16_t* wb = sw + d * 16384 + (size_t)(tn * 16 + r) * 64 + q * 8;
            const bf16x8 b0 = *(const bf16x8*)wb, b1 = *(const bf16x8*)(wb + 32);
#pragma unroll
            for (int tm = 0; tm < 4; ++tm) {
                const LAS bf16_t* ap = lin + (tm * 16 + r) * LL + d * 64 + q * 8;
                f32x4 acc = (f32x4){0.f, 0.f, 0.f, 0.f};
                acc = mfma16(*(const LAS bf16x8*)ap, b0, acc); acc = mfma16(*(const LAS bf16x8*)(ap + 32), b1, acc);
#pragma unroll
                for (int jj = 0; jj < 4; ++jj) B.rw[(size_t)(4 + d) * RWA + (size_t)(t0 + tm * 16 + q * 4 + jj) * 256 + c] = (bf16_t)f2bf(sigm(w0c + acc[jj]) * 0.60653066f);
            }
        }
#pragma unroll 1
    for (int tt = 0; tt < 2; ++tt) {
        const int tn = 2 * w + tt, c = tn * 16 + r;
        const bf16_t* wb = sw + 65536 + (size_t)(tn * 16 + r) * 128 + q * 8;
        const bf16x8 b0 = *(const bf16x8*)wb, b1 = *(const bf16x8*)(wb + 32), b2 = *(const bf16x8*)(wb + 64), b3 = *(const bf16x8*)(wb + 96);
#pragma unroll
        for (int tm = 0; tm < 4; ++tm) {
            const LAS bf16_t* ap = lin + (tm * 16 + r) * LL + 256 + q * 8;
            f32x4 acc = (f32x4){0.f, 0.f, 0.f, 0.f};
            acc = mfma16(*(const LAS bf16x8*)ap, b0, acc); acc = mfma16(*(const LAS bf16x8*)(ap + 32), b1, acc);
            acc = mfma16(*(const LAS bf16x8*)(ap + 64), b2, acc); acc = mfma16(*(const LAS bf16x8*)(ap + 96), b3, acc);
#pragma unroll
            for (int jj = 0; jj < 4; ++jj) B.rw[(size_t)3 * RWA + (size_t)(t0 + tm * 16 + q * 4 + jj) * 256 + c] = (bf16_t)f2bf(acc[jj]);
        }
    }
#pragma unroll 1
    for (int d = 0; d < 2; ++d) {
        const int c = w * 16 + r;
        const float bias = P.in[6][(layer * 2 + d) * 128 + c];
        const bf16x8 b0 = *(const bf16x8*)(sw + 98304 + d * 4096 + (size_t)(w * 16 + r) * 32 + q * 8);
#pragma unroll
        for (int tm = 0; tm < 4; ++tm) {
            f32x4 acc = (f32x4){0.f, 0.f, 0.f, 0.f};
            acc = mfma16(*(const LAS bf16x8*)(gin + (tm * 16 + r) * 40 + q * 8), b0, acc);
#pragma unroll
            for (int jj = 0; jj < 4; ++jj) B.gla_la[((size_t)d * TG + t0 + tm * 16 + q * 4 + jj) * 128 + c] = -softplus(-(acc[jj] + bias)) * (1.0f / 16.0f);
        }
    }
    {
        const int c0 = (tid & 127) * 8;
        float wt[5][8], bs[8];
        { const f32x4 b0 = *(const f32x4*)(P.in[20] + layer * 1024 + c0), b1 = *(const f32x4*)(P.in[20] + layer * 1024 + c0 + 4);
          bs[0] = b0[0]; bs[1] = b0[1]; bs[2] = b0[2]; bs[3] = b0[3]; bs[4] = b1[0]; bs[5] = b1[1]; bs[6] = b1[2]; bs[7] = b1[3]; }
#pragma unroll
        for (int tap = 0; tap < 5; ++tap) { const float* wp = P.in[19] + (size_t)(layer * 5 + tap) * 1024 + c0;
            const f32x4 w0 = *(const f32x4*)wp, w1 = *(const f32x4*)(wp + 4);
            wt[tap][0] = w0[0]; wt[tap][1] = w0[1]; wt[tap][2] = w0[2]; wt[tap][3] = w0[3]; wt[tap][4] = w1[0]; wt[tap][5] = w1[1]; wt[tap][6] = w1[2]; wt[tap][7] = w1[3]; }
        u32x4 xr[5], xn[5];
#define CONV_LOAD(dst, ii) do { const int t_ = (tid + 512 * (ii)) >> 7, tl_ = t0 + t_, pos_ = tl_ % L; \
            _Pragma("unroll") for (int tap = 0; tap < 5; ++tap) { const int pp = pos_ + tap - 2; \
                dst[tap] = (pp >= 0 && pp < L) ? *(const u32x4*)(p + (size_t)(tl_ + tap - 2) * DINP + PC_XBC + c0) : (u32x4){0u, 0u, 0u, 0u}; } } while (0)
        CONV_LOAD(xn, 0);
#pragma unroll 1
        for (int i = 0; i < 16; ++i) {
#pragma unroll
            for (int tap = 0; tap < 5; ++tap) xr[tap] = xn[tap];
            if (i < 15) CONV_LOAD(xn, i + 1);
            float acc[8];
#pragma unroll
            for (int j = 0; j < 8; ++j) acc[j] = bs[j];
#pragma unroll
            for (int tap = 0; tap < 5; ++tap) { float x[8]; unpack8(xr[tap], x);
#pragma unroll
                for (int j = 0; j < 8; ++j) acc[j] += wt[tap][j] * x[j]; }
            const int tl = t0 + ((tid + 512 * i) >> 7);
            u32x4 o; o.x = pk2(silu(acc[0]), silu(acc[1])); o.y = pk2(silu(acc[2]), silu(acc[3])); o.z = pk2(silu(acc[4]), silu(acc[5])); o.w = pk2(silu(acc[6]), silu(acc[7]));
            *(u32x4*)(B.ssd_x + (size_t)tl * 1024 + c0) = o;
        }
#undef CONV_LOAD
    }
#pragma unroll
    for (int i = 0; i < 2; ++i) { const int idx = tid + 512 * i, t = idx >> 4, j = idx & 15, tl = t0 + t;
        B.ssd_dt[(size_t)tl * 16 + j] = softplus(bf2f(p[(size_t)tl * DINP + PC_DT + j]) + P.in[21][layer * 16 + j]); }
}

__device__ __forceinline__ f32x4 mma_nt(f32x4 acc, const LAS bf16_t* A, int lda, const LAS bf16_t* Bt, int ldb, int K, int lane) {
    const int r = lane & 15, q = lane >> 4;
    for (int k = 0; k < K; k += 32) {
        const bf16x8 a = *(const LAS bf16x8*)(A + r * lda + k + q * 8);
        const bf16x8 b = *(const LAS bf16x8*)(Bt + r * ldb + k + q * 8);
        acc = __builtin_amdgcn_mfma_f32_16x16x32_bf16(a, b, acc, 0, 0, 0);
    }
    return acc;
}
__device__ __forceinline__ f32x4 mma_nt_x(f32x4 acc, const LAS bf16_t* A, int lda, const LAS bf16_t* Bt, int ldb, int K, int lane, int xa, int xb) {
    const int r = lane & 15, q = lane >> 4;
    for (int k = 0; k < K; k += 32) {
        const bf16x8 a = *(const LAS bf16x8*)(A + r * lda + ((((k >> 3) + q) ^ xa) << 3));
        const bf16x8 b = *(const LAS bf16x8*)(Bt + r * ldb + ((((k >> 3) + q) ^ xb) << 3));
        acc = __builtin_amdgcn_mfma_f32_16x16x32_bf16(a, b, acc, 0, 0, 0);
    }
    return acc;
}
__device__ __forceinline__ f32x4 mma_tn_x(f32x4 acc, const LAS bf16_t* A, int lda, const LAS bf16_t* Bt, int ldb, int K, int lane, int xa, int xb) {
    const int r = lane & 15, q = lane >> 4;
    for (int k = 0; k < K; k += 32) {
        const bf16x8 a = *(const LAS bf16x8*)(A + r * lda + ((((k >> 3) + q) ^ xa) << 3));
        const bf16x8 b = *(const LAS bf16x8*)(Bt + r * ldb + ((((k >> 3) + q) ^ xb) << 3));
        acc = __builtin_amdgcn_mfma_f32_16x16x32_bf16(b, a, acc, 0, 0, 0);
    }
    return acc;
}
template <int DK> struct CL {
    static constexpr int LQ = DK + 8, LT = 72;
    static constexpr int QA = 0, KA = QA + 64 * LQ * 2, KBT = KA + 64 * LQ * 2, VT = KBT + DK * LT * 2, SC = VT + 64 * LT * 2, STT = SC + 64 * LT * 2;
    static constexpr int FA = STT + 64 * LQ * 2;
};

__device__ __forceinline__ void ssd_unit(LAS unsigned char* lds, const Params& P, const MixBufs& B, float* segst, int layer, int L, int seq, int h, int d, int seg, bool state_only) {
    typedef CL<128> C;
    const int tid = otid(), w = tid >> 6, lane = tid & 63, r = lane & 15, q = lane >> 4;
    LAS bf16_t* Qa = (LAS bf16_t*)(lds + C::QA); LAS bf16_t* Ka = (LAS bf16_t*)(lds + C::KA); LAS bf16_t* KbT = (LAS bf16_t*)(lds + C::KBT);
    LAS bf16_t* VT = (LAS bf16_t*)(lds + C::VT); LAS bf16_t* Sc = (LAS bf16_t*)(lds + C::SC); LAS bf16_t* StT = (LAS bf16_t*)(lds + C::STT);
    LAS float* acum = (LAS float*)(lds + C::FA); LAS float* dtl = acum + 64;
    const int grp = h >> 2;
    const float Aneg = -__expf(P.in[22][layer * 16 + d * 8 + h]);
    const int base = seq * L, cbeg = seg * 32, cend = cbeg + 32;
    __syncthreads();
    f32x4 st[4];
#pragma unroll
    for (int i = 0; i < 4; ++i) st[i] = (f32x4){0.f, 0.f, 0.f, 0.f};
    const int kidx = h * 2 + d;
    if (!state_only) {
        for (int ps = 0; ps < seg; ++ps) {
            const float* sp = segst + (size_t)((seq * 8 + ps) * 24 + kidx) * 8256;
            const float dcy = __expf(sp[8192]);
#pragma unroll
            for (int tv = 0; tv < 4; ++tv)
#pragma unroll
                for (int jj = 0; jj < 4; ++jj) st[tv][jj] = st[tv][jj] * dcy + sp[(tv * 4 + jj) * 512 + tid];
        }
#pragma unroll
        for (int tv = 0; tv < 4; ++tv) {
            u32x2 o; o.x = pk2(st[tv][0], st[tv][1]); o.y = pk2(st[tv][2], st[tv][3]);
            *(LAS u32x2*)(StT + (tv * 16 + r) * C::LQ + w * 16 + q * 4) = o;
        }
    }
    float asum = 0.f;
    const int row = tid >> 3, part = tid & 7;
    const int tm = w >> 1, tn0 = (w & 1) * 2;
    bf16_t* yout = B.ssd_y + (size_t)d * TG * 512;
    u32x4 c0, c1, b0, b1, x0; float dtv;
#define SSD_LOAD(cc) do { const int n0_ = (cc) * 64; \
        const int tok = d == 0 ? base + n0_ + row : base + L - 1 - (n0_ + row); \
        const bf16_t* xr = B.ssd_x + (size_t)tok * 1024; \
        c0 = *(const u32x4*)(xr + 768 + grp * 128 + part * 16); c1 = *(const u32x4*)(xr + 768 + grp * 128 + part * 16 + 8); \
        b0 = *(const u32x4*)(xr + 512 + grp * 128 + part * 16); b1 = *(const u32x4*)(xr + 512 + grp * 128 + part * 16 + 8); \
        x0 = *(const u32x4*)(xr + h * 64 + part * 8); \
        const int tl_ = d == 0 ? base + n0_ + lane : base + L - 1 - (n0_ + lane); \
        dtv = B.ssd_dt[(size_t)tl_ * 16 + d * 8 + h]; } while (0)
    SSD_LOAD(cbeg);
    for (int c = cbeg; c < cend; ++c) {
        const int n0 = c * 64;
        const float ac = wave_incl_scan(dtv * Aneg, lane);
        const float alast = lane_bcast(ac, 63);
        asum += alast;
        if (w == 0) { acum[lane] = ac; dtl[lane] = dtv; }
        {
            const float ks = __shfl(dtv, row) * __expf(alast - __shfl(ac, row));
            *(LAS u32x4*)(Qa + row * C::LQ + part * 16) = c0; *(LAS u32x4*)(Qa + row * C::LQ + part * 16 + 8) = c1;
            *(LAS u32x4*)(Ka + row * C::LQ + part * 16) = b0; *(LAS u32x4*)(Ka + row * C::LQ + part * 16 + 8) = b1;
            float bf[16]; unpack8(b0, bf); unpack8(b1, bf + 8);
            const int rsw = row ^ (part << 3);
#pragma unroll
            for (int j = 0; j < 16; ++j) KbT[(part * 16 + j) * C::LT + rsw] = (bf16_t)f2bf(bf[j] * ks);
            const unsigned xs[4] = {x0.x, x0.y, x0.z, x0.w};
#pragma unroll
            for (int j = 0; j < 4; ++j) { VT[(part * 8 + 2 * j) * C::LT + rsw] = (bf16_t)(xs[j] & 0xffffu); VT[(part * 8 + 2 * j + 1) * C::LT + rsw] = (bf16_t)(xs[j] >> 16); }
        }
        if (c + 1 < cend) SSD_LOAD(c + 1);
        lds_barrier();
        if (!state_only) {
#pragma unroll
        for (int tt = 0; tt < 2; ++tt) {
            const int tn = tn0 + tt;
            f32x4 s = (f32x4){0.f, 0.f, 0.f, 0.f};
            s = mma_tn_x(s, Qa + tm * 16 * C::LQ, C::LQ, Ka + tn * 16 * C::LQ, C::LQ, 128, lane, 0, 0);
            const int i = tm * 16 + r, j0 = tn * 16 + q * 4;
            const float ai = acum[i];
            const f32x4 aj = *(const LAS f32x4*)(acum + j0), dj = *(const LAS f32x4*)(dtl + j0);
            float v[4];
#pragma unroll
            for (int jj = 0; jj < 4; ++jj) {
                const int j = j0 + jj;
                const bool on = d == 0 ? (i >= j) : (i > j);
                v[jj] = on ? s[jj] * __expf(ai - aj[jj]) * dj[jj] : 0.f;
            }
            u32x2 o; o.x = pk2(v[0], v[1]); o.y = pk2(v[2], v[3]);
            *(LAS u32x2*)(Sc + i * C::LT + j0) = o;
        }
        lds_barrier();
#pragma unroll
        for (int tt = 0; tt < 2; ++tt) {
            const int tn = tn0 + tt;
            f32x4 o1 = (f32x4){0.f, 0.f, 0.f, 0.f}, o2 = (f32x4){0.f, 0.f, 0.f, 0.f};
            o1 = mma_tn_x(o1, Sc + tm * 16 * C::LT, C::LT, VT + tn * 16 * C::LT, C::LT, 64, lane, 0, (tn * 2 + (r >> 3)) & 7);
            o2 = mma_tn_x(o2, Qa + tm * 16 * C::LQ, C::LQ, StT + tn * 16 * C::LQ, C::LQ, 128, lane, 0, 0);
            const int i = tm * 16 + r;
            const int tl = d == 0 ? base + n0 + i : base + L - 1 - (n0 + i);
            const float ei = __expf(acum[i]);
            { const f32x4 ov = o1 + o2 * ei; u32x2 o; o.x = pk2(ov[0], ov[1]); o.y = pk2(ov[2], ov[3]); *(u32x2*)(yout + (size_t)tl * 512 + h * 64 + tn * 16 + q * 4) = o; }
        }
        }
        {
            const float ds = __expf(alast);
#pragma unroll
            for (int tv = 0; tv < 4; ++tv) {
                st[tv] = st[tv] * ds;
                st[tv] = mma_nt_x(st[tv], KbT + w * 16 * C::LT, C::LT, VT + tv * 16 * C::LT, C::LT, 64, lane, w, (tv * 2 + (r >> 3)) & 7);
            }
        }
        lds_barrier();
        if (!state_only) {
#pragma unroll
        for (int tv = 0; tv < 4; ++tv) {
            u32x2 o; o.x = pk2(st[tv][0], st[tv][1]); o.y = pk2(st[tv][2], st[tv][3]);
            *(LAS u32x2*)(StT + (tv * 16 + r) * C::LQ + w * 16 + q * 4) = o;
        }
        }
    }
    if (state_only) {
        float* sp = segst + (size_t)((seq * 8 + seg) * 24 + kidx) * 8256;
#pragma unroll
        for (int tv = 0; tv < 4; ++tv)
#pragma unroll
            for (int jj = 0; jj < 4; ++jj) sp[(tv * 4 + jj) * 512 + tid] = st[tv][jj];
        if (tid == 0) sp[8192] = asum;
    }
#undef SSD_LOAD
}

__device__ __forceinline__ void gla_unit(LAS unsigned char* lds, const Params& P, const MixBufs& B, float* segst, int layer, int L, int seq, int h, int d, int seg, bool state_only) {
    typedef CL<32> C;
    const int tid = otid(), w = tid >> 6, lane = tid & 63, r = lane & 15, q = lane >> 4;
    LAS bf16_t* Qa = (LAS bf16_t*)(lds + C::QA); LAS bf16_t* Ka = (LAS bf16_t*)(lds + C::KA); LAS bf16_t* KbT = (LAS bf16_t*)(lds + C::KBT);
    LAS bf16_t* VT = (LAS bf16_t*)(lds + C::VT); LAS bf16_t* Sc = (LAS bf16_t*)(lds + C::SC); LAS bf16_t* StT = (LAS bf16_t*)(lds + C::STT);
    LAS float* dstate = (LAS float*)(lds + C::FA);
    const int base = seq * L, cbeg = seg * 32, cend = cbeg + 32;
    __syncthreads();
    f32x4 st = (f32x4){0.f, 0.f, 0.f, 0.f};
    const int row = tid >> 3, part = tid & 7;
    const int tm = w >> 1, tn0 = (w & 1) * 2;
    const int tk = w >> 2, tv = w & 3;
    const int kidx = 16 + h * 2 + d;
    if (!state_only) {
        for (int ps = 0; ps < seg; ++ps) {
            const float* sp = segst + (size_t)((seq * 8 + ps) * 24 + kidx) * 8256;
#pragma unroll
            for (int jj = 0; jj < 4; ++jj) st[jj] = st[jj] * __expf(sp[8192 + tk * 16 + q * 4 + jj]) + sp[jj * 512 + tid];
        }
        { u32x2 o; o.x = pk2(st[0], st[1]); o.y = pk2(st[2], st[3]); *(LAS u32x2*)(StT + (tv * 16 + r) * C::LQ + tk * 16 + q * 4) = o; }
    }
    float blsum[4] = {0.f, 0.f, 0.f, 0.f};
    const float* la = B.gla_la + (size_t)d * TG * 128;
    bf16_t* oout = B.gla_o + (size_t)d * TG * 256;
    const float qscale = 0.17677669529663687f;
    f32x4 lv; u32x2 qr, kr; u32x4 x0;
#define GLA_LOAD(cc) do { const int n0_ = (cc) * 64; \
        const int tl_ = d == 0 ? base + n0_ + lane : base + L - 1 - (n0_ + lane); \
        lv = *(const f32x4*)(la + (size_t)tl_ * 128 + h * 32 + 4 * w); \
        qr = *(const u32x2*)(B.p + (size_t)tl_ * DINP + PC_GQ + h * 32 + 4 * w); \
        kr = *(const u32x2*)(B.p + (size_t)tl_ * DINP + PC_GK + h * 32 + 4 * w); \
        const int tr_ = d == 0 ? base + n0_ + row : base + L - 1 - (n0_ + row); \
        x0 = *(const u32x4*)(B.p + (size_t)tr_ * DINP + PC_GV + h * 64 + part * 8); } while (0)
    GLA_LOAD(cbeg);
    for (int c = cbeg; c < cend; ++c) {
        const int n0 = c * 64;
        {
            const float qf[4] = {__uint_as_float(qr.x << 16), __uint_as_float(qr.x & 0xffff0000u), __uint_as_float(qr.y << 16), __uint_as_float(qr.y & 0xffff0000u)};
            const float kf[4] = {__uint_as_float(kr.x << 16), __uint_as_float(kr.x & 0xffff0000u), __uint_as_float(kr.y << 16), __uint_as_float(kr.y & 0xffff0000u)};
            float qd[4], kd[4];
#pragma unroll
            for (int kk = 0; kk < 4; ++kk) {
                const float b = wave_incl_scan(lv[kk], lane);
                const float bl = lane_bcast(b, 63);
                blsum[kk] += bl;
                qd[kk] = qf[kk] * qscale * __expf(b); kd[kk] = kf[kk] * __expf(-b);
                KbT[(4 * w + kk) * C::LT + lane] = (bf16_t)f2bf(kf[kk] * __expf(bl - b));
                if (lane == 63) dstate[4 * w + kk] = __expf(bl);
            }
            u32x2 o; o.x = pk2(qd[0], qd[1]); o.y = pk2(qd[2], qd[3]); *(LAS u32x2*)(Qa + lane * C::LQ + 4 * w) = o;
            o.x = pk2(kd[0], kd[1]); o.y = pk2(kd[2], kd[3]); *(LAS u32x2*)(Ka + lane * C::LQ + 4 * w) = o;
            const unsigned xs[4] = {x0.x, x0.y, x0.z, x0.w};
            const int rsw = row ^ (part << 3);
#pragma unroll
            for (int j = 0; j < 4; ++j) { VT[(part * 8 + 2 * j) * C::LT + rsw] = (bf16_t)(xs[j] & 0xffffu); VT[(part * 8 + 2 * j + 1) * C::LT + rsw] = (bf16_t)(xs[j] >> 16); }
        }
        if (c + 1 < cend) GLA_LOAD(c + 1);
        lds_barrier();
        if (!state_only) {
#pragma unroll
        for (int tt = 0; tt < 2; ++tt) {
            const int tn = tn0 + tt;
            f32x4 s = (f32x4){0.f, 0.f, 0.f, 0.f};
            s = mma_tn_x(s, Qa + tm * 16 * C::LQ, C::LQ, Ka + tn * 16 * C::LQ, C::LQ, 32, lane, 0, 0);
            const int i = tm * 16 + r, j0 = tn * 16 + q * 4;
            float v[4];
#pragma unroll
            for (int jj = 0; jj < 4; ++jj) { const int j = j0 + jj; const bool on = d == 0 ? (i >= j) : (i > j); v[jj] = on ? s[jj] : 0.f; }
            u32x2 o; o.x = pk2(v[0], v[1]); o.y = pk2(v[2], v[3]);
            *(LAS u32x2*)(Sc + i * C::LT + j0) = o;
        }
        lds_barrier();
#pragma unroll
        for (int tt = 0; tt < 2; ++tt) {
            const int tn = tn0 + tt;
            f32x4 o1 = (f32x4){0.f, 0.f, 0.f, 0.f};
            o1 = mma_tn_x(o1, Sc + tm * 16 * C::LT, C::LT, VT + tn * 16 * C::LT, C::LT, 64, lane, 0, (tn * 2 + (r >> 3)) & 7);
            o1 = mma_tn_x(o1, Qa + tm * 16 * C::LQ, C::LQ, StT + tn * 16 * C::LQ, C::LQ, 32, lane, 0, 0);
            const int i = tm * 16 + r;
            const int tl = d == 0 ? base + n0 + i : base + L - 1 - (n0 + i);
            { u32x2 o; o.x = pk2(o1[0], o1[1]); o.y = pk2(o1[2], o1[3]); *(u32x2*)(oout + (size_t)tl * 256 + h * 64 + tn * 16 + q * 4) = o; }
        }
        }
        {
#pragma unroll
            for (int jj = 0; jj < 4; ++jj) st[jj] *= dstate[tk * 16 + q * 4 + jj];
            st = mma_nt_x(st, KbT + tk * 16 * C::LT, C::LT, VT + tv * 16 * C::LT, C::LT, 64, lane, 0, (tv * 2 + (r >> 3)) & 7);
        }
        lds_barrier();
        if (!state_only) { u32x2 o; o.x = pk2(st[0], st[1]); o.y = pk2(st[2], st[3]); *(LAS u32x2*)(StT + (tv * 16 + r) * C::LQ + tk * 16 + q * 4) = o; }
    }
    if (state_only) {
        float* sp = segst + (size_t)((seq * 8 + seg) * 24 + kidx) * 8256;
#pragma unroll
        for (int jj = 0; jj < 4; ++jj) sp[jj * 512 + tid] = st[jj];
        if (lane == 0) {
#pragma unroll
            for (int kk = 0; kk < 4; ++kk) sp[8192 + 4 * w + kk] = blsum[kk];
        }
    }
#undef GLA_LOAD
}

constexpr int RL = 72;
struct RwRaw { u32x4 e, kk, bb, kd, rr, v; };
__device__ __forceinline__ void rwkv_pre_load(RwRaw& R, const MixBufs& B, int L, int u, int tid) {
    const int w = tid >> 6, lane = tid & 63, nch = L / 64, hd = u & 7, ch = u >> 3, h = hd >> 1, d = hd & 1;
    const int base = (ch / nch) * L, n0 = (ch % nch) * 64;
    const int tl = d == 0 ? base + n0 + lane : base + L - 1 - (n0 + lane);
    const size_t o = (size_t)tl * 256 + h * 64 + 8 * w;
    R.e = *(const u32x4*)(B.rw + (4 + d) * RWA + o); R.kk = *(const u32x4*)(B.rw + 2 * RWA + o);
    R.bb = *(const u32x4*)(B.rw + (8 + d) * RWA + o); R.kd = *(const u32x4*)(B.rw + (6 + d) * RWA + o);
    R.rr = *(const u32x4*)(B.rw + 0 * RWA + o);
    const int row = tid >> 3, part = tid & 7;
    const int tr = d == 0 ? base + n0 + row : base + L - 1 - (n0 + row);
    R.v = *(const u32x4*)(B.rw + 1 * RWA + (size_t)tr * 256 + h * 64 + part * 8);
}
__device__ __forceinline__ void rwkv_pre(LAS unsigned char* lds, const MixBufs& B, bf16_t* rq, int L, int u, int unext, RwRaw& R) {
    const int tid = otid(), w = tid >> 6, lane = tid & 63, r = lane & 15, q = lane >> 4;
#define RG(i) ((LAS bf16_t*)(lds + (i) * 9216))
    LAS bf16_t* At = RG(0); LAS bf16_t* Bt_ = RG(1); LAS bf16_t* Kt = RG(2); LAS bf16_t* Rt = RG(3); LAS bf16_t* AtT = RG(4); LAS bf16_t* BhT = RG(5);
    LAS bf16_t* KhT = RG(6); LAS bf16_t* VT = RG(7); LAS bf16_t* Lak = RG(8); LAS bf16_t* Mrb = RG(9); LAS bf16_t* Mrk = RG(10); LAS bf16_t* WT = RG(11);
    LAS bf16_t* Tm = RG(0); LAS bf16_t* XT = RG(1); LAS bf16_t* UT = RG(2);
#undef RG
    LAS float* Lf = (LAS float*)(lds + 12 * 9216);
    LAS float* gC = (LAS float*)(lds + 12 * 9216 + 17408);
    LAS bf16_t* L21b = (LAS bf16_t*)(lds + 12 * 9216 + 17408 + 512);
    LAS bf16_t* T11T = WT;
    LAS bf16_t* X1T = WT + 32 * 40;
    const int nch = L / 64, hd = u & 7, ch = u >> 3, h = hd >> 1, d = hd & 1, seq = ch / nch, c = ch % nch;
    const int base = seq * L, n0 = c * 64;
    const int cu = (((seq * nch + c) * 4 + h) * 2 + d);
    bf16_t* gq = rq + (size_t)cu * 3 * 4096;
    lds_barrier();
    {
        float e[8], kk[8], bb[8], kd[8], rr[8];
        unpack8(R.e, e); unpack8(R.kk, kk); unpack8(R.bb, bb); unpack8(R.kd, kd); unpack8(R.rr, rr);
        float at[8], bt[8], kt[8], rt[8];
#pragma unroll
        for (int j = 0; j < 8; ++j) {
            const float cum = wave_incl_scan(e[j], lane);
            const float cmid = lane_bcast(cum, 31), clast = lane_bcast(cum, 63);
            const float ea = __expf(-(cum - e[j] - cmid)), eb = __expf(cum - cmid), er = __expf(-(cum - cmid)), eh = __expf(-(clast - cum));
            at[j] = -kk[j] * ea; bt[j] = bb[j] * eb; kt[j] = kd[j] * eb; rt[j] = rr[j] * er;
            AtT[(8 * w + j) * RL + lane] = (bf16_t)f2bf(at[j]);
            BhT[(8 * w + j) * RL + lane] = (bf16_t)f2bf(bb[j] * eh);
            KhT[(8 * w + j) * RL + lane] = (bf16_t)f2bf(kd[j] * eh);
            if (lane == 63) { gC[8 * w + j] = __expf(-clast); gC[64 + 8 * w + j] = __expf(-cmid); }
        }
        u32x4 o4;
        o4.x = pk2(at[0], at[1]); o4.y = pk2(at[2], at[3]); o4.z = pk2(at[4], at[5]); o4.w = pk2(at[6], at[7]); *(LAS u32x4*)(At + lane * RL + 8 * w) = o4;
        o4.x = pk2(bt[0], bt[1]); o4.y = pk2(bt[2], bt[3]); o4.z = pk2(bt[4], bt[5]); o4.w = pk2(bt[6], bt[7]); *(LAS u32x4*)(Bt_ + lane * RL + 8 * w) = o4;
        o4.x = pk2(kt[0], kt[1]); o4.y = pk2(kt[2], kt[3]); o4.z = pk2(kt[4], kt[5]); o4.w = pk2(kt[6], kt[7]); *(LAS u32x4*)(Kt + lane * RL + 8 * w) = o4;
        o4.x = pk2(rt[0], rt[1]); o4.y = pk2(rt[2], rt[3]); o4.z = pk2(rt[4], rt[5]); o4.w = pk2(rt[6], rt[7]); *(LAS u32x4*)(Rt + lane * RL + 8 * w) = o4;
        const int row = tid >> 3, part = tid & 7;
        const unsigned xs[4] = {R.v.x, R.v.y, R.v.z, R.v.w};
#pragma unroll
        for (int j = 0; j < 4; ++j) { VT[(part * 8 + 2 * j) * RL + row] = (bf16_t)(xs[j] & 0xffffu); VT[(part * 8 + 2 * j + 1) * RL + row] = (bf16_t)(xs[j] >> 16); }
    }
    if (unext >= 0) rwkv_pre_load(R, B, L, unext, tid);
    lds_barrier();
    const int tm = w >> 1, tn0 = (w & 1) * 2;
    const f32x4 Z4 = (f32x4){0.f, 0.f, 0.f, 0.f};
#pragma unroll
    for (int tt = 0; tt < 2; ++tt) {
        const int tn = tn0 + tt;
        const f32x4 lab = mma_tn_x(Z4, At + tm * 16 * RL, RL, Bt_ + tn * 16 * RL, RL, 64, lane, 0, 0);
        const f32x4 lak = mma_tn_x(Z4, At + tm * 16 * RL, RL, Kt + tn * 16 * RL, RL, 64, lane, 0, 0);
        const f32x4 mrb = mma_tn_x(Z4, Rt + tm * 16 * RL, RL, Bt_ + tn * 16 * RL, RL, 64, lane, 0, 0);
        const f32x4 mrk = mma_tn_x(Z4, Rt + tm * 16 * RL, RL, Kt + tn * 16 * RL, RL, 64, lane, 0, 0);
        const int i = tm * 16 + r, j0 = tn * 16 + q * 4;
        f32x4 lf; float vk[4], vb[4], vm[4];
#pragma unroll
        for (int jj = 0; jj < 4; ++jj) {
            const int j = j0 + jj; const bool st_ = j < i, in_ = j <= i;
            lf[jj] = st_ ? lab[jj] : 0.f; vk[jj] = st_ ? lak[jj] : 0.f; vb[jj] = in_ ? mrb[jj] : 0.f; vm[jj] = in_ ? mrk[jj] : 0.f;
        }
        *(LAS f32x4*)(Lf + i * 68 + j0) = lf;
        u32x2 o;
        if (tm >= 2 && tn < 2) { o.x = pk2(lab[0], lab[1]); o.y = pk2(lab[2], lab[3]); *(LAS u32x2*)(L21b + (i - 32) * 40 + j0) = o; }
        o.x = pk2(vk[0], vk[1]); o.y = pk2(vk[2], vk[3]); *(LAS u32x2*)(Lak + i * RL + j0) = o;
        o.x = pk2(vb[0], vb[1]); o.y = pk2(vb[2], vb[3]); *(LAS u32x2*)(Mrb + i * RL + j0) = o;
        o.x = pk2(vm[0], vm[1]); o.y = pk2(vm[2], vm[3]); *(LAS u32x2*)(Mrk + i * RL + j0) = o;
    }
    lds_barrier();
#pragma unroll
    for (int tt = 0; tt < 2; ++tt) {
        const int tn = tn0 + tt;
        const f32x4 x = mma_nt(Z4, Lak + tm * 16 * RL, RL, VT + tn * 16 * RL, RL, 64, lane);
        u32x2 o; o.x = pk2(x[0], x[1]); o.y = pk2(x[2], x[3]);
        *(LAS u32x2*)(XT + (tn * 16 + r) * RL + tm * 16 + q * 4) = o;
    }
    if (w < 2) {
        const int ob = w * 32, j = lane & 31;
        float T[32];
        int zv = 0; asm volatile("" : "+v"(zv));
        const LAS float* Lfz = Lf + zv + ob * 68 + ob;
#pragma unroll
        for (int t = 0; t < 32; ++t) {
            float a0 = (t == j) ? 1.f : 0.f, a1 = 0.f;
#pragma unroll
            for (int s4 = 0; s4 < (t + 3) / 4; ++s4) {
                const f32x4 l = *(const LAS f32x4*)(Lfz + t * 68 + s4 * 4);
#pragma unroll
                for (int e2 = 0; e2 < 4; ++e2) { const int s_ = s4 * 4 + e2; if (s_ < t) { if (e2 & 1) a1 += l[e2] * T[s_]; else a0 += l[e2] * T[s_]; } }
            }
            T[t] = a0 + a1;
            if (lane < 32) {
                Tm[(ob + t) * RL + ob + j] = (bf16_t)f2bf(T[t]);
                if (w == 0) T11T[j * 40 + t] = (bf16_t)f2bf(T[t]);
            }
        }
    } else if (w == 2) {
        for (int i = lane; i < 32 * 16; i += 64) { const int t = i >> 4, c2 = (i & 15) * 2; *(LAS unsigned*)(Tm + t * RL + 32 + c2) = 0u; }
    }
    lds_barrier();
    if (w < 4) {
        const int mi = w >> 1, ni = w & 1;
        const f32x4 x1 = mma_nt(Z4, L21b + mi * 16 * 40, 40, T11T + ni * 16 * 40, 40, 32, lane);
        u32x2 o; o.x = pk2(x1[0], x1[1]); o.y = pk2(x1[2], x1[3]);
        *(LAS u32x2*)(X1T + (ni * 16 + r) * 40 + mi * 16 + q * 4) = o;
    }
    lds_barrier();
    if (w < 4) {
        const int mi = w >> 1, ni = w & 1;
        const f32x4 t21 = mma_tn_x(Z4, Tm + (32 + mi * 16) * RL + 32, RL, X1T + ni * 16 * 40, 40, 32, lane, 0, 0);
        u32x2 o; o.x = pk2(t21[0], t21[1]); o.y = pk2(t21[2], t21[3]);
        *(LAS u32x2*)(Tm + (32 + mi * 16 + r) * RL + ni * 16 + q * 4) = o;
    }
    lds_barrier();
    f32x4 uu[2], ww[2];
#pragma unroll
    for (int tt = 0; tt < 2; ++tt) {
        const int tn = tn0 + tt;
        uu[tt] = mma_nt(Z4, Tm + tm * 16 * RL, RL, XT + tn * 16 * RL, RL, 64, lane);
        ww[tt] = mma_nt(Z4, Tm + tm * 16 * RL, RL, AtT + tn * 16 * RL, RL, 64, lane);
    }
#pragma unroll
    for (int tt = 0; tt < 2; ++tt) {
        const int tn = tn0 + tt;
        u32x2 o; o.x = pk2(uu[tt][0], uu[tt][1]); o.y = pk2(uu[tt][2], uu[tt][3]);
        *(LAS u32x2*)(UT + (tn * 16 + r) * RL + tm * 16 + q * 4) = o;
        o.x = pk2(ww[tt][0], ww[tt][1]); o.y = pk2(ww[tt][2], ww[tt][3]);
        *(LAS u32x2*)(WT + (tn * 16 + r) * RL + tm * 16 + q * 4) = o;
    }
    lds_barrier();
    bf16_t* yout = B.rw_y + (size_t)d * TG * 256;
#pragma unroll
    for (int tt = 0; tt < 2; ++tt) {
        const int tn = tn0 + tt;
        const f32x4 qe = mma_tn_x(Z4, Mrb + tm * 16 * RL, RL, WT + tn * 16 * RL, RL, 64, lane, 0, 0);
        f32x4 yl = mma_tn_x(Z4, Mrb + tm * 16 * RL, RL, UT + tn * 16 * RL, RL, 64, lane, 0, 0);
        yl = mma_tn_x(yl, Mrk + tm * 16 * RL, RL, VT + tn * 16 * RL, RL, 64, lane, 0, 0);
        const f32x4 pe = mma_tn_x(Z4, BhT + tm * 16 * RL, RL, WT + tn * 16 * RL, RL, 64, lane, 0, 0);
        f32x4 hl = mma_nt(Z4, BhT + tm * 16 * RL, RL, UT + tn * 16 * RL, RL, 64, lane);
        hl = mma_nt(hl, KhT + tm * 16 * RL, RL, VT + tn * 16 * RL, RL, 64, lane);
        const int i = tm * 16 + r, n0c = tn * 16 + q * 4;
        const f32x4 um = *(const LAS f32x4*)(gC + 64 + n0c);
        const u32x2 rtp = *(const LAS u32x2*)(Rt + i * RL + n0c);
        const float rt4[4] = {__uint_as_float(rtp.x << 16), __uint_as_float(rtp.x & 0xffff0000u), __uint_as_float(rtp.y << 16), __uint_as_float(rtp.y & 0xffff0000u)};
        const float gci = gC[i];
        float qv[4], pv[4];
#pragma unroll
        for (int jj = 0; jj < 4; ++jj) { qv[jj] = (qe[jj] + rt4[jj]) * um[jj]; pv[jj] = pe[jj] * um[jj] + ((n0c + jj) == i ? gci : 0.f); }
        u32x2 o; o.x = pk2(qv[0], qv[1]); o.y = pk2(qv[2], qv[3]); *(u32x2*)(gq + i * 64 + n0c) = o;
        o.x = pk2(pv[0], pv[1]); o.y = pk2(pv[2], pv[3]); *(u32x2*)(gq + 4096 + i * 64 + n0c) = o;
        const int tl = d == 0 ? base + n0 + i : base + L - 1 - (n0 + i);
        o.x = pk2(yl[0], yl[1]); o.y = pk2(yl[2], yl[3]); *(u32x2*)(yout + (size_t)tl * 256 + h * 64 + n0c) = o;
        o.x = pk2(hl[0], hl[1]); o.y = pk2(hl[2], hl[3]);
        *(u32x2*)(gq + 8192 + (tn * 16 + r) * 64 + tm * 16 + q * 4) = o;
    }
}

__device__ __forceinline__ void rwkv_seq(LAS unsigned char* lds, const MixBufs& B, const bf16_t* rq, int L, int seq, int h, int d) {
    const int tid = otid(), w = tid >> 6, lane = tid & 63, r = lane & 15, q = lane >> 4;
    const int tm = w >> 1, tn0 = (w & 1) * 2;
    const int base = seq * L, nch = L / 64;
    __syncthreads();
    for (int i = tid; i < 64 * RL / 2; i += 512) ((LAS unsigned*)lds)[i] = 0u;
    bf16_t* yout = B.rw_y + (size_t)d * TG * 256;
    const size_t custride = (size_t)8 * 3 * 4096;
    const bf16_t* g = rq + (size_t)(((seq * nch) * 4 + h) * 2 + d) * 3 * 4096;
    const int aoff = (tm * 16 + r) * 64 + q * 8;
    bf16x8 qa0 = *(const bf16x8*)(g + aoff), qa1 = *(const bf16x8*)(g + aoff + 32);
    bf16x8 pa0 = *(const bf16x8*)(g + 4096 + aoff), pa1 = *(const bf16x8*)(g + 4096 + aoff + 32);
    u32x2 hl0 = *(const u32x2*)(g + 8192 + (tn0 * 16 + r) * 64 + tm * 16 + q * 4), hl1 = *(const u32x2*)(g + 8192 + ((tn0 + 1) * 16 + r) * 64 + tm * 16 + q * 4);
    for (int c = 0; c < nch; ++c) {
        const bf16_t* gn = g + (c + 1 < nch ? custride : 0);
        const bf16x8 nqa0 = *(const bf16x8*)(gn + aoff), nqa1 = *(const bf16x8*)(gn + aoff + 32);
        const bf16x8 npa0 = *(const bf16x8*)(gn + 4096 + aoff), npa1 = *(const bf16x8*)(gn + 4096 + aoff + 32);
        const u32x2 nhl0 = *(const u32x2*)(gn + 8192 + (tn0 * 16 + r) * 64 + tm * 16 + q * 4), nhl1 = *(const u32x2*)(gn + 8192 + ((tn0 + 1) * 16 + r) * 64 + tm * 16 + q * 4);
        u32x2 yl[2];
        const int ti_ = tm * 16 + r;
        bf16_t* yrow = yout + (size_t)(d == 0 ? base + c * 64 + ti_ : base + L - 1 - (c * 64 + ti_)) * 256 + h * 64 + q * 4;
#pragma unroll
        for (int tt = 0; tt < 2; ++tt) yl[tt] = *(const u32x2*)(yrow + (tn0 + tt) * 16);
        lds_barrier();
        const LAS bf16_t* cur = (const LAS bf16_t*)(lds + (c & 1) * 9216);
        LAS bf16_t* nxt = (LAS bf16_t*)(lds + ((c + 1) & 1) * 9216);
#pragma unroll
        for (int tt = 0; tt < 2; ++tt) {
            const int tn = tn0 + tt;
            const bf16x8 b0 = *(const LAS bf16x8*)(cur + (tn * 16 + r) * RL + q * 8), b1 = *(const LAS bf16x8*)(cur + (tn * 16 + r) * RL + 32 + q * 8);
            f32x4 y = (f32x4){0.f, 0.f, 0.f, 0.f}, hn = (f32x4){0.f, 0.f, 0.f, 0.f};
            y = __builtin_amdgcn_mfma_f32_16x16x32_bf16(b0, qa0, y, 0, 0, 0); y = __builtin_amdgcn_mfma_f32_16x16x32_bf16(b1, qa1, y, 0, 0, 0);
            hn = __builtin_amdgcn_mfma_f32_16x16x32_bf16(pa0, b0, hn, 0, 0, 0); hn = __builtin_amdgcn_mfma_f32_16x16x32_bf16(pa1, b1, hn, 0, 0, 0);
            const u32x2 hl = tt == 0 ? hl0 : hl1;
            hn[0] += __uint_as_float(hl.x << 16); hn[1] += __uint_as_float(hl.x & 0xffff0000u); hn[2] += __uint_as_float(hl.y << 16); hn[3] += __uint_as_float(hl.y & 0xffff0000u);
            u32x2 o; o.x = pk2(hn[0], hn[1]); o.y = pk2(hn[2], hn[3]);
            *(LAS u32x2*)(nxt + (tn * 16 + r) * RL + tm * 16 + q * 4) = o;
            { const u32x2 yo = yl[tt];
              y[0] += __uint_as_float(yo.x << 16); y[1] += __uint_as_float(yo.x & 0xffff0000u); y[2] += __uint_as_float(yo.y << 16); y[3] += __uint_as_float(yo.y & 0xffff0000u);
              u32x2 o2; o2.x = pk2(y[0], y[1]); o2.y = pk2(y[2], y[3]); *(u32x2*)(yrow + tn * 16) = o2; }
        }
        g = gn; qa0 = nqa0; qa1 = nqa1; pa0 = npa0; pa1 = npa1; hl0 = nhl0; hl1 = nhl1;
    }
}

__device__ __forceinline__ void phase_post(const Params& P, const MixBufs& B, int layer) {
    const int tid_ = otid(); const int lane = tid_ & 63, gw = blockIdx.x * 8 + (tid_ >> 6), nw = gridDim.x * 8;
    const float gng = P.in[7][layer * 64 + lane];
    const float* ssdn = P.in[24] + layer * 512;
    float lng[4], lnb[4];
#pragma unroll
    for (int h = 0; h < 4; ++h) { lng[h] = P.in[17][layer * 256 + h * 64 + lane]; lnb[h] = P.in[18][layer * 256 + h * 64 + lane]; }
    const int c0 = lane * 8;
    const f32x4 sg0 = *(const f32x4*)(ssdn + c0), sg1 = *(const f32x4*)(ssdn + c0 + 4);
    const float Dh = P.in[23][layer * 8 + (lane >> 3)];
    for (int tl = gw; tl < TG; tl += nw) {
        const bf16_t* pr = B.p + (size_t)tl * DINP;
        bf16_t* mr = B.mix + (size_t)tl * DM;
        bf16_t go0[4], go1[4], ry0[4], ry1[4]; bf16_t ggt[4], rvv[4], rgg[4];
#pragma unroll
        for (int h = 0; h < 4; ++h) {
            const size_t o = (size_t)tl * 256 + h * 64 + lane;
            go0[h] = B.gla_o[o]; go1[h] = B.gla_o[(size_t)TG * 256 + o]; ggt[h] = pr[PC_GG + h * 64 + lane];
            ry0[h] = B.rw_y[o]; ry1[h] = B.rw_y[(size_t)TG * 256 + o]; rvv[h] = B.rw[1 * RWA + o]; rgg[h] = B.rw[3 * RWA + o];
        }
        const f32x4 srk = *(const f32x4*)(B.rw_s + (size_t)tl * 4), skr = *(const f32x4*)(B.rw_s + (size_t)TG * 4 + (size_t)tl * 4);
        const u32x4 ya = *(const u32x4*)(B.ssd_y + (size_t)tl * 512 + c0), yb = *(const u32x4*)(B.ssd_y + (size_t)TG * 512 + (size_t)tl * 512 + c0);
        const u32x4 xsr = *(const u32x4*)(B.ssd_x + (size_t)tl * 1024 + c0), zr = *(const u32x4*)(pr + PC_Z + c0);
#pragma unroll
        for (int h = 0; h < 4; ++h) {
            const float o = bf2f(go0[h]) + bf2f(go1[h]);
            const float ms = wave_sum(o * o) * (1.0f / 64.0f);
            mr[h * 64 + lane] = (bf16_t)f2bf(o * rsqrtf(ms + EPS) * gng * silu(bf2f(ggt[h])));
        }
#pragma unroll
        for (int h = 0; h < 4; ++h) {
            const float v = bf2f(rvv[h]);
            const float y = bf2f(ry0[h]) + bf2f(ry1[h]) - v * skr[h];
            const float mean = wave_sum(y) * (1.0f / 64.0f);
            const float dv = y - mean; const float var = wave_sum(dv * dv) * (1.0f / 64.0f);
            float oo = dv * rsqrtf(var + 64e-5f) * lng[h] + lnb[h];
            oo += srk[h] * v;
            mr[256 + h * 64 + lane] = (bf16_t)f2bf(oo * bf2f(rgg[h]));
        }
        {
            float xs[8], z[8], yfa[8], yfb[8]; unpack8(xsr, xs); unpack8(zr, z); unpack8(ya, yfa); unpack8(yb, yfb);
            float yv[8]; float ss = 0.f;
#pragma unroll
            for (int j = 0; j < 8; ++j) { const float yy = (yfa[j] + yfb[j]) + Dh * xs[j]; yv[j] = yy * silu(z[j]); ss += yv[j] * yv[j]; }
            ss = wave_sum(ss);
            const float rs = rsqrtf(ss * (1.0f / 512.0f) + EPS);
            u32x4 o; o.x = pk2(yv[0] * rs * sg0[0], yv[1] * rs * sg0[1]); o.y = pk2(yv[2] * rs * sg0[2], yv[3] * rs * sg0[3]);
            o.z = pk2(yv[4] * rs * sg1[0], yv[5] * rs * sg1[1]); o.w = pk2(yv[6] * rs * sg1[2], yv[7] * rs * sg1[3]);
            *(u32x4*)(mr + 512 + c0) = o;
        }
    }
}

#define RWKV_PRE_QUEUE(pool_base) do { \
        unsigned* qctr_ = (unsigned*)(ws + WS_CTL) + 4096 + 16 * (g * 2 + layer); \
        volatile LAS unsigned* qs_ = (volatile LAS unsigned*)(lds + 131072 + 1024 + 64); \
        unsigned tick_ = 0u; \
        if (threadIdx.x == 0) tick_ = __hip_atomic_fetch_add(qctr_, 1u, __ATOMIC_RELAXED, __HIP_MEMORY_SCOPE_AGENT); \
        for (;;) { \
            if (threadIdx.x == 0) qs_[0] = tick_; \
            __syncthreads(); \
            const int uq_ = (pool_base) + (int)qs_[0]; \
            __syncthreads(); \
            if (uq_ >= 4096) break; \
            if (threadIdx.x == 0) tick_ = __hip_atomic_fetch_add(qctr_, 1u, __ATOMIC_RELAXED, __HIP_MEMORY_SCOPE_AGENT); \
            RwRaw Rq_; rwkv_pre_load(Rq_, B, L, uq_, otid()); rwkv_pre(lds, B, rq, L, uq_, -1, Rq_); \
        } } while (0)

__global__ void __launch_bounds__(512, 2) fwd_megakernel(Params P) {
    extern __shared__ __attribute__((aligned(16))) unsigned char shm[];
    LAS unsigned char* lds = (LAS unsigned char*)shm;
    unsigned char* ws = P.ws;
    volatile LAS unsigned* bst = (volatile LAS unsigned*)(lds + 131072 + 1024);
    if (threadIdx.x == 0) { bst[0] = 0u; bst[1] = 0u; }
    __syncthreads();
    const XcdBarrier xbar = xcd_barrier_post((unsigned*)(ws + WS_CTL), bst);
    bf16_t* xb = (bf16_t*)(ws + WS_XB); float* ssp = (float*)(ws + WS_SSP); bf16_t* pbuf = (bf16_t*)(ws + WS_P);

    phase_weights(lds, P);
    for (int g = 0; g < NGROUP; ++g) {
        const int L = g < 2 ? 2048 : 16384, nseq = TG / L;
        phase_xprep(P, g);
        if (g == 0) cg::this_grid().sync(); else xcd_barrier(xbar);
        for (int layer = 0; layer < 2; ++layer) {
            pg8::StaticOrder S;
            {
                pg8::Gemm gm; gm.A = xb; gm.Bt = (const bf16_t*)(ws + WS_WIN) + (size_t)layer * DINP * DM; gm.M = TG; gm.N = DINP; gm.K = DM;
                S.init(TG, DINP, gridDim.x, blockIdx.x);
                EpiInproj E; E.O = pbuf; E.ssp = ssp;
                pg8::gemm_phase(lds, gm, S, E);
            }
            xcd_barrier(xbar);
            { const MixBufs B = mixbufs(P); const bf16_t* sw = (const bf16_t*)(ws + WS_SW) + (size_t)layer * SW_L;
              for (int t = blockIdx.x; t < TG / 64; t += gridDim.x) prep_tile64(lds, P, B, sw, layer, L, t); }
            xcd_barrier(xbar);
            {
                const MixBufs B = mixbufs(P);
                bf16_t* rq = (bf16_t*)(ws + WS_RWQ); float* segst = P.out + (size_t)g * TG * DM;
                const int nseg = L / 2048, nch = L / 64;
                const int nchain = nseg == 1 ? nseq * 24 : nseq * (nseg - 1) * 24;
                if (nseg == 1 && gridDim.x == 256) {
                    const int b = blockIdx.x;
                    ssd_unit(lds, P, B, segst, layer, L, b / 24 * 0 + (b >> 4), (b >> 1) & 7, b & 1, 0, false);
                    const int p0 = b * 10, pn = 10;
                    __syncthreads();
                    { RwRaw R; rwkv_pre_load(R, B, L, p0, otid());
                      for (int u = p0; u < p0 + pn; ++u) rwkv_pre(lds, B, rq, L, u, u + 1 < p0 + pn ? u + 1 : -1, R); }
                    RWKV_PRE_QUEUE(256 * 10);
                } else if (nseg == 8 && nseq == 2 && gridDim.x == 256) {
                    const int b = blockIdx.x;
                    for (int rep = 0; rep < 2; ++rep) {
                        const int it = b + rep * 256;
                        if (it < nchain) {
                            const int k = it % 24, sg = it / 24, seq = sg / (nseg - 1), seg = sg % (nseg - 1);
                            if (k < 16) ssd_unit(lds, P, B, segst, layer, L, seq, k >> 1, k & 1, seg, true);
                            else gla_unit(lds, P, B, segst, layer, L, seq, (k - 16) >> 1, k & 1, seg, true);
                        }
                    }
                    const int kx = b - 80;
                    const int p0 = b < 80 ? b * 5 : 400 + kx * 13, pn = b < 80 ? 5 : 13;
                    __syncthreads();
                    { RwRaw R; rwkv_pre_load(R, B, L, p0, otid());
                      for (int u = p0; u < p0 + pn; ++u) rwkv_pre(lds, B, rq, L, u, u + 1 < p0 + pn ? u + 1 : -1, R); }
                    RWKV_PRE_QUEUE(400 + 176 * 13);
                } else
                for (int it = blockIdx.x; it < nchain + 4096; it += gridDim.x) {
                    if (it < nchain) {
                        const int k = it % 24, sg = it / 24, seq = nseg == 1 ? sg : sg / (nseg - 1), seg = nseg == 1 ? 0 : sg % (nseg - 1);
                        if (k < 16) ssd_unit(lds, P, B, segst, layer, L, seq, k >> 1, k & 1, seg, nseg > 1);
                        else gla_unit(lds, P, B, segst, layer, L, seq, (k - 16) >> 1, k & 1, seg, nseg > 1);
                    } else { const int u = it - nchain; __syncthreads(); RwRaw R; rwkv_pre_load(R, B, L, u, otid()); rwkv_pre(lds, B, rq, L, u, -1, R); }
                }
            }
            xcd_barrier(xbar);
            {
                const MixBufs B = mixbufs(P);
                const bf16_t* rq = (const bf16_t*)(ws + WS_RWQ); float* segst = P.out + (size_t)g * TG * DM;
                const int nseg = L / 2048;
                const int nchain = nseg == 1 ? 0 : nseq * nseg * 24;
                const int nrs = nseq * 8, G = gridDim.x;
                if (nseg == 1 && G == 256) {
                    const int b = blockIdx.x;
                    if (b < 128) rwkv_seq(lds, B, rq, L, b >> 3, (b >> 1) & 3, b & 1);
                    else { const int u = b - 128; gla_unit(lds, P, B, segst, layer, L, u >> 3, (u >> 1) & 3, u & 1, 0, false); }
                } else
                for (int rnd = 0; rnd * G < nchain + nrs; ++rnd) {
                    const int it = rnd * G + ((rnd & 1) ? (G - 1 - (int)blockIdx.x) : (int)blockIdx.x);
                    if (it >= nchain + nrs) continue;
                    if (it >= nrs) {
                        const int ci = it - nrs, k = ci % 24, sg = ci / 24, seq = sg / nseg, seg = sg % nseg;
                        if (k < 16) ssd_unit(lds, P, B, segst, layer, L, seq, k >> 1, k & 1, seg, false);
                        else gla_unit(lds, P, B, segst, layer, L, seq, (k - 16) >> 1, k & 1, seg, false);
                    } else { rwkv_seq(lds, B, rq, L, it >> 3, (it >> 1) & 3, it & 1); }
                }
            }
            xcd_barrier(xbar);
            { const MixBufs B = mixbufs(P); phase_post(P, B, layer); }
            xcd_barrier(xbar);
            {
                pg8::Gemm gm; gm.A = (const bf16_t*)(ws + WS_MIX); gm.Bt = (const bf16_t*)(ws + WS_WOUT) + (size_t)layer * DM * DM; gm.M = TG; gm.N = DM; gm.K = DM;
                S.init(TG, DM, gridDim.x, blockIdx.x);
                EpiResid E; E.XB = xb; E.ssp = ssp;
                pg8::gemm_phase(lds, gm, S, E);
            }
            xcd_barrier(xbar);
            {
                pg8::Gemm gm; gm.A = xb; gm.Bt = (const bf16_t*)(ws + WS_WGU) + (size_t)layer * 2 * DFF * DM; gm.M = TG; gm.N = 2 * DFF; gm.K = DM;
                S.init(TG, 2 * DFF, gridDim.x, blockIdx.x);
                EpiGateUp E; E.O = pbuf; E.ssp = ssp;
                pg8::gemm_phase(lds, gm, S, E);
            }
            xcd_barrier(xbar);
            {
                pg8::Gemm gm; gm.A = pbuf; gm.Bt = (const bf16_t*)(ws + WS_WDN) + (size_t)layer * DM * DFF; gm.M = TG; gm.N = DM; gm.K = DFF;
                S.init(TG, DM, gridDim.x, blockIdx.x);
                EpiResid E; E.XB = xb; E.ssp = ssp;
                pg8::gemm_phase(lds, gm, S, E);
            }
            xcd_barrier(xbar);
        }
        phase_final(P, g);
        xcd_barrier(xbar);
    }
}

extern "C" void kernel_launch(void* const* d_in, const int* in_sizes, int n_in, void* d_out, int out_size, void* d_ws, size_t ws_size, hipStream_t stream) {
    static int grid = 0;
    if (grid == 0) {
        if (n_in != 30 || ws_size < WS_END) { fprintf(stderr, "kernel_launch: need 30 inputs and %zu ws bytes; got %d, %zu\n", (size_t)WS_END, n_in, ws_size); grid = -1; return; }
        int dev = 0, cus = 0, per_cu = 0;
        hipGetDevice(&dev);
        hipDeviceGetAttribute(&cus, hipDeviceAttributeMultiprocessorCount, dev);
        hipFuncSetAttribute((const void*)fwd_megakernel, hipFuncAttributeMaxDynamicSharedMemorySize, LDS_BYTES);
        hipOccupancyMaxActiveBlocksPerMultiprocessor(&per_cu, (const void*)fwd_megakernel, 512, LDS_BYTES);
        if (per_cu < 1) per_cu = 1;
        grid = cus * 1;
        if (grid > 256) grid = 256;
    }
    if (grid < 0) return;
    if (hipMemsetAsync((char*)d_ws + WS_CTL, 0, 65536, stream) != hipSuccess) { fprintf(stderr, "memset failed\n"); return; }
    Params p{};
    for (int i = 0; i < 30; ++i) p.in[i] = (const float*)d_in[i];
    p.out = (float*)d_out; p.ws = (unsigned char*)d_ws;
    void* args[] = {&p};
    hipError_t e = hipLaunchCooperativeKernel((const void*)fwd_megakernel, dim3(grid), dim3(512), args, LDS_BYTES, stream);
    if (e != hipSuccess) fprintf(stderr, "cooperative launch failed: %s (grid %d)\n", hipGetErrorString(e), grid);
}
```

```cpp
#include <hip/hip_runtime.h>
#include <hip/hip_cooperative_groups.h>
#include <cstdio>
namespace cg = cooperative_groups;

#define LAS __attribute__((address_space(3)))
typedef unsigned short bf16_t;
typedef short bf16x8 __attribute__((ext_vector_type(8)));
typedef float f32x4 __attribute__((ext_vector_type(4)));
typedef float f32x2 __attribute__((ext_vector_type(2)));
typedef unsigned u32x4 __attribute__((ext_vector_type(4)));
typedef unsigned u32x2 __attribute__((ext_vector_type(2)));

constexpr int DM = 1024, TALL = 98304, TG = 32768, NGROUP = 3;
constexpr int DINP = 3584, DIN = 3504, DFF = 2816;
constexpr int LDS_BYTES = 131072 + 2048;
constexpr float EPS = 1e-6f;
constexpr int PC_GQ = 0, PC_GK = 128, PC_GV = 256, PC_GG = 512, PC_GAF = 768;
constexpr int PC_R = 800, PC_RK = 1056, PC_RV = 1312, PC_RLOW = 1568;
constexpr int PC_Z = 1952, PC_XBC = 2464, PC_DT = 3488;

constexpr size_t WS_CTL = 0;
constexpr size_t WS_SW = 65536;
constexpr int SW_L = 106496;
constexpr size_t WS_WIN = WS_SW + 524288;
constexpr size_t WS_WOUT = WS_WIN + (size_t)2 * DINP * DM * 2;
constexpr size_t WS_WGU = WS_WOUT + (size_t)2 * DM * DM * 2;
constexpr size_t WS_WDN = WS_WGU + (size_t)2 * 2 * DFF * DM * 2;
constexpr size_t WS_XB = WS_WDN + (size_t)2 * DM * DFF * 2;
constexpr size_t WS_P = WS_XB + (size_t)TG * DM * 2;
constexpr size_t WS_MIX = WS_P + (size_t)TG * DINP * 2;
constexpr size_t WS_SSP = WS_MIX + (size_t)TG * DM * 2;
constexpr size_t WS_GLA_LA = WS_SSP + (size_t)TG * 16 * 4;
constexpr size_t WS_GLA_O = WS_GLA_LA + (size_t)2 * TG * 128 * 4;
constexpr size_t WS_RW = WS_GLA_O + (size_t)2 * TG * 256 * 4;
constexpr size_t WS_RW_S = WS_RW + (size_t)10 * TG * 256 * 2;
constexpr size_t WS_RW_Y = WS_RW_S + (size_t)2 * TG * 4 * 4;
constexpr size_t WS_SSD_X = WS_RW_Y + (size_t)2 * TG * 256 * 4;
constexpr size_t WS_SSD_DT = WS_SSD_X + (size_t)TG * 1024 * 2;
constexpr size_t WS_SSD_Y = WS_SSD_DT + (size_t)TG * 16 * 4;
constexpr size_t WS_RWQ = WS_SSD_Y + (size_t)2 * TG * 512 * 4;
constexpr size_t WS_END = WS_RWQ + (size_t)4096 * 3 * 4096 * 2;
static_assert(WS_END <= ((size_t)1 << 30), "workspace over 1 GiB");

struct Params { const float* in[30]; float* out; unsigned char* ws; };

__device__ __forceinline__ int otid() { int t = threadIdx.x; asm volatile("" : "+v"(t)); return t; }
__device__ __forceinline__ float bf2f(bf16_t b) { return __uint_as_float(((unsigned)b) << 16); }
typedef __bf16 bf16x2_t __attribute__((ext_vector_type(2)));
__device__ __forceinline__ unsigned pk2(float lo, float hi) { f32x2 f = {lo, hi}; bf16x2_t v = __builtin_convertvector(f, bf16x2_t); return __builtin_bit_cast(unsigned, v); }
__device__ __forceinline__ unsigned f2bf(float f) { return (unsigned)__builtin_bit_cast(unsigned short, (__bf16)f); }
__device__ __forceinline__ float sigm(float x) { return __builtin_amdgcn_rcpf(1.0f + __expf(-x)); }
__device__ __forceinline__ float silu(float x) { return x * __builtin_amdgcn_rcpf(1.0f + __expf(-x)); }
__device__ __forceinline__ float softplus(float x) { return fmaxf(x, 0.f) + __logf(1.0f + __expf(-fabsf(x))); }
__device__ __forceinline__ void lds_barrier() { asm volatile("s_waitcnt lgkmcnt(0)" ::: "memory"); __builtin_amdgcn_s_barrier(); asm volatile("" ::: "memory"); }

__device__ __forceinline__ float dpp_add(float v, float src_carrier) { return v + src_carrier; }
#define DPPF(x, ctrl, rmask) __int_as_float(__builtin_amdgcn_update_dpp(0, __float_as_int(x), (ctrl), (rmask), 0xf, false))
__device__ __forceinline__ float wave_incl_scan(float v, int lane) {
    v += DPPF(v, 0x111, 0xf);
    v += DPPF(v, 0x112, 0xf);
    v += DPPF(v, 0x114, 0xf);
    v += DPPF(v, 0x118, 0xf);
    v += DPPF(v, 0x142, 0xa);
    v += DPPF(v, 0x143, 0xc);
    return v;
}
__device__ __forceinline__ float lane_bcast(float v, int l) { return __int_as_float(__builtin_amdgcn_readlane(__float_as_int(v), l)); }
__device__ __forceinline__ float wave_sum(float v) { return lane_bcast(wave_incl_scan(v, 0), 63); }
__device__ __forceinline__ void unpack8(u32x4 v, float* f) {
    f[0] = __uint_as_float(v.x << 16); f[1] = __uint_as_float(v.x & 0xffff0000u);
    f[2] = __uint_as_float(v.y << 16); f[3] = __uint_as_float(v.y & 0xffff0000u);
    f[4] = __uint_as_float(v.z << 16); f[5] = __uint_as_float(v.z & 0xffff0000u);
    f[6] = __uint_as_float(v.w << 16); f[7] = __uint_as_float(v.w & 0xffff0000u);
}


#define XB_TMO      128
#define XB_XCNT(j)  (256  + 64 * (j))
#define XB_XSUB(j)  (1280 + 64 * (j))
#define XB_XGEN(j)  (2304 + 64 * (j))
#define XB_TOP      3328
#define XB_TOPGEN   3392
#define XB_SPIN_CAP (1u << 22)
__device__ __forceinline__ unsigned xb_ld(unsigned* p)              { return __hip_atomic_load(p, __ATOMIC_RELAXED, __HIP_MEMORY_SCOPE_AGENT); }
__device__ __forceinline__ unsigned xb_add(unsigned* p, unsigned v) { return __hip_atomic_fetch_add(p, v, __ATOMIC_RELAXED, __HIP_MEMORY_SCOPE_AGENT); }
__device__ __forceinline__ unsigned xb_xcc_id() { return (unsigned)__builtin_amdgcn_s_getreg((3 << 11) | 20) & 0xFu; }
#define XB_SPIN(cond, bar) do { unsigned _sp = 0; while (cond) { __builtin_amdgcn_s_sleep(1); \
    if ((++_sp & 255u) == 0u) { if (xb_ld(&(bar)[XB_TMO])) break; if (_sp > XB_SPIN_CAP) { atomicAdd(&(bar)[XB_TMO], 1u); break; } } } } while (0)
struct XcdBarrier { unsigned* bar; unsigned x; volatile LAS unsigned* st; };
__device__ __forceinline__ XcdBarrier xcd_barrier_post(unsigned* bar, volatile LAS unsigned* st) {
    XcdBarrier b; b.bar = bar; b.x = xb_xcc_id(); b.st = st;
    if (threadIdx.x == 0) (void)xb_add(&bar[XB_XCNT(b.x)], 1u);
    return b;
}
__device__ __forceinline__ void xcd_barrier_complete(unsigned* bar, unsigned x, unsigned& nloc, unsigned& nx) {
    const unsigned G = gridDim.x * gridDim.y * gridDim.z;
    unsigned sum, cnt, mine, sp = 0u;
    for (;;) {
        sum = 0u; cnt = 0u; mine = 0u;
#pragma unroll
        for (unsigned j = 0; j < 16; ++j) { const unsigned c = xb_ld(&bar[XB_XCNT(j)]); sum += c; cnt += (c > 0u) ? 1u : 0u; mine = (j == x) ? c : mine; }
        if (sum == G) break;
        __builtin_amdgcn_s_sleep(1);
        if ((++sp & 255u) == 0u) { if (xb_ld(&bar[XB_TMO])) break; if (sp > XB_SPIN_CAP) { atomicAdd(&bar[XB_TMO], 1u); break; } }
    }
    nloc = mine > 0u ? mine : 1u; nx = cnt > 0u ? cnt : 1u;
}
__device__ __forceinline__ void xcd_barrier(const XcdBarrier& b) {
    asm volatile("s_waitcnt vmcnt(0)" ::: "memory");
    __syncthreads();
    if (threadIdx.x == 0) {
        unsigned* bar = b.bar;
        __builtin_amdgcn_s_waitcnt(0);
        unsigned nloc = b.st[0], nx = b.st[1];
        if (nloc == 0u) { xcd_barrier_complete(bar, b.x, nloc, nx); b.st[0] = nloc; b.st[1] = nx; }
        const unsigned old = xb_add(&bar[XB_XSUB(b.x)], 1u);
        const unsigned gen = old / nloc;
        if (old + 1u == (gen + 1u) * nloc) {
            __builtin_amdgcn_fence(__ATOMIC_RELEASE, "agent");
            asm volatile("s_waitcnt vmcnt(0)" ::: "memory");
            const unsigned og = xb_add(&bar[XB_TOP], 1u);
            const unsigned tg = og / nx;
            if (og + 1u == (tg + 1u) * nx) xb_add(&bar[XB_TOPGEN], 1u);
            else XB_SPIN(xb_ld(&bar[XB_TOPGEN]) == tg, bar);
            __builtin_amdgcn_fence(__ATOMIC_ACQUIRE, "agent");
            xb_add(&bar[XB_XGEN(b.x)], 1u);
            asm volatile("s_waitcnt vmcnt(0)" ::: "memory");
        } else {
            XB_SPIN(xb_ld(&bar[XB_XGEN(b.x)]) == gen, bar);
            __builtin_amdgcn_fence(__ATOMIC_ACQUIRE, "agent");
            asm volatile("s_waitcnt vmcnt(0)" ::: "memory");
        }
    }
    __syncthreads();
}

namespace pg8 {
constexpr int BM = 256, BK = 64, HALF = 128, HTB = HALF * BK * 2, NXCD = 8, WGM = 4;
__device__ __forceinline__ int lds_byte(int r, int c) { const int st = (r >> 4) * 2 + (c >> 5), rr = r & 15, cc = c & 31, ob = rr * 64 + cc * 2; return st * 1024 + (ob ^ (((ob >> 9) & 1) << 5)); }
__device__ __forceinline__ void stage_rc(int b, int& R, int& C) { const int st = b / 1024, sb = b % 1024, swz = sb ^ (((sb >> 9) & 1) << 5); R = (st >> 1) * 16 + swz / 64; C = (st & 1) * 32 + (swz % 64) / 2; }
__device__ __forceinline__ int perm32(int rho) { const int n = rho >> 4, i = rho & 15; return 8 * (i >> 2) + 4 * n + (i & 3); }
struct Unit { int pm, pn; };
struct Gemm { const bf16_t* A; const bf16_t* Bt; int M, N, K; };
struct StaticOrder {
    int nM, nN, nwg, G, c;
    __device__ void init(int M, int N, int G_, int c_) { nM = M / BM; nN = N / BM; nwg = nM * nN; G = G_; c = c_; }
    __device__ bool next(int i, Unit& u) const {
        const long L = (long)i * G + c; if (L >= nwg) return false;
        int wgid = (int)L; { const int q = nwg / NXCD, r = nwg % NXCD, xcd = wgid % NXCD, off = wgid / NXCD; wgid = (xcd < r ? xcd * (q + 1) : r * (q + 1) + (xcd - r) * q) + off; }
        const int nig = WGM * nN, gid = wgid / nig, fm = gid * WGM, gsz = (nM - fm) < WGM ? (nM - fm) : WGM;
        u.pm = fm + ((wgid % nig) % gsz); u.pn = (wgid % nig) / gsz; return true;
    }
};

template <class Epi>
__device__ __forceinline__ void gemm_phase(LAS unsigned char* lds, const Gemm g, const StaticOrder& S, const Epi& E) {
    const int tid = otid(), wid = __builtin_amdgcn_readfirstlane(tid >> 6), lane = tid & 63, wr = wid >> 2, wc = wid & 3, fr = lane & 15, fq = lane >> 4;
    const int K = g.K, nt = K / BK;
    unsigned voffA[2], voffB[2];
#pragma unroll
    for (int i = 0; i < 2; ++i) { int R, C; stage_rc(tid * 16 + i * 8192, R, C); const int Rb = Epi::PERM ? ((R & ~31) + perm32(R & 31)) : R;
        voffA[i] = (unsigned)(R * K + C) * 2u; voffB[i] = (unsigned)(Rb * K + C) * 2u; }
    const size_t kstep = (size_t)(BK * 2);
    const size_t hstep = (size_t)HALF * K * 2;
    const size_t tstep = 2 * hstep;
    const unsigned ldsw = (unsigned)wid * 1024u;
    const int aoff = lds_byte(wr * 64 + fr, fq * 8), boff = lds_byte(wc * 32 + fr, fq * 8);
#define PG8_SA(b, h) (((b) * 2 + (h)) * HTB)
#define PG8_SB(b, h) ((4 + (b) * 2 + (h)) * HTB)
#define PG8_STAGE(bufoff, gbase, voff) do { _Pragma("unroll") for (int _i = 0; _i < 2; ++_i) \
        __builtin_amdgcn_global_load_lds((const unsigned*)((const char*)(gbase) + (voff)[_i]), (LAS unsigned*)(lds + (bufoff) + ldsw + _i * 8192), 16, 0, 0); } while (0)
#define PG8_LDA(dst, b, h) do { _Pragma("unroll") for (int m = 0; m < 4; ++m) _Pragma("unroll") for (int k = 0; k < 2; ++k) dst[m][k] = *(const LAS bf16x8*)(lds + PG8_SA(b, h) + aoff + m * 2048 + k * 1024); } while (0)
#define PG8_LDB(dst, b, h) do { _Pragma("unroll") for (int n = 0; n < 2; ++n) _Pragma("unroll") for (int k = 0; k < 2; ++k) dst[n][k] = *(const LAS bf16x8*)(lds + PG8_SB(b, h) + boff + n * 2048 + k * 1024); } while (0)
#define PG8_MMA(ai, bj, At, Bt) do { __builtin_amdgcn_s_setprio(1); _Pragma("unroll") for (int m = 0; m < 4; ++m) _Pragma("unroll") for (int n = 0; n < 2; ++n) _Pragma("unroll") for (int k = 0; k < 2; ++k) \
        acc[ai][bj][m][n] = __builtin_amdgcn_mfma_f32_16x16x32_bf16(Bt[n][k], At[m][k], acc[ai][bj][m][n], 0, 0, 0); __builtin_amdgcn_s_setprio(0); } while (0)
#define PG8_WAIT_V(n) asm volatile("s_waitcnt vmcnt(" #n ")" ::: "memory")
#define PG8_WAIT_L(n) asm volatile("s_waitcnt lgkmcnt(" #n ")" ::: "memory")
#define PG8_BAR __builtin_amdgcn_s_barrier()
#define PG8_SCHED __builtin_amdgcn_sched_barrier(0)
    Unit cur, nxt; int ui = 0;
    if (!S.next(0, cur)) return;
    f32x4 acc[2][2][4][2];
#pragma unroll
    for (int a = 0; a < 2; ++a)
#pragma unroll
        for (int b = 0; b < 2; ++b)
#pragma unroll
            for (int m = 0; m < 4; ++m)
#pragma unroll
                for (int n = 0; n < 2; ++n) acc[a][b][m][n] = (f32x4){0.f, 0.f, 0.f, 0.f};
    bf16x8 At[4][2], B0[2][2], B1[2][2];
    const char* cA = (const char*)g.A + (size_t)cur.pm * tstep; const char* cB = (const char*)g.Bt + (size_t)cur.pn * tstep;
    PG8_STAGE(PG8_SB(0, 0), cB, voffB); PG8_STAGE(PG8_SA(0, 0), cA, voffA); PG8_STAGE(PG8_SB(0, 1), cB + hstep, voffB); PG8_STAGE(PG8_SA(0, 1), cA + hstep, voffA);
    if (wr == 1) PG8_BAR;
    PG8_WAIT_V(4); PG8_BAR;
    PG8_STAGE(PG8_SB(1, 0), cB + kstep, voffB); PG8_STAGE(PG8_SA(1, 0), cA + kstep, voffA); PG8_STAGE(PG8_SB(1, 1), cB + hstep + kstep, voffB);
    PG8_WAIT_V(6); PG8_BAR;
    for (;;) {
        const bool has_next = S.next(ui + 1, nxt);
        const char* nA = has_next ? (const char*)g.A + (size_t)nxt.pm * tstep : cA; const char* nB = has_next ? (const char*)g.Bt + (size_t)nxt.pn * tstep : cB;
        for (int t = 0; t < nt; t += 2) {
            const bool last = (t == nt - 2);
            const char* a1 = cA + (size_t)(t + 1) * kstep;
            const char* a2 = last ? nA : cA + (size_t)(t + 2) * kstep; const char* b2 = last ? nB : cB + (size_t)(t + 2) * kstep;
            const char* a3 = a2 + kstep; const char* b3 = b2 + kstep;
            PG8_LDB(B0, 0, 0); PG8_SCHED; PG8_LDA(At, 0, 0); PG8_STAGE(PG8_SA(1, 1), a1 + hstep, voffA);
            PG8_WAIT_L(8); PG8_BAR; PG8_WAIT_L(0); PG8_MMA(0, 0, At, B0); PG8_BAR; PG8_SCHED;
            PG8_LDB(B1, 0, 1); PG8_STAGE(PG8_SB(0, 0), b2, voffB);
            PG8_BAR; PG8_WAIT_L(0); PG8_MMA(0, 1, At, B1); PG8_BAR;
            PG8_LDA(At, 0, 1); PG8_STAGE(PG8_SA(0, 0), a2, voffA);
            PG8_BAR; PG8_WAIT_L(0); PG8_MMA(1, 0, At, B0); PG8_BAR; PG8_SCHED;
            PG8_STAGE(PG8_SB(0, 1), b2 + hstep, voffB);
            PG8_WAIT_V(6); PG8_BAR; PG8_MMA(1, 1, At, B1); PG8_BAR;
            PG8_LDB(B0, 1, 0); PG8_SCHED; PG8_LDA(At, 1, 0); PG8_STAGE(PG8_SA(0, 1), a2 + hstep, voffA);
            PG8_WAIT_L(8); PG8_BAR; PG8_WAIT_L(0); PG8_MMA(0, 0, At, B0); PG8_BAR; PG8_SCHED;
            PG8_LDB(B1, 1, 1); PG8_STAGE(PG8_SB(1, 0), b3, voffB);
            PG8_BAR; PG8_WAIT_L(0); PG8_MMA(0, 1, At, B1); PG8_BAR;
            PG8_LDA(At, 1, 1); PG8_STAGE(PG8_SA(1, 0), a3, voffA);
            PG8_BAR; PG8_WAIT_L(0); PG8_MMA(1, 0, At, B0); PG8_BAR; PG8_SCHED;
            PG8_STAGE(PG8_SB(1, 1), b3 + hstep, voffB);
            PG8_WAIT_V(6); PG8_BAR; PG8_MMA(1, 1, At, B1); PG8_BAR;
        }
        E(acc, cur, wr, wc, fr, fq);
        if (!has_next) break;
#pragma unroll
        for (int a = 0; a < 2; ++a)
#pragma unroll
            for (int b = 0; b < 2; ++b)
#pragma unroll
                for (int m = 0; m < 4; ++m)
#pragma unroll
                    for (int n = 0; n < 2; ++n) acc[a][b][m][n] = (f32x4){0.f, 0.f, 0.f, 0.f};
        cur = nxt; cA = nA; cB = nB; ++ui;
    }
    PG8_WAIT_V(0);
    if (wr == 0) PG8_BAR;
    PG8_BAR;
#undef PG8_SA
#undef PG8_SB
#undef PG8_STAGE
#undef PG8_LDA
#undef PG8_LDB
#undef PG8_MMA
#undef PG8_WAIT_V
#undef PG8_WAIT_L
#undef PG8_BAR
#undef PG8_SCHED
}
}

__device__ __forceinline__ float row_rs(const float* ssp, int row) {
    const f32x4* p = (const f32x4*)(ssp + (size_t)row * 16);
    f32x4 a = p[0], b = p[1], c = p[2], d = p[3];
    float s = (a[0] + a[1] + a[2] + a[3]) + (b[0] + b[1] + b[2] + b[3]) + (c[0] + c[1] + c[2] + c[3]) + (d[0] + d[1] + d[2] + d[3]);
    return rsqrtf(s * (1.0f / 1024.0f) + EPS);
}

__device__ __forceinline__ f32x4 rs_part(const float* ssp, int row, int fq) { return *(const f32x4*)(ssp + (size_t)row * 16 + fq * 4); }
__device__ __forceinline__ float rs_fin(f32x4 a) { float s = (a[0] + a[1]) + (a[2] + a[3]); s += __shfl_xor(s, 16); s += __shfl_xor(s, 32); return rsqrtf(s * (1.0f / 1024.0f) + EPS); }
struct EpiInproj {
    static constexpr bool PERM = true;
    bf16_t* O; const float* ssp;
    __device__ __forceinline__ void operator()(const f32x4 (&acc)[2][2][4][2], const pg8::Unit& u, int wr, int wc, int fr, int fq) const {
        const int row0 = u.pm * 256 + wr * 64 + fr, col0 = u.pn * 256 + wc * 32 + 8 * fq;
        f32x4 rp[2][4];
#pragma unroll
        for (int ai = 0; ai < 2; ++ai)
#pragma unroll
            for (int m = 0; m < 4; ++m) rp[ai][m] = rs_part(ssp, row0 + ai * 128 + m * 16, fq);
#pragma unroll
        for (int ai = 0; ai < 2; ++ai)
#pragma unroll
            for (int m = 0; m < 4; ++m) {
                const int row = row0 + ai * 128 + m * 16; const float rs = rs_fin(rp[ai][m]);
                bf16_t* rowp = O + (size_t)row * DINP + col0;
#pragma unroll
                for (int bj = 0; bj < 2; ++bj) { f32x4 v0 = acc[ai][bj][m][0] * rs, v1 = acc[ai][bj][m][1] * rs;
                    u32x4 w; w.x = pk2(v0[0], v0[1]); w.y = pk2(v0[2], v0[3]); w.z = pk2(v1[0], v1[1]); w.w = pk2(v1[2], v1[3]);
                    __builtin_nontemporal_store(w, (u32x4*)(rowp + bj * 128)); }
            }
    }
};
struct EpiGateUp {
    static constexpr bool PERM = true;
    bf16_t* O; const float* ssp;
    __device__ __forceinline__ void operator()(const f32x4 (&acc)[2][2][4][2], const pg8::Unit& u, int wr, int wc, int fr, int fq) const {
        const int row0 = u.pm * 256 + wr * 64 + fr, col0 = u.pn * 128 + wc * 32 + 8 * fq;
        f32x4 rp[2][4];
#pragma unroll
        for (int ai = 0; ai < 2; ++ai)
#pragma unroll
            for (int m = 0; m < 4; ++m) rp[ai][m] = rs_part(ssp, row0 + ai * 128 + m * 16, fq);
#pragma unroll
        for (int ai = 0; ai < 2; ++ai)
#pragma unroll
            for (int m = 0; m < 4; ++m) {
                const int row = row0 + ai * 128 + m * 16; const float rs = rs_fin(rp[ai][m]);
                float h[8];
#pragma unroll
                for (int n = 0; n < 2; ++n)
#pragma unroll
                    for (int j = 0; j < 4; ++j) h[n * 4 + j] = silu(acc[ai][0][m][n][j] * rs) * (acc[ai][1][m][n][j] * rs);
                u32x4 w; w.x = pk2(h[0], h[1]); w.y = pk2(h[2], h[3]); w.z = pk2(h[4], h[5]); w.w = pk2(h[6], h[7]);
                __builtin_nontemporal_store(w, (u32x4*)(O + (size_t)row * DFF + col0));
            }
    }
};
struct EpiResid {
    static constexpr bool PERM = true;
    bf16_t* XB; float* ssp;
    __device__ __forceinline__ void operator()(const f32x4 (&acc)[2][2][4][2], const pg8::Unit& u, int wr, int wc, int fr, int fq) const {
        const int row0 = u.pm * 256 + wr * 64 + fr, col0 = u.pn * 256 + wc * 32 + 8 * fq;
        u32x4 xnx[2];
        { const bf16_t* xr0 = XB + (size_t)row0 * DM + col0; xnx[0] = *(const u32x4*)xr0; xnx[1] = *(const u32x4*)(xr0 + 128); }
#pragma unroll
        for (int ai = 0; ai < 2; ++ai)
#pragma unroll
            for (int m = 0; m < 4; ++m) {
                const int row = row0 + ai * 128 + m * 16;
                bf16_t* br = XB + (size_t)row * DM + col0;
                const u32x4 xc0 = xnx[0], xc1 = xnx[1];
                if (ai * 4 + m < 7) { const int idx = ai * 4 + m + 1; const bf16_t* xrn = XB + (size_t)(row0 + (idx >> 2) * 128 + (idx & 3) * 16) * DM + col0;
                    xnx[0] = *(const u32x4*)xrn; xnx[1] = *(const u32x4*)(xrn + 128); }
                float ss = 0.f;
#pragma unroll
                for (int bj = 0; bj < 2; ++bj) {
                    float xo[8]; unpack8(bj == 0 ? xc0 : xc1, xo);
                    const f32x4 a0 = acc[ai][bj][m][0], a1 = acc[ai][bj][m][1];
                    float v[8];
#pragma unroll
                    for (int j = 0; j < 4; ++j) { v[j] = xo[j] + a0[j]; v[4 + j] = xo[4 + j] + a1[j]; }
#pragma unroll
                    for (int j = 0; j < 8; ++j) ss += v[j] * v[j];
                    u32x4 w; w.x = pk2(v[0], v[1]); w.y = pk2(v[2], v[3]); w.z = pk2(v[4], v[5]); w.w = pk2(v[6], v[7]);
                    *(u32x4*)(br + bj * 128) = w;
                }
                ss += __shfl_xor(ss, 16); ss += __shfl_xor(ss, 32);
                if (fq == 0) ssp[(size_t)row * 16 + u.pn * 4 + wc] = ss;
                asm volatile("" ::: "memory");
            }
    }
};

__device__ __forceinline__ void wtile(LAS float* tile, const float* src, int lds_src, const float* gain, bf16_t* dst, int K, int n0, int k0, int c0, int nvalid) {
    const int tid = otid();
    __syncthreads();
#pragma unroll
    for (int i = 0; i < 8; ++i) {
        const int kk = (tid >> 6) + 8 * i, c = tid & 63;
        float v = 0.f;
        if (c0 + c < nvalid) { v = src[(size_t)(k0 + kk) * lds_src + c0 + c]; if (gain) v *= gain[k0 + kk]; }
        tile[kk * 65 + c] = v;
    }
    __syncthreads();
    const int n = tid >> 3, kc = (tid & 7) * 8;
    float f[8];
#pragma unroll
    for (int j = 0; j < 8; ++j) f[j] = tile[(kc + j) * 65 + n];
    u32x4 w; w.x = pk2(f[0], f[1]); w.y = pk2(f[2], f[3]); w.z = pk2(f[4], f[5]); w.w = pk2(f[6], f[7]);
    *(u32x4*)(dst + (size_t)(n0 + n) * K + k0 + kc) = w;
}
__device__ __forceinline__ void phase_weights(LAS unsigned char* lds, const Params& P) {
    LAS float* tile = (LAS float*)lds;
    unsigned char* ws = P.ws;
    constexpr int T_IN = 56 * 16, T_OUT = 16 * 16, T_GU = 88 * 16, T_DN = 16 * 44, T_L = T_IN + T_OUT + T_GU + T_DN;
    for (int t = blockIdx.x; t < 2 * 24; t += gridDim.x) {
        const int l = t / 24, idx = t % 24; bf16_t* sw = (bf16_t*)(ws + WS_SW) + (size_t)l * SW_L;
        if (idx < 16) { const int m = idx >> 2, nb = idx & 3, d = m & 1;
            const float* src = (m < 2 ? P.in[10] : P.in[12]) + (size_t)(l * 2 + d) * 64 * 256;
            wtile(tile, src, 256, nullptr, sw + m * 16384, 64, nb * 64, 0, nb * 64, 256);
        } else { const int nb = (idx - 16) >> 1, kb = (idx - 16) & 1;
            wtile(tile, P.in[13] + (size_t)l * 128 * 256, 256, nullptr, sw + 65536, 128, nb * 64, kb * 64, nb * 64, 256); }
    }
    for (int i = blockIdx.x * 512 + threadIdx.x; i < 2 * 8192; i += gridDim.x * 512) {
        const int l = i >> 13, rem = i & 8191, d = rem >> 12, c = (rem & 4095) >> 5, k = rem & 31;
        const float v = ((k >> 4) == d) ? P.in[5][((size_t)(l * 2 + d) * 16 + (k & 15)) * 128 + c] : 0.f;
        ((bf16_t*)(ws + WS_SW))[(size_t)l * SW_L + 98304 + rem] = (bf16_t)f2bf(v);
    }
    for (int t = blockIdx.x; t < 2 * T_L; t += gridDim.x) {
        const int l = t / T_L; int r = t % T_L;
        if (r < T_IN) { const int nb = r / 16, kb = r % 16;
            wtile(tile, P.in[3] + (size_t)l * DM * DIN, DIN, P.in[2] + l * DM, (bf16_t*)(ws + WS_WIN) + (size_t)l * DINP * DM, DM, nb * 64, kb * 64, nb * 64, DIN);
        } else if ((r -= T_IN) < T_OUT) { const int nb = r / 16, kb = r % 16;
            wtile(tile, P.in[4] + (size_t)l * DM * DM, DM, nullptr, (bf16_t*)(ws + WS_WOUT) + (size_t)l * DM * DM, DM, nb * 64, kb * 64, nb * 64, DM);
        } else if ((r -= T_OUT) < T_GU) { const int nb = r / 16, kb = r % 16;
            const int j = nb >> 2, qd = nb & 3; const float* src = (qd < 2 ? P.in[26] : P.in[27]) + (size_t)l * DM * DFF;
            wtile(tile, src, DFF, P.in[25] + l * DM, (bf16_t*)(ws + WS_WGU) + (size_t)l * 2 * DFF * DM, DM, nb * 64, kb * 64, j * 128 + (qd & 1) * 64, DFF);
        } else { r -= T_GU; const int nb = r / 44, kb = r % 44;
            wtile(tile, P.in[28] + (size_t)l * DFF * DM, DM, nullptr, (bf16_t*)(ws + WS_WDN) + (size_t)l * DM * DFF, DFF, nb * 64, kb * 64, nb * 64, DM);
        }
    }
}

__device__ __forceinline__ void phase_xprep(const Params& P, int g) {
    const float* xin = (g < 2) ? P.in[0] + (size_t)g * TG * DM : P.in[1];
    bf16_t* xb = (bf16_t*)(P.ws + WS_XB); float* ssp = (float*)(P.ws + WS_SSP);
    const int tid_ = otid(); const int lane = tid_ & 63, gw = blockIdx.x * 8 + (tid_ >> 6), nw = gridDim.x * 8;
    int row = gw;
    for (; row + nw < TG; row += 2 * nw) {
        f32x4 v0[4], v1[4];
#pragma unroll
        for (int i = 0; i < 4; ++i) { v0[i] = *(const f32x4*)(xin + (size_t)row * DM + i * 256 + lane * 4); v1[i] = *(const f32x4*)(xin + (size_t)(row + nw) * DM + i * 256 + lane * 4); }
        float s0 = 0.f, s1 = 0.f;
#pragma unroll
        for (int i = 0; i < 4; ++i) {
            const int c = i * 256 + lane * 4;
            u32x2 w; w.x = pk2(v0[i][0], v0[i][1]); w.y = pk2(v0[i][2], v0[i][3]); *(u32x2*)(xb + (size_t)row * DM + c) = w;
            w.x = pk2(v1[i][0], v1[i][1]); w.y = pk2(v1[i][2], v1[i][3]); *(u32x2*)(xb + (size_t)(row + nw) * DM + c) = w;
            s0 += (v0[i][0] * v0[i][0] + v0[i][1] * v0[i][1]) + (v0[i][2] * v0[i][2] + v0[i][3] * v0[i][3]);
            s1 += (v1[i][0] * v1[i][0] + v1[i][1] * v1[i][1]) + (v1[i][2] * v1[i][2] + v1[i][3] * v1[i][3]);
        }
        s0 = wave_sum(s0); s1 = wave_sum(s1);
        if (lane < 16) { ssp[(size_t)row * 16 + lane] = (lane == 0) ? s0 : 0.f; ssp[(size_t)(row + nw) * 16 + lane] = (lane == 0) ? s1 : 0.f; }
    }
    for (; row < TG; row += nw) {
        float ss = 0.f;
#pragma unroll
        for (int i = 0; i < 4; ++i) {
            const int c = i * 256 + lane * 4;
            f32x4 v = *(const f32x4*)(xin + (size_t)row * DM + c);
            u32x2 w; w.x = pk2(v[0], v[1]); w.y = pk2(v[2], v[3]);
            *(u32x2*)(xb + (size_t)row * DM + c) = w;
            ss += (v[0] * v[0] + v[1] * v[1]) + (v[2] * v[2] + v[3] * v[3]);
        }
        ss = wave_sum(ss);
        if (lane < 16) ssp[(size_t)row * 16 + lane] = (lane == 0) ? ss : 0.f;
    }
}
__device__ __forceinline__ void phase_final(const Params& P, int g) {
    float* xo = P.out + (size_t)g * TG * DM; const bf16_t* xb = (const bf16_t*)(P.ws + WS_XB); const float* ssp = (const float*)(P.ws + WS_SSP); const float* gn = P.in[29];
    const int tid_ = otid(); const int lane = tid_ & 63, gw = blockIdx.x * 8 + (tid_ >> 6), nw = gridDim.x * 8;
    f32x4 gg[4];
#pragma unroll
    for (int i = 0; i < 2; ++i) { gg[2 * i] = *(const f32x4*)(gn + i * 512 + lane * 8); gg[2 * i + 1] = *(const f32x4*)(gn + i * 512 + lane * 8 + 4); }
    for (int row0 = gw; row0 < TG; row0 += 2 * nw) {
        const int nr = row0 + nw < TG ? 2 : 1;
        u32x4 xv[2][2]; float rs[2];
#pragma unroll
        for (int rr = 0; rr < 2; ++rr) if (rr < nr) { const int row = row0 + rr * nw;
            xv[rr][0] = *(const u32x4*)(xb + (size_t)row * DM + lane * 8); xv[rr][1] = *(const u32x4*)(xb + (size_t)row * DM + 512 + lane * 8); rs[rr] = row_rs(ssp, row); }
#pragma unroll
        for (int rr = 0; rr < 2; ++rr) if (rr < nr) { const int row = row0 + rr * nw;
#pragma unroll
            for (int i = 0; i < 2; ++i) {
                const int c = i * 512 + lane * 8;
                float v[8]; unpack8(xv[rr][i], v);
                const f32x4 g0 = gg[2 * i], g1 = gg[2 * i + 1]; const float r_ = rs[rr];
                *(f32x4*)(xo + (size_t)row * DM + c) = (f32x4){v[0] * r_ * g0[0], v[1] * r_ * g0[1], v[2] * r_ * g0[2], v[3] * r_ * g0[3]};
                *(f32x4*)(xo + (size_t)row * DM + c + 4) = (f32x4){v[4] * r_ * g1[0], v[5] * r_ * g1[1], v[6] * r_ * g1[2], v[7] * r_ * g1[3]};
            } }
    }
}

struct MixBufs {
    const bf16_t* p; float* gla_la; bf16_t* gla_o; bf16_t* rw; float* rw_s; bf16_t* rw_y; bf16_t* ssd_x; float* ssd_dt; bf16_t* ssd_y; bf16_t* mix;
};
__device__ __forceinline__ MixBufs mixbufs(const Params& P) {
    MixBufs B; unsigned char* ws = P.ws;
    B.p = (const bf16_t*)(ws + WS_P); B.gla_la = (float*)(ws + WS_GLA_LA); B.gla_o = (bf16_t*)(ws + WS_GLA_O); B.rw = (bf16_t*)(ws + WS_RW);
    B.rw_s = (float*)(ws + WS_RW_S); B.rw_y = (bf16_t*)(ws + WS_RW_Y); B.ssd_x = (bf16_t*)(ws + WS_SSD_X); B.ssd_dt = (float*)(ws + WS_SSD_DT);
    B.ssd_y = (bf16_t*)(ws + WS_SSD_Y); B.mix = (bf16_t*)(ws + WS_MIX); return B;
}
constexpr size_t RWA = (size_t)TG * 256;

__device__ __forceinline__ void prep_tile(LAS unsigned char* lds, const Params& P, const MixBufs& B, int layer, int L, int tile) {
    const int tid = otid(), lane = tid & 63;
    const int t0 = tile * 32;
    LAS float* lin = (LAS float*)lds;
    LAS float* gin = (LAS float*)(lds + 49152);
    const bf16_t* p = B.p;
    const float* mu = P.in[8] + layer * 1152;
    __syncthreads();
    for (int idx = tid; idx < 32 * 384; idx += 512) {
        const int t = idx / 384, cc = idx % 384, tl = t0 + t, pos = tl % L, col = PC_RLOW + cc;
        const float cur = bf2f(p[(size_t)tl * DINP + col]);
        const float prv = pos > 0 ? bf2f(p[(size_t)(tl - 1) * DINP + col]) : 0.f;
        const float nxt = pos < L - 1 ? bf2f(p[(size_t)(tl + 1) * DINP + col]) : 0.f;
        float v = cur + mu[col - PC_R] * (0.5f * (prv + nxt) - cur);
        if (cc < 128) { const float e = __expf(2.f * v); v = 1.f - 2.f / (e + 1.f); }
        else if (cc >= 256) v = sigm(v);
        lin[t * 384 + cc] = v;
    }
    for (int idx = tid; idx < 32 * 32; idx += 512) { const int t = idx >> 5, j = idx & 31; gin[idx] = bf2f(p[(size_t)(t0 + t) * DINP + PC_GAF + j]); }
    __syncthreads();
#pragma unroll 1
    for (int i = 0; i < 8; ++i) {
        const int idx = tid + 512 * i, t = idx >> 7, c0 = (idx & 127) * 8, tl = t0 + t, pos = tl % L;
        float acc[8];
        { const f32x4 b0 = *(const f32x4*)(P.in[20] + layer * 1024 + c0), b1 = *(const f32x4*)(P.in[20] + layer * 1024 + c0 + 4);
          acc[0] = b0[0]; acc[1] = b0[1]; acc[2] = b0[2]; acc[3] = b0[3]; acc[4] = b1[0]; acc[5] = b1[1]; acc[6] = b1[2]; acc[7] = b1[3]; }
#pragma unroll
        for (int tap = 0; tap < 5; ++tap) {
            const int pp = pos + tap - 2;
            if (pp >= 0 && pp < L) {
                float x[8]; unpack8(*(const u32x4*)(p + (size_t)(tl + tap - 2) * DINP + PC_XBC + c0), x);
                const float* w = P.in[19] + (size_t)(layer * 5 + tap) * 1024 + c0;
                const f32x4 w0 = *(const f32x4*)w, w1 = *(const f32x4*)(w + 4);
                acc[0] += w0[0] * x[0]; acc[1] += w0[1] * x[1]; acc[2] += w0[2] * x[2]; acc[3] += w0[3] * x[3];
                acc[4] += w1[0] * x[4]; acc[5] += w1[1] * x[5]; acc[6] += w1[2] * x[6]; acc[7] += w1[3] * x[7];
            }
        }
        u32x4 o; o.x = pk2(silu(acc[0]), silu(acc[1])); o.y = pk2(silu(acc[2]), silu(acc[3])); o.z = pk2(silu(acc[4]), silu(acc[5])); o.w = pk2(silu(acc[6]), silu(acc[7]));
        *(u32x4*)(B.ssd_x + (size_t)tl * 1024 + c0) = o;
    }
    { const int t = tid >> 4, j = tid & 15, tl = t0 + t;
      B.ssd_dt[(size_t)tl * 16 + j] = softplus(bf2f(p[(size_t)tl * DINP + PC_DT + j]) + P.in[21][layer * 16 + j]); }
    if (tid < 256) {
        const int d = tid >> 7, c = tid & 127;
        float ac[16];
#pragma unroll
        for (int j = 0; j < 16; ++j) ac[j] = P.in[5][((size_t)(layer * 2 + d) * 16 + j) * 128 + c];
        const float bias = P.in[6][(layer * 2 + d) * 128 + c];
#pragma unroll 4
        for (int t = 0; t < 32; ++t) {
            float a = bias;
#pragma unroll
            for (int j = 0; j < 16; ++j) a += gin[t * 32 + d * 16 + j] * ac[j];
            B.gla_la[((size_t)d * TG + t0 + t) * 128 + c] = -softplus(-a) * (1.0f / 16.0f);
        }
    }
    asm volatile("" ::: "memory");
    {
        const int h2 = __builtin_amdgcn_readfirstlane(tid >> 8), c = tid & 255, head = c >> 6;
        float wcol[64];
        const float kkc = P.in[14][layer * 256 + c], kac = P.in[15][layer * 256 + c], rkc = P.in[16][layer * 256 + c];
        const float mur = mu[c], muk = mu[256 + c], muv = mu[512 + c];
        {
            { const float* wsrc = P.in[10] + (size_t)(layer * 2 + h2) * 64 * 256;
#pragma unroll
            for (int k = 0; k < 64; ++k) wcol[k] = wsrc[k * 256 + c]; }
            const float w0c = P.in[9][(layer * 2 + h2) * 256 + c];
#pragma unroll 1
            for (int t = 0; t < 32; ++t) {
                float aw = w0c;
                const LAS f32x4* lw = (const LAS f32x4*)(lin + t * 384 + h2 * 64);
#pragma unroll
                for (int k4 = 0; k4 < 16; ++k4) { const f32x4 x = lw[k4];
                    aw += x[0] * wcol[k4 * 4] + x[1] * wcol[k4 * 4 + 1] + x[2] * wcol[k4 * 4 + 2] + x[3] * wcol[k4 * 4 + 3]; }
                B.rw[(4 + h2) * RWA + (size_t)(t0 + t) * 256 + c] = (bf16_t)f2bf(sigm(aw) * 0.60653066f);
            }
        }
        asm volatile("" ::: "memory");
        {
            { const float* wsrc = P.in[12] + (size_t)(layer * 2 + h2) * 64 * 256;
#pragma unroll
            for (int k = 0; k < 64; ++k) wcol[k] = wsrc[k * 256 + c]; }
            const float a0c = P.in[11][(layer * 2 + h2) * 256 + c];
#pragma unroll 1
            for (int t = 0; t < 32; ++t) {
                const int tl = t0 + t, pos = tl % L;
                const bf16_t* pc = p + (size_t)tl * DINP;
                const bool hp = pos > 0, hn = pos < L - 1;
                const float rc = bf2f(pc[PC_R + c]), kc = bf2f(pc[PC_RK + c]), vc = bf2f(pc[PC_RV + c]);
                const float rp = hp ? bf2f(pc[PC_R + c - DINP]) : 0.f, kp = hp ? bf2f(pc[PC_RK + c - DINP]) : 0.f, vp = hp ? bf2f(pc[PC_RV + c - DINP]) : 0.f;
                const float rn = hn ? bf2f(pc[PC_R + c + DINP]) : 0.f, kn = hn ? bf2f(pc[PC_RK + c + DINP]) : 0.f, vn = hn ? bf2f(pc[PC_RV + c + DINP]) : 0.f;
                const float r = rc + mur * (0.5f * (rp + rn) - rc), k = kc + muk * (0.5f * (kp + kn) - kc), v = vc + muv * (0.5f * (vp + vn) - vc);
                float aa = a0c;
                const LAS f32x4* la = (const LAS f32x4*)(lin + t * 384 + 128 + h2 * 64);
#pragma unroll
                for (int k4 = 0; k4 < 16; ++k4) { const f32x4 y = la[k4];
                    aa += y[0] * wcol[k4 * 4] + y[1] * wcol[k4 * 4 + 1] + y[2] * wcol[k4 * 4 + 2] + y[3] * wcol[k4 * 4 + 3]; }
                const float asg = sigm(aa);
                const float kr = k * kkc; const float kk = kr * rsqrtf(wave_sum(kr * kr) + 1e-12f);
                const float kd = k * (1.f + (asg - 1.f) * kac), bb = kk * asg;
                const size_t o = (size_t)tl * 256 + c;
                B.rw[(6 + h2) * RWA + o] = (bf16_t)f2bf(kd); B.rw[(8 + h2) * RWA + o] = (bf16_t)f2bf(bb);
                if (h2 == 0) {
                    B.rw[0 * RWA + o] = (bf16_t)f2bf(r); B.rw[1 * RWA + o] = (bf16_t)f2bf(v); B.rw[2 * RWA + o] = (bf16_t)f2bf(kk);
                    const float s = wave_sum(r * k * rkc); if (lane == 0) B.rw_s[(size_t)tl * 4 + head] = s;
                } else {
                    const float s = wave_sum(bf2f((bf16_t)f2bf(kd)) * bf2f((bf16_t)f2bf(r))); if (lane == 0) B.rw_s[(size_t)TG * 4 + (size_t)tl * 4 + head] = s;
                }
            }
        }
        asm volatile("" ::: "memory");
        float ga[16];
#pragma unroll
        for (int i = 0; i < 16; ++i) ga[i] = 0.f;
#pragma unroll 1
        for (int sub = 0; sub < 2; ++sub) {
            asm volatile("" ::: "memory");
            { const float* wsrc = P.in[13] + (size_t)(layer * 128 + sub * 64) * 256;
#pragma unroll
            for (int k = 0; k < 64; ++k) wcol[k] = wsrc[k * 256 + c]; }
#pragma unroll
            for (int tt = 0; tt < 16; ++tt) {
                const LAS f32x4* lg = (const LAS f32x4*)(lin + (h2 * 16 + tt) * 384 + 256 + sub * 64);
                float a = ga[tt];
#pragma unroll
                for (int k4 = 0; k4 < 16; ++k4) { const f32x4 x = lg[k4]; a += x[0] * wcol[k4 * 4] + x[1] * wcol[k4 * 4 + 1] + x[2] * wcol[k4 * 4 + 2] + x[3] * wcol[k4 * 4 + 3]; }
                ga[tt] = a;
            }
        }
#pragma unroll
        for (int tt = 0; tt < 16; ++tt) B.rw[3 * RWA + (size_t)(t0 + h2 * 16 + tt) * 256 + c] = (bf16_t)f2bf(ga[tt]);
    }
}

__device__ __forceinline__ f32x4 mfma16(bf16x8 a, bf16x8 b, f32x4 c) { return __builtin_amdgcn_mfma_f32_16x16x32_bf16(a, b, c, 0, 0, 0); }
__device__ __forceinline__ void prep_tile64(LAS unsigned char* lds, const Params& P, const MixBufs& B, const bf16_t* sw, int layer, int L, int tile) {
    const int tid = otid(), w = tid >> 6, lane = tid & 63, r = lane & 15, q = lane >> 4;
    const int t0 = tile * 64;
    constexpr int LL = 392, LA = 264;
    LAS bf16_t* lin = (LAS bf16_t*)lds;
    LAS bf16_t* gin = (LAS bf16_t*)(lds + 50176);
    LAS bf16_t* AS = (LAS bf16_t*)(lds + 55296);
    const bf16_t* p = B.p;
    const float* mu = P.in[8] + layer * 1152;
    __syncthreads();
#pragma unroll 3
    for (int i6 = 0; i6 < 6; ++i6) {
        const int it = tid + 512 * i6;
        const int t = it / 48, cg8 = it % 48, tl = t0 + t, pos = tl % L, col = PC_RLOW + cg8 * 8;
        float cur[8], prv[8], nxt[8], v[8];
        unpack8(*(const u32x4*)(p + (size_t)tl * DINP + col), cur);
        if (pos > 0) unpack8(*(const u32x4*)(p + (size_t)(tl - 1) * DINP + col), prv); else {
#pragma unroll
            for (int j = 0; j < 8; ++j) prv[j] = 0.f; }
        if (pos < L - 1) unpack8(*(const u32x4*)(p + (size_t)(tl + 1) * DINP + col), nxt); else {
#pragma unroll
            for (int j = 0; j < 8; ++j) nxt[j] = 0.f; }
        const f32x4 m0 = *(const f32x4*)(mu + col - PC_R), m1 = *(const f32x4*)(mu + col - PC_R + 4);
#pragma unroll
        for (int j = 0; j < 8; ++j) { const float m = j < 4 ? m0[j] : m1[j - 4]; v[j] = cur[j] + m * (0.5f * (prv[j] + nxt[j]) - cur[j]); }
        if (cg8 < 16) {
#pragma unroll
            for (int j = 0; j < 8; ++j) { const float e = __expf(2.f * v[j]); v[j] = 1.f - 2.f * __builtin_amdgcn_rcpf(e + 1.f); }
        } else if (cg8 >= 32) {
#pragma unroll
            for (int j = 0; j < 8; ++j) v[j] = sigm(v[j]);
        }
        u32x4 o; o.x = pk2(v[0], v[1]); o.y = pk2(v[2], v[3]); o.z = pk2(v[4], v[5]); o.w = pk2(v[6], v[7]);
        *(LAS u32x4*)(lin + t * LL + cg8 * 8) = o;
    }
    if (tid < 256) { const int t = tid >> 2, g4 = tid & 3; *(LAS u32x4*)(gin + t * 40 + g4 * 8) = *(const u32x4*)(p + (size_t)(t0 + t) * DINP + PC_GAF + g4 * 8); }
    __syncthreads();
#pragma unroll 1
    for (int d = 0; d < 2; ++d)
#pragma unroll 1
        for (int tt = 0; tt < 2; ++tt) {
            const int tn = 2 * w + tt, c = tn * 16 + r;
            const float a0c = P.in[11][(layer * 2 + d) * 256 + c];
            const bf16_t* wb = sw + 32768 + d * 16384 + (size_t)(tn * 16 + r) * 64 + q * 8;
            const bf16x8 b0 = *(const bf16x8*)wb, b1 = *(const bf16x8*)(wb + 32);
#pragma unroll
            for (int tm = 0; tm < 4; ++tm) {
                const LAS bf16_t* ap = lin + (tm * 16 + r) * LL + 128 + d * 64 + q * 8;
                f32x4 acc = (f32x4){0.f, 0.f, 0.f, 0.f};
                acc = mfma16(*(const LAS bf16x8*)ap, b0, acc); acc = mfma16(*(const LAS bf16x8*)(ap + 32), b1, acc);
#pragma unroll
                for (int jj = 0; jj < 4; ++jj) AS[(d * 64 + tm * 16 + q * 4 + jj) * LA + c] = (bf16_t)f2bf(sigm(a0c + acc[jj]));
            }
        }
    __syncthreads();
    {
        const int c0 = (tid & 31) * 8, head = (tid & 31) >> 3;
        float mr_[8], mk_[8], mv_[8], kkc[8], kac[8], rkc[8];
#define LD8F(dst, ptr) do { const f32x4 a_ = *(const f32x4*)(ptr), b_ = *(const f32x4*)((ptr) + 4); dst[0] = a_[0]; dst[1] = a_[1]; dst[2] = a_[2]; dst[3] = a_[3]; dst[4] = b_[0]; dst[5] = b_[1]; dst[6] = b_[2]; dst[7] = b_[3]; } while (0)
        LD8F(mr_, mu + c0); LD8F(mk_, mu + 256 + c0); LD8F(mv_, mu + 512 + c0);
        LD8F(kkc, P.in[14] + layer * 256 + c0); LD8F(kac, P.in[15] + layer * 256 + c0); LD8F(rkc, P.in[16] + layer * 256 + c0);
#undef LD8F
        u32x4 nx[9], cu[9];
        const u32x4 Z = (u32x4){0u, 0u, 0u, 0u};
#define EL_LOAD(dst, ii) do { const int t_ = (tid + 512 * (ii)) >> 5, tl_ = t0 + t_, pos_ = tl_ % L; const bf16_t* pc_ = p + (size_t)tl_ * DINP + c0; \
            const bool hp_ = pos_ > 0, hn_ = pos_ < L - 1; \
            dst[0] = *(const u32x4*)(pc_ + PC_R); dst[1] = *(const u32x4*)(pc_ + PC_RK); dst[2] = *(const u32x4*)(pc_ + PC_RV); \
            dst[3] = hp_ ? *(const u32x4*)(pc_ + PC_R - DINP) : Z; dst[4] = hp_ ? *(const u32x4*)(pc_ + PC_RK - DINP) : Z; dst[5] = hp_ ? *(const u32x4*)(pc_ + PC_RV - DINP) : Z; \
            dst[6] = hn_ ? *(const u32x4*)(pc_ + PC_R + DINP) : Z; dst[7] = hn_ ? *(const u32x4*)(pc_ + PC_RK + DINP) : Z; dst[8] = hn_ ? *(const u32x4*)(pc_ + PC_RV + DINP) : Z; } while (0)
        EL_LOAD(nx, 0);
#pragma unroll 1
        for (int i = 0; i < 4; ++i) {
#pragma unroll
            for (int e = 0; e < 9; ++e) cu[e] = nx[e];
            if (i < 3) EL_LOAD(nx, i + 1);
            const int t = (tid + 512 * i) >> 5, tl = t0 + t;
            float rr[8], kx[8], vx[8], c_[8], p_[8], n_[8];
            unpack8(cu[0], c_); unpack8(cu[3], p_); unpack8(cu[6], n_);
#pragma unroll
            for (int j = 0; j < 8; ++j) rr[j] = c_[j] + mr_[j] * (0.5f * (p_[j] + n_[j]) - c_[j]);
            unpack8(cu[1], c_); unpack8(cu[4], p_); unpack8(cu[7], n_);
#pragma unroll
            for (int j = 0; j < 8; ++j) kx[j] = c_[j] + mk_[j] * (0.5f * (p_[j] + n_[j]) - c_[j]);
            unpack8(cu[2], c_); unpack8(cu[5], p_); unpack8(cu[8], n_);
#pragma unroll
            for (int j = 0; j < 8; ++j) vx[j] = c_[j] + mv_[j] * (0.5f * (p_[j] + n_[j]) - c_[j]);
            float as0[8], as1[8];
            unpack8(*(const LAS u32x4*)(AS + (0 * 64 + t) * LA + c0), as0); unpack8(*(const LAS u32x4*)(AS + (1 * 64 + t) * LA + c0), as1);
            float kr[8], ss = 0.f, srk = 0.f;
#pragma unroll
            for (int j = 0; j < 8; ++j) { kr[j] = kx[j] * kkc[j]; ss += kr[j] * kr[j]; srk += rr[j] * kx[j] * rkc[j]; }
            ss += __shfl_xor(ss, 1); ss += __shfl_xor(ss, 2); ss += __shfl_xor(ss, 4);
            const float inv = rsqrtf(ss + 1e-12f);
            float kkv[8], kd0[8], kd1[8], b0v[8], b1v[8], skr = 0.f;
#pragma unroll
            for (int j = 0; j < 8; ++j) {
                kkv[j] = kr[j] * inv; kd0[j] = kx[j] * (1.f + (as0[j] - 1.f) * kac[j]); kd1[j] = kx[j] * (1.f + (as1[j] - 1.f) * kac[j]);
                b0v[j] = kkv[j] * as0[j]; b1v[j] = kkv[j] * as1[j];
                skr += bf2f((bf16_t)f2bf(kd1[j])) * bf2f((bf16_t)f2bf(rr[j])); }
            srk += __shfl_xor(srk, 1); srk += __shfl_xor(srk, 2); srk += __shfl_xor(srk, 4);
            skr += __shfl_xor(skr, 1); skr += __shfl_xor(skr, 2); skr += __shfl_xor(skr, 4);
            const size_t o = (size_t)tl * 256 + c0;
#define ST8(arr, f) do { u32x4 o4; o4.x = pk2(f[0], f[1]); o4.y = pk2(f[2], f[3]); o4.z = pk2(f[4], f[5]); o4.w = pk2(f[6], f[7]); *(u32x4*)(B.rw + (size_t)(arr) * RWA + o) = o4; } while (0)
            ST8(0, rr); ST8(1, vx); ST8(2, kkv); ST8(6, kd0); ST8(7, kd1); ST8(8, b0v); ST8(9, b1v);
#undef ST8
            if ((lane & 7) == 0) { B.rw_s[(size_t)tl * 4 + head] = srk; B.rw_s[(size_t)TG * 4 + (size_t)tl * 4 + head] = skr; }
        }
#undef EL_LOAD
    }
#pragma unroll 1
    for (int d = 0; d < 2; ++d)
#pragma unroll 1
        for (int tt = 0; tt < 2; ++tt) {
            const int tn = 2 * w + tt, c = tn * 16 + r;
            const float w0c = P.in[9][(layer * 2 + d) * 256 + c];
            const bf16_t* wb = sw + d * 16384 + (size_t)(tn * 16 + r) * 64 + q * 8;
            const bf16x8 b0 = *(const bf16x8*)wb, b1 = *(const bf16x8*)(wb + 32);
#pragma unroll
            for (int tm = 0; tm < 4; ++tm) {
                const LAS bf16_t* ap = lin + (tm * 16 + r) * LL + d * 64 + q * 8;
                f32x4 acc = (f32x4){0.f, 0.f, 0.f, 0.f};
                acc = mfma16(*(const LAS bf16x8*)ap, b0, acc); acc = mfma16(*(const LAS bf16x8*)(ap + 32), b1, acc);
#pragma unroll
                for (int jj = 0; jj < 4; ++jj) B.rw[(size_t)(4 + d) * RWA + (size_t)(t0 + tm * 16 + q * 4 + jj) * 256 + c] = (bf16_t)f2bf(sigm(w0c + acc[jj]) * 0.60653066f);
            }
        }
#pragma unroll 1
    for (int tt = 0; tt < 2; ++tt) {
        const int tn = 2 * w + tt, c = tn * 16 + r;
        const bf16_t* wb = sw + 65536 + (size_t)(tn * 16 + r) * 128 + q * 8;
        const bf16x8 b0 = *(const bf16x8*)wb, b1 = *(const bf16x8*)(wb + 32), b2 = *(const bf16x8*)(wb + 64), b3 = *(const bf16x8*)(wb + 96);
#pragma unroll
        for (int tm = 0; tm < 4; ++tm) {
            const LAS bf16_t* ap = lin + (tm * 16 + r) * LL + 256 + q * 8;
            f32x4 acc = (f32x4){0.f, 0.f, 0.f, 0.f};
            acc = mfma16(*(const LAS bf16x8*)ap, b0, acc); acc = mfma16(*(const LAS bf16x8*)(ap + 32), b1, acc);
            acc = mfma16(*(const LAS bf16x8*)(ap + 64), b2, acc); acc = mfma16(*(const LAS bf16x8*)(ap + 96), b3, acc);
#pragma unroll
            for (int jj = 0; jj < 4; ++jj) B.rw[(size_t)3 * RWA + (size_t)(t0 + tm * 16 + q * 4 + jj) * 256 + c] = (bf16_t)f2bf(acc[jj]);
        }
    }
#pragma unroll 1
    for (int d = 0; d < 2; ++d) {
        const int c = w * 16 + r;
        const float bias = P.in[6][(layer * 2 + d) * 128 + c];
        const bf16x8 b0 = *(const bf16x8*)(sw + 98304 + d * 4096 + (size_t)(w * 16 + r) * 32 + q * 8);
#pragma unroll
        for (int tm = 0; tm < 4; ++tm) {
            f32x4 acc = (f32x4){0.f, 0.f, 0.f, 0.f};
            acc = mfma16(*(const LAS bf16x8*)(gin + (tm * 16 + r) * 40 + q * 8), b0, acc);
#pragma unroll
            for (int jj = 0; jj < 4; ++jj) B.gla_la[((size_t)d * TG + t0 + tm * 16 + q * 4 + jj) * 128 + c] = -softplus(-(acc[jj] + bias)) * (1.0f / 16.0f);
        }
    }
    {
        const int c0 = (tid & 127) * 8;
        float wt[5][8], bs[8];
        { const f32x4 b0 = *(const f32x4*)(P.in[20] + layer * 1024 + c0), b1 = *(const f32x4*)(P.in[20] + layer * 1024 + c0 + 4);
          bs[0] = b0[0]; bs[1] = b0[1]; bs[2] = b0[2]; bs[3] = b0[3]; bs[4] = b1[0]; bs[5] = b1[1]; bs[6] = b1[2]; bs[7] = b1[3]; }
#pragma unroll
        for (int tap = 0; tap < 5; ++tap) { const float* wp = P.in[19] + (size_t)(layer * 5 + tap) * 1024 + c0;
            const f32x4 w0 = *(const f32x4*)wp, w1 = *(const f32x4*)(wp + 4);
            wt[tap][0] = w0[0]; wt[tap][1] = w0[1]; wt[tap][2] = w0[2]; wt[tap][3] = w0[3]; wt[tap][4] = w1[0]; wt[tap][5] = w1[1]; wt[tap][6] = w1[2]; wt[tap][7] = w1[3]; }
        u32x4 xr[5], xn[5];
#define CONV_LOAD(dst, ii) do { const int t_ = (tid + 512 * (ii)) >> 7, tl_ = t0 + t_, pos_ = tl_ % L; \
            _Pragma("unroll") for (int tap = 0; tap < 5; ++tap) { const int pp = pos_ + tap - 2; \
                dst[tap] = (pp >= 0 && pp < L) ? *(const u32x4*)(p + (size_t)(tl_ + tap - 2) * DINP + PC_XBC + c0) : (u32x4){0u, 0u, 0u, 0u}; } } while (0)
        CONV_LOAD(xn, 0);
#pragma unroll 1
        for (int i = 0; i < 16; ++i) {
#pragma unroll
            for (int tap = 0; tap < 5; ++tap) xr[tap] = xn[tap];
            if (i < 15) CONV_LOAD(xn, i + 1);
            float acc[8];
#pragma unroll
            for (int j = 0; j < 8; ++j) acc[j] = bs[j];
#pragma unroll
            for (int tap = 0; tap < 5; ++tap) { float x[8]; unpack8(xr[tap], x);
#pragma unroll
                for (int j = 0; j < 8; ++j) acc[j] += wt[tap][j] * x[j]; }
            const int tl = t0 + ((tid + 512 * i) >> 7);
            u32x4 o; o.x = pk2(silu(acc[0]), silu(acc[1])); o.y = pk2(silu(acc[2]), silu(acc[3])); o.z = pk2(silu(acc[4]), silu(acc[5])); o.w = pk2(silu(acc[6]), silu(acc[7]));
            *(u32x4*)(B.ssd_x + (size_t)tl * 1024 + c0) = o;
        }
#undef CONV_LOAD
    }
#pragma unroll
    for (int i = 0; i < 2; ++i) { const int idx = tid + 512 * i, t = idx >> 4, j = idx & 15, tl = t0 + t;
        B.ssd_dt[(size_t)tl * 16 + j] = softplus(bf2f(p[(size_t)tl * DINP + PC_DT + j]) + P.in[21][layer * 16 + j]); }
}

__device__ __forceinline__ f32x4 mma_nt(f32x4 acc, const LAS bf16_t* A, int lda, const LAS bf16_t* Bt, int ldb, int K, int lane) {
    const int r = lane & 15, q = lane >> 4;
    for (int k = 0; k < K; k += 32) {
        const bf16x8 a = *(const LAS bf16x8*)(A + r * lda + k + q * 8);
        const bf16x8 b = *(const LAS bf16x8*)(Bt + r * ldb + k + q * 8);
        acc = __builtin_amdgcn_mfma_f32_16x16x32_bf16(a, b, acc, 0, 0, 0);
    }
    return acc;
}
__device__ __forceinline__ f32x4 mma_nt_x(f32x4 acc, const LAS bf16_t* A, int lda, const LAS bf16_t* Bt, int ldb, int K, int lane, int xa, int xb) {
    const int r = lane & 15, q = lane >> 4;
    for (int k = 0; k < K; k += 32) {
        const bf16x8 a = *(const LAS bf16x8*)(A + r * lda + ((((k >> 3) + q) ^ xa) << 3));
        const bf16x8 b = *(const LAS bf16x8*)(Bt + r * ldb + ((((k >> 3) + q) ^ xb) << 3));
        acc = __builtin_amdgcn_mfma_f32_16x16x32_bf16(a, b, acc, 0, 0, 0);
    }
    return acc;
}
__device__ __forceinline__ f32x4 mma_tn_x(f32x4 acc, const LAS bf16_t* A, int lda, const LAS bf16_t* Bt, int ldb, int K, int lane, int xa, int xb) {
    const int r = lane & 15, q = lane >> 4;
    for (int k = 0; k < K; k += 32) {
        const bf16x8 a = *(const LAS bf16x8*)(A + r * lda + ((((k >> 3) + q) ^ xa) << 3));
        const bf16x8 b = *(const LAS bf16x8*)(Bt + r * ldb + ((((k >> 3) + q) ^ xb) << 3));
        acc = __builtin_amdgcn_mfma_f32_16x16x32_bf16(b, a, acc, 0, 0, 0);
    }
    return acc;
}
template <int DK> struct CL {
    static constexpr int LQ = DK + 8, LT = 72;
    static constexpr int QA = 0, KA = QA + 64 * LQ * 2, KBT = KA + 64 * LQ * 2, VT = KBT + DK * LT * 2, SC = VT + 64 * LT * 2, STT = SC + 64 * LT * 2;
    static constexpr int FA = STT + 64 * LQ * 2;
};

__device__ __forceinline__ void ssd_unit(LAS unsigned char* lds, const Params& P, const MixBufs& B, float* segst, int layer, int L, int seq, int h, int d, int seg, bool state_only) {
    typedef CL<128> C;
    const int tid = otid(), w = tid >> 6, lane = tid & 63, r = lane & 15, q = lane >> 4;
    LAS bf16_t* Qa = (LAS bf16_t*)(lds + C::QA); LAS bf16_t* Ka = (LAS bf16_t*)(lds + C::KA); LAS bf16_t* KbT = (LAS bf16_t*)(lds + C::KBT);
    LAS bf16_t* VT = (LAS bf16_t*)(lds + C::VT); LAS bf16_t* Sc = (LAS bf16_t*)(lds + C::SC); LAS bf16_t* StT = (LAS bf16_t*)(lds + C::STT);
    LAS float* acum = (LAS float*)(lds + C::FA); LAS float* dtl = acum + 64;
    const int grp = h >> 2;
    const float Aneg = -__expf(P.in[22][layer * 16 + d * 8 + h]);
    const int base = seq * L, cbeg = seg * 32, cend = cbeg + 32;
    __syncthreads();
    f32x4 st[4];
#pragma unroll
    for (int i = 0; i < 4; ++i) st[i] = (f32x4){0.f, 0.f, 0.f, 0.f};
    const int kidx = h * 2 + d;
    if (!state_only) {
        for (int ps = 0; ps < seg; ++ps) {
            const float* sp = segst + (size_t)((seq * 8 + ps) * 24 + kidx) * 8256;
            const float dcy = __expf(sp[8192]);
#pragma unroll
            for (int tv = 0; tv < 4; ++tv)
#pragma unroll
                for (int jj = 0; jj < 4; ++jj) st[tv][jj] = st[tv][jj] * dcy + sp[(tv * 4 + jj) * 512 + tid];
        }
#pragma unroll
        for (int tv = 0; tv < 4; ++tv) {
            u32x2 o; o.x = pk2(st[tv][0], st[tv][1]); o.y = pk2(st[tv][2], st[tv][3]);
            *(LAS u32x2*)(StT + (tv * 16 + r) * C::LQ + w * 16 + q * 4) = o;
        }
    }
    float asum = 0.f;
    const int row = tid >> 3, part = tid & 7;
    const int tm = w >> 1, tn0 = (w & 1) * 2;
    bf16_t* yout = B.ssd_y + (size_t)d * TG * 512;
    u32x4 c0, c1, b0, b1, x0; float dtv;
#define SSD_LOAD(cc) do { const int n0_ = (cc) * 64; \
        const int tok = d == 0 ? base + n0_ + row : base + L - 1 - (n0_ + row); \
        const bf16_t* xr = B.ssd_x + (size_t)tok * 1024; \
        c0 = *(const u32x4*)(xr + 768 + grp * 128 + part * 16); c1 = *(const u32x4*)(xr + 768 + grp * 128 + part * 16 + 8); \
        b0 = *(const u32x4*)(xr + 512 + grp * 128 + part * 16); b1 = *(const u32x4*)(xr + 512 + grp * 128 + part * 16 + 8); \
        x0 = *(const u32x4*)(xr + h * 64 + part * 8); \
        const int tl_ = d == 0 ? base + n0_ + lane : base + L - 1 - (n0_ + lane); \
        dtv = B.ssd_dt[(size_t)tl_ * 16 + d * 8 + h]; } while (0)
    SSD_LOAD(cbeg);
    for (int c = cbeg; c < cend; ++c) {
        const int n0 = c * 64;
        const float ac = wave_incl_scan(dtv * Aneg, lane);
        const float alast = lane_bcast(ac, 63);
        asum += alast;
        if (w == 0) { acum[lane] = ac; dtl[lane] = dtv; }
        {
            const float ks = __shfl(dtv, row) * __expf(alast - __shfl(ac, row));
            *(LAS u32x4*)(Qa + row * C::LQ + part * 16) = c0; *(LAS u32x4*)(Qa + row * C::LQ + part * 16 + 8) = c1;
            *(LAS u32x4*)(Ka + row * C::LQ + part * 16) = b0; *(LAS u32x4*)(Ka + row * C::LQ + part * 16 + 8) = b1;
            float bf[16]; unpack8(b0, bf); unpack8(b1, bf + 8);
            const int rsw = row ^ (part << 3);
#pragma unroll
            for (int j = 0; j < 16; ++j) KbT[(part * 16 + j) * C::LT + rsw] = (bf16_t)f2bf(bf[j] * ks);
            const unsigned xs[4] = {x0.x, x0.y, x0.z, x0.w};
#pragma unroll
            for (int j = 0; j < 4; ++j) { VT[(part * 8 + 2 * j) * C::LT + rsw] = (bf16_t)(xs[j] & 0xffffu); VT[(part * 8 + 2 * j + 1) * C::LT + rsw] = (bf16_t)(xs[j] >> 16); }
        }
        if (c + 1 < cend) SSD_LOAD(c + 1);
        lds_barrier();
        if (!state_only) {
#pragma unroll
        for (int tt = 0; tt < 2; ++tt) {
            const int tn = tn0 + tt;
            f32x4 s = (f32x4){0.f, 0.f, 0.f, 0.f};
            s = mma_tn_x(s, Qa + tm * 16 * C::LQ, C::LQ, Ka + tn * 16 * C::LQ, C::LQ, 128, lane, 0, 0);
            const int i = tm * 16 + r, j0 = tn * 16 + q * 4;
            const float ai = acum[i];
            const f32x4 aj = *(const LAS f32x4*)(acum + j0), dj = *(const LAS f32x4*)(dtl + j0);
            float v[4];
#pragma unroll
            for (int jj = 0; jj < 4; ++jj) {
                const int j = j0 + jj;
                const bool on = d == 0 ? (i >= j) : (i > j);
                v[jj] = on ? s[jj] * __expf(ai - aj[jj]) * dj[jj] : 0.f;
            }
            u32x2 o; o.x = pk2(v[0], v[1]); o.y = pk2(v[2], v[3]);
            *(LAS u32x2*)(Sc + i * C::LT + j0) = o;
        }
        lds_barrier();
#pragma unroll
        for (int tt = 0; tt < 2; ++tt) {
            const int tn = tn0 + tt;
            f32x4 o1 = (f32x4){0.f, 0.f, 0.f, 0.f}, o2 = (f32x4){0.f, 0.f, 0.f, 0.f};
            o1 = mma_tn_x(o1, Sc + tm * 16 * C::LT, C::LT, VT + tn * 16 * C::LT, C::LT, 64, lane, 0, (tn * 2 + (r >> 3)) & 7);
            o2 = mma_tn_x(o2, Qa + tm * 16 * C::LQ, C::LQ, StT + tn * 16 * C::LQ, C::LQ, 128, lane, 0, 0);
            const int i = tm * 16 + r;
            const int tl = d == 0 ? base + n0 + i : base + L - 1 - (n0 + i);
            const float ei = __expf(acum[i]);
            { const f32x4 ov = o1 + o2 * ei; u32x2 o; o.x = pk2(ov[0], ov[1]); o.y = pk2(ov[2], ov[3]); *(u32x2*)(yout + (size_t)tl * 512 + h * 64 + tn * 16 + q * 4) = o; }
        }
        }
        {
            const float ds = __expf(alast);
#pragma unroll
            for (int tv = 0; tv < 4; ++tv) {
                st[tv] = st[tv] * ds;
                st[tv] = mma_nt_x(st[tv], KbT + w * 16 * C::LT, C::LT, VT + tv * 16 * C::LT, C::LT, 64, lane, w, (tv * 2 + (r >> 3)) & 7);
            }
        }
        lds_barrier();
        if (!state_only) {
#pragma unroll
        for (int tv = 0; tv < 4; ++tv) {
            u32x2 o; o.x = pk2(st[tv][0], st[tv][1]); o.y = pk2(st[tv][2], st[tv][3]);
            *(LAS u32x2*)(StT + (tv * 16 + r) * C::LQ + w * 16 + q * 4) = o;
        }
        }
    }
    if (state_only) {
        float* sp = segst + (size_t)((seq * 8 + seg) * 24 + kidx) * 8256;
#pragma unroll
        for (int tv = 0; tv < 4; ++tv)
#pragma unroll
            for (int jj = 0; jj < 4; ++jj) sp[(tv * 4 + jj) * 512 + tid] = st[tv][jj];
        if (tid == 0) sp[8192] = asum;
    }
#undef SSD_LOAD
}

__device__ __forceinline__ void gla_unit(LAS unsigned char* lds, const Params& P, const MixBufs& B, float* segst, int layer, int L, int seq, int h, int d, int seg, bool state_only) {
    typedef CL<32> C;
    const int tid = otid(), w = tid >> 6, lane = tid & 63, r = lane & 15, q = lane >> 4;
    LAS bf16_t* Qa = (LAS bf16_t*)(lds + C::QA); LAS bf16_t* Ka = (LAS bf16_t*)(lds + C::KA); LAS bf16_t* KbT = (LAS bf16_t*)(lds + C::KBT);
    LAS bf16_t* VT = (LAS bf16_t*)(lds + C::VT); LAS bf16_t* Sc = (LAS bf16_t*)(lds + C::SC); LAS bf16_t* StT = (LAS bf16_t*)(lds + C::STT);
    LAS float* dstate = (LAS float*)(lds + C::FA);
    const int base = seq * L, cbeg = seg * 32, cend = cbeg + 32;
    __syncthreads();
    f32x4 st = (f32x4){0.f, 0.f, 0.f, 0.f};
    const int row = tid >> 3, part = tid & 7;
    const int tm = w >> 1, tn0 = (w & 1) * 2;
    const int tk = w >> 2, tv = w & 3;
    const int kidx = 16 + h * 2 + d;
    if (!state_only) {
        for (int ps = 0; ps < seg; ++ps) {
            const float* sp = segst + (size_t)((seq * 8 + ps) * 24 + kidx) * 8256;
#pragma unroll
            for (int jj = 0; jj < 4; ++jj) st[jj] = st[jj] * __expf(sp[8192 + tk * 16 + q * 4 + jj]) + sp[jj * 512 + tid];
        }
        { u32x2 o; o.x = pk2(st[0], st[1]); o.y = pk2(st[2], st[3]); *(LAS u32x2*)(StT + (tv * 16 + r) * C::LQ + tk * 16 + q * 4) = o; }
    }
    float blsum[4] = {0.f, 0.f, 0.f, 0.f};
    const float* la = B.gla_la + (size_t)d * TG * 128;
    bf16_t* oout = B.gla_o + (size_t)d * TG * 256;
    const float qscale = 0.17677669529663687f;
    f32x4 lv; u32x2 qr, kr; u32x4 x0;
#define GLA_LOAD(cc) do { const int n0_ = (cc) * 64; \
        const int tl_ = d == 0 ? base + n0_ + lane : base + L - 1 - (n0_ + lane); \
        lv = *(const f32x4*)(la + (size_t)tl_ * 128 + h * 32 + 4 * w); \
        qr = *(const u32x2*)(B.p + (size_t)tl_ * DINP + PC_GQ + h * 32 + 4 * w); \
        kr = *(const u32x2*)(B.p + (size_t)tl_ * DINP + PC_GK + h * 32 + 4 * w); \
        const int tr_ = d == 0 ? base + n0_ + row : base + L - 1 - (n0_ + row); \
        x0 = *(const u32x4*)(B.p + (size_t)tr_ * DINP + PC_GV + h * 64 + part * 8); } while (0)
    GLA_LOAD(cbeg);
    for (int c = cbeg; c < cend; ++c) {
        const int n0 = c * 64;
        {
            const float qf[4] = {__uint_as_float(qr.x << 16), __uint_as_float(qr.x & 0xffff0000u), __uint_as_float(qr.y << 16), __uint_as_float(qr.y & 0xffff0000u)};
            const float kf[4] = {__uint_as_float(kr.x << 16), __uint_as_float(kr.x & 0xffff0000u), __uint_as_float(kr.y << 16), __uint_as_float(kr.y & 0xffff0000u)};
            float qd[4], kd[4];
#pragma unroll
            for (int kk = 0; kk < 4; ++kk) {
                const float b = wave_incl_scan(lv[kk], lane);
                const float bl = lane_bcast(b, 63);
                blsum[kk] += bl;
                qd[kk] = qf[kk] * qscale * __expf(b); kd[kk] = kf[kk] * __expf(-b);
                KbT[(4 * w + kk) * C::LT + lane] = (bf16_t)f2bf(kf[kk] * __expf(bl - b));
                if (lane == 63) dstate[4 * w + kk] = __expf(bl);
            }
            u32x2 o; o.x = pk2(qd[0], qd[1]); o.y = pk2(qd[2], qd[3]); *(LAS u32x2*)(Qa + lane * C::LQ + 4 * w) = o;
            o.x = pk2(kd[0], kd[1]); o.y = pk2(kd[2], kd[3]); *(LAS u32x2*)(Ka + lane * C::LQ + 4 * w) = o;
            const unsigned xs[4] = {x0.x, x0.y, x0.z, x0.w};
            const int rsw = row ^ (part << 3);
#pragma unroll
            for (int j = 0; j < 4; ++j) { VT[(part * 8 + 2 * j) * C::LT + rsw] = (bf16_t)(xs[j] & 0xffffu); VT[(part * 8 + 2 * j + 1) * C::LT + rsw] = (bf16_t)(xs[j] >> 16); }
        }
        if (c + 1 < cend) GLA_LOAD(c + 1);
        lds_barrier();
        if (!state_only) {
#pragma unroll
        for (int tt = 0; tt < 2; ++tt) {
            const int tn = tn0 + tt;
            f32x4 s = (f32x4){0.f, 0.f, 0.f, 0.f};
            s = mma_tn_x(s, Qa + tm * 16 * C::LQ, C::LQ, Ka + tn * 16 * C::LQ, C::LQ, 32, lane, 0, 0);
            const int i = tm * 16 + r, j0 = tn * 16 + q * 4;
            float v[4];
#pragma unroll
            for (int jj = 0; jj < 4; ++jj) { const int j = j0 + jj; const bool on = d == 0 ? (i >= j) : (i > j); v[jj] = on ? s[jj] : 0.f; }
            u32x2 o; o.x = pk2(v[0], v[1]); o.y = pk2(v[2], v[3]);
            *(LAS u32x2*)(Sc + i * C::LT + j0) = o;
        }
        lds_barrier();
#pragma unroll
        for (int tt = 0; tt < 2; ++tt) {
            const int tn = tn0 + tt;
            f32x4 o1 = (f32x4){0.f, 0.f, 0.f, 0.f};
            o1 = mma_tn_x(o1, Sc + tm * 16 * C::LT, C::LT, VT + tn * 16 * C::LT, C::LT, 64, lane, 0, (tn * 2 + (r >> 3)) & 7);
            o1 = mma_tn_x(o1, Qa + tm * 16 * C::LQ, C::LQ, StT + tn * 16 * C::LQ, C::LQ, 32, lane, 0, 0);
            const int i = tm * 16 + r;
            const int tl = d == 0 ? base + n0 + i : base + L - 1 - (n0 + i);
            { u32x2 o; o.x = pk2(o1[0], o1[1]); o.y = pk2(o1[2], o1[3]); *(u32x2*)(oout + (size_t)tl * 256 + h * 64 + tn * 16 + q * 4) = o; }
        }
        }
        {
#pragma unroll
            for (int jj = 0; jj < 4; ++jj) st[jj] *= dstate[tk * 16 + q * 4 + jj];
            st = mma_nt_x(st, KbT + tk * 16 * C::LT, C::LT, VT + tv * 16 * C::LT, C::LT, 64, lane, 0, (tv * 2 + (r >> 3)) & 7);
        }
        lds_barrier();
        if (!state_only) { u32x2 o; o.x = pk2(st[0], st[1]); o.y = pk2(st[2], st[3]); *(LAS u32x2*)(StT + (tv * 16 + r) * C::LQ + tk * 16 + q * 4) = o; }
    }
    if (state_only) {
        float* sp = segst + (size_t)((seq * 8 + seg) * 24 + kidx) * 8256;
#pragma unroll
        for (int jj = 0; jj < 4; ++jj) sp[jj * 512 + tid] = st[jj];
        if (lane == 0) {
#pragma unroll
            for (int kk = 0; kk < 4; ++kk) sp[8192 + 4 * w + kk] = blsum[kk];
        }
    }
#undef GLA_LOAD
}

constexpr int RL = 72;
struct RwRaw { u32x4 e, kk, bb, kd, rr, v; };
__device__ __forceinline__ void rwkv_pre_load(RwRaw& R, const MixBufs& B, int L, int u, int tid) {
    const int w = tid >> 6, lane = tid & 63, nch = L / 64, hd = u & 7, ch = u >> 3, h = hd >> 1, d = hd & 1;
    const int base = (ch / nch) * L, n0 = (ch % nch) * 64;
    const int tl = d == 0 ? base + n0 + lane : base + L - 1 - (n0 + lane);
    const size_t o = (size_t)tl * 256 + h * 64 + 8 * w;
    R.e = *(const u32x4*)(B.rw + (4 + d) * RWA + o); R.kk = *(const u32x4*)(B.rw + 2 * RWA + o);
    R.bb = *(const u32x4*)(B.rw + (8 + d) * RWA + o); R.kd = *(const u32x4*)(B.rw + (6 + d) * RWA + o);
    R.rr = *(const u32x4*)(B.rw + 0 * RWA + o);
    const int row = tid >> 3, part = tid & 7;
    const int tr = d == 0 ? base + n0 + row : base + L - 1 - (n0 + row);
    R.v = *(const u32x4*)(B.rw + 1 * RWA + (size_t)tr * 256 + h * 64 + part * 8);
}
__device__ __forceinline__ void rwkv_pre(LAS unsigned char* lds, const MixBufs& B, bf16_t* rq, int L, int u, int unext, RwRaw& R) {
    const int tid = otid(), w = tid >> 6, lane = tid & 63, r = lane & 15, q = lane >> 4;
#define RG(i) ((LAS bf16_t*)(lds + (i) * 9216))
    LAS bf16_t* At = RG(0); LAS bf16_t* Bt_ = RG(1); LAS bf16_t* Kt = RG(2); LAS bf16_t* Rt = RG(3); LAS bf16_t* AtT = RG(4); LAS bf16_t* BhT = RG(5);
    LAS bf16_t* KhT = RG(6); LAS bf16_t* VT = RG(7); LAS bf16_t* Lak = RG(8); LAS bf16_t* Mrb = RG(9); LAS bf16_t* Mrk = RG(10); LAS bf16_t* WT = RG(11);
    LAS bf16_t* Tm = RG(0); LAS bf16_t* XT = RG(1); LAS bf16_t* UT = RG(2);
#undef RG
    LAS float* Lf = (LAS float*)(lds + 12 * 9216);
    LAS float* gC = (LAS float*)(lds + 12 * 9216 + 17408);
    LAS bf16_t* L21b = (LAS bf16_t*)(lds + 12 * 9216 + 17408 + 512);
    LAS bf16_t* T11T = WT;
    LAS bf16_t* X1T = WT + 32 * 40;
    const int nch = L / 64, hd = u & 7, ch = u >> 3, h = hd >> 1, d = hd & 1, seq = ch / nch, c = ch % nch;
    const int base = seq * L, n0 = c * 64;
    const int cu = (((seq * nch + c) * 4 + h) * 2 + d);
    bf16_t* gq = rq + (size_t)cu * 3 * 4096;
    lds_barrier();
    {
        float e[8], kk[8], bb[8], kd[8], rr[8];
        unpack8(R.e, e); unpack8(R.kk, kk); unpack8(R.bb, bb); unpack8(R.kd, kd); unpack8(R.rr, rr);
        float at[8], bt[8], kt[8], rt[8];
#pragma unroll
        for (int j = 0; j < 8; ++j) {
            const float cum = wave_incl_scan(e[j], lane);
            const float cmid = lane_bcast(cum, 31), clast = lane_bcast(cum, 63);
            const float ea = __expf(-(cum - e[j] - cmid)), eb = __expf(cum - cmid), er = __expf(-(cum - cmid)), eh = __expf(-(clast - cum));
            at[j] = -kk[j] * ea; bt[j] = bb[j] * eb; kt[j] = kd[j] * eb; rt[j] = rr[j] * er;
            AtT[(8 * w + j) * RL + lane] = (bf16_t)f2bf(at[j]);
            BhT[(8 * w + j) * RL + lane] = (bf16_t)f2bf(bb[j] * eh);
            KhT[(8 * w + j) * RL + lane] = (bf16_t)f2bf(kd[j] * eh);
            if (lane == 63) { gC[8 * w + j] = __expf(-clast); gC[64 + 8 * w + j] = __expf(-cmid); }
        }
        u32x4 o4;
        o4.x = pk2(at[0], at[1]); o4.y = pk2(at[2], at[3]); o4.z = pk2(at[4], at[5]); o4.w = pk2(at[6], at[7]); *(LAS u32x4*)(At + lane * RL + 8 * w) = o4;
        o4.x = pk2(bt[0], bt[1]); o4.y = pk2(bt[2], bt[3]); o4.z = pk2(bt[4], bt[5]); o4.w = pk2(bt[6], bt[7]); *(LAS u32x4*)(Bt_ + lane * RL + 8 * w) = o4;
        o4.x = pk2(kt[0], kt[1]); o4.y = pk2(kt[2], kt[3]); o4.z = pk2(kt[4], kt[5]); o4.w = pk2(kt[6], kt[7]); *(LAS u32x4*)(Kt + lane * RL + 8 * w) = o4;
        o4.x = pk2(rt[0], rt[1]); o4.y = pk2(rt[2], rt[3]); o4.z = pk2(rt[4], rt[5]); o4.w = pk2(rt[6], rt[7]); *(LAS u32x4*)(Rt + lane * RL + 8 * w) = o4;
        const int row = tid >> 3, part = tid & 7;
        const unsigned xs[4] = {R.v.x, R.v.y, R.v.z, R.v.w};
#pragma unroll
        for (int j = 0; j < 4; ++j) { VT[(part * 8 + 2 * j) * RL + row] = (bf16_t)(xs[j] & 0xffffu); VT[(part * 8 + 2 * j + 1) * RL + row] = (bf16_t)(xs[j] >> 16); }
    }
    if (unext >= 0) rwkv_pre_load(R, B, L, unext, tid);
    lds_barrier();
    const int tm = w >> 1, tn0 = (w & 1) * 2;
    const f32x4 Z4 = (f32x4){0.f, 0.f, 0.f, 0.f};
#pragma unroll
    for (int tt = 0; tt < 2; ++tt) {
        const int tn = tn0 + tt;
        const f32x4 lab = mma_tn_x(Z4, At + tm * 16 * RL, RL, Bt_ + tn * 16 * RL, RL, 64, lane, 0, 0);
        const f32x4 lak = mma_tn_x(Z4, At + tm * 16 * RL, RL, Kt + tn * 16 * RL, RL, 64, lane, 0, 0);
        const f32x4 mrb = mma_tn_x(Z4, Rt + tm * 16 * RL, RL, Bt_ + tn * 16 * RL, RL, 64, lane, 0, 0);
        const f32x4 mrk = mma_tn_x(Z4, Rt + tm * 16 * RL, RL, Kt + tn * 16 * RL, RL, 64, lane, 0, 0);
        const int i = tm * 16 + r, j0 = tn * 16 + q * 4;
        f32x4 lf; float vk[4], vb[4], vm[4];
#pragma unroll
        for (int jj = 0; jj < 4; ++jj) {
            const int j = j0 + jj; const bool st_ = j < i, in_ = j <= i;
            lf[jj] = st_ ? lab[jj] : 0.f; vk[jj] = st_ ? lak[jj] : 0.f; vb[jj] = in_ ? mrb[jj] : 0.f; vm[jj] = in_ ? mrk[jj] : 0.f;
        }
        *(LAS f32x4*)(Lf + i * 68 + j0) = lf;
        u32x2 o;
        if (tm >= 2 && tn < 2) { o.x = pk2(lab[0], lab[1]); o.y = pk2(lab[2], lab[3]); *(LAS u32x2*)(L21b + (i - 32) * 40 + j0) = o; }
        o.x = pk2(vk[0], vk[1]); o.y = pk2(vk[2], vk[3]); *(LAS u32x2*)(Lak + i * RL + j0) = o;
        o.x = pk2(vb[0], vb[1]); o.y = pk2(vb[2], vb[3]); *(LAS u32x2*)(Mrb + i * RL + j0) = o;
        o.x = pk2(vm[0], vm[1]); o.y = pk2(vm[2], vm[3]); *(LAS u32x2*)(Mrk + i * RL + j0) = o;
    }
    lds_barrier();
#pragma unroll
    for (int tt = 0; tt < 2; ++tt) {
        const int tn = tn0 + tt;
        const f32x4 x = mma_nt(Z4, Lak + tm * 16 * RL, RL, VT + tn * 16 * RL, RL, 64, lane);
        u32x2 o; o.x = pk2(x[0], x[1]); o.y = pk2(x[2], x[3]);
        *(LAS u32x2*)(XT + (tn * 16 + r) * RL + tm * 16 + q * 4) = o;
    }
    if (w < 2) {
        const int ob = w * 32, j = lane & 31;
        float T[32];
        int zv = 0; asm volatile("" : "+v"(zv));
        const LAS float* Lfz = Lf + zv + ob * 68 + ob;
#pragma unroll
        for (int t = 0; t < 32; ++t) {
            float a0 = (t == j) ? 1.f : 0.f, a1 = 0.f;
#pragma unroll
            for (int s4 = 0; s4 < (t + 3) / 4; ++s4) {
                const f32x4 l = *(const LAS f32x4*)(Lfz + t * 68 + s4 * 4);
#pragma unroll
                for (int e2 = 0; e2 < 4; ++e2) { const int s_ = s4 * 4 + e2; if (s_ < t) { if (e2 & 1) a1 += l[e2] * T[s_]; else a0 += l[e2] * T[s_]; } }
            }
            T[t] = a0 + a1;
            if (lane < 32) {
                Tm[(ob + t) * RL + ob + j] = (bf16_t)f2bf(T[t]);
                if (w == 0) T11T[j * 40 + t] = (bf16_t)f2bf(T[t]);
            }
        }
    } else if (w == 2) {
        for (int i = lane; i < 32 * 16; i += 64) { const int t = i >> 4, c2 = (i & 15) * 2; *(LAS unsigned*)(Tm + t * RL + 32 + c2) = 0u; }
    }
    lds_barrier();
    if (w < 4) {
        const int mi = w >> 1, ni = w & 1;
        const f32x4 x1 = mma_nt(Z4, L21b + mi * 16 * 40, 40, T11T + ni * 16 * 40, 40, 32, lane);
        u32x2 o; o.x = pk2(x1[0], x1[1]); o.y = pk2(x1[2], x1[3]);
        *(LAS u32x2*)(X1T + (ni * 16 + r) * 40 + mi * 16 + q * 4) = o;
    }
    lds_barrier();
    if (w < 4) {
        const int mi = w >> 1, ni = w & 1;
        const f32x4 t21 = mma_tn_x(Z4, Tm + (32 + mi * 16) * RL + 32, RL, X1T + ni * 16 * 40, 40, 32, lane, 0, 0);
        u32x2 o; o.x = pk2(t21[0], t21[1]); o.y = pk2(t21[2], t21[3]);
        *(LAS u32x2*)(Tm + (32 + mi * 16 + r) * RL + ni * 16 + q * 4) = o;
    }
    lds_barrier();
    f32x4 uu[2], ww[2];
#pragma unroll
    for (int tt = 0; tt < 2; ++tt) {
        const int tn = tn0 + tt;
        uu[tt] = mma_nt(Z4, Tm + tm * 16 * RL, RL, XT + tn * 16 * RL, RL, 64, lane);
        ww[tt] = mma_nt(Z4, Tm + tm * 16 * RL, RL, AtT + tn * 16 * RL, RL, 64, lane);
    }
#pragma unroll
    for (int tt = 0; tt < 2; ++tt) {
        const int tn = tn0 + tt;
        u32x2 o; o.x = pk2(uu[tt][0], uu[tt][1]); o.y = pk2(uu[tt][2], uu[tt][3]);
        *(LAS u32x2*)(UT + (tn * 16 + r) * RL + tm * 16 + q * 4) = o;
        o.x = pk2(ww[tt][0], ww[tt][1]); o.y = pk2(ww[tt][2], ww[tt][3]);
        *(LAS u32x2*)(WT + (tn * 16 + r) * RL + tm * 16 + q * 4) = o;
    }
    lds_barrier();
    bf16_t* yout = B.rw_y + (size_t)d * TG * 256;
#pragma unroll
    for (int tt = 0; tt < 2; ++tt) {
        const int tn = tn0 + tt;
        const f32x4 qe = mma_tn_x(Z4, Mrb + tm * 16 * RL, RL, WT + tn * 16 * RL, RL, 64, lane, 0, 0);
        f32x4 yl = mma_tn_x(Z4, Mrb + tm * 16 * RL, RL, UT + tn * 16 * RL, RL, 64, lane, 0, 0);
        yl = mma_tn_x(yl, Mrk + tm * 16 * RL, RL, VT + tn * 16 * RL, RL, 64, lane, 0, 0);
        const f32x4 pe = mma_tn_x(Z4, BhT + tm * 16 * RL, RL, WT + tn * 16 * RL, RL, 64, lane, 0, 0);
        f32x4 hl = mma_nt(Z4, BhT + tm * 16 * RL, RL, UT + tn * 16 * RL, RL, 64, lane);
        hl = mma_nt(hl, KhT + tm * 16 * RL, RL, VT + tn * 16 * RL, RL, 64, lane);
        const int i = tm * 16 + r, n0c = tn * 16 + q * 4;
        const f32x4 um = *(const LAS f32x4*)(gC + 64 + n0c);
        const u32x2 rtp = *(const LAS u32x2*)(Rt + i * RL + n0c);
        const float rt4[4] = {__uint_as_float(rtp.x << 16), __uint_as_float(rtp.x & 0xffff0000u), __uint_as_float(rtp.y << 16), __uint_as_float(rtp.y & 0xffff0000u)};
        const float gci = gC[i];
        float qv[4], pv[4];
#pragma unroll
        for (int jj = 0; jj < 4; ++jj) { qv[jj] = (qe[jj] + rt4[jj]) * um[jj]; pv[jj] = pe[jj] * um[jj] + ((n0c + jj) == i ? gci : 0.f); }
        u32x2 o; o.x = pk2(qv[0], qv[1]); o.y = pk2(qv[2], qv[3]); *(u32x2*)(gq + i * 64 + n0c) = o;
        o.x = pk2(pv[0], pv[1]); o.y = pk2(pv[2], pv[3]); *(u32x2*)(gq + 4096 + i * 64 + n0c) = o;
        const int tl = d == 0 ? base + n0 + i : base + L - 1 - (n0 + i);
        o.x = pk2(yl[0], yl[1]); o.y = pk2(yl[2], yl[3]); *(u32x2*)(yout + (size_t)tl * 256 + h * 64 + n0c) = o;
        o.x = pk2(hl[0], hl[1]); o.y = pk2(hl[2], hl[3]);
        *(u32x2*)(gq + 8192 + (tn * 16 + r) * 64 + tm * 16 + q * 4) = o;
    }
}

__device__ __forceinline__ void rwkv_seq(LAS unsigned char* lds, const MixBufs& B, const bf16_t* rq, int L, int seq, int h, int d) {
    const int tid = otid(), w = tid >> 6, lane = tid & 63, r = lane & 15, q = lane >> 4;
    const int tm = w >> 1, tn0 = (w & 1) * 2;
    const int base = seq * L, nch = L / 64;
    __syncthreads();
    for (int i = tid; i < 64 * RL / 2; i += 512) ((LAS unsigned*)lds)[i] = 0u;
    bf16_t* yout = B.rw_y + (size_t)d * TG * 256;
    const size_t custride = (size_t)8 * 3 * 4096;
    const bf16_t* g = rq + (size_t)(((seq * nch) * 4 + h) * 2 + d) * 3 * 4096;
    const int aoff = (tm * 16 + r) * 64 + q * 8;
    bf16x8 qa0 = *(const bf16x8*)(g + aoff), qa1 = *(const bf16x8*)(g + aoff + 32);
    bf16x8 pa0 = *(const bf16x8*)(g + 4096 + aoff), pa1 = *(const bf16x8*)(g + 4096 + aoff + 32);
    u32x2 hl0 = *(const u32x2*)(g + 8192 + (tn0 * 16 + r) * 64 + tm * 16 + q * 4), hl1 = *(const u32x2*)(g + 8192 + ((tn0 + 1) * 16 + r) * 64 + tm * 16 + q * 4);
    for (int c = 0; c < nch; ++c) {
        const bf16_t* gn = g + (c + 1 < nch ? custride : 0);
        const bf16x8 nqa0 = *(const bf16x8*)(gn + aoff), nqa1 = *(const bf16x8*)(gn + aoff + 32);
        const bf16x8 npa0 = *(const bf16x8*)(gn + 4096 + aoff), npa1 = *(const bf16x8*)(gn + 4096 + aoff + 32);
        const u32x2 nhl0 = *(const u32x2*)(gn + 8192 + (tn0 * 16 + r) * 64 + tm * 16 + q * 4), nhl1 = *(const u32x2*)(gn + 8192 + ((tn0 + 1) * 16 + r) * 64 + tm * 16 + q * 4);
        u32x2 yl[2];
        const int ti_ = tm * 16 + r;
        bf16_t* yrow = yout + (size_t)(d == 0 ? base + c * 64 + ti_ : base + L - 1 - (c * 64 + ti_)) * 256 + h * 64 + q * 4;
#pragma unroll
        for (int tt = 0; tt < 2; ++tt) yl[tt] = *(const u32x2*)(yrow + (tn0 + tt) * 16);
        lds_barrier();
        const LAS bf16_t* cur = (const LAS bf16_t*)(lds + (c & 1) * 9216);
        LAS bf16_t* nxt = (LAS bf16_t*)(lds + ((c + 1) & 1) * 9216);
#pragma unroll
        for (int tt = 0; tt < 2; ++tt) {
            const int tn = tn0 + tt;
            const bf16x8 b0 = *(const LAS bf16x8*)(cur + (tn * 16 + r) * RL + q * 8), b1 = *(const LAS bf16x8*)(cur + (tn * 16 + r) * RL + 32 + q * 8);
            f32x4 y = (f32x4){0.f, 0.f, 0.f, 0.f}, hn = (f32x4){0.f, 0.f, 0.f, 0.f};
            y = __builtin_amdgcn_mfma_f32_16x16x32_bf16(b0, qa0, y, 0, 0, 0); y = __builtin_amdgcn_mfma_f32_16x16x32_bf16(b1, qa1, y, 0, 0, 0);
            hn = __builtin_amdgcn_mfma_f32_16x16x32_bf16(pa0, b0, hn, 0, 0, 0); hn = __builtin_amdgcn_mfma_f32_16x16x32_bf16(pa1, b1, hn, 0, 0, 0);
            const u32x2 hl = tt == 0 ? hl0 : hl1;
            hn[0] += __uint_as_float(hl.x << 16); hn[1] += __uint_as_float(hl.x & 0xffff0000u); hn[2] += __uint_as_float(hl.y << 16); hn[3] += __uint_as_float(hl.y & 0xffff0000u);
            u32x2 o; o.x = pk2(hn[0], hn[1]); o.y = pk2(hn[2], hn[3]);
            *(LAS u32x2*)(nxt + (tn * 16 + r) * RL + tm * 16 + q * 4) = o;
            { const u32x2 yo = yl[tt];
              y[0] += __uint_as_float(yo.x << 16); y[1] += __uint_as_float(yo.x & 0xffff0000u); y[2] += __uint_as_float(yo.y << 16); y[3] += __uint_as_float(yo.y & 0xffff0000u);
              u32x2 o2; o2.x = pk2(y[0], y[1]); o2.y = pk2(y[2], y[3]); *(u32x2*)(yrow + tn * 16) = o2; }
        }
        g = gn; qa0 = nqa0; qa1 = nqa1; pa0 = npa0; pa1 = npa1; hl0 = nhl0; hl1 = nhl1;
    }
}

__device__ __forceinline__ void phase_post(const Params& P, const MixBufs& B, int layer) {
    const int tid_ = otid(); const int lane = tid_ & 63, gw = blockIdx.x * 8 + (tid_ >> 6), nw = gridDim.x * 8;
    const float gng = P.in[7][layer * 64 + lane];
    const float* ssdn = P.in[24] + layer * 512;
    float lng[4], lnb[4];
#pragma unroll
    for (int h = 0; h < 4; ++h) { lng[h] = P.in[17][layer * 256 + h * 64 + lane]; lnb[h] = P.in[18][layer * 256 + h * 64 + lane]; }
    const int c0 = lane * 8;
    const f32x4 sg0 = *(const f32x4*)(ssdn + c0), sg1 = *(const f32x4*)(ssdn + c0 + 4);
    const float Dh = P.in[23][layer * 8 + (lane >> 3)];
    for (int tl = gw; tl < TG; tl += nw) {
        const bf16_t* pr = B.p + (size_t)tl * DINP;
        bf16_t* mr = B.mix + (size_t)tl * DM;
        bf16_t go0[4], go1[4], ry0[4], ry1[4]; bf16_t ggt[4], rvv[4], rgg[4];
#pragma unroll
        for (int h = 0; h < 4; ++h) {
            const size_t o = (size_t)tl * 256 + h * 64 + lane;
            go0[h] = B.gla_o[o]; go1[h] = B.gla_o[(size_t)TG * 256 + o]; ggt[h] = pr[PC_GG + h * 64 + lane];
            ry0[h] = B.rw_y[o]; ry1[h] = B.rw_y[(size_t)TG * 256 + o]; rvv[h] = B.rw[1 * RWA + o]; rgg[h] = B.rw[3 * RWA + o];
        }
        const f32x4 srk = *(const f32x4*)(B.rw_s + (size_t)tl * 4), skr = *(const f32x4*)(B.rw_s + (size_t)TG * 4 + (size_t)tl * 4);
        const u32x4 ya = *(const u32x4*)(B.ssd_y + (size_t)tl * 512 + c0), yb = *(const u32x4*)(B.ssd_y + (size_t)TG * 512 + (size_t)tl * 512 + c0);
        const u32x4 xsr = *(const u32x4*)(B.ssd_x + (size_t)tl * 1024 + c0), zr = *(const u32x4*)(pr + PC_Z + c0);
#pragma unroll
        for (int h = 0; h < 4; ++h) {
            const float o = bf2f(go0[h]) + bf2f(go1[h]);
            const float ms = wave_sum(o * o) * (1.0f / 64.0f);
            mr[h * 64 + lane] = (bf16_t)f2bf(o * rsqrtf(ms + EPS) * gng * silu(bf2f(ggt[h])));
        }
#pragma unroll
        for (int h = 0; h < 4; ++h) {
            const float v = bf2f(rvv[h]);
            const float y = bf2f(ry0[h]) + bf2f(ry1[h]) - v * skr[h];
            const float mean = wave_sum(y) * (1.0f / 64.0f);
            const float dv = y - mean; const float var = wave_sum(dv * dv) * (1.0f / 64.0f);
            float oo = dv * rsqrtf(var + 64e-5f) * lng[h] + lnb[h];
            oo += srk[h] * v;
            mr[256 + h * 64 + lane] = (bf16_t)f2bf(oo * bf2f(rgg[h]));
        }
        {
            float xs[8], z[8], yfa[8], yfb[8]; unpack8(xsr, xs); unpack8(zr, z); unpack8(ya, yfa); unpack8(yb, yfb);
            float yv[8]; float ss = 0.f;
#pragma unroll
            for (int j = 0; j < 8; ++j) { const float yy = (yfa[j] + yfb[j]) + Dh * xs[j]; yv[j] = yy * silu(z[j]); ss += yv[j] * yv[j]; }
            ss = wave_sum(ss);
            const float rs = rsqrtf(ss * (1.0f / 512.0f) + EPS);
            u32x4 o; o.x = pk2(yv[0] * rs * sg0[0], yv[1] * rs * sg0[1]); o.y = pk2(yv[2] * rs * sg0[2], yv[3] * rs * sg0[3]);
            o.z = pk2(yv[4] * rs * sg1[0], yv[5] * rs * sg1[1]); o.w = pk2(yv[6] * rs * sg1[2], yv[7] * rs * sg1[3]);
            *(u32x4*)(mr + 512 + c0) = o;
        }
    }
}

#define RWKV_PRE_QUEUE(pool_base) do { \
        unsigned* qctr_ = (unsigned*)(ws + WS_CTL) + 4096 + 16 * (g * 2 + layer); \
        volatile LAS unsigned* qs_ = (volatile LAS unsigned*)(lds + 131072 + 1024 + 64); \
        unsigned tick_ = 0u; \
        if (threadIdx.x == 0) tick_ = __hip_atomic_fetch_add(qctr_, 1u, __ATOMIC_RELAXED, __HIP_MEMORY_SCOPE_AGENT); \
        for (;;) { \
            if (threadIdx.x == 0) qs_[0] = tick_; \
            __syncthreads(); \
            const int uq_ = (pool_base) + (int)qs_[0]; \
            __syncthreads(); \
            if (uq_ >= 4096) break; \
            if (threadIdx.x == 0) tick_ = __hip_atomic_fetch_add(qctr_, 1u, __ATOMIC_RELAXED, __HIP_MEMORY_SCOPE_AGENT); \
            RwRaw Rq_; rwkv_pre_load(Rq_, B, L, uq_, otid()); rwkv_pre(lds, B, rq, L, uq_, -1, Rq_); \
        } } while (0)

__global__ void __launch_bounds__(512, 2) fwd_megakernel(Params P) {
    extern __shared__ __attribute__((aligned(16))) unsigned char shm[];
    LAS unsigned char* lds = (LAS unsigned char*)shm;
    unsigned char* ws = P.ws;
    volatile LAS unsigned* bst = (volatile LAS unsigned*)(lds + 131072 + 1024);
    if (threadIdx.x == 0) { bst[0] = 0u; bst[1] = 0u; }
    __syncthreads();
    const XcdBarrier xbar = xcd_barrier_post((unsigned*)(ws + WS_CTL), bst);
    bf16_t* xb = (bf16_t*)(ws + WS_XB); float* ssp = (float*)(ws + WS_SSP); bf16_t* pbuf = (bf16_t*)(ws + WS_P);

    phase_weights(lds, P);
    for (int g = 0; g < NGROUP; ++g) {
        const int L = g < 2 ? 2048 : 16384, nseq = TG / L;
        phase_xprep(P, g);
        if (g == 0) cg::this_grid().sync(); else xcd_barrier(xbar);
        for (int layer = 0; layer < 2; ++layer) {
            pg8::StaticOrder S;
            {
                pg8::Gemm gm; gm.A = xb; gm.Bt = (const bf16_t*)(ws + WS_WIN) + (size_t)layer * DINP * DM; gm.M = TG; gm.N = DINP; gm.K = DM;
                S.init(TG, DINP, gridDim.x, blockIdx.x);
                EpiInproj E; E.O = pbuf; E.ssp = ssp;
                pg8::gemm_phase(lds, gm, S, E);
            }
            xcd_barrier(xbar);
            { const MixBufs B = mixbufs(P); const bf16_t* sw = (const bf16_t*)(ws + WS_SW) + (size_t)layer * SW_L;
              for (int t = blockIdx.x; t < TG / 64; t += gridDim.x) prep_tile64(lds, P, B, sw, layer, L, t); }
            xcd_barrier(xbar);
            {
                const MixBufs B = mixbufs(P);
                bf16_t* rq = (bf16_t*)(ws + WS_RWQ); float* segst = P.out + (size_t)g * TG * DM;
                const int nseg = L / 2048, nch = L / 64;
                const int nchain = nseg == 1 ? nseq * 24 : nseq * (nseg - 1) * 24;
                if (nseg == 1 && gridDim.x == 256) {
                    const int b = blockIdx.x;
                    ssd_unit(lds, P, B, segst, layer, L, b / 24 * 0 + (b >> 4), (b >> 1) & 7, b & 1, 0, false);
                    const int p0 = b * 10, pn = 10;
                    __syncthreads();
                    { RwRaw R; rwkv_pre_load(R, B, L, p0, otid());
                      for (int u = p0; u < p0 + pn; ++u) rwkv_pre(lds, B, rq, L, u, u + 1 < p0 + pn ? u + 1 : -1, R); }
                    RWKV_PRE_QUEUE(256 * 10);
                } else if (nseg == 8 && nseq == 2 && gridDim.x == 256) {
                    const int b = blockIdx.x;
                    for (int rep = 0; rep < 2; ++rep) {
                        const int it = b + rep * 256;
                        if (it < nchain) {
                            const int k = it % 24, sg = it / 24, seq = sg / (nseg - 1), seg = sg % (nseg - 1);
                            if (k < 16) ssd_unit(lds, P, B, segst, layer, L, seq, k >> 1, k & 1, seg, true);
                            else gla_unit(lds, P, B, segst, layer, L, seq, (k - 16) >> 1, k & 1, seg, true);
                        }
                    }
                    const int kx = b - 80;
                    const int p0 = b < 80 ? b * 5 : 400 + kx * 13, pn = b < 80 ? 5 : 13;
                    __syncthreads();
                    { RwRaw R; rwkv_pre_load(R, B, L, p0, otid());
                      for (int u = p0; u < p0 + pn; ++u) rwkv_pre(lds, B, rq, L, u, u + 1 < p0 + pn ? u + 1 : -1, R); }
                    RWKV_PRE_QUEUE(400 + 176 * 13);
                } else
                for (int it = blockIdx.x; it < nchain + 4096; it += gridDim.x) {
                    if (it < nchain) {
                        const int k = it % 24, sg = it / 24, seq = nseg == 1 ? sg : sg / (nseg - 1), seg = nseg == 1 ? 0 : sg % (nseg - 1);
                        if (k < 16) ssd_unit(lds, P, B, segst, layer, L, seq, k >> 1, k & 1, seg, nseg > 1);
                        else gla_unit(lds, P, B, segst, layer, L, seq, (k - 16) >> 1, k & 1, seg, nseg > 1);
                    } else { const int u = it - nchain; __syncthreads(); RwRaw R; rwkv_pre_load(R, B, L, u, otid()); rwkv_pre(lds, B, rq, L, u, -1, R); }
                }
            }
            xcd_barrier(xbar);
            {
                const MixBufs B = mixbufs(P);
                const bf16_t* rq = (const bf16_t*)(ws + WS_RWQ); float* segst = P.out + (size_t)g * TG * DM;
                const int nseg = L / 2048;
                const int nchain = nseg == 1 ? 0 : nseq * nseg * 24;
                const int nrs = nseq * 8, G = gridDim.x;
                if (nseg == 1 && G == 256) {
                    const int b = blockIdx.x;
                    if (b < 128) rwkv_seq(lds, B, rq, L, b >> 3, (b >> 1) & 3, b & 1);
                    else { const int u = b - 128; gla_unit(lds, P, B, segst, layer, L, u >> 3, (u >> 1) & 3, u & 1, 0, false); }
                } else
                for (int rnd = 0; rnd * G < nchain + nrs; ++rnd) {
                    const int it = rnd * G + ((rnd & 1) ? (G - 1 - (int)blockIdx.x) : (int)blockIdx.x);
                    if (it >= nchain + nrs) continue;
                    if (it >= nrs) {
                        const int ci = it - nrs, k = ci % 24, sg = ci / 24, seq = sg / nseg, seg = sg % nseg;
                        if (k < 16) ssd_unit(lds, P, B, segst, layer, L, seq, k >> 1, k & 1, seg, false);
                        else gla_unit(lds, P, B, segst, layer, L, seq, (k - 16) >> 1, k & 1, seg, false);
                    } else { rwkv_seq(lds, B, rq, L, it >> 3, (it >> 1) & 3, it & 1); }
                }
            }
            xcd_barrier(xbar);
            { const MixBufs B = mixbufs(P); phase_post(P, B, layer); }
            xcd_barrier(xbar);
            {
                pg8::Gemm gm; gm.A = (const bf16_t*)(ws + WS_MIX); gm.Bt = (const bf16_t*)(ws + WS_WOUT) + (size_t)layer * DM * DM; gm.M = TG; gm.N = DM; gm.K = DM;
                S.init(TG, DM, gridDim.x, blockIdx.x);
                EpiResid E; E.XB = xb; E.ssp = ssp;
                pg8::gemm_phase(lds, gm, S, E);
            }
            xcd_barrier(xbar);
            {
                pg8::Gemm gm; gm.A = xb; gm.Bt = (const bf16_t*)(ws + WS_WGU) + (size_t)layer * 2 * DFF * DM; gm.M = TG; gm.N = 2 * DFF; gm.K = DM;
                S.init(TG, 2 * DFF, gridDim.x, blockIdx.x);
                EpiGateUp E; E.O = pbuf; E.ssp = ssp;
                pg8::gemm_phase(lds, gm, S, E);
            }
            xcd_barrier(xbar);
            {
                pg8::Gemm gm; gm.A = pbuf; gm.Bt = (const bf16_t*)(ws + WS_WDN) + (size_t)layer * DM * DFF; gm.M = TG; gm.N = DM; gm.K = DFF;
                S.init(TG, DM, gridDim.x, blockIdx.x);
                EpiResid E; E.XB = xb; E.ssp = ssp;
                pg8::gemm_phase(lds, gm, S, E);
            }
            xcd_barrier(xbar);
        }
        phase_final(P, g);
        xcd_barrier(xbar);
    }
}

extern "C" void kernel_launch(void* const* d_in, const int* in_sizes, int n_in, void* d_out, int out_size, void* d_ws, size_t ws_size, hipStream_t stream) {
    static int grid = 0;
    if (grid == 0) {
        if (n_in != 30 || ws_size < WS_END) { fprintf(stderr, "kernel_launch: need 30 inputs and %zu ws bytes; got %d, %zu\n", (size_t)WS_END, n_in, ws_size); grid = -1; return; }
        int dev = 0, cus = 0, per_cu = 0;
        hipGetDevice(&dev);
        hipDeviceGetAttribute(&cus, hipDeviceAttributeMultiprocessorCount, dev);
        hipFuncSetAttribute((const void*)fwd_megakernel, hipFuncAttributeMaxDynamicSharedMemorySize, LDS_BYTES);
        hipOccupancyMaxActiveBlocksPerMultiprocessor(&per_cu, (const void*)fwd_megakernel, 512, LDS_BYTES);
        if (per_cu < 1) per_cu = 1;
        grid = cus * 1;
        if (grid > 256) grid = 256;
    }
    if (grid < 0) return;
    if (hipMemsetAsync((char*)d_ws + WS_CTL, 0, 65536, stream) != hipSuccess) { fprintf(stderr, "memset failed\n"); return; }
    Params p{};
    for (int i = 0; i < 30; ++i) p.in[i] = (const float*)d_in[i];
    p.out = (float*)d_out; p.ws = (unsigned char*)d_ws;
    void* args[] = {&p};
    hipError_t e = hipLaunchCooperativeKernel((const void*)fwd_megakernel, dim3(grid), dim3(512), args, LDS_BYTES, stream);
    if (e != hipSuccess) fprintf(stderr, "cooperative launch failed: %s (grid %d)\n", hipGetErrorString(e), grid);
}
```
